# Optimizing an MI355X kernel written in HIP

```python
import jax, jax.numpy as jnp
from jax import lax
import numpy as np

D_MODEL = 1024
BATCH = 2
SEQ = 8192
DEPTH = 1

N_HEADS = 8
HEAD_DK = 128
HEAD_DV = 128
KEY_DIM = N_HEADS * HEAD_DK
VAL_DIM = N_HEADS * HEAD_DV
QKV_CONV = 4
CHUNK = 64
SC_DIM = D_MODEL
SC_CONV = 3
N_GROUPS = 4
EXPERTS_PER_GROUP = 8
N_EXPERTS = N_GROUPS * EXPERTS_PER_GROUP
TOP_K = 2
D_EXPERT = 512
MOE_BLOCK = 128
N_MOD = 6
EPS = 1e-6
IN_WIDTHS = (2 * KEY_DIM + VAL_DIM, VAL_DIM, N_HEADS, N_HEADS, SC_DIM, SC_DIM, SC_DIM, D_MODEL, D_MODEL)
IN_TOTAL = 2 * KEY_DIM + 2 * VAL_DIM + 2 * N_HEADS + 3 * SC_DIM + 2 * D_MODEL

kernel_name = "hybrid_gdn_shortconv_hmoe_adaln"


def rmsnorm(x, g):
    xf = x.astype(jnp.float32)
    y = xf * lax.rsqrt(jnp.mean(xf * xf, axis=-1, keepdims=True) + EPS)
    return (y * g.astype(jnp.float32)).astype(x.dtype)


def l2norm(x):
    return x * lax.rsqrt(jnp.sum(x * x, axis=-1, keepdims=True) + EPS)


def causal_depthwise_conv(x, w):
    k_w, ch = w.shape
    return lax.conv_general_dilated(
        x, w[:, None, :].astype(x.dtype), window_strides=(1,), padding=((k_w - 1, 0),),
        dimension_numbers=("NWC", "WIO", "NWC"), feature_group_count=ch)


def split_cols(y):
    idx = np.cumsum(np.array(IN_WIDTHS))[:-1].tolist()
    return jnp.split(y, idx, axis=-1)


def gated_delta_rule_chunked(q, k, v, g, beta):
    bsz, t_len, h, dk = q.shape
    dv = v.shape[-1]
    n = t_len // CHUNK
    q = l2norm(q) * (dk ** -0.5)
    k = l2norm(k)

    def to_chunks(t):
        return t.reshape(bsz, n, CHUNK, h, -1).transpose(0, 3, 1, 2, 4)

    q, k, v = to_chunks(q), to_chunks(k), to_chunks(v)
    g = jnp.cumsum(g.reshape(bsz, n, CHUNK, h).transpose(0, 3, 1, 2), axis=-1)
    beta = beta.reshape(bsz, n, CHUNK, h).transpose(0, 3, 1, 2)[..., None]
    causal = jnp.tril(jnp.ones((CHUNK, CHUNK), bool))
    strict = jnp.tril(jnp.ones((CHUNK, CHUNK), bool), k=-1)
    diff = g[..., :, None] - g[..., None, :]
    decay = jnp.where(causal, jnp.exp(jnp.where(causal, diff, 0.0)), 0.0)
    k_beta = k * beta
    a = jnp.where(strict, jnp.einsum('bhnik,bhnjk->bhnij', k_beta, k) * decay, 0.0)
    eye = jnp.eye(CHUNK, dtype=a.dtype)
    t_inv = lax.linalg.triangular_solve(eye + a, jnp.broadcast_to(eye, a.shape),
                                        left_side=True, lower=True, unit_diagonal=True)
    u = jnp.einsum('bhnij,bhnjv->bhniv', t_inv, v * beta)
    w = jnp.einsum('bhnij,bhnjk->bhnik', t_inv, k_beta * jnp.exp(g)[..., None])
    intra = jnp.einsum('bhnik,bhnjk->bhnij', q, k) * decay
    q_dec = q * jnp.exp(g)[..., None]
    g_last = g[..., -1]
    k_dec = k * jnp.exp(g_last[..., None] - g)[..., None]

    def step(state, inp):
        u_n, w_n, q_n, intra_n, k_n, dec_n = inp
        v_new = u_n - jnp.einsum('bhck,bhkv->bhcv', w_n, state)
        o_n = jnp.einsum('bhck,bhkv->bhcv', q_n, state) + jnp.einsum('bhcs,bhsv->bhcv', intra_n, v_new)
        state = state * dec_n[..., None, None] + jnp.einsum('bhck,bhcv->bhkv', k_n, v_new)
        return state, o_n

    xs = tuple(jnp.moveaxis(t, 2, 0) for t in (u, w, q_dec, intra, k_dec, jnp.exp(g_last)))
    s0 = jnp.zeros((bsz, h, dk, dv), jnp.float32)
    _, o = lax.scan(step, s0, xs)
    return o.transpose(1, 0, 3, 2, 4).reshape(bsz, t_len, h, dv)


def hybrid_mixer(h, w_in, conv_qkv_w, a_log, dt_bias, onorm_g, w_proj_a, conv_sc_w, w_proj_b, w_out):
    bsz, t_len, _ = h.shape
    qkv, z, b_lg, a_lg, s_b, s_c, s_x, g_a, g_b = split_cols(h @ w_in)
    qkv = jax.nn.silu(causal_depthwise_conv(qkv, conv_qkv_w)).astype(jnp.float32)
    q, k, v = jnp.split(qkv, [KEY_DIM, 2 * KEY_DIM], axis=-1)
    q = q.reshape(bsz, t_len, N_HEADS, HEAD_DK)
    k = k.reshape(bsz, t_len, N_HEADS, HEAD_DK)
    v = v.reshape(bsz, t_len, N_HEADS, HEAD_DV)
    beta = jax.nn.sigmoid(b_lg.astype(jnp.float32))
    g = -jnp.exp(a_log.astype(jnp.float32)) * jax.nn.softplus(a_lg.astype(jnp.float32) + dt_bias.astype(jnp.float32))
    o = gated_delta_rule_chunked(q, k, v, g, beta)
    o = o * lax.rsqrt(jnp.mean(o * o, axis=-1, keepdims=True) + EPS) * onorm_g.astype(jnp.float32)
    o = o * jax.nn.silu(z.astype(jnp.float32).reshape(bsz, t_len, N_HEADS, HEAD_DV))
    y_a = o.reshape(bsz, t_len, VAL_DIM).astype(h.dtype) @ w_proj_a
    y_b = (s_b * causal_depthwise_conv(s_c * s_x, conv_sc_w)) @ w_proj_b
    merged = jax.nn.sigmoid(g_a) * y_a + jax.nn.sigmoid(g_b) * y_b
    return merged @ w_out


def hierarchical_moe(h, w_group, b_group, w_expert, b_expert, w1, w3, w2):
    bsz, t_len, d = h.shape
    tok = h.reshape(-1, d)
    m = tok.shape[0]
    g_logits = (tok @ w_group).astype(jnp.float32) + b_group.astype(jnp.float32)
    g_sel = jnp.argmax(g_logits, axis=-1)
    p_group = jnp.take_along_axis(jax.nn.softmax(g_logits, axis=-1), g_sel[:, None], axis=-1)
    e_logits = ((tok @ w_expert).astype(jnp.float32) + b_expert.astype(jnp.float32)).reshape(m, N_GROUPS, EXPERTS_PER_GROUP)
    e_logits = jnp.take_along_axis(e_logits, g_sel[:, None, None], axis=1)[:, 0]
    top_v, top_i = lax.top_k(e_logits, TOP_K)
    wts = p_group * jax.nn.softmax(top_v, axis=-1)
    flat_e = (g_sel[:, None] * EXPERTS_PER_GROUP + top_i).reshape(-1)
    n_rows = m * TOP_K
    order = jnp.argsort(flat_e)
    sorted_e = flat_e[order]
    tok_idx = order // TOP_K
    wts_sorted = wts.reshape(-1)[order]
    sizes = jnp.bincount(flat_e, length=N_EXPERTS)
    padded = ((sizes + MOE_BLOCK - 1) // MOE_BLOCK) * MOE_BLOCK
    pad_end = jnp.cumsum(padded)
    pad_start = pad_end - padded
    start = jnp.cumsum(sizes) - sizes
    dest = pad_start[sorted_e] + (jnp.arange(n_rows) - start[sorted_e])
    n_blocks = -(-n_rows // MOE_BLOCK) + N_EXPERTS
    cap = n_blocks * MOE_BLOCK
    buf_tok = jnp.full((cap,), m, jnp.int32).at[dest].set(tok_idx.astype(jnp.int32))
    buf_w = jnp.zeros((cap,), tok.dtype).at[dest].set(wts_sorted.astype(tok.dtype))
    block_expert = jnp.clip(jnp.searchsorted(pad_end, jnp.arange(n_blocks) * MOE_BLOCK, side='right'), 0, N_EXPERTS - 1)
    tok_pad = jnp.concatenate([tok, jnp.zeros((1, d), tok.dtype)], axis=0)
    xs = tok_pad[buf_tok].reshape(n_blocks, MOE_BLOCK, d)

    def expert_block(args):
        xb, e = args
        hid = jax.nn.silu(xb @ w1[e]) * (xb @ w3[e])
        return hid @ w2[e]

    ys = lax.map(expert_block, (xs, block_expert)).reshape(cap, d)
    out = jax.ops.segment_sum(ys * buf_w[:, None], buf_tok, num_segments=m + 1)[:m]
    return out.reshape(bsz, t_len, d)


def setup_inputs(seed: int = 0) -> dict:
    key = jax.random.key(seed)
    ks = jax.random.split(key, 32)
    f32 = jnp.float32
    L, D = DEPTH, D_MODEL

    def nrm(k, shape, fan_in, gain=1.0):
        return gain * (fan_in ** -0.5) * jax.random.normal(k, shape, f32)

    def gain_init(k, shape):
        return 1.0 + 0.02 * jax.random.normal(k, shape, f32)

    dt = jnp.exp(jax.random.uniform(ks[8], (L, N_HEADS), f32, float(np.log(1e-3)), float(np.log(1e-1))))
    return {
        "x": jax.random.normal(ks[0], (BATCH, SEQ, D), f32),
        "c": jax.random.normal(ks[1], (BATCH, D), f32),
        "w_ada": nrm(ks[2], (L, D, N_MOD * D), D, 0.5),
        "b_ada": 0.02 * jax.random.normal(ks[3], (L, N_MOD * D), f32),
        "norm1_g": gain_init(ks[4], (L, D)),
        "w_in": nrm(ks[5], (L, D, IN_TOTAL), D),
        "conv_qkv_w": nrm(ks[6], (L, QKV_CONV, 2 * KEY_DIM + VAL_DIM), QKV_CONV),
        "a_log": jnp.log(jax.random.uniform(ks[7], (L, N_HEADS), f32, 1.0, 16.0)),
        "dt_bias": dt + jnp.log(-jnp.expm1(-dt)),
        "onorm_g": gain_init(ks[9], (L, HEAD_DV)),
        "w_proj_a": nrm(ks[10], (L, VAL_DIM, D), VAL_DIM),
        "conv_sc_w": nrm(ks[11], (L, SC_CONV, SC_DIM), SC_CONV),
        "w_proj_b": nrm(ks[12], (L, SC_DIM, D), SC_DIM),
        "w_out": nrm(ks[13], (L, D, D), D),
        "norm2_g": gain_init(ks[14], (L, D)),
        "w_group": nrm(ks[15], (L, D, N_GROUPS), D),
        "b_group": 0.01 * jax.random.normal(ks[16], (L, N_GROUPS), f32),
        "w_expert": nrm(ks[17], (L, D, N_EXPERTS), D),
        "b_expert": 0.01 * jax.random.normal(ks[18], (L, N_EXPERTS), f32),
        "w1": nrm(ks[19], (L, N_EXPERTS, D, D_EXPERT), D),
        "w3": nrm(ks[20], (L, N_EXPERTS, D, D_EXPERT), D),
        "w2": nrm(ks[21], (L, N_EXPERTS, D_EXPERT, D), D_EXPERT),
        "normf_g": gain_init(ks[22], (D,)),
    }


def reference(x, c, w_ada, b_ada, norm1_g, w_in, conv_qkv_w, a_log, dt_bias, onorm_g, w_proj_a,
              conv_sc_w, w_proj_b, w_out, norm2_g, w_group, b_group, w_expert, b_expert, w1, w3, w2, normf_g):
    c_act = jax.nn.silu(c)
    for l in range(DEPTH):
        mod = (c_act @ w_ada[l] + b_ada[l])[:, None, :]
        sh1, sc1, gt1, sh2, sc2, gt2 = jnp.split(mod, N_MOD, axis=-1)
        h = rmsnorm(x, norm1_g[l]) * (1.0 + sc1) + sh1
        x = x + gt1 * hybrid_mixer(h, w_in[l], conv_qkv_w[l], a_log[l], dt_bias[l], onorm_g[l],
                                   w_proj_a[l], conv_sc_w[l], w_proj_b[l], w_out[l])
        h = rmsnorm(x, norm2_g[l]) * (1.0 + sc2) + sh2
        x = x + gt2 * hierarchical_moe(h, w_group[l], b_group[l], w_expert[l], b_expert[l], w1[l], w3[l], w2[l])
    return rmsnorm(x, normf_g)
```

```cpp
#include <hip/hip_runtime.h>
#include <cstdio>
#include <cstdint>
namespace pg8 {
#define PG8_LAS __attribute__((address_space(3)))
typedef unsigned short bf16_t;
typedef short bf16x8 __attribute__((ext_vector_type(8)));
typedef float f32x4 __attribute__((ext_vector_type(4)));
typedef unsigned u32x4 __attribute__((ext_vector_type(4)));
constexpr int BM = 256, BK = 64, HALF = 128, HTB = HALF * BK * 2  , STAGE_BYTES = 8 * HTB, NXCD = 8, WGM = 8;

__host__ __device__ __forceinline__ int lds_byte(int r, int c) { const int st = (r >> 4) * 2 + (c >> 5), rr = r & 15, cc = c & 31, ob = rr * 64 + cc * 2; return st * 1024 + (ob ^ (((ob >> 9) & 1) << 5)); }
__host__ __device__ __forceinline__ void stage_rc(int b, int& R, int& C) { const int st = b / 1024, sb = b % 1024, swz = sb ^ (((sb >> 9) & 1) << 5); R = (st >> 1) * 16 + swz / 64; C = (st & 1) * 32 + (swz % 64) / 2; }
__host__ __device__ __forceinline__ int perm32(int rho) { const int n = rho >> 4, i = rho & 15; return 8 * (i >> 2) + 4 * n + (i & 3); }

struct Unit { int pm, pn; };
struct Gemm { const bf16_t* A; const bf16_t* Bt; int M, N, K; };

struct StaticOrder {
    int nM, nN, nwg, G, c;
    __host__ __device__ void init(int M, int N, int G_, int c_) { nM = M / BM; nN = N / BM; nwg = nM * nN; G = G_; c = c_; }
    __host__ __device__ bool next(int i, Unit& u) const {
        const long L = (long)i * G + c; if (L >= nwg) return false;
        int wgid = (int)L; { const int q = nwg / NXCD, r = nwg % NXCD, xcd = wgid % NXCD, off = wgid / NXCD; wgid = (xcd < r ? xcd * (q + 1) : r * (q + 1) + (xcd - r) * q) + off; }
        const int nig = WGM * nN, gid = wgid / nig, fm = gid * WGM, gsz = (nM - fm) < WGM ? (nM - fm) : WGM;
        u.pm = fm + ((wgid % nig) % gsz); u.pn = (wgid % nig) / gsz; return true;
    }
    __device__ __forceinline__ void a_ready(const Unit&) const {}
    __device__ __forceinline__ void done(const Unit&) const {}
};

__device__ __forceinline__ unsigned cvt_pk_bf16(float lo, float hi) { unsigned r; asm volatile("v_cvt_pk_bf16_f32 %0, %1, %2" : "=v"(r) : "v"(lo), "v"(hi)); return r; }
template <class Epi, class Sched, bool ALIGN_EPI = false, bool SP2 = false>
__device__ __forceinline__ void gemm_phase(PG8_LAS unsigned char* lds, const Gemm g, const Sched& S, const Epi& E) {
    const int tid = threadIdx.x, wid = __builtin_amdgcn_readfirstlane(tid >> 6), lane = tid & 63, wr = wid >> 2, wc = wid & 3, fr = lane & 15, fq = lane >> 4;
    const int K = g.K, nt = K / BK;
    unsigned voffA[2], voffB[2];
#pragma unroll
    for (int i = 0; i < 2; ++i) { int R, C; stage_rc(tid * 16 + i * 8192, R, C); const int Rb = Epi::PERM ? ((R & ~31) + perm32(R & 31)) : R;
        voffA[i] = (unsigned)(R * K + C) * 2u; voffB[i] = (unsigned)(Rb * K + C) * 2u; }
    const size_t kstep = (size_t)(BK * 2);
    const size_t hstep = (size_t)HALF * K * 2;
    const size_t tstep = 2 * hstep;
    const unsigned ldsw = (unsigned)wid * 1024u;
    const int aoff = lds_byte(wr * 64 + fr, fq * 8), boff = lds_byte(wc * 32 + fr, fq * 8);
#define PG8_SA(b, h) (((b) * 2 + (h)) * HTB)
#define PG8_SB(b, h) ((4 + (b) * 2 + (h)) * HTB)
#define PG8_STAGE(bufoff, gbase, voff) do { _Pragma("unroll") for (int _i = 0; _i < 2; ++_i) \
        __builtin_amdgcn_global_load_lds((const unsigned*)((const char*)(gbase) + (voff)[_i]), (PG8_LAS unsigned*)(lds + (bufoff) + ldsw + _i * 8192), 16, 0, 0); } while (0)
#define PG8_LDA(dst, b, h) do { _Pragma("unroll") for (int m = 0; m < 4; ++m) _Pragma("unroll") for (int k = 0; k < 2; ++k) dst[m][k] = *(const PG8_LAS bf16x8*)(lds + PG8_SA(b, h) + aoff + m * 2048 + k * 1024); } while (0)
#define PG8_LDB(dst, b, h) do { _Pragma("unroll") for (int n = 0; n < 2; ++n) _Pragma("unroll") for (int k = 0; k < 2; ++k) dst[n][k] = *(const PG8_LAS bf16x8*)(lds + PG8_SB(b, h) + boff + n * 2048 + k * 1024); } while (0)
#define PG8_MMA(ai, bj, At, Bt) do { __builtin_amdgcn_s_setprio(1); _Pragma("unroll") for (int m = 0; m < 4; ++m) _Pragma("unroll") for (int n = 0; n < 2; ++n) _Pragma("unroll") for (int k = 0; k < 2; ++k) \
        acc[ai][bj][m][n] = __builtin_amdgcn_mfma_f32_16x16x32_bf16(Bt[n][k], At[m][k], acc[ai][bj][m][n], 0, 0, 0); __builtin_amdgcn_s_setprio(0); } while (0)
#define PG8_WAIT_V(n) asm volatile("s_waitcnt vmcnt(" #n ")" ::: "memory")
#define PG8_WAIT_L(n) asm volatile("s_waitcnt lgkmcnt(" #n ")" ::: "memory")
#define PG8_BAR __builtin_amdgcn_s_barrier()
#define PG8_SCHED __builtin_amdgcn_sched_barrier(0)
    Unit cur, nxt; int ui = 0;
    if (!S.next(0, cur)) return;
    f32x4 acc[2][2][4][2];
#pragma unroll
    for (int a = 0; a < 2; ++a)
#pragma unroll
        for (int b = 0; b < 2; ++b)
#pragma unroll
            for (int m = 0; m < 4; ++m)
#pragma unroll
                for (int n = 0; n < 2; ++n) acc[a][b][m][n] = (f32x4){0.f, 0.f, 0.f, 0.f};
    bf16x8 At[4][2], B0[2][2], B1[2][2];
    const char* cA = (const char*)g.A + (size_t)cur.pm * tstep; const char* cB = (const char*)g.Bt + (size_t)cur.pn * tstep;
    S.a_ready(cur);
    if constexpr (SP2) {
        PG8_STAGE(PG8_SB(0, 0), cB, voffB); PG8_STAGE(PG8_SB(0, 1), cB + hstep, voffB); PG8_STAGE(PG8_SA(0, 0), cA, voffA); PG8_STAGE(PG8_SA(0, 1), cA + hstep, voffA);
        if (wr == 1) PG8_BAR;
        PG8_WAIT_V(2); PG8_BAR;
        PG8_STAGE(PG8_SB(1, 0), cB + kstep, voffB); PG8_STAGE(PG8_SA(1, 0), cA + kstep, voffA); PG8_STAGE(PG8_SB(1, 1), cB + hstep + kstep, voffB);
        PG8_WAIT_V(6); PG8_BAR;
    } else {
        PG8_STAGE(PG8_SB(0, 0), cB, voffB); PG8_STAGE(PG8_SA(0, 0), cA, voffA); PG8_STAGE(PG8_SB(0, 1), cB + hstep, voffB); PG8_STAGE(PG8_SA(0, 1), cA + hstep, voffA);
        if (wr == 1) PG8_BAR;
        PG8_WAIT_V(4); PG8_BAR;
        PG8_STAGE(PG8_SB(1, 0), cB + kstep, voffB); PG8_STAGE(PG8_SA(1, 0), cA + kstep, voffA); PG8_STAGE(PG8_SB(1, 1), cB + hstep + kstep, voffB);
        PG8_WAIT_V(6); PG8_BAR;
    }
    for (;;) {
        const bool has_next = S.next(ui + 1, nxt);
        const char* nA = has_next ? (const char*)g.A + (size_t)nxt.pm * tstep : cA; const char* nB = has_next ? (const char*)g.Bt + (size_t)nxt.pn * tstep : cB;
        for (int t = 0; t < nt; t += 2) {
            const bool last = (t == nt - 2);
            const char* a1 = cA + (size_t)(t + 1) * kstep;
            const char* a2 = last ? nA : cA + (size_t)(t + 2) * kstep; const char* b2 = last ? nB : cB + (size_t)(t + 2) * kstep;
            const char* a3 = a2 + kstep; const char* b3 = b2 + kstep;
            if (last && has_next) S.a_ready(nxt);
            if constexpr (SP2) {
            PG8_LDB(B0, 0, 0); PG8_LDB(B1, 0, 1); PG8_SCHED; PG8_LDA(At, 0, 0); PG8_STAGE(PG8_SA(1, 1), a1 + hstep, voffA);
            PG8_WAIT_V(8); PG8_WAIT_L(0); PG8_BAR; PG8_MMA(0, 0, At, B0); PG8_MMA(0, 1, At, B1); PG8_BAR; PG8_SCHED;
            PG8_LDA(At, 0, 1); PG8_STAGE(PG8_SB(0, 0), b2, voffB); PG8_STAGE(PG8_SB(0, 1), b2 + hstep, voffB); PG8_STAGE(PG8_SA(0, 0), a2, voffA);
            PG8_WAIT_V(8); PG8_WAIT_L(0); PG8_BAR; PG8_MMA(1, 0, At, B0); PG8_MMA(1, 1, At, B1); PG8_BAR; PG8_SCHED;
            PG8_LDB(B0, 1, 0); PG8_LDB(B1, 1, 1); PG8_SCHED; PG8_LDA(At, 1, 0); PG8_STAGE(PG8_SA(0, 1), a2 + hstep, voffA);
            PG8_WAIT_V(8); PG8_WAIT_L(0); PG8_BAR; PG8_MMA(0, 0, At, B0); PG8_MMA(0, 1, At, B1); PG8_BAR; PG8_SCHED;
            PG8_LDA(At, 1, 1); PG8_STAGE(PG8_SB(1, 0), b3, voffB); PG8_STAGE(PG8_SB(1, 1), b3 + hstep, voffB); PG8_STAGE(PG8_SA(1, 0), a3, voffA);
            PG8_WAIT_V(8); PG8_WAIT_L(0); PG8_BAR; PG8_MMA(1, 0, At, B0); PG8_MMA(1, 1, At, B1); PG8_BAR; PG8_SCHED;
            } else {
            PG8_LDB(B0, 0, 0); PG8_SCHED; PG8_LDA(At, 0, 0); PG8_STAGE(PG8_SA(1, 1), a1 + hstep, voffA);
            PG8_WAIT_L(8); PG8_BAR; PG8_WAIT_L(0); PG8_MMA(0, 0, At, B0); PG8_BAR; PG8_SCHED;
            PG8_LDB(B1, 0, 1); PG8_STAGE(PG8_SB(0, 0), b2, voffB);
            PG8_BAR; PG8_WAIT_L(0); PG8_MMA(0, 1, At, B1); PG8_BAR;
            PG8_LDA(At, 0, 1); PG8_STAGE(PG8_SA(0, 0), a2, voffA);
            PG8_BAR; PG8_WAIT_L(0); PG8_MMA(1, 0, At, B0); PG8_BAR; PG8_SCHED;
            PG8_STAGE(PG8_SB(0, 1), b2 + hstep, voffB);
            PG8_WAIT_V(6); PG8_BAR; PG8_MMA(1, 1, At, B1); PG8_BAR;
            PG8_LDB(B0, 1, 0); PG8_SCHED; PG8_LDA(At, 1, 0); PG8_STAGE(PG8_SA(0, 1), a2 + hstep, voffA);
            PG8_WAIT_L(8); PG8_BAR; PG8_WAIT_L(0); PG8_MMA(0, 0, At, B0); PG8_BAR; PG8_SCHED;
            PG8_LDB(B1, 1, 1); PG8_STAGE(PG8_SB(1, 0), b3, voffB);
            PG8_BAR; PG8_WAIT_L(0); PG8_MMA(0, 1, At, B1); PG8_BAR;
            PG8_LDA(At, 1, 1); PG8_STAGE(PG8_SA(1, 0), a3, voffA);
            PG8_BAR; PG8_WAIT_L(0); PG8_MMA(1, 0, At, B0); PG8_BAR; PG8_SCHED;
            PG8_STAGE(PG8_SB(1, 1), b3 + hstep, voffB);
            PG8_WAIT_V(6); PG8_BAR; PG8_MMA(1, 1, At, B1); PG8_BAR;
            }
        }
        if constexpr (ALIGN_EPI) { if (wr == 0) PG8_BAR; }
        if constexpr (!Epi::AFTER_DRAIN) { E(acc, cur, wr, wc, fr, fq); S.done(cur); }
        if (!has_next) break;
#pragma unroll
        for (int a = 0; a < 2; ++a)
#pragma unroll
            for (int b = 0; b < 2; ++b)
#pragma unroll
                for (int m = 0; m < 4; ++m)
#pragma unroll
                    for (int n = 0; n < 2; ++n) acc[a][b][m][n] = (f32x4){0.f, 0.f, 0.f, 0.f};
        cur = nxt; cA = nA; cB = nB; ++ui;
        if constexpr (ALIGN_EPI) { if (wr == 1) PG8_BAR; }
    }
    PG8_WAIT_V(0);
    if constexpr (!ALIGN_EPI) { if (wr == 0) PG8_BAR; }
    PG8_BAR;
    if constexpr (Epi::AFTER_DRAIN) { E.fused(acc, cur, wr, wc, fr, fq, lds, wid, lane); S.done(cur); }
#undef PG8_SA
#undef PG8_SB
#undef PG8_STAGE
#undef PG8_LDA
#undef PG8_LDB
#undef PG8_MMA
#undef PG8_WAIT_V
#undef PG8_WAIT_L
#undef PG8_BAR
#undef PG8_SCHED
}
}

constexpr int NB = 2, T = 8192, D = 1024, M = NB * T;
constexpr int NH = 8, DK = 128, DV = 128, CH = 64, NCH = T / CH;
constexpr int NQKV = 3072, IN_TOTAL = 9232;
constexpr int NE = 32, EPG = 8, NGRP = 4, DE = 512;
constexpr int NUNIT = NB * NH * NCH;
constexpr float EPS = 1e-6f;
constexpr int MOE_CAP = 40960;
constexpr int NWAVES = 8;

constexpr size_t MiB = 1u << 20;
constexpr size_t WS_CTL = 0, CTL_ZERO_BYTES = 1 * MiB;
constexpr size_t WS_BG = 1 * MiB;
constexpr size_t WS_TOKE = 2 * MiB;
constexpr size_t WS_TOKW = WS_TOKE + 128 * 1024;
constexpr size_t WS_ROWTOK = WS_TOKE + 256 * 1024;
constexpr size_t WS_ROWW = WS_TOKE + 512 * 1024;
constexpr size_t WS_DEC = 3 * MiB;
constexpr size_t WS_WINA = 4 * MiB;
constexpr size_t WS_IN = 4 * MiB;
constexpr size_t WS_WINB = 20 * MiB;
constexpr size_t WS_WA = 27 * MiB, WS_WB = 29 * MiB, WS_WO = 31 * MiB;
constexpr size_t WS_QKV = 33 * MiB;
constexpr size_t WS_W13 = 33 * MiB;
constexpr size_t WS_W2 = 97 * MiB;
constexpr size_t WS_SB = 129 * MiB, WS_YB = 129 * MiB;
constexpr size_t WS_P = 161 * MiB, WS_OR = 161 * MiB;
constexpr size_t WS_UT = 193 * MiB, WS_W = 225 * MiB, WS_QD = 257 * MiB, WS_KDT = 289 * MiB;
constexpr size_t WS_GA = 193 * MiB, WS_GB = 225 * MiB;
constexpr size_t WS_H2 = 257 * MiB;
constexpr size_t WS_XS = 129 * MiB;
constexpr size_t WS_HID = 209 * MiB;
constexpr size_t WS_YBUF = 129 * MiB;
constexpr size_t WS_END = 321 * MiB;
constexpr int CW_TMO = 0, CW_BAR = 4096, CW_CNT = 8192, CW_CUR = 8192 + 64;
constexpr size_t CTL_MODACC = 64 * 1024;
constexpr size_t CTL_SSQ = 128 * 1024;
constexpr int LDS_BYTES = 163840, MISC_OFF = LDS_BYTES - 2048;

#define GAS __attribute__((address_space(1)))
#define LAS __attribute__((address_space(3)))
typedef unsigned short bf16;
typedef unsigned v4u __attribute__((ext_vector_type(4)));
typedef unsigned v2u __attribute__((ext_vector_type(2)));
typedef float f32x4 __attribute__((ext_vector_type(4)));
#define LDS_WAIT() asm volatile("s_waitcnt lgkmcnt(0)" ::: "memory")
__device__ __forceinline__ unsigned f2bf(float f) { unsigned u = __builtin_bit_cast(unsigned, f); return (u + 0x7fffu + ((u >> 16) & 1u)) >> 16; }
__device__ __forceinline__ unsigned pk2(float lo, float hi) { return f2bf(lo) | (f2bf(hi) << 16); }
__device__ __forceinline__ float bf2f(unsigned short b) { return __builtin_bit_cast(float, ((unsigned)b) << 16); }
__device__ __forceinline__ float bflo(unsigned w) { return __builtin_bit_cast(float, w << 16); }
__device__ __forceinline__ float bfhi(unsigned w) { return __builtin_bit_cast(float, w & 0xffff0000u); }
__device__ __forceinline__ float sigmoidf_(float x) { return 1.0f / (1.0f + __expf(-x)); }
__device__ __forceinline__ float siluf_(float x) { return x / (1.0f + __expf(-x)); }
__device__ __forceinline__ float wave_sum(float v) {
#pragma unroll
    for (int o = 1; o < 64; o <<= 1) v += __shfl_xor(v, o);
    return v;
}

#define XB_TMO      128
#define XB_XCNT(j)  (256  + 64 * (j))
#define XB_XSUB(j)  (1280 + 64 * (j))
#define XB_XGEN(j)  (2304 + 64 * (j))
#define XB_TOP      3328
#define XB_TOPGEN   3392
#define XCD_BAR_WORDS 3456
#define XB_SPIN_CAP (1u << 18)
__device__ __forceinline__ unsigned xb_ld(unsigned* p)              { return __hip_atomic_load(p, __ATOMIC_RELAXED, __HIP_MEMORY_SCOPE_AGENT); }
__device__ __forceinline__ unsigned xb_add(unsigned* p, unsigned v) { return __hip_atomic_fetch_add(p, v, __ATOMIC_RELAXED, __HIP_MEMORY_SCOPE_AGENT); }
__device__ __forceinline__ unsigned xb_xcc_id() { return (unsigned)__builtin_amdgcn_s_getreg((3 << 11) | 20) & 0xFu; }
#define XB_SPIN(cond, bar) do { unsigned _sp = 0; while (cond) { __builtin_amdgcn_s_sleep(1); \
    if ((++_sp & 255u) == 0u) { if (xb_ld(&(bar)[XB_TMO])) break; if (_sp > XB_SPIN_CAP) { atomicAdd(&(bar)[XB_TMO], 1u); break; } } } } while (0)
struct XcdBarrier { unsigned* bar; unsigned x; volatile LAS unsigned* st; };
__device__ __forceinline__ XcdBarrier xcd_barrier_post(unsigned* bar, volatile LAS unsigned* st) {
    XcdBarrier b; b.bar = bar; b.x = xb_xcc_id(); b.st = st;
    if (threadIdx.x == 0) (void)xb_add(&bar[XB_XCNT(b.x)], 1u);
    return b;
}
__device__ __forceinline__ void xcd_barrier_complete(unsigned* bar, unsigned x, unsigned& nloc, unsigned& nx) {
    const unsigned G = gridDim.x * gridDim.y * gridDim.z;
    unsigned sum, cnt, mine, sp = 0u;
    for (;;) {
        sum = 0u; cnt = 0u; mine = 0u;
#pragma unroll
        for (unsigned j = 0; j < 16; ++j) { const unsigned c = xb_ld(&bar[XB_XCNT(j)]); sum += c; cnt += (c > 0u) ? 1u : 0u; mine = (j == x) ? c : mine; }
        if (sum == G) break;
        __builtin_amdgcn_s_sleep(1);
        if ((++sp & 255u) == 0u) { if (xb_ld(&bar[XB_TMO])) break; if (sp > XB_SPIN_CAP) { atomicAdd(&bar[XB_TMO], 1u); break; } }
    }
    nloc = mine > 0u ? mine : 1u; nx = cnt > 0u ? cnt : 1u;
}
__device__ __forceinline__ void xcd_barrier(const XcdBarrier& b) {
    asm volatile("s_waitcnt vmcnt(0)" ::: "memory");
    __syncthreads();
    if (threadIdx.x == 0) {
        unsigned* bar = b.bar;
        __builtin_amdgcn_s_waitcnt(0);
        unsigned nloc = b.st[0], nx = b.st[1];
        if (nloc == 0u) { xcd_barrier_complete(bar, b.x, nloc, nx); b.st[0] = nloc; b.st[1] = nx; }
        const unsigned old = xb_add(&bar[XB_XSUB(b.x)], 1u);
        const unsigned gen = old / nloc;
        if (old + 1u == (gen + 1u) * nloc) {
            __builtin_amdgcn_fence(__ATOMIC_RELEASE, "agent");
            asm volatile("s_waitcnt vmcnt(0)" ::: "memory");
            const unsigned og = xb_add(&bar[XB_TOP], 1u);
            const unsigned tg = og / nx;
            if (og + 1u == (tg + 1u) * nx) xb_add(&bar[XB_TOPGEN], 1u);
            else XB_SPIN(xb_ld(&bar[XB_TOPGEN]) == tg, bar);
            __builtin_amdgcn_fence(__ATOMIC_ACQUIRE, "agent");
            xb_add(&bar[XB_XGEN(b.x)], 1u);
            asm volatile("s_waitcnt vmcnt(0)" ::: "memory");
        } else {
            XB_SPIN(xb_ld(&bar[XB_XGEN(b.x)]) == gen, bar);
            __builtin_amdgcn_fence(__ATOMIC_ACQUIRE, "agent");
            asm volatile("s_waitcnt vmcnt(0)" ::: "memory");
        }
    }
    __syncthreads();
}

struct Frame {
    LAS unsigned char* lds;
    volatile LAS unsigned* MISC;
    unsigned* ctl;
    int tid, lane, wave, vcu, G;
    const float *x, *c, *w_ada, *b_ada, *norm1_g, *w_in, *conv_qkv_w, *a_log, *dt_bias, *onorm_g, *w_proj_a, *conv_sc_w, *w_proj_b, *w_out,
                *norm2_g, *w_group, *b_group, *w_expert, *b_expert, *w1, *w3, *w2, *normf_g;
    float* out; unsigned char* ws;
};
__device__ __forceinline__ float mod_at(const Frame& F, int b, int idx) {
    return ((const float*)(F.ws + CTL_MODACC))[b * 6144 + idx] + F.b_ada[idx];
}

using pg8::Unit; using pg8::cvt_pk_bf16;
__device__ __forceinline__ v4u pack8(const f32x4 a, const f32x4 b) { v4u w; w.x = cvt_pk_bf16(a[0], a[1]); w.y = cvt_pk_bf16(a[2], a[3]); w.z = cvt_pk_bf16(b[0], b[1]); w.w = cvt_pk_bf16(b[2], b[3]); return w; }
__device__ __forceinline__ void unpack8(const v4u w, f32x4& a, f32x4& b) { a = (f32x4){bflo(w.x), bfhi(w.x), bflo(w.y), bfhi(w.y)}; b = (f32x4){bflo(w.z), bfhi(w.z), bflo(w.w), bfhi(w.w)}; }

struct EpiInA {
    static constexpr bool PERM = true, AFTER_DRAIN = false;
    bf16 *QKV, *SB, *P;
    __device__ __forceinline__ void operator()(const f32x4 (&acc)[2][2][4][2], const Unit& u, int wr, int wc, int fr, int fq) const {
        const int row0 = u.pm * 256 + wr * 64 + fr;
        if (u.pn < 16) {
            bf16* base; int ldc, colt;
            if (u.pn < 12) { base = QKV; ldc = NQKV; colt = u.pn * 256; } else { base = SB; ldc = D; colt = (u.pn - 12) * 256; }
            const int col0 = colt + wc * 32 + 8 * fq;
#pragma unroll
            for (int ai = 0; ai < 2; ++ai)
#pragma unroll
                for (int m = 0; m < 4; ++m) { bf16* rowp = base + (size_t)(row0 + ai * 128 + m * 16) * ldc + col0;
#pragma unroll
                    for (int bj = 0; bj < 2; ++bj) *(v4u*)(rowp + bj * 128) = pack8(acc[ai][bj][m][0], acc[ai][bj][m][1]); }
        } else {
            const int col0 = (u.pn - 16) * 128 + wc * 32 + 8 * fq;
#pragma unroll
            for (int ai = 0; ai < 2; ++ai)
#pragma unroll
                for (int m = 0; m < 4; ++m) { bf16* rowp = P + (size_t)(row0 + ai * 128 + m * 16) * D + col0;
                    *(v4u*)rowp = pack8(acc[ai][0][m][0] * acc[ai][1][m][0], acc[ai][0][m][1] * acc[ai][1][m][1]); }
        }
    }
};
struct EpiInB {
    static constexpr bool PERM = true, AFTER_DRAIN = false;
    bf16 *OG, *GA, *GB; const float* SSQ; const float* onorm_g;
    __device__ __forceinline__ void operator()(const f32x4 (&acc)[2][2][4][2], const Unit& u, int wr, int wc, int fr, int fq) const {
        const int row0 = u.pm * 256 + wr * 64 + fr;
        if (u.pn < 4) {
            const int col0 = u.pn * 256 + wc * 32 + 8 * fq;
            const f32x4 g0 = *(const f32x4*)(onorm_g + (col0 & 127)), g1 = *(const f32x4*)(onorm_g + (col0 & 127) + 4);
#pragma unroll
            for (int ai = 0; ai < 2; ++ai)
#pragma unroll
                for (int m = 0; m < 4; ++m) { const int row = row0 + ai * 128 + m * 16;
#pragma unroll
                    for (int bj = 0; bj < 2; ++bj) { const int col = col0 + bj * 128; bf16* p = OG + (size_t)row * D + col;
                        const float rstd = __frsqrt_rn(SSQ[row * 8 + (col >> 7)] * (1.0f / 128.0f) + EPS);
                        f32x4 o0, o1; unpack8(*(const v4u*)p, o0, o1);
                        f32x4 z0 = acc[ai][bj][m][0], z1 = acc[ai][bj][m][1];
#pragma unroll
                        for (int j = 0; j < 4; ++j) { z0[j] = siluf_(z0[j]) * o0[j] * rstd * g0[j]; z1[j] = siluf_(z1[j]) * o1[j] * rstd * g1[j]; }
                        *(v4u*)p = pack8(z0, z1); } }
        } else {
            bf16* base = (u.pn < 8) ? GA : GB; const int col0 = (u.pn & 3) * 256 + wc * 32 + 8 * fq;
#pragma unroll
            for (int ai = 0; ai < 2; ++ai)
#pragma unroll
                for (int m = 0; m < 4; ++m) { bf16* rowp = base + (size_t)(row0 + ai * 128 + m * 16) * D + col0;
#pragma unroll
                    for (int bj = 0; bj < 2; ++bj) { f32x4 a = acc[ai][bj][m][0], b = acc[ai][bj][m][1];
#pragma unroll
                        for (int j = 0; j < 4; ++j) { a[j] = sigmoidf_(a[j]); b[j] = sigmoidf_(b[j]); }
                        *(v4u*)(rowp + bj * 128) = pack8(a, b); } }
        }
    }
};
struct EpiPlain {
    static constexpr bool PERM = true, AFTER_DRAIN = false;
    bf16* O; int ldc;
    __device__ __forceinline__ void operator()(const f32x4 (&acc)[2][2][4][2], const Unit& u, int wr, int wc, int fr, int fq) const {
        const int row0 = u.pm * 256 + wr * 64 + fr, col0 = u.pn * 256 + wc * 32 + 8 * fq;
#pragma unroll
        for (int ai = 0; ai < 2; ++ai)
#pragma unroll
            for (int m = 0; m < 4; ++m) { bf16* rowp = O + (size_t)(row0 + ai * 128 + m * 16) * ldc + col0;
#pragma unroll
                for (int bj = 0; bj < 2; ++bj) *(v4u*)(rowp + bj * 128) = pack8(acc[ai][bj][m][0], acc[ai][bj][m][1]); }
    }
};
struct EpiMerge {
    static constexpr bool PERM = true, AFTER_DRAIN = false;
    const bf16 *GA, *GB, *YB; bf16* MG;
    __device__ __forceinline__ void operator()(const f32x4 (&acc)[2][2][4][2], const Unit& u, int wr, int wc, int fr, int fq) const {
        const int row0 = u.pm * 256 + wr * 64 + fr, col0 = u.pn * 256 + wc * 32 + 8 * fq;
#pragma unroll
        for (int ai = 0; ai < 2; ++ai)
#pragma unroll
            for (int m = 0; m < 4; ++m) { const size_t off = (size_t)(row0 + ai * 128 + m * 16) * D + col0;
#pragma unroll
                for (int bj = 0; bj < 2; ++bj) { f32x4 a0, a1, b0, b1, y0, y1;
                    unpack8(*(const v4u*)(GA + off + bj * 128), a0, a1); unpack8(*(const v4u*)(GB + off + bj * 128), b0, b1); unpack8(*(const v4u*)(YB + off + bj * 128), y0, y1);
                    *(v4u*)(MG + off + bj * 128) = pack8(a0 * acc[ai][bj][m][0] + b0 * y0, a1 * acc[ai][bj][m][1] + b1 * y1); } }
    }
};
struct EpiX1 {
    static constexpr bool PERM = true, AFTER_DRAIN = false;
    const float* X; float* X1; const float* modacc; const float* b_ada;
    __device__ __forceinline__ void operator()(const f32x4 (&acc)[2][2][4][2], const Unit& u, int wr, int wc, int fr, int fq) const {
        const int row0 = u.pm * 256 + wr * 64 + fr, col0 = u.pn * 256 + wc * 32 + 8 * fq, b = u.pm >> 5;
        f32x4 gt[2][2];
#pragma unroll
        for (int bj = 0; bj < 2; ++bj)
#pragma unroll
            for (int n = 0; n < 2; ++n) gt[bj][n] = *(const f32x4*)(modacc + b * 6144 + 2048 + col0 + bj * 128 + 4 * n) + *(const f32x4*)(b_ada + 2048 + col0 + bj * 128 + 4 * n);
#pragma unroll
        for (int ai = 0; ai < 2; ++ai)
#pragma unroll
            for (int m = 0; m < 4; ++m) { const size_t off = (size_t)(row0 + ai * 128 + m * 16) * D + col0;
#pragma unroll
                for (int bj = 0; bj < 2; ++bj)
#pragma unroll
                    for (int n = 0; n < 2; ++n) { const f32x4 xv = *(const f32x4*)(X + off + bj * 128 + 4 * n);
                        *(f32x4*)(X1 + off + bj * 128 + 4 * n) = xv + gt[bj][n] * acc[ai][bj][m][n]; } }
    }
};
struct EpiHid {
    static constexpr bool PERM = true, AFTER_DRAIN = false;
    bf16* HID;
    __device__ __forceinline__ void operator()(const f32x4 (&acc)[2][2][4][2], const Unit& u, int wr, int wc, int fr, int fq) const {
        const int row0 = u.pm * 256 + wr * 64 + fr, col0 = (u.pn & 3) * 128 + wc * 32 + 8 * fq;
#pragma unroll
        for (int ai = 0; ai < 2; ++ai)
#pragma unroll
            for (int m = 0; m < 4; ++m) { f32x4 a = acc[ai][0][m][0], b = acc[ai][0][m][1];
#pragma unroll
                for (int j = 0; j < 4; ++j) { a[j] = siluf_(a[j]) * acc[ai][1][m][0][j]; b[j] = siluf_(b[j]) * acc[ai][1][m][1][j]; }
                *(v4u*)(HID + (size_t)(row0 + ai * 128 + m * 16) * DE + col0) = pack8(a, b); }
    }
};
struct EpiMoeOut {
    static constexpr bool PERM = true, AFTER_DRAIN = false;
    bf16* YBUF; const int* ROWTOK; const float* ROWW;
    __device__ __forceinline__ void operator()(const f32x4 (&acc)[2][2][4][2], const Unit& u, int wr, int wc, int fr, int fq) const {
        const int row0 = u.pm * 256 + wr * 64 + fr, col0 = (u.pn & 3) * 256 + wc * 32 + 8 * fq;
#pragma unroll
        for (int ai = 0; ai < 2; ++ai)
#pragma unroll
            for (int m = 0; m < 4; ++m) { const int r = row0 + ai * 128 + m * 16; const int tk = ROWTOK[r];
                if (tk >= 0) { const float w = ROWW[r]; bf16* rowp = YBUF + (size_t)tk * D + col0;
#pragma unroll
                    for (int bj = 0; bj < 2; ++bj) *(v4u*)(rowp + bj * 128) = pack8(acc[ai][bj][m][0] * w, acc[ai][bj][m][1] * w); } }
    }
};
struct MoeOrder {
    int n4, G, c; const volatile LAS int* tile_e;
    __device__ __forceinline__ bool next(int i, Unit& u) const { const int L = i * G + c; if (L >= n4) return false; const int rb = L >> 2; u.pm = rb; u.pn = tile_e[rb] * 4 + (L & 3); return true; }
    __device__ __forceinline__ void a_ready(const Unit&) const {}
    __device__ __forceinline__ void done(const Unit&) const {}
};

__device__ __forceinline__ void transpose_item(const float* W, int ldw, int src_col0, int k0, bf16* WT, int dst_row0, int K, LAS float* scr, int lane) {
#pragma unroll 8
    for (int i = 0; i < 32; ++i) { const int kk = 2 * i + (lane >> 5); scr[kk * 33 + (lane & 31)] = W[(size_t)(k0 + kk) * ldw + src_col0 + (lane & 31)]; }
    LDS_WAIT(); asm volatile("" ::: "memory");
    const int c = lane & 7;
#pragma unroll
    for (int j = 0; j < 4; ++j) { const int n = (lane >> 3) + 8 * j; const LAS float* s = scr + (8 * c) * 33 + n;
        v4u o; o.x = pk2(s[0 * 33], s[1 * 33]); o.y = pk2(s[2 * 33], s[3 * 33]); o.z = pk2(s[4 * 33], s[5 * 33]); o.w = pk2(s[6 * 33], s[7 * 33]);
        *(v4u*)(WT + (size_t)(dst_row0 + n) * K + k0 + 8 * c) = o; }
    LDS_WAIT(); asm volatile("" ::: "memory");
}
__device__ __forceinline__ int win_src_col(int d0) {
    if (d0 < 3072) return d0;
    if (d0 < 4096) return 4112 + (d0 - 3072);
    if (d0 < 6144) { const int j = (d0 - 4096) >> 8, r = (d0 - 4096) & 255; return (r < 128 ? 5136 + r : 6160 + (r - 128)) + 128 * j; }
    if (d0 < 7168) return 3072 + (d0 - 6144);
    if (d0 < 8192) return 7184 + (d0 - 7168);
    return 8208 + (d0 - 8192);
}

__device__ __forceinline__ void p0_prologue(Frame& F) {
    LAS float* sC = (LAS float*)(F.lds + 8 * 8448);
    for (int i = F.tid; i < 2 * D; i += 512) sC[i] = siluf_(F.c[i]);
    __syncthreads();
    const int gw = F.vcu * NWAVES + F.wave, NGW = F.G * NWAVES;
    float* modacc = (float*)(F.ws + CTL_MODACC);
    for (int it = gw; it < 96 * 8; it += NGW) {
        const int cg = it % 96, ks = it / 96, col = cg * 64 + F.lane, k0 = ks * 128;
        float a0 = 0.f, a1 = 0.f;
#pragma unroll 16
        for (int k = 0; k < 128; ++k) { const float wv = F.w_ada[(size_t)(k0 + k) * 6144 + col]; a0 += sC[k0 + k] * wv; a1 += sC[D + k0 + k] * wv; }
        atomicAdd(modacc + col, a0); atomicAdd(modacc + 6144 + col, a1);
    }
    LAS float* scr = (LAS float*)(F.lds + F.wave * 8448);
    constexpr int I_IN = 288 * 16, I_SQ = 32 * 16;
    for (int it = gw; it < I_IN + 3 * I_SQ; it += NGW) {
        int r = it;
        if (r < I_IN) { const int dg = r % 288, kb = r / 288, d0 = dg * 32; bf16* dst = (d0 < 6144) ? (bf16*)(F.ws + WS_WINA) : (bf16*)(F.ws + WS_WINB);
            transpose_item(F.w_in, IN_TOTAL, win_src_col(d0), kb * 64, dst, d0 < 6144 ? d0 : d0 - 6144, D, scr, F.lane); continue; }
        r -= I_IN;
        if (r < I_SQ) { transpose_item(F.w_proj_a, D, (r % 32) * 32, (r / 32) * 64, (bf16*)(F.ws + WS_WA), (r % 32) * 32, D, scr, F.lane); continue; } r -= I_SQ;
        if (r < I_SQ) { transpose_item(F.w_proj_b, D, (r % 32) * 32, (r / 32) * 64, (bf16*)(F.ws + WS_WB), (r % 32) * 32, D, scr, F.lane); continue; } r -= I_SQ;
        transpose_item(F.w_out, D, (r % 32) * 32, (r / 32) * 64, (bf16*)(F.ws + WS_WO), (r % 32) * 32, D, scr, F.lane);
    }
}
__device__ __forceinline__ void p_moe_weights(Frame& F) {
    LAS float* scr = (LAS float*)(F.lds + F.wave * 8448);
    const int gw = F.vcu * NWAVES + F.wave, NGW = F.G * NWAVES;
    constexpr int I13 = NE * 32 * 16, I2 = NE * 32 * 8;
    for (int it = gw; it < I13 + I2; it += NGW) {
        if (it < I13) { const int e = it / 512, r = it % 512, dg = r % 32, kb = r / 32, d0 = dg * 32, j = d0 >> 8, rr = d0 & 255;
            if (rr < 128) transpose_item(F.w1 + (size_t)e * D * DE, DE, 128 * j + (rr & 127), kb * 64, (bf16*)(F.ws + WS_W13) + (size_t)e * D * D, d0, D, scr, F.lane);
            else          transpose_item(F.w3 + (size_t)e * D * DE, DE, 128 * j + (rr & 127), kb * 64, (bf16*)(F.ws + WS_W13) + (size_t)e * D * D, d0, D, scr, F.lane);
        } else { const int r2 = it - I13, e = r2 / 256, r = r2 % 256, dg = r % 32, kb = r / 32;
            transpose_item(F.w2 + (size_t)e * DE * D, D, dg * 32, kb * 64, (bf16*)(F.ws + WS_W2) + (size_t)e * D * DE, dg * 32, DE, scr, F.lane); }
    }
}

__device__ __forceinline__ void p1_norm1(Frame& F) {
    LAS float* sBA = (LAS float*)F.lds;
    for (int i = F.tid; i < 16 * D; i += 512) { const int k = i >> 4, o = i & 15; sBA[o * D + k] = F.w_in[(size_t)k * IN_TOTAL + 4096 + o]; }
    __syncthreads();
    const int gw = F.vcu * NWAVES + F.wave, NGW = F.G * NWAVES;
    bf16* H = (bf16*)F.out; float* BG = (float*)(F.ws + WS_BG);
    for (int m = gw; m < M; m += NGW) {
        const int b = m / T;
        const f32x4* xr = (const f32x4*)(F.x + (size_t)m * D) + F.lane;
        f32x4 v[4]; float s = 0.f;
#pragma unroll
        for (int j = 0; j < 4; ++j) { v[j] = xr[64 * j]; s += (v[j].x * v[j].x + v[j].y * v[j].y) + (v[j].z * v[j].z + v[j].w * v[j].w); }
        const float rstd = __frsqrt_rn(wave_sum(s) * (1.f / D) + EPS);
        f32x4 hv[4];
#pragma unroll
        for (int j = 0; j < 4; ++j) { const int col = 256 * j + 4 * F.lane;
            const f32x4 g1 = *(const f32x4*)(F.norm1_g + col);
#pragma unroll
            for (int e = 0; e < 4; ++e) hv[j][e] = v[j][e] * rstd * g1[e] * (1.0f + mod_at(F, b, D + col + e)) + mod_at(F, b, col + e);
            *(v2u*)(H + (size_t)m * D + col) = (v2u){pk2(hv[j][0], hv[j][1]), pk2(hv[j][2], hv[j][3])};
        }
        float val = 0.f;
#pragma unroll 2
        for (int o = 0; o < 16; ++o) { float p = 0.f;
#pragma unroll
            for (int j = 0; j < 4; ++j) { const f32x4 w = *(const LAS f32x4*)(sBA + o * D + 256 * j + 4 * F.lane); p += (hv[j][0] * w[0] + hv[j][1] * w[1]) + (hv[j][2] * w[2] + hv[j][3] * w[3]); }
            p = wave_sum(p); val = (F.lane == o) ? p : val; }
        if (F.lane < 16) {
            float r;
            if (F.lane < 8) r = sigmoidf_(val);
            else { const int hh = F.lane - 8; const float xx = val + F.dt_bias[hh]; const float sp = xx > 20.f ? xx : log1pf(__expf(xx)); r = -__expf(F.a_log[hh]) * sp; }
            BG[(size_t)m * 16 + F.lane] = r;
        }
    }
}

__device__ __forceinline__ void p3a_ybp(Frame& F) {
    const bf16* SB = (const bf16*)(F.ws + WS_SB); const bf16* P = (const bf16*)(F.ws + WS_P); bf16* YBP = (bf16*)F.out + (size_t)M * D;
    const size_t total = (size_t)M * (D / 8);
    for (size_t i = (size_t)blockIdx.x * 512 + F.tid; i < total; i += (size_t)F.G * 512) {
        const int m = (int)(i >> 7), c8 = (int)(i & 127) * 8, t = m % T;
        f32x4 a0 = {0.f, 0.f, 0.f, 0.f}, a1 = a0;
#pragma unroll
        for (int j = 0; j < 3; ++j) { const int tt = t - 2 + j;
            if (tt >= 0) { f32x4 p0, p1; unpack8(*(const v4u*)(P + (size_t)(m - 2 + j) * D + c8), p0, p1);
                a0 += *(const f32x4*)(F.conv_sc_w + j * D + c8) * p0; a1 += *(const f32x4*)(F.conv_sc_w + j * D + c8 + 4) * p1; } }
        f32x4 s0, s1; unpack8(*(const v4u*)(SB + (size_t)m * D + c8), s0, s1);
        *(v4u*)(YBP + (size_t)m * D + c8) = pack8(s0 * a0, s1 * a1);
    }
}

__device__ __forceinline__ void p3b_chunk(Frame& F, int unit) {
    const int n = unit % NCH, bh = unit / NCH, h = bh % NH, b = bh / NH, t0 = n * CH, row0 = b * T + t0;
    LAS float* sq = (LAS float*)F.lds; LAS float* sk = sq + 64 * 129; LAS float* sv = sk + 64 * 129; LAS float* sA = sv + 64 * 129; LAS float* sT = sA + 64 * 65;
    LAS float* sgc = sT + 64 * 65; LAS float* sbeta = sgc + 64;
    const bf16* QKV = (const bf16*)(F.ws + WS_QKV); const float* BG = (const float*)(F.ws + WS_BG);
    for (int idx = F.tid; idx < 3 * 64 * 128; idx += 512) {
        const int sec = idx >> 13, r = (idx >> 7) & 63, c = idx & 127, gcol = sec * 1024 + h * 128 + c;
        float a = 0.f;
#pragma unroll
        for (int j = 0; j < 4; ++j) { const int tt = t0 + r - 3 + j; if (tt >= 0) a += F.conv_qkv_w[j * NQKV + gcol] * bf2f(QKV[(size_t)(b * T + tt) * NQKV + gcol]); }
        sq[sec * (64 * 129) + r * 129 + c] = siluf_(a);
    }
    if (F.tid < 64) { sgc[F.tid] = BG[(size_t)(row0 + F.tid) * 16 + 8 + h]; sbeta[F.tid] = BG[(size_t)(row0 + F.tid) * 16 + h]; }
    __syncthreads();
    for (int r = F.wave * 8; r < F.wave * 8 + 8; ++r) {
        const float q0 = sq[r * 129 + F.lane], q1 = sq[r * 129 + 64 + F.lane], k0 = sk[r * 129 + F.lane], k1 = sk[r * 129 + 64 + F.lane];
        const float qs = __frsqrt_rn(wave_sum(q0 * q0 + q1 * q1) + EPS) * 0.08838834764831845f, ks = __frsqrt_rn(wave_sum(k0 * k0 + k1 * k1) + EPS);
        sq[r * 129 + F.lane] = q0 * qs; sq[r * 129 + 64 + F.lane] = q1 * qs; sk[r * 129 + F.lane] = k0 * ks; sk[r * 129 + 64 + F.lane] = k1 * ks;
    }
    if (F.tid == 0) { float a = 0.f; for (int i = 0; i < 64; ++i) { a += sgc[i]; sgc[i] = a; } }
    __syncthreads();
    bf16* INo = (bf16*)(F.ws + WS_IN) + (size_t)unit * 4096;
    for (int idx = F.tid; idx < 4096; idx += 512) {
        const int i = idx >> 6, j = idx & 63; float av = 0.f, iv = 0.f;
        if (j <= i) { float dkk = 0.f, dqk = 0.f;
            for (int d = 0; d < 128; ++d) { const float kj = sk[j * 129 + d]; dkk += sk[i * 129 + d] * kj; dqk += sq[i * 129 + d] * kj; }
            const float dec = __expf(sgc[i] - sgc[j]); iv = dqk * dec; av = (j < i) ? sbeta[i] * dkk * dec : 0.f; }
        sA[i * 65 + j] = av; INo[idx] = (bf16)f2bf(iv);
    }
    __syncthreads();
    if (F.tid < 64) { const int c = F.tid;
        for (int i = 0; i < 64; ++i) { float t = 0.f;
            for (int j = 0; j < i; ++j) t -= sA[i * 65 + j] * sT[j * 65 + c];
            sT[i * 65 + c] = (i == c) ? 1.0f : ((i < c) ? 0.f : t); } }
    __syncthreads();
    bf16* UTo = (bf16*)(F.ws + WS_UT) + (size_t)unit * 8192; bf16* Wo = (bf16*)(F.ws + WS_W) + (size_t)unit * 8192;
    bf16* QDo = (bf16*)(F.ws + WS_QD) + (size_t)unit * 8192; bf16* KDTo = (bf16*)(F.ws + WS_KDT) + (size_t)unit * 8192;
    const float glast = sgc[63];
    for (int idx = F.tid; idx < 8192; idx += 512) {
        { const int dv = idx >> 6, i = idx & 63; float u = 0.f;
          for (int j = 0; j <= i; ++j) u += sT[i * 65 + j] * sbeta[j] * sv[j * 129 + dv];
          UTo[idx] = (bf16)f2bf(u);
          KDTo[idx] = (bf16)f2bf(sk[i * 129 + dv] * __expf(glast - sgc[i])); }
        { const int i = idx >> 7, dk = idx & 127; float w = 0.f;
          for (int j = 0; j <= i; ++j) w += sT[i * 65 + j] * sbeta[j] * __expf(sgc[j]) * sk[j * 129 + dk];
          Wo[idx] = (bf16)f2bf(w);
          QDo[idx] = (bf16)f2bf(sq[i * 129 + dk] * __expf(sgc[i])); }
    }
    if (F.tid == 0) ((float*)(F.ws + WS_DEC))[unit] = __expf(glast);
    __syncthreads();
}

__device__ __forceinline__ void p4_scan(Frame& F, int item) {
    const int bh = item >> 2, sl = item & 3, h = bh % NH, b = bh / NH;
    LAS float* sS = (LAS float*)F.lds;
    LAS float* sV = sS + 128 * 33;
    LAS bf16* sW = (LAS bf16*)(sV + 64 * 33);
    LAS bf16* sQ = sW + 64 * 136;
    LAS bf16* sK = sQ + 64 * 136;
    LAS bf16* sI = sK + 128 * 72;
    for (int i = F.tid; i < 128 * 33; i += 512) sS[i] = 0.f;
    bf16* OR = (bf16*)(F.ws + WS_OR); float* SSQ = (float*)(F.ws + CTL_SSQ);
    const int c = F.tid >> 3, d4 = (F.tid & 7) * 4, dk2 = F.tid >> 2, d8 = (F.tid & 3) * 8;
    for (int n = 0; n < NCH; ++n) {
        const int unit = bh * NCH + n;
        const bf16* Wg = (const bf16*)(F.ws + WS_W) + (size_t)unit * 8192; const bf16* Qg = (const bf16*)(F.ws + WS_QD) + (size_t)unit * 8192;
        const bf16* Kg = (const bf16*)(F.ws + WS_KDT) + (size_t)unit * 8192; const bf16* Ig = (const bf16*)(F.ws + WS_IN) + (size_t)unit * 4096;
        const bf16* Ug = (const bf16*)(F.ws + WS_UT) + (size_t)unit * 8192;
        __syncthreads();
        for (int i = F.tid; i < 1024; i += 512) { const int r = i >> 4, c8 = (i & 15) * 8;
            *(LAS v4u*)(sW + r * 136 + c8) = *(const v4u*)(Wg + r * 128 + c8); *(LAS v4u*)(sQ + r * 136 + c8) = *(const v4u*)(Qg + r * 128 + c8); }
        for (int i = F.tid; i < 1024; i += 512) { const int r = i >> 3, c8 = (i & 7) * 8; *(LAS v4u*)(sK + r * 72 + c8) = *(const v4u*)(Kg + r * 64 + c8); }
        { const int r = F.tid >> 3, c8 = (F.tid & 7) * 8; *(LAS v4u*)(sI + r * 72 + c8) = *(const v4u*)(Ig + r * 64 + c8); }
        const float dec = ((const float*)(F.ws + WS_DEC))[unit];
        __syncthreads();
        float pS[4] = {0.f, 0.f, 0.f, 0.f}, qS[4] = {0.f, 0.f, 0.f, 0.f};
        for (int dk = 0; dk < 128; ++dk) { const float wv = bf2f(sW[c * 136 + dk]), qv = bf2f(sQ[c * 136 + dk]);
#pragma unroll
            for (int e = 0; e < 4; ++e) { const float s = sS[dk * 33 + d4 + e]; pS[e] += wv * s; qS[e] += qv * s; } }
        float vn[4];
#pragma unroll
        for (int e = 0; e < 4; ++e) { vn[e] = bf2f(Ug[(sl * 32 + d4 + e) * 64 + c]) - pS[e]; sV[c * 33 + d4 + e] = vn[e]; }
        __syncthreads();
        float o[4] = {qS[0], qS[1], qS[2], qS[3]};
        for (int j = 0; j < 64; ++j) { const float iv = bf2f(sI[c * 72 + j]);
#pragma unroll
            for (int e = 0; e < 4; ++e) o[e] += iv * sV[j * 33 + d4 + e]; }
        const int row = b * T + n * CH + c;
        *(v2u*)(OR + (size_t)row * D + h * 128 + sl * 32 + d4) = (v2u){pk2(o[0], o[1]), pk2(o[2], o[3])};
        float ss = (o[0] * o[0] + o[1] * o[1]) + (o[2] * o[2] + o[3] * o[3]);
        ss += __shfl_xor(ss, 1); ss += __shfl_xor(ss, 2); ss += __shfl_xor(ss, 4);
        if ((F.tid & 7) == 0) atomicAdd(SSQ + (size_t)row * 8 + h, ss);
        float sn[8];
#pragma unroll
        for (int e = 0; e < 8; ++e) sn[e] = dec * sS[dk2 * 33 + d8 + e];
        for (int cc = 0; cc < 64; ++cc) { const float kv = bf2f(sK[dk2 * 72 + cc]);
#pragma unroll
            for (int e = 0; e < 8; ++e) sn[e] += kv * sV[cc * 33 + d8 + e]; }
        __syncthreads();
#pragma unroll
        for (int e = 0; e < 8; ++e) sS[dk2 * 33 + d8 + e] = sn[e];
    }
    __syncthreads();
}

__device__ __forceinline__ void p8_router(Frame& F) {
    const int gw = F.vcu * NWAVES + F.wave, NGW = F.G * NWAVES;
    bf16* H2 = (bf16*)(F.ws + WS_H2); int* TOKE = (int*)(F.ws + WS_TOKE); float* TOKW = (float*)(F.ws + WS_TOKW);
    for (int m = gw; m < M; m += NGW) {
        const int b = m / T;
        const f32x4* xr = (const f32x4*)(F.out + (size_t)m * D) + F.lane;
        f32x4 v[4]; float s = 0.f;
#pragma unroll
        for (int j = 0; j < 4; ++j) { v[j] = xr[64 * j]; s += (v[j].x * v[j].x + v[j].y * v[j].y) + (v[j].z * v[j].z + v[j].w * v[j].w); }
        const float rstd = __frsqrt_rn(wave_sum(s) * (1.f / D) + EPS);
        float gl[4] = {0.f, 0.f, 0.f, 0.f};
#pragma unroll
        for (int j = 0; j < 4; ++j) { const int col = 256 * j + 4 * F.lane;
            const f32x4 g2 = *(const f32x4*)(F.norm2_g + col);
#pragma unroll
            for (int e = 0; e < 4; ++e) { v[j][e] = v[j][e] * rstd * g2[e] * (1.0f + mod_at(F, b, 4 * D + col + e)) + mod_at(F, b, 3 * D + col + e);
                const f32x4 wg = *(const f32x4*)(F.w_group + (size_t)(col + e) * 4);
#pragma unroll
                for (int q = 0; q < 4; ++q) gl[q] += v[j][e] * wg[q]; }
            *(v2u*)(H2 + (size_t)m * D + col) = (v2u){pk2(v[j][0], v[j][1]), pk2(v[j][2], v[j][3])};
        }
#pragma unroll
        for (int q = 0; q < 4; ++q) gl[q] = wave_sum(gl[q]) + F.b_group[q];
        int gs = 0; float gm = gl[0];
#pragma unroll
        for (int q = 1; q < 4; ++q) if (gl[q] > gm) { gm = gl[q]; gs = q; }
        float den = 0.f;
#pragma unroll
        for (int q = 0; q < 4; ++q) den += __expf(gl[q] - gm);
        const float pg = 1.0f / den;
        float el[8] = {0.f, 0.f, 0.f, 0.f, 0.f, 0.f, 0.f, 0.f};
#pragma unroll
        for (int j = 0; j < 4; ++j) { const int col = 256 * j + 4 * F.lane;
#pragma unroll
            for (int e = 0; e < 4; ++e) { const float* wp = F.w_expert + (size_t)(col + e) * NE + gs * 8; const f32x4 w0 = *(const f32x4*)wp, w1 = *(const f32x4*)(wp + 4);
#pragma unroll
                for (int q = 0; q < 4; ++q) { el[q] += v[j][e] * w0[q]; el[4 + q] += v[j][e] * w1[q]; } } }
#pragma unroll
        for (int q = 0; q < 8; ++q) el[q] = wave_sum(el[q]) + F.b_expert[gs * 8 + q];
        int i0 = 0; float v0 = el[0];
#pragma unroll
        for (int q = 1; q < 8; ++q) if (el[q] > v0) { v0 = el[q]; i0 = q; }
        int i1 = -1; float v1 = -3.0e38f;
#pragma unroll
        for (int q = 0; q < 8; ++q) if (q != i0 && el[q] > v1) { v1 = el[q]; i1 = q; }
        const float e1 = __expf(v1 - v0), sw = 1.0f / (1.0f + e1);
        if (F.lane == 0) {
            const int ea = gs * 8 + i0, eb = gs * 8 + i1;
            TOKE[m * 2] = ea; TOKE[m * 2 + 1] = eb; TOKW[m * 2] = pg * sw; TOKW[m * 2 + 1] = pg * e1 * sw;
            atomicAdd(F.ctl + CW_CNT + ea, 1u);
            atomicAdd(F.ctl + CW_CNT + eb, 1u);
        }
    }
}

__device__ __forceinline__ int moe_tables(Frame& F) {
    volatile LAS int* ps = (volatile LAS int*)(F.lds + MISC_OFF + 64); volatile LAS int* te = (volatile LAS int*)(F.lds + MISC_OFF + 256);
    __syncthreads();
    if (F.tid == 0) { int a = 0;
        for (int e = 0; e < NE; ++e) { const int cnt = (int)__hip_atomic_load(F.ctl + CW_CNT + e, __ATOMIC_RELAXED, __HIP_MEMORY_SCOPE_AGENT); ps[e] = a; const int nb = (cnt + 255) >> 8;
            for (int r = 0; r < nb; ++r) te[(a >> 8) + r] = e; a += nb << 8; }
        ps[32] = a; }
    __syncthreads();
    return ps[32] >> 8;
}
__device__ __forceinline__ void p9_gather(Frame& F) {
    moe_tables(F);
    volatile LAS int* ps = (volatile LAS int*)(F.lds + MISC_OFF + 64);
    const int gw = F.vcu * NWAVES + F.wave, NGW = F.G * NWAVES;
    int* ROWTOK = (int*)(F.ws + WS_ROWTOK); float* ROWW = (float*)(F.ws + WS_ROWW);
    const int* TOKE = (const int*)(F.ws + WS_TOKE); const float* TOKW = (const float*)(F.ws + WS_TOKW);
    const bf16* H2 = (const bf16*)(F.ws + WS_H2); bf16* XS = (bf16*)(F.ws + WS_XS);
    for (int e = blockIdx.x; e < NE; e += F.G) { const int cnt = (int)__hip_atomic_load(F.ctl + CW_CNT + e, __ATOMIC_RELAXED, __HIP_MEMORY_SCOPE_AGENT);
        for (int r = ps[e] + cnt + F.tid; r < ps[e + 1]; r += 512) ROWTOK[r] = -1; }
    for (int m = gw; m < M; m += NGW) {
        int pos = 0;
        if (F.lane < 2) { const int e = TOKE[m * 2 + F.lane]; pos = ps[e] + (int)atomicAdd(F.ctl + CW_CUR + e, 1u); ROWTOK[pos] = m * 2 + F.lane; ROWW[pos] = TOKW[m * 2 + F.lane]; }
        const int p0 = __shfl(pos, 0), p1 = __shfl(pos, 1);
        const v4u a = *((const v4u*)(H2 + (size_t)m * D) + F.lane), bb = *((const v4u*)(H2 + (size_t)m * D) + 64 + F.lane);
        *((v4u*)(XS + (size_t)p0 * D) + F.lane) = a; *((v4u*)(XS + (size_t)p0 * D) + 64 + F.lane) = bb;
        *((v4u*)(XS + (size_t)p1 * D) + F.lane) = a; *((v4u*)(XS + (size_t)p1 * D) + 64 + F.lane) = bb;
    }
}
__device__ __forceinline__ void p12_final(Frame& F) {
    const int gw = F.vcu * NWAVES + F.wave, NGW = F.G * NWAVES;
    const bf16* YBUF = (const bf16*)(F.ws + WS_YBUF);
    for (int m = gw; m < M; m += NGW) {
        const int b = m / T;
        f32x4* xr = (f32x4*)(F.out + (size_t)m * D) + F.lane;
        f32x4 v[4]; float s = 0.f;
#pragma unroll
        for (int j = 0; j < 4; ++j) { const int col = 256 * j + 4 * F.lane; v[j] = xr[64 * j];
            const v2u y0 = *(const v2u*)(YBUF + (size_t)(2 * m) * D + col), y1 = *(const v2u*)(YBUF + (size_t)(2 * m + 1) * D + col);
            const f32x4 ys = {bflo(y0.x) + bflo(y1.x), bfhi(y0.x) + bfhi(y1.x), bflo(y0.y) + bflo(y1.y), bfhi(y0.y) + bfhi(y1.y)};
#pragma unroll
            for (int e = 0; e < 4; ++e) v[j][e] += mod_at(F, b, 5 * D + col + e) * ys[e];
            s += (v[j].x * v[j].x + v[j].y * v[j].y) + (v[j].z * v[j].z + v[j].w * v[j].w); }
        const float rstd = __frsqrt_rn(wave_sum(s) * (1.f / D) + EPS);
#pragma unroll
        for (int j = 0; j < 4; ++j) { const f32x4 gf = *(const f32x4*)(F.normf_g + 256 * j + 4 * F.lane); xr[64 * j] = v[j] * rstd * gf; }
    }
}

constexpr int NPH = 16;
struct Args { const float* in[23]; float* out; unsigned char* ws; int ph_lo, ph_hi; };
__global__ void __launch_bounds__(NWAVES * 64, 2) fwd(Args args) {
    extern __shared__ __attribute__((aligned(16))) unsigned char lds[];
    Frame F;
    F.lds = (LAS unsigned char*)lds; F.MISC = (volatile LAS unsigned*)(F.lds + MISC_OFF);
    F.tid = threadIdx.x; F.lane = F.tid & 63; F.wave = __builtin_amdgcn_readfirstlane(F.tid >> 6);
    F.G = gridDim.x; { const int bx = blockIdx.x; F.vcu = (F.G % 8 == 0) ? (bx % 8) * (F.G / 8) + bx / 8 : bx; }
    F.ws = args.ws; F.out = args.out; F.ctl = (unsigned*)(args.ws + WS_CTL);
    F.x = args.in[0]; F.c = args.in[1]; F.w_ada = args.in[2]; F.b_ada = args.in[3]; F.norm1_g = args.in[4]; F.w_in = args.in[5]; F.conv_qkv_w = args.in[6];
    F.a_log = args.in[7]; F.dt_bias = args.in[8]; F.onorm_g = args.in[9]; F.w_proj_a = args.in[10]; F.conv_sc_w = args.in[11]; F.w_proj_b = args.in[12]; F.w_out = args.in[13];
    F.norm2_g = args.in[14]; F.w_group = args.in[15]; F.b_group = args.in[16]; F.w_expert = args.in[17]; F.b_expert = args.in[18]; F.w1 = args.in[19]; F.w3 = args.in[20];
    F.w2 = args.in[21]; F.normf_g = args.in[22];
    if (F.tid < 4) F.MISC[F.tid] = 0u;
    __syncthreads();
    const int lo = args.ph_lo, hi = args.ph_hi;
    const bool fused = (hi - lo) > 1;
    XcdBarrier bar; bar.bar = F.ctl + CW_BAR; bar.x = 0; bar.st = F.MISC;
    if (fused) bar = xcd_barrier_post(F.ctl + CW_BAR, F.MISC);
#ifndef PH_MASK
#define PH_MASK 0xFFFF
#endif
#define IN(k) (((PH_MASK >> (k)) & 1) && lo <= (k) && (k) < hi)
#define SEAM(k) do { if (IN(k) && IN((k) + 1)) xcd_barrier(bar); } while (0)
    bf16* H = (bf16*)F.out; bf16* YBP = (bf16*)F.out + (size_t)M * D;

    if (IN(0)) { p0_prologue(F); } SEAM(0);
    if (IN(1)) { p1_norm1(F); } SEAM(1);
    if (IN(2)) {
        pg8::Gemm g{H, (const bf16*)(F.ws + WS_WINA), M, 6144, D}; pg8::StaticOrder S; S.init(M, 6144, F.G, (int)blockIdx.x);
        EpiInA E{(bf16*)(F.ws + WS_QKV), (bf16*)(F.ws + WS_SB), (bf16*)(F.ws + WS_P)};
        pg8::gemm_phase<EpiInA, pg8::StaticOrder, true, true>(F.lds, g, S, E);
    } SEAM(2);
    if (IN(3)) { p3a_ybp(F); } SEAM(3);
    if (IN(4)) { for (int u = blockIdx.x; u < NUNIT; u += F.G) p3b_chunk(F, u); } SEAM(4);
    if (IN(5)) {
        pg8::Gemm g{YBP, (const bf16*)(F.ws + WS_WB), M, D, D}; pg8::StaticOrder S; S.init(M, D, F.G, (int)blockIdx.x);
        EpiPlain E{(bf16*)(F.ws + WS_YB), D};
        pg8::gemm_phase<EpiPlain, pg8::StaticOrder, true, true>(F.lds, g, S, E);
    } SEAM(5);
    if (IN(6)) { p_moe_weights(F); } SEAM(6);
    if (IN(7)) { for (int it = blockIdx.x; it < NB * NH * 4; it += F.G) p4_scan(F, it); } SEAM(7);
    if (IN(8)) {
        pg8::Gemm g{H, (const bf16*)(F.ws + WS_WINB), M, 3072, D}; pg8::StaticOrder S; S.init(M, 3072, F.G, (int)blockIdx.x);
        EpiInB E{(bf16*)(F.ws + WS_OR), (bf16*)(F.ws + WS_GA), (bf16*)(F.ws + WS_GB), (const float*)(F.ws + CTL_SSQ), F.onorm_g};
        pg8::gemm_phase<EpiInB, pg8::StaticOrder, true, true>(F.lds, g, S, E);
    } SEAM(8);
    if (IN(9)) {
        pg8::Gemm g{(const bf16*)(F.ws + WS_OR), (const bf16*)(F.ws + WS_WA), M, D, D}; pg8::StaticOrder S; S.init(M, D, F.G, (int)blockIdx.x);
        EpiMerge E{(const bf16*)(F.ws + WS_GA), (const bf16*)(F.ws + WS_GB), (const bf16*)(F.ws + WS_YB), (bf16*)(F.ws + WS_GA)};
        pg8::gemm_phase<EpiMerge, pg8::StaticOrder, true, true>(F.lds, g, S, E);
    } SEAM(9);
    if (IN(10)) {
        pg8::Gemm g{(const bf16*)(F.ws + WS_GA), (const bf16*)(F.ws + WS_WO), M, D, D}; pg8::StaticOrder S; S.init(M, D, F.G, (int)blockIdx.x);
        EpiX1 E{F.x, F.out, (const float*)(F.ws + CTL_MODACC), F.b_ada};
        pg8::gemm_phase<EpiX1, pg8::StaticOrder, true, true>(F.lds, g, S, E);
    } SEAM(10);
    if (IN(11)) { p8_router(F); } SEAM(11);
    if (IN(12)) { p9_gather(F); } SEAM(12);
    if (IN(13)) {
        const int nt = moe_tables(F);
        pg8::Gemm g{(const bf16*)(F.ws + WS_XS), (const bf16*)(F.ws + WS_W13), MOE_CAP, NE * D, D};
        MoeOrder S{nt * 4, F.G, (int)blockIdx.x, (const volatile LAS int*)(F.lds + MISC_OFF + 256)};
        EpiHid E{(bf16*)(F.ws + WS_HID)};
        pg8::gemm_phase<EpiHid, MoeOrder, true, true>(F.lds, g, S, E);
    } SEAM(13);
    if (IN(14)) {
        const int nt = moe_tables(F);
        pg8::Gemm g{(const bf16*)(F.ws + WS_HID), (const bf16*)(F.ws + WS_W2), MOE_CAP, NE * D, DE};
        MoeOrder S{nt * 4, F.G, (int)blockIdx.x, (const volatile LAS int*)(F.lds + MISC_OFF + 256)};
        EpiMoeOut E{(bf16*)(F.ws + WS_YBUF), (const int*)(F.ws + WS_ROWTOK), (const float*)(F.ws + WS_ROWW)};
        pg8::gemm_phase<EpiMoeOut, MoeOrder, true, true>(F.lds, g, S, E);
    } SEAM(14);
    if (IN(15)) { p12_final(F); }
#undef IN
#undef SEAM
}

extern "C" void kernel_launch(void* const* d_in, const int* in_sizes, int n_in, void* d_out, int out_size, void* d_ws, size_t ws_size, hipStream_t stream) {
    static int grid = 0;
    if (grid == 0) {
        if (n_in != 23 || out_size != M * D || ws_size < WS_END) { fprintf(stderr, "kernel_launch: unexpected problem (n_in %d, out %d, ws %zu)\n", n_in, out_size, ws_size); grid = -1; return; }
        int dev = 0, cus = 0, per_cu = 0;
        if (hipGetDevice(&dev) != hipSuccess || hipDeviceGetAttribute(&cus, hipDeviceAttributeMultiprocessorCount, dev) != hipSuccess) { grid = -1; return; }
        if (hipFuncSetAttribute((const void*)fwd, hipFuncAttributeMaxDynamicSharedMemorySize, LDS_BYTES) != hipSuccess) { fprintf(stderr, "kernel_launch: hipFuncSetAttribute failed\n"); grid = -1; return; }
        if (hipOccupancyMaxActiveBlocksPerMultiprocessor(&per_cu, (const void*)fwd, NWAVES * 64, LDS_BYTES) != hipSuccess || per_cu < 1) { fprintf(stderr, "kernel_launch: occupancy query says %d\n", per_cu); }
        (void)hipGetLastError();
        grid = cus;
    }
    if (grid < 0) return;
    (void)hipMemsetAsync((char*)d_ws + WS_CTL, 0, CTL_ZERO_BYTES, stream);
    Args a{};
    for (int i = 0; i < 23; ++i) a.in[i] = (const float*)d_in[i];
    a.out = (float*)d_out; a.ws = (unsigned char*)d_ws;
#ifndef MK_FUSED
#define MK_FUSED 1
#endif
    if (MK_FUSED) { a.ph_lo = 0; a.ph_hi = NPH; hipLaunchKernelGGL(fwd, dim3(grid), dim3(NWAVES * 64), LDS_BYTES, stream, a); }
    else for (int p = 0; p < NPH; ++p) { a.ph_lo = p; a.ph_hi = p + 1; hipLaunchKernelGGL(fwd, dim3(grid), dim3(NWAVES * 64), LDS_BYTES, stream, a); }
}
```

```cpp
#include <hip/hip_runtime.h>
#include <cstdio>
#include <cstdint>
namespace pg8 {
#define PG8_LAS __attribute__((address_space(3)))
typedef unsigned short bf16_t;
typedef short bf16x8 __attribute__((ext_vector_type(8)));
typedef float f32x4 __attribute__((ext_vector_type(4)));
typedef unsigned u32x4 __attribute__((ext_vector_type(4)));
constexpr int BM = 256, BK = 64, HALF = 128, HTB = HALF * BK * 2  , STAGE_BYTES = 8 * HTB, NXCD = 8, WGM = 8;

__host__ __device__ __forceinline__ int lds_byte(int r, int c) { const int st = (r >> 4) * 2 + (c >> 5), rr = r & 15, cc = c & 31, ob = rr * 64 + cc * 2; return st * 1024 + (ob ^ (((ob >> 9) & 1) << 5)); }
__host__ __device__ __forceinline__ void stage_rc(int b, int& R, int& C) { const int st = b / 1024, sb = b % 1024, swz = sb ^ (((sb >> 9) & 1) << 5); R = (st >> 1) * 16 + swz / 64; C = (st & 1) * 32 + (swz % 64) / 2; }
__host__ __device__ __forceinline__ int perm32(int rho) { const int n = rho >> 4, i = rho & 15; return 8 * (i >> 2) + 4 * n + (i & 3); }

struct Unit { int pm, pn; };
struct Gemm { const bf16_t* A; const bf16_t* Bt; int M, N, K; };

struct StaticOrder {
    int nM, nN, nwg, G, c;
    __host__ __device__ void init(int M, int N, int G_, int c_) { nM = M / BM; nN = N / BM; nwg = nM * nN; G = G_; c = c_; }
    __host__ __device__ bool next(int i, Unit& u) const {
        const long L = (long)i * G + c; if (L >= nwg) return false;
        int wgid = (int)L; { const int q = nwg / NXCD, r = nwg % NXCD, xcd = wgid % NXCD, off = wgid / NXCD; wgid = (xcd < r ? xcd * (q + 1) : r * (q + 1) + (xcd - r) * q) + off; }
        const int nig = WGM * nN, gid = wgid / nig, fm = gid * WGM, gsz = (nM - fm) < WGM ? (nM - fm) : WGM;
        u.pm = fm + ((wgid % nig) % gsz); u.pn = (wgid % nig) / gsz; return true;
    }
    __device__ __forceinline__ void a_ready(const Unit&) const {}
    __device__ __forceinline__ void done(const Unit&) const {}
};

typedef float f32x2_cv __attribute__((ext_vector_type(2)));
typedef __bf16 bf16x2_cv __attribute__((ext_vector_type(2)));
__device__ __forceinline__ unsigned cvt_pk_bf16(float lo, float hi) { const f32x2_cv v = {lo, hi}; return __builtin_bit_cast(unsigned, __builtin_convertvector(v, bf16x2_cv)); }
template <class Epi, class Sched, bool ALIGN_EPI = false, bool SP2 = false>
__device__ __forceinline__ void gemm_phase(PG8_LAS unsigned char* lds, const Gemm g, const Sched& S, const Epi& E) {
    const int tid = threadIdx.x, wid = __builtin_amdgcn_readfirstlane(tid >> 6), lane = tid & 63, wr = wid >> 2, wc = wid & 3, fr = lane & 15, fq = lane >> 4;
    const int K = g.K, nt = K / BK;
    unsigned voffA[2], voffB[2];
#pragma unroll
    for (int i = 0; i < 2; ++i) { int R, C; stage_rc(tid * 16 + i * 8192, R, C); const int Rb = Epi::PERM ? ((R & ~31) + perm32(R & 31)) : R;
        voffA[i] = (unsigned)(R * K + C) * 2u; voffB[i] = (unsigned)(Rb * K + C) * 2u; }
    const size_t kstep = (size_t)(BK * 2);
    const size_t hstep = (size_t)HALF * K * 2;
    const size_t tstep = 2 * hstep;
    const unsigned ldsw = (unsigned)wid * 1024u;
    const int aoff = lds_byte(wr * 64 + fr, fq * 8), boff = lds_byte(wc * 32 + fr, fq * 8);
#define PG8_SA(b, h) (((b) * 2 + (h)) * HTB)
#define PG8_SB(b, h) ((4 + (b) * 2 + (h)) * HTB)
#define PG8_STAGE(bufoff, gbase, voff) do { _Pragma("unroll") for (int _i = 0; _i < 2; ++_i) \
        __builtin_amdgcn_global_load_lds((const unsigned*)((const char*)(gbase) + (voff)[_i]), (PG8_LAS unsigned*)(lds + (bufoff) + ldsw + _i * 8192), 16, 0, 0); } while (0)
#define PG8_LDA(dst, b, h) do { _Pragma("unroll") for (int m = 0; m < 4; ++m) _Pragma("unroll") for (int k = 0; k < 2; ++k) dst[m][k] = *(const PG8_LAS bf16x8*)(lds + PG8_SA(b, h) + aoff + m * 2048 + k * 1024); } while (0)
#define PG8_LDB(dst, b, h) do { _Pragma("unroll") for (int n = 0; n < 2; ++n) _Pragma("unroll") for (int k = 0; k < 2; ++k) dst[n][k] = *(const PG8_LAS bf16x8*)(lds + PG8_SB(b, h) + boff + n * 2048 + k * 1024); } while (0)
#define PG8_MMA(ai, bj, At, Bt) do { __builtin_amdgcn_s_setprio(1); _Pragma("unroll") for (int m = 0; m < 4; ++m) _Pragma("unroll") for (int n = 0; n < 2; ++n) _Pragma("unroll") for (int k = 0; k < 2; ++k) \
        acc[ai][bj][m][n] = __builtin_amdgcn_mfma_f32_16x16x32_bf16(Bt[n][k], At[m][k], acc[ai][bj][m][n], 0, 0, 0); __builtin_amdgcn_s_setprio(0); } while (0)
#define PG8_WAIT_V(n) asm volatile("s_waitcnt vmcnt(" #n ")" ::: "memory")
#define PG8_WAIT_L(n) asm volatile("s_waitcnt lgkmcnt(" #n ")" ::: "memory")
#define PG8_BAR __builtin_amdgcn_s_barrier()
#define PG8_SCHED __builtin_amdgcn_sched_barrier(0)
    Unit cur, nxt; int ui = 0;
    if (!S.next(0, cur)) return;
    f32x4 acc[2][2][4][2];
#pragma unroll
    for (int a = 0; a < 2; ++a)
#pragma unroll
        for (int b = 0; b < 2; ++b)
#pragma unroll
            for (int m = 0; m < 4; ++m)
#pragma unroll
                for (int n = 0; n < 2; ++n) acc[a][b][m][n] = (f32x4){0.f, 0.f, 0.f, 0.f};
    bf16x8 At[4][2], B0[2][2], B1[2][2];
    const char* cA = (const char*)g.A + (size_t)cur.pm * tstep; const char* cB = (const char*)g.Bt + (size_t)cur.pn * tstep;
    S.a_ready(cur);
    if constexpr (SP2) {
        PG8_STAGE(PG8_SB(0, 0), cB, voffB); PG8_STAGE(PG8_SB(0, 1), cB + hstep, voffB); PG8_STAGE(PG8_SA(0, 0), cA, voffA); PG8_STAGE(PG8_SA(0, 1), cA + hstep, voffA);
        if (wr == 1) PG8_BAR;
        PG8_WAIT_V(2); PG8_BAR;
        PG8_STAGE(PG8_SB(1, 0), cB + kstep, voffB); PG8_STAGE(PG8_SA(1, 0), cA + kstep, voffA); PG8_STAGE(PG8_SB(1, 1), cB + hstep + kstep, voffB);
        PG8_WAIT_V(6); PG8_BAR;
    } else {
        PG8_STAGE(PG8_SB(0, 0), cB, voffB); PG8_STAGE(PG8_SA(0, 0), cA, voffA); PG8_STAGE(PG8_SB(0, 1), cB + hstep, voffB); PG8_STAGE(PG8_SA(0, 1), cA + hstep, voffA);
        if (wr == 1) PG8_BAR;
        PG8_WAIT_V(4); PG8_BAR;
        PG8_STAGE(PG8_SB(1, 0), cB + kstep, voffB); PG8_STAGE(PG8_SA(1, 0), cA + kstep, voffA); PG8_STAGE(PG8_SB(1, 1), cB + hstep + kstep, voffB);
        PG8_WAIT_V(6); PG8_BAR;
    }
    for (;;) {
        const bool has_next = S.next(ui + 1, nxt);
        const char* nA = has_next ? (const char*)g.A + (size_t)nxt.pm * tstep : cA; const char* nB = has_next ? (const char*)g.Bt + (size_t)nxt.pn * tstep : cB;
        for (int t = 0; t < nt; t += 2) {
            const bool last = (t == nt - 2);
            const char* a1 = cA + (size_t)(t + 1) * kstep;
            const char* a2 = last ? nA : cA + (size_t)(t + 2) * kstep; const char* b2 = last ? nB : cB + (size_t)(t + 2) * kstep;
            const char* a3 = a2 + kstep; const char* b3 = b2 + kstep;
            if (last && has_next) S.a_ready(nxt);
            if constexpr (SP2) {
            PG8_LDB(B0, 0, 0); PG8_LDB(B1, 0, 1); PG8_SCHED; PG8_LDA(At, 0, 0); PG8_STAGE(PG8_SA(1, 1), a1 + hstep, voffA);
            PG8_WAIT_V(8); PG8_WAIT_L(0); PG8_BAR; PG8_MMA(0, 0, At, B0); PG8_MMA(0, 1, At, B1); PG8_BAR; PG8_SCHED;
            PG8_LDA(At, 0, 1); PG8_STAGE(PG8_SB(0, 0), b2, voffB); PG8_STAGE(PG8_SB(0, 1), b2 + hstep, voffB); PG8_STAGE(PG8_SA(0, 0), a2, voffA);
            PG8_WAIT_V(8); PG8_WAIT_L(0); PG8_BAR; PG8_MMA(1, 0, At, B0); PG8_MMA(1, 1, At, B1); PG8_BAR; PG8_SCHED;
            PG8_LDB(B0, 1, 0); PG8_LDB(B1, 1, 1); PG8_SCHED; PG8_LDA(At, 1, 0); PG8_STAGE(PG8_SA(0, 1), a2 + hstep, voffA);
            PG8_WAIT_V(8); PG8_WAIT_L(0); PG8_BAR; PG8_MMA(0, 0, At, B0); PG8_MMA(0, 1, At, B1); PG8_BAR; PG8_SCHED;
            PG8_LDA(At, 1, 1); PG8_STAGE(PG8_SB(1, 0), b3, voffB); PG8_STAGE(PG8_SB(1, 1), b3 + hstep, voffB); PG8_STAGE(PG8_SA(1, 0), a3, voffA);
            PG8_WAIT_V(8); PG8_WAIT_L(0); PG8_BAR; PG8_MMA(1, 0, At, B0); PG8_MMA(1, 1, At, B1); PG8_BAR; PG8_SCHED;
            } else {
            PG8_LDB(B0, 0, 0); PG8_SCHED; PG8_LDA(At, 0, 0); PG8_STAGE(PG8_SA(1, 1), a1 + hstep, voffA);
            PG8_WAIT_L(8); PG8_BAR; PG8_WAIT_L(0); PG8_MMA(0, 0, At, B0); PG8_BAR; PG8_SCHED;
            PG8_LDB(B1, 0, 1); PG8_STAGE(PG8_SB(0, 0), b2, voffB);
            PG8_BAR; PG8_WAIT_L(0); PG8_MMA(0, 1, At, B1); PG8_BAR;
            PG8_LDA(At, 0, 1); PG8_STAGE(PG8_SA(0, 0), a2, voffA);
            PG8_BAR; PG8_WAIT_L(0); PG8_MMA(1, 0, At, B0); PG8_BAR; PG8_SCHED;
            PG8_STAGE(PG8_SB(0, 1), b2 + hstep, voffB);
            PG8_WAIT_V(6); PG8_BAR; PG8_MMA(1, 1, At, B1); PG8_BAR;
            PG8_LDB(B0, 1, 0); PG8_SCHED; PG8_LDA(At, 1, 0); PG8_STAGE(PG8_SA(0, 1), a2 + hstep, voffA);
            PG8_WAIT_L(8); PG8_BAR; PG8_WAIT_L(0); PG8_MMA(0, 0, At, B0); PG8_BAR; PG8_SCHED;
            PG8_LDB(B1, 1, 1); PG8_STAGE(PG8_SB(1, 0), b3, voffB);
            PG8_BAR; PG8_WAIT_L(0); PG8_MMA(0, 1, At, B1); PG8_BAR;
            PG8_LDA(At, 1, 1); PG8_STAGE(PG8_SA(1, 0), a3, voffA);
            PG8_BAR; PG8_WAIT_L(0); PG8_MMA(1, 0, At, B0); PG8_BAR; PG8_SCHED;
            PG8_STAGE(PG8_SB(1, 1), b3 + hstep, voffB);
            PG8_WAIT_V(6); PG8_BAR; PG8_MMA(1, 1, At, B1); PG8_BAR;
            }
        }
        if constexpr (ALIGN_EPI) { if (wr == 0) PG8_BAR; }
        if constexpr (!Epi::AFTER_DRAIN) { E(acc, cur, wr, wc, fr, fq); S.done(cur); }
        if (!has_next) break;
#pragma unroll
        for (int a = 0; a < 2; ++a)
#pragma unroll
            for (int b = 0; b < 2; ++b)
#pragma unroll
                for (int m = 0; m < 4; ++m)
#pragma unroll
                    for (int n = 0; n < 2; ++n) acc[a][b][m][n] = (f32x4){0.f, 0.f, 0.f, 0.f};
        cur = nxt; cA = nA; cB = nB; ++ui;
        if constexpr (ALIGN_EPI) { if (wr == 1) PG8_BAR; }
    }
    PG8_WAIT_V(0);
    if constexpr (!ALIGN_EPI) { if (wr == 0) PG8_BAR; }
    PG8_BAR;
    if constexpr (Epi::AFTER_DRAIN) { E.fused(acc, cur, wr, wc, fr, fq, lds, wid, lane); S.done(cur); }
#undef PG8_SA
#undef PG8_SB
#undef PG8_STAGE
#undef PG8_LDA
#undef PG8_LDB
#undef PG8_MMA
#undef PG8_WAIT_V
#undef PG8_WAIT_L
#undef PG8_BAR
#undef PG8_SCHED
}
}

constexpr int NB = 2, T = 8192, D = 1024, M = NB * T;
constexpr int NH = 8, DK = 128, DV = 128, CH = 64, NCH = T / CH;
constexpr int NQKV = 3072, IN_TOTAL = 9232;
constexpr int NE = 32, EPG = 8, NGRP = 4, DE = 512;
constexpr int NUNIT = NB * NH * NCH;
constexpr float EPS = 1e-6f;
constexpr int MOE_CAP = 40960;
constexpr int NWAVES = 8;

constexpr size_t MiB = 1u << 20;
constexpr size_t WS_CTL = 0, CTL_ZERO_BYTES = 1 * MiB;
constexpr size_t WS_BG = 1 * MiB;
constexpr size_t WS_TOKE = 2 * MiB;
constexpr size_t WS_TOKW = WS_TOKE + 128 * 1024;
constexpr size_t WS_ROWTOK = WS_TOKE + 256 * 1024;
constexpr size_t WS_ROWW = WS_TOKE + 512 * 1024;
constexpr size_t WS_DEC = 3 * MiB;
constexpr size_t WS_WINA = 4 * MiB;
constexpr size_t WS_IN = 4 * MiB;
constexpr size_t WS_WINB = 20 * MiB;
constexpr size_t WS_WA = 27 * MiB, WS_WB = 29 * MiB, WS_WO = 31 * MiB;
constexpr size_t WS_QKV = 33 * MiB;
constexpr size_t WS_W13 = 33 * MiB;
constexpr size_t WS_W2 = 97 * MiB;
constexpr size_t WS_SB = 129 * MiB, WS_YB = 129 * MiB;
constexpr size_t WS_P = 161 * MiB, WS_OR = 161 * MiB;
constexpr size_t WS_UT = 193 * MiB, WS_W = 225 * MiB, WS_QD = 257 * MiB, WS_KDT = 289 * MiB;
constexpr size_t WS_GA = 193 * MiB, WS_GB = 225 * MiB;
constexpr size_t WS_H2 = 257 * MiB;
constexpr size_t WS_XS = 129 * MiB;
constexpr size_t WS_HID = 209 * MiB;
constexpr size_t WS_YBUF = 129 * MiB;
constexpr size_t WS_END = 321 * MiB;
constexpr int CW_TMO = 0, CW_BAR = 4096, CW_CNT = 8192, CW_CUR = 8192 + 64;
constexpr size_t CTL_MODACC = 64 * 1024;
constexpr size_t CTL_SSQ = 128 * 1024;
constexpr int LDS_BYTES = 163840, MISC_OFF = LDS_BYTES - 2048;

#define GAS __attribute__((address_space(1)))
#define LAS __attribute__((address_space(3)))
typedef unsigned short bf16;
typedef unsigned v4u __attribute__((ext_vector_type(4)));
typedef unsigned v2u __attribute__((ext_vector_type(2)));
typedef float f32x4 __attribute__((ext_vector_type(4)));
#define LDS_WAIT() asm volatile("s_waitcnt lgkmcnt(0)" ::: "memory")
__device__ __forceinline__ unsigned f2bf(float f) { unsigned u = __builtin_bit_cast(unsigned, f); return (u + 0x7fffu + ((u >> 16) & 1u)) >> 16; }
__device__ __forceinline__ unsigned pk2(float lo, float hi) { return f2bf(lo) | (f2bf(hi) << 16); }
__device__ __forceinline__ float bf2f(unsigned short b) { return __builtin_bit_cast(float, ((unsigned)b) << 16); }
__device__ __forceinline__ float bflo(unsigned w) { return __builtin_bit_cast(float, w << 16); }
__device__ __forceinline__ float bfhi(unsigned w) { return __builtin_bit_cast(float, w & 0xffff0000u); }
__device__ __forceinline__ float sigmoidf_(float x) { return 1.0f / (1.0f + __expf(-x)); }
__device__ __forceinline__ float siluf_(float x) { return x / (1.0f + __expf(-x)); }
__device__ __forceinline__ float wave_sum(float v) {
#pragma unroll
    for (int o = 1; o < 64; o <<= 1) v += __shfl_xor(v, o);
    return v;
}

#define XB_TMO      128
#define XB_XCNT(j)  (256  + 64 * (j))
#define XB_XSUB(j)  (1280 + 64 * (j))
#define XB_XGEN(j)  (2304 + 64 * (j))
#define XB_TOP      3328
#define XB_TOPGEN   3392
#define XCD_BAR_WORDS 3456
#define XB_SPIN_CAP (1u << 18)
__device__ __forceinline__ unsigned xb_ld(unsigned* p)              { return __hip_atomic_load(p, __ATOMIC_RELAXED, __HIP_MEMORY_SCOPE_AGENT); }
__device__ __forceinline__ unsigned xb_add(unsigned* p, unsigned v) { return __hip_atomic_fetch_add(p, v, __ATOMIC_RELAXED, __HIP_MEMORY_SCOPE_AGENT); }
__device__ __forceinline__ unsigned xb_xcc_id() { return (unsigned)__builtin_amdgcn_s_getreg((3 << 11) | 20) & 0xFu; }
#define XB_SPIN(cond, bar) do { unsigned _sp = 0; while (cond) { __builtin_amdgcn_s_sleep(1); \
    if ((++_sp & 255u) == 0u) { if (xb_ld(&(bar)[XB_TMO])) break; if (_sp > XB_SPIN_CAP) { atomicAdd(&(bar)[XB_TMO], 1u); break; } } } } while (0)
struct XcdBarrier { unsigned* bar; unsigned x; volatile LAS unsigned* st; };
__device__ __forceinline__ XcdBarrier xcd_barrier_post(unsigned* bar, volatile LAS unsigned* st) {
    XcdBarrier b; b.bar = bar; b.x = xb_xcc_id(); b.st = st;
    if (threadIdx.x == 0) (void)xb_add(&bar[XB_XCNT(b.x)], 1u);
    return b;
}
__device__ __forceinline__ void xcd_barrier_complete(unsigned* bar, unsigned x, unsigned& nloc, unsigned& nx) {
    const unsigned G = gridDim.x * gridDim.y * gridDim.z;
    unsigned sum, cnt, mine, sp = 0u;
    for (;;) {
        sum = 0u; cnt = 0u; mine = 0u;
#pragma unroll
        for (unsigned j = 0; j < 16; ++j) { const unsigned c = xb_ld(&bar[XB_XCNT(j)]); sum += c; cnt += (c > 0u) ? 1u : 0u; mine = (j == x) ? c : mine; }
        if (sum == G) break;
        __builtin_amdgcn_s_sleep(1);
        if ((++sp & 255u) == 0u) { if (xb_ld(&bar[XB_TMO])) break; if (sp > XB_SPIN_CAP) { atomicAdd(&bar[XB_TMO], 1u); break; } }
    }
    nloc = mine > 0u ? mine : 1u; nx = cnt > 0u ? cnt : 1u;
}
__device__ __forceinline__ void xcd_barrier(const XcdBarrier& b) {
    asm volatile("s_waitcnt vmcnt(0)" ::: "memory");
    __syncthreads();
    if (threadIdx.x == 0) {
        unsigned* bar = b.bar;
        __builtin_amdgcn_s_waitcnt(0);
        unsigned nloc = b.st[0], nx = b.st[1];
        if (nloc == 0u) { xcd_barrier_complete(bar, b.x, nloc, nx); b.st[0] = nloc; b.st[1] = nx; }
        const unsigned old = xb_add(&bar[XB_XSUB(b.x)], 1u);
        const unsigned gen = old / nloc;
        if (old + 1u == (gen + 1u) * nloc) {
            __builtin_amdgcn_fence(__ATOMIC_RELEASE, "agent");
            asm volatile("s_waitcnt vmcnt(0)" ::: "memory");
            const unsigned og = xb_add(&bar[XB_TOP], 1u);
            const unsigned tg = og / nx;
            if (og + 1u == (tg + 1u) * nx) xb_add(&bar[XB_TOPGEN], 1u);
            else XB_SPIN(xb_ld(&bar[XB_TOPGEN]) == tg, bar);
            __builtin_amdgcn_fence(__ATOMIC_ACQUIRE, "agent");
            xb_add(&bar[XB_XGEN(b.x)], 1u);
            asm volatile("s_waitcnt vmcnt(0)" ::: "memory");
        } else {
            XB_SPIN(xb_ld(&bar[XB_XGEN(b.x)]) == gen, bar);
            __builtin_amdgcn_fence(__ATOMIC_ACQUIRE, "agent");
            asm volatile("s_waitcnt vmcnt(0)" ::: "memory");
        }
    }
    __syncthreads();
}

struct Frame {
    LAS unsigned char* lds;
    volatile LAS unsigned* MISC;
    unsigned* ctl;
    int tid, lane, wave, vcu, G;
    const float *x, *c, *w_ada, *b_ada, *norm1_g, *w_in, *conv_qkv_w, *a_log, *dt_bias, *onorm_g, *w_proj_a, *conv_sc_w, *w_proj_b, *w_out,
                *norm2_g, *w_group, *b_group, *w_expert, *b_expert, *w1, *w3, *w2, *normf_g;
    float* out; unsigned char* ws;
};
__device__ __forceinline__ float mod_at(const Frame& F, int b, int idx) {
    return ((const float*)(F.ws + CTL_MODACC))[b * 6144 + idx];
}

using pg8::Unit; using pg8::cvt_pk_bf16;
__device__ __forceinline__ v4u pack8(const f32x4 a, const f32x4 b) { v4u w; w.x = cvt_pk_bf16(a[0], a[1]); w.y = cvt_pk_bf16(a[2], a[3]); w.z = cvt_pk_bf16(b[0], b[1]); w.w = cvt_pk_bf16(b[2], b[3]); return w; }
__device__ __forceinline__ void unpack8(const v4u w, f32x4& a, f32x4& b) { a = (f32x4){bflo(w.x), bfhi(w.x), bflo(w.y), bfhi(w.y)}; b = (f32x4){bflo(w.z), bfhi(w.z), bflo(w.w), bfhi(w.w)}; }

struct EpiInA {
    static constexpr bool PERM = true, AFTER_DRAIN = false;
    bf16 *QKV, *SB, *P;
    __device__ __forceinline__ void operator()(const f32x4 (&acc)[2][2][4][2], const Unit& u, int wr, int wc, int fr, int fq) const {
        const int row0 = u.pm * 256 + wr * 64 + fr;
        if (u.pn < 16) {
            bf16* base; int ldc, colt;
            if (u.pn < 12) { base = QKV; ldc = NQKV; colt = u.pn * 256; } else { base = SB; ldc = D; colt = (u.pn - 12) * 256; }
            const int col0 = colt + wc * 32 + 8 * fq;
#pragma unroll
            for (int ai = 0; ai < 2; ++ai)
#pragma unroll
                for (int m = 0; m < 4; ++m) { bf16* rowp = base + (size_t)(row0 + ai * 128 + m * 16) * ldc + col0;
#pragma unroll
                    for (int bj = 0; bj < 2; ++bj) *(v4u*)(rowp + bj * 128) = pack8(acc[ai][bj][m][0], acc[ai][bj][m][1]); }
        } else {
            const int col0 = (u.pn - 16) * 128 + wc * 32 + 8 * fq;
#pragma unroll
            for (int ai = 0; ai < 2; ++ai)
#pragma unroll
                for (int m = 0; m < 4; ++m) { bf16* rowp = P + (size_t)(row0 + ai * 128 + m * 16) * D + col0;
                    *(v4u*)rowp = pack8(acc[ai][0][m][0] * acc[ai][1][m][0], acc[ai][0][m][1] * acc[ai][1][m][1]); }
        }
    }
};
struct EpiInB {
    static constexpr bool PERM = true, AFTER_DRAIN = false;
    bf16 *OG, *GA, *GB; const float* SSQ; const float* onorm_g;
    __device__ __forceinline__ void operator()(const f32x4 (&acc)[2][2][4][2], const Unit& u, int wr, int wc, int fr, int fq) const {
        const int row0 = u.pm * 256 + wr * 64 + fr;
        if (u.pn < 4) {
            const int col0 = u.pn * 256 + wc * 32 + 8 * fq;
#pragma unroll
            for (int ai = 0; ai < 2; ++ai)
#pragma unroll
                for (int m = 0; m < 4; ++m) { const int row = row0 + ai * 128 + m * 16;
#pragma unroll
                    for (int bj = 0; bj < 2; ++bj) { const int col = col0 + bj * 128; bf16* p = OG + (size_t)row * D + col;
                        f32x4 o0, o1; unpack8(*(const v4u*)p, o0, o1);
                        f32x4 z0 = acc[ai][bj][m][0], z1 = acc[ai][bj][m][1];
#pragma unroll
                        for (int j = 0; j < 4; ++j) { z0[j] = siluf_(z0[j]) * o0[j]; z1[j] = siluf_(z1[j]) * o1[j]; }
                        *(v4u*)p = pack8(z0, z1); } }
        } else {
            bf16* base = (u.pn < 8) ? GA : GB; const int col0 = (u.pn & 3) * 256 + wc * 32 + 8 * fq;
#pragma unroll
            for (int ai = 0; ai < 2; ++ai)
#pragma unroll
                for (int m = 0; m < 4; ++m) { bf16* rowp = base + (size_t)(row0 + ai * 128 + m * 16) * D + col0;
#pragma unroll
                    for (int bj = 0; bj < 2; ++bj) { f32x4 a = acc[ai][bj][m][0], b = acc[ai][bj][m][1];
#pragma unroll
                        for (int j = 0; j < 4; ++j) { a[j] = sigmoidf_(a[j]); b[j] = sigmoidf_(b[j]); }
                        *(v4u*)(rowp + bj * 128) = pack8(a, b); } }
        }
    }
};
struct EpiPlain {
    static constexpr bool PERM = true, AFTER_DRAIN = false;
    bf16* O; int ldc;
    __device__ __forceinline__ void operator()(const f32x4 (&acc)[2][2][4][2], const Unit& u, int wr, int wc, int fr, int fq) const {
        const int row0 = u.pm * 256 + wr * 64 + fr, col0 = u.pn * 256 + wc * 32 + 8 * fq;
#pragma unroll
        for (int ai = 0; ai < 2; ++ai)
#pragma unroll
            for (int m = 0; m < 4; ++m) { bf16* rowp = O + (size_t)(row0 + ai * 128 + m * 16) * ldc + col0;
#pragma unroll
                for (int bj = 0; bj < 2; ++bj) *(v4u*)(rowp + bj * 128) = pack8(acc[ai][bj][m][0], acc[ai][bj][m][1]); }
    }
};
struct EpiMerge {
    static constexpr bool PERM = true, AFTER_DRAIN = false;
    const bf16 *GA, *GB, *YB; bf16* MG;
    __device__ __forceinline__ void operator()(const f32x4 (&acc)[2][2][4][2], const Unit& u, int wr, int wc, int fr, int fq) const {
        const int row0 = u.pm * 256 + wr * 64 + fr, col0 = u.pn * 256 + wc * 32 + 8 * fq;
#pragma unroll
        for (int ai = 0; ai < 2; ++ai)
#pragma unroll
            for (int m = 0; m < 4; ++m) { const size_t off = (size_t)(row0 + ai * 128 + m * 16) * D + col0;
#pragma unroll
                for (int bj = 0; bj < 2; ++bj) { f32x4 a0, a1, b0, b1, y0, y1;
                    unpack8(*(const v4u*)(GA + off + bj * 128), a0, a1); unpack8(*(const v4u*)(GB + off + bj * 128), b0, b1); unpack8(*(const v4u*)(YB + off + bj * 128), y0, y1);
                    *(v4u*)(MG + off + bj * 128) = pack8(a0 * acc[ai][bj][m][0] + b0 * y0, a1 * acc[ai][bj][m][1] + b1 * y1); } }
    }
};
struct EpiX1 {
    static constexpr bool PERM = true, AFTER_DRAIN = false;
    const float* X; float* X1; const float* modacc; const float* b_ada;
    __device__ __forceinline__ void operator()(const f32x4 (&acc)[2][2][4][2], const Unit& u, int wr, int wc, int fr, int fq) const {
        const int row0 = u.pm * 256 + wr * 64 + fr, col0 = u.pn * 256 + wc * 32 + 8 * fq, b = u.pm >> 5;
        f32x4 gt[2][2];
#pragma unroll
        for (int bj = 0; bj < 2; ++bj)
#pragma unroll
            for (int n = 0; n < 2; ++n) gt[bj][n] = *(const f32x4*)(modacc + b * 6144 + 2048 + col0 + bj * 128 + 4 * n);
#pragma unroll
        for (int ai = 0; ai < 2; ++ai)
#pragma unroll
            for (int m = 0; m < 4; ++m) { const size_t off = (size_t)(row0 + ai * 128 + m * 16) * D + col0;
#pragma unroll
                for (int bj = 0; bj < 2; ++bj)
#pragma unroll
                    for (int n = 0; n < 2; ++n) { const f32x4 xv = *(const f32x4*)(X + off + bj * 128 + 4 * n);
                        *(f32x4*)(X1 + off + bj * 128 + 4 * n) = xv + gt[bj][n] * acc[ai][bj][m][n]; } }
    }
};
struct EpiHid {
    static constexpr bool PERM = true, AFTER_DRAIN = false;
    bf16* HID;
    __device__ __forceinline__ void operator()(const f32x4 (&acc)[2][2][4][2], const Unit& u, int wr, int wc, int fr, int fq) const {
        const int row0 = u.pm * 256 + wr * 64 + fr, col0 = (u.pn & 3) * 128 + wc * 32 + 8 * fq;
#pragma unroll
        for (int ai = 0; ai < 2; ++ai)
#pragma unroll
            for (int m = 0; m < 4; ++m) { f32x4 a = acc[ai][0][m][0], b = acc[ai][0][m][1];
#pragma unroll
                for (int j = 0; j < 4; ++j) { a[j] = siluf_(a[j]) * acc[ai][1][m][0][j]; b[j] = siluf_(b[j]) * acc[ai][1][m][1][j]; }
                *(v4u*)(HID + (size_t)(row0 + ai * 128 + m * 16) * DE + col0) = pack8(a, b); }
    }
};
struct EpiMoeOut {
    static constexpr bool PERM = true, AFTER_DRAIN = false;
    bf16* YBUF; const int* ROWTOK; const float* ROWW;
    __device__ __forceinline__ void operator()(const f32x4 (&acc)[2][2][4][2], const Unit& u, int wr, int wc, int fr, int fq) const {
        const int row0 = u.pm * 256 + wr * 64 + fr, col0 = (u.pn & 3) * 256 + wc * 32 + 8 * fq;
#pragma unroll
        for (int ai = 0; ai < 2; ++ai)
#pragma unroll
            for (int m = 0; m < 4; ++m) { const int r = row0 + ai * 128 + m * 16; const int tk = ROWTOK[r];
                if (tk >= 0) { const float w = ROWW[r]; bf16* rowp = YBUF + (size_t)tk * D + col0;
#pragma unroll
                    for (int bj = 0; bj < 2; ++bj) *(v4u*)(rowp + bj * 128) = pack8(acc[ai][bj][m][0] * w, acc[ai][bj][m][1] * w); } }
    }
};
struct MoeOrder {
    int n4, G, c; const volatile LAS int* tile_e;
    __device__ __forceinline__ bool next(int i, Unit& u) const { const int L = i * G + c; if (L >= n4) return false; const int rb = L >> 2; u.pm = rb; u.pn = tile_e[rb] * 4 + (L & 3); return true; }
    __device__ __forceinline__ void a_ready(const Unit&) const {}
    __device__ __forceinline__ void done(const Unit&) const {}
};

__device__ __forceinline__ void transpose_item(const float* W, int ldw, int src_col0, int k0, bf16* WT, int dst_row0, int K, LAS float* scr, int lane) {
#pragma unroll 8
    for (int i = 0; i < 32; ++i) { const int kk = 2 * i + (lane >> 5); scr[kk * 33 + (lane & 31)] = W[(size_t)(k0 + kk) * ldw + src_col0 + (lane & 31)]; }
    LDS_WAIT(); asm volatile("" ::: "memory");
    const int c = lane & 7;
#pragma unroll
    for (int j = 0; j < 4; ++j) { const int n = (lane >> 3) + 8 * j; const LAS float* s = scr + (8 * c) * 33 + n;
        v4u o; o.x = pk2(s[0 * 33], s[1 * 33]); o.y = pk2(s[2 * 33], s[3 * 33]); o.z = pk2(s[4 * 33], s[5 * 33]); o.w = pk2(s[6 * 33], s[7 * 33]);
        *(v4u*)(WT + (size_t)(dst_row0 + n) * K + k0 + 8 * c) = o; }
    LDS_WAIT(); asm volatile("" ::: "memory");
}
__device__ __forceinline__ int win_src_col(int d0) {
    if (d0 < 3072) return d0;
    if (d0 < 4096) return 4112 + (d0 - 3072);
    if (d0 < 6144) { const int j = (d0 - 4096) >> 8, r = (d0 - 4096) & 255; return (r < 128 ? 5136 + r : 6160 + (r - 128)) + 128 * j; }
    if (d0 < 7168) return 3072 + (d0 - 6144);
    if (d0 < 8192) return 7184 + (d0 - 7168);
    return 8208 + (d0 - 8192);
}

__device__ __forceinline__ void p0_prologue(Frame& F) {
    LAS float* sC = (LAS float*)(F.lds + 8 * 8448);
    for (int i = F.tid; i < 2 * D; i += 512) sC[i] = siluf_(F.c[i]);
    __syncthreads();
    const int gw = F.vcu * NWAVES + F.wave, NGW = F.G * NWAVES;
    float* modv = (float*)(F.ws + CTL_MODACC);
    LAS float* sPart = sC + 2 * D;
    for (int cg = blockIdx.x; cg < 96; cg += F.G) {
        const int col = cg * 64 + F.lane, k0 = F.wave * 128;
        float a0 = 0.f, a1 = 0.f;
#pragma unroll 16
        for (int k = 0; k < 128; ++k) { const float wv = F.w_ada[(size_t)(k0 + k) * 6144 + col]; a0 += sC[k0 + k] * wv; a1 += sC[D + k0 + k] * wv; }
        sPart[F.wave * 128 + F.lane] = a0; sPart[F.wave * 128 + 64 + F.lane] = a1;
        __syncthreads();
        if (F.wave < 2) { float t = 0.f;
#pragma unroll
            for (int q = 0; q < 8; ++q) t += sPart[q * 128 + F.wave * 64 + F.lane];
            modv[F.wave * 6144 + col] = t + F.b_ada[col]; }
        __syncthreads();
    }
    LAS float* scr = (LAS float*)(F.lds + F.wave * 8448);
    constexpr int I_IN = 288 * 16, I_SQ = 32 * 16;
    for (int it = gw; it < I_IN + 3 * I_SQ; it += NGW) {
        int r = it;
        if (r < I_IN) { const int dg = r % 288, kb = r / 288, d0 = dg * 32; bf16* dst = (d0 < 6144) ? (bf16*)(F.ws + WS_WINA) : (bf16*)(F.ws + WS_WINB);
            transpose_item(F.w_in, IN_TOTAL, win_src_col(d0), kb * 64, dst, d0 < 6144 ? d0 : d0 - 6144, D, scr, F.lane); continue; }
        r -= I_IN;
        if (r < I_SQ) { transpose_item(F.w_proj_a, D, (r % 32) * 32, (r / 32) * 64, (bf16*)(F.ws + WS_WA), (r % 32) * 32, D, scr, F.lane); continue; } r -= I_SQ;
        if (r < I_SQ) { transpose_item(F.w_proj_b, D, (r % 32) * 32, (r / 32) * 64, (bf16*)(F.ws + WS_WB), (r % 32) * 32, D, scr, F.lane); continue; } r -= I_SQ;
        transpose_item(F.w_out, D, (r % 32) * 32, (r / 32) * 64, (bf16*)(F.ws + WS_WO), (r % 32) * 32, D, scr, F.lane);
    }
}
__device__ __forceinline__ void p_moe_weights(Frame& F) {
    LAS float* scr = (LAS float*)(F.lds + F.wave * 8448);
    const int gw = F.vcu * NWAVES + F.wave, NGW = F.G * NWAVES;
    constexpr int I13 = NE * 32 * 16, I2 = NE * 32 * 8;
    for (int it = gw; it < I13 + I2; it += NGW) {
        if (it < I13) { const int e = it / 512, r = it % 512, dg = r % 32, kb = r / 32, d0 = dg * 32, j = d0 >> 8, rr = d0 & 255;
            if (rr < 128) transpose_item(F.w1 + (size_t)e * D * DE, DE, 128 * j + (rr & 127), kb * 64, (bf16*)(F.ws + WS_W13) + (size_t)e * D * D, d0, D, scr, F.lane);
            else          transpose_item(F.w3 + (size_t)e * D * DE, DE, 128 * j + (rr & 127), kb * 64, (bf16*)(F.ws + WS_W13) + (size_t)e * D * D, d0, D, scr, F.lane);
        } else { const int r2 = it - I13, e = r2 / 256, r = r2 % 256, dg = r % 32, kb = r / 32;
            transpose_item(F.w2 + (size_t)e * DE * D, D, dg * 32, kb * 64, (bf16*)(F.ws + WS_W2) + (size_t)e * D * DE, dg * 32, DE, scr, F.lane); }
    }
}

__device__ __forceinline__ void p1_norm1(Frame& F) {
    LAS float* sBA = (LAS float*)F.lds;
    for (int i = F.tid; i < 16 * D; i += 512) { const int k = i >> 4, o = i & 15; sBA[o * D + k] = F.w_in[(size_t)k * IN_TOTAL + 4096 + o]; }
    __syncthreads();
    const int gw = F.vcu * NWAVES + F.wave, NGW = F.G * NWAVES;
    bf16* H = (bf16*)F.out; float* BG = (float*)(F.ws + WS_BG);
    for (int m = gw; m < M; m += NGW) {
        const int b = m / T;
        const f32x4* xr = (const f32x4*)(F.x + (size_t)m * D) + F.lane;
        f32x4 v[4]; float s = 0.f;
#pragma unroll
        for (int j = 0; j < 4; ++j) { v[j] = xr[64 * j]; s += (v[j].x * v[j].x + v[j].y * v[j].y) + (v[j].z * v[j].z + v[j].w * v[j].w); }
        const float rstd = __frsqrt_rn(wave_sum(s) * (1.f / D) + EPS);
        f32x4 hv[4];
#pragma unroll
        for (int j = 0; j < 4; ++j) { const int col = 256 * j + 4 * F.lane;
            const f32x4 g1 = *(const f32x4*)(F.norm1_g + col);
#pragma unroll
            for (int e = 0; e < 4; ++e) hv[j][e] = v[j][e] * rstd * g1[e] * (1.0f + mod_at(F, b, D + col + e)) + mod_at(F, b, col + e);
            *(v2u*)(H + (size_t)m * D + col) = (v2u){pk2(hv[j][0], hv[j][1]), pk2(hv[j][2], hv[j][3])};
        }
        float val = 0.f;
#pragma unroll 2
        for (int o = 0; o < 16; ++o) { float p = 0.f;
#pragma unroll
            for (int j = 0; j < 4; ++j) { const f32x4 w = *(const LAS f32x4*)(sBA + o * D + 256 * j + 4 * F.lane); p += (hv[j][0] * w[0] + hv[j][1] * w[1]) + (hv[j][2] * w[2] + hv[j][3] * w[3]); }
            p = wave_sum(p); val = (F.lane == o) ? p : val; }
        if (F.lane < 16) {
            float r;
            if (F.lane < 8) r = sigmoidf_(val);
            else { const int hh = F.lane - 8; const float xx = val + F.dt_bias[hh]; const float sp = xx > 20.f ? xx : log1pf(__expf(xx)); r = -__expf(F.a_log[hh]) * sp; }
            BG[(size_t)m * 16 + F.lane] = r;
        }
    }
}

__device__ __forceinline__ void p3a_ybp(Frame& F) {
    const bf16* SB = (const bf16*)(F.ws + WS_SB); const bf16* P = (const bf16*)(F.ws + WS_P); bf16* YBP = (bf16*)F.out + (size_t)M * D;
    const size_t total = (size_t)M * (D / 8);
    for (size_t i = (size_t)blockIdx.x * 512 + F.tid; i < total; i += (size_t)F.G * 512) {
        const int m = (int)(i >> 7), c8 = (int)(i & 127) * 8, t = m % T;
        f32x4 a0 = {0.f, 0.f, 0.f, 0.f}, a1 = a0;
#pragma unroll
        for (int j = 0; j < 3; ++j) { const int tt = t - 2 + j;
            if (tt >= 0) { f32x4 p0, p1; unpack8(*(const v4u*)(P + (size_t)(m - 2 + j) * D + c8), p0, p1);
                a0 += *(const f32x4*)(F.conv_sc_w + j * D + c8) * p0; a1 += *(const f32x4*)(F.conv_sc_w + j * D + c8 + 4) * p1; } }
        f32x4 s0, s1; unpack8(*(const v4u*)(SB + (size_t)m * D + c8), s0, s1);
        *(v4u*)(YBP + (size_t)m * D + c8) = pack8(s0 * a0, s1 * a1);
    }
}

__device__ __forceinline__ void p3b_chunk(Frame& F, int unit) {
    const int n = unit % NCH, bh = unit / NCH, h = bh % NH, b = bh / NH, t0 = n * CH, row0 = b * T + t0;
    LAS float* sq = (LAS float*)F.lds; LAS float* sk = sq + 64 * 129; LAS float* sv = sk + 64 * 129; LAS float* sA = sv + 64 * 129; LAS float* sT = sA + 64 * 65;
    LAS float* sgc = sT + 64 * 65; LAS float* sbeta = sgc + 64;
    const bf16* QKV = (const bf16*)(F.ws + WS_QKV); const float* BG = (const float*)(F.ws + WS_BG);
    for (int idx = F.tid; idx < 3 * 64 * 128; idx += 512) {
        const int sec = idx >> 13, r = (idx >> 7) & 63, c = idx & 127, gcol = sec * 1024 + h * 128 + c;
        float a = 0.f;
#pragma unroll
        for (int j = 0; j < 4; ++j) { const int tt = t0 + r - 3 + j; if (tt >= 0) a += F.conv_qkv_w[j * NQKV + gcol] * bf2f(QKV[(size_t)(b * T + tt) * NQKV + gcol]); }
        sq[sec * (64 * 129) + r * 129 + c] = siluf_(a);
    }
    if (F.tid < 64) { sgc[F.tid] = BG[(size_t)(row0 + F.tid) * 16 + 8 + h]; sbeta[F.tid] = BG[(size_t)(row0 + F.tid) * 16 + h]; }
    __syncthreads();
    for (int r = F.wave * 8; r < F.wave * 8 + 8; ++r) {
        const float q0 = sq[r * 129 + F.lane], q1 = sq[r * 129 + 64 + F.lane], k0 = sk[r * 129 + F.lane], k1 = sk[r * 129 + 64 + F.lane];
        const float qs = __frsqrt_rn(wave_sum(q0 * q0 + q1 * q1) + EPS) * 0.08838834764831845f, ks = __frsqrt_rn(wave_sum(k0 * k0 + k1 * k1) + EPS);
        sq[r * 129 + F.lane] = q0 * qs; sq[r * 129 + 64 + F.lane] = q1 * qs; sk[r * 129 + F.lane] = k0 * ks; sk[r * 129 + 64 + F.lane] = k1 * ks;
    }
    if (F.tid == 0) { float a = 0.f; for (int i = 0; i < 64; ++i) { a += sgc[i]; sgc[i] = a; } }
    __syncthreads();
    bf16* INo = (bf16*)(F.ws + WS_IN) + (size_t)unit * 4096;
    for (int idx = F.tid; idx < 4096; idx += 512) {
        const int i = idx >> 6, j = idx & 63; float av = 0.f, iv = 0.f;
        if (j <= i) { float dkk = 0.f, dqk = 0.f;
            for (int d = 0; d < 128; ++d) { const float kj = sk[j * 129 + d]; dkk += sk[i * 129 + d] * kj; dqk += sq[i * 129 + d] * kj; }
            const float dec = __expf(sgc[i] - sgc[j]); iv = dqk * dec; av = (j < i) ? sbeta[i] * dkk * dec : 0.f; }
        sA[i * 65 + j] = av; INo[idx] = (bf16)f2bf(iv);
    }
    __syncthreads();
    if (F.tid < 64) { const int c = F.tid;
        for (int i = 0; i < 64; ++i) { float t = 0.f;
            for (int j = 0; j < i; ++j) t -= sA[i * 65 + j] * sT[j * 65 + c];
            sT[i * 65 + c] = (i == c) ? 1.0f : ((i < c) ? 0.f : t); } }
    __syncthreads();
    bf16* UTo = (bf16*)(F.ws + WS_UT) + (size_t)unit * 8192; bf16* Wo = (bf16*)(F.ws + WS_W) + (size_t)unit * 8192;
    bf16* QDo = (bf16*)(F.ws + WS_QD) + (size_t)unit * 8192; bf16* KDTo = (bf16*)(F.ws + WS_KDT) + (size_t)unit * 8192;
    const float glast = sgc[63];
    for (int idx = F.tid; idx < 8192; idx += 512) {
        { const int dv = idx >> 6, i = idx & 63; float u = 0.f;
          for (int j = 0; j <= i; ++j) u += sT[i * 65 + j] * sbeta[j] * sv[j * 129 + dv];
          UTo[idx] = (bf16)f2bf(u);
          KDTo[idx] = (bf16)f2bf(sk[i * 129 + dv] * __expf(glast - sgc[i])); }
        { const int i = idx >> 7, dk = idx & 127; float w = 0.f;
          for (int j = 0; j <= i; ++j) w += sT[i * 65 + j] * sbeta[j] * __expf(sgc[j]) * sk[j * 129 + dk];
          Wo[idx] = (bf16)f2bf(w);
          QDo[idx] = (bf16)f2bf(sq[i * 129 + dk] * __expf(sgc[i])); }
    }
    if (F.tid == 0) ((float*)(F.ws + WS_DEC))[unit] = __expf(glast);
    __syncthreads();
}

__device__ __forceinline__ void p4_scan(Frame& F, int item) {
    const int bh = item >> 2, sl = item & 3, h = bh % NH, b = bh / NH;
    LAS float* sS = (LAS float*)F.lds;
    LAS float* sV = sS + 128 * 33;
    LAS bf16* sW = (LAS bf16*)(sV + 64 * 33);
    LAS bf16* sQ = sW + 64 * 136;
    LAS bf16* sK = sQ + 64 * 136;
    LAS bf16* sI = sK + 128 * 72;
    for (int i = F.tid; i < 128 * 33; i += 512) sS[i] = 0.f;
    bf16* OR = (bf16*)(F.ws + WS_OR); float* SSQ = (float*)(F.ws + CTL_SSQ);
    const int c = F.tid >> 3, d4 = (F.tid & 7) * 4, dk2 = F.tid >> 2, d8 = (F.tid & 3) * 8;
    for (int n = 0; n < NCH; ++n) {
        const int unit = bh * NCH + n;
        const bf16* Wg = (const bf16*)(F.ws + WS_W) + (size_t)unit * 8192; const bf16* Qg = (const bf16*)(F.ws + WS_QD) + (size_t)unit * 8192;
        const bf16* Kg = (const bf16*)(F.ws + WS_KDT) + (size_t)unit * 8192; const bf16* Ig = (const bf16*)(F.ws + WS_IN) + (size_t)unit * 4096;
        const bf16* Ug = (const bf16*)(F.ws + WS_UT) + (size_t)unit * 8192;
        __syncthreads();
        for (int i = F.tid; i < 1024; i += 512) { const int r = i >> 4, c8 = (i & 15) * 8;
            *(LAS v4u*)(sW + r * 136 + c8) = *(const v4u*)(Wg + r * 128 + c8); *(LAS v4u*)(sQ + r * 136 + c8) = *(const v4u*)(Qg + r * 128 + c8); }
        for (int i = F.tid; i < 1024; i += 512) { const int r = i >> 3, c8 = (i & 7) * 8; *(LAS v4u*)(sK + r * 72 + c8) = *(const v4u*)(Kg + r * 64 + c8); }
        { const int r = F.tid >> 3, c8 = (F.tid & 7) * 8; *(LAS v4u*)(sI + r * 72 + c8) = *(const v4u*)(Ig + r * 64 + c8); }
        const float dec = ((const float*)(F.ws + WS_DEC))[unit];
        __syncthreads();
        float pS[4] = {0.f, 0.f, 0.f, 0.f}, qS[4] = {0.f, 0.f, 0.f, 0.f};
        for (int dk = 0; dk < 128; ++dk) { const float wv = bf2f(sW[c * 136 + dk]), qv = bf2f(sQ[c * 136 + dk]);
#pragma unroll
            for (int e = 0; e < 4; ++e) { const float s = sS[dk * 33 + d4 + e]; pS[e] += wv * s; qS[e] += qv * s; } }
        float vn[4];
#pragma unroll
        for (int e = 0; e < 4; ++e) { vn[e] = bf2f(Ug[(sl * 32 + d4 + e) * 64 + c]) - pS[e]; sV[c * 33 + d4 + e] = vn[e]; }
        __syncthreads();
        float o[4] = {qS[0], qS[1], qS[2], qS[3]};
        for (int j = 0; j < 64; ++j) { const float iv = bf2f(sI[c * 72 + j]);
#pragma unroll
            for (int e = 0; e < 4; ++e) o[e] += iv * sV[j * 33 + d4 + e]; }
        const int row = b * T + n * CH + c;
        *(v2u*)(OR + (size_t)row * D + h * 128 + sl * 32 + d4) = (v2u){pk2(o[0], o[1]), pk2(o[2], o[3])};
        float ss = (o[0] * o[0] + o[1] * o[1]) + (o[2] * o[2] + o[3] * o[3]);
        ss += __shfl_xor(ss, 1); ss += __shfl_xor(ss, 2); ss += __shfl_xor(ss, 4);
        if ((F.tid & 7) == 0) atomicAdd(SSQ + (size_t)row * 8 + h, ss);
        float sn[8];
#pragma unroll
        for (int e = 0; e < 8; ++e) sn[e] = dec * sS[dk2 * 33 + d8 + e];
        for (int cc = 0; cc < 64; ++cc) { const float kv = bf2f(sK[dk2 * 72 + cc]);
#pragma unroll
            for (int e = 0; e < 8; ++e) sn[e] += kv * sV[cc * 33 + d8 + e]; }
        __syncthreads();
#pragma unroll
        for (int e = 0; e < 8; ++e) sS[dk2 * 33 + d8 + e] = sn[e];
    }
    __syncthreads();
}


typedef pg8::bf16x8 bx8;
#define MFMA16(a, b, c) __builtin_amdgcn_mfma_f32_16x16x32_bf16(a, b, c, 0, 0, 0)
__device__ __forceinline__ v2u pack4(const f32x4 a) { v2u r; r.x = cvt_pk_bf16(a[0], a[1]); r.y = cvt_pk_bf16(a[2], a[3]); return r; }
__device__ __forceinline__ void p4_scan_fast(Frame& F, int bh) {
    const int h = bh % NH, b = bh / NH, w = F.wave, l15 = F.lane & 15, lq = F.lane >> 4, ct = w >> 1, dvh = w & 1;
    LAS bf16* sST = (LAS bf16*)F.lds;
    LAS bf16* sVT = sST + 128 * 136;
    LAS float* sSS = (LAS float*)(sVT + 128 * 72);
    LAS float* sDEC = sSS + 128;
    if (F.tid < NCH) sDEC[F.tid] = ((const float*)(F.ws + WS_DEC))[bh * NCH + F.tid];
    for (int i = F.tid; i < 128 * 136 / 2; i += 512) ((LAS unsigned*)sST)[i] = 0u;
    const bf16* Wg = (const bf16*)(F.ws + WS_W) + (size_t)bh * NCH * 8192 + (16 * ct + l15) * 128 + 8 * lq;
    const bf16* Qg = (const bf16*)(F.ws + WS_QD) + (size_t)bh * NCH * 8192 + (16 * ct + l15) * 128 + 8 * lq;
    const bf16* Ig = (const bf16*)(F.ws + WS_IN) + (size_t)bh * NCH * 4096 + (16 * ct + l15) * 64 + 8 * lq;
    const bf16* Kg = (const bf16*)(F.ws + WS_KDT) + (size_t)bh * NCH * 8192 + (16 * w + l15) * 64 + 8 * lq;
    const bf16* Ug = (const bf16*)(F.ws + WS_UT) + (size_t)bh * NCH * 8192 + (16 * 4 * dvh + l15) * 64 + 16 * ct + 4 * lq;
    bf16* OR = (bf16*)(F.ws + WS_OR);
    bx8 fW[4], fQ[4], fI[2], fK[2]; v2u fU[4];
#pragma unroll
    for (int ks = 0; ks < 4; ++ks) { fW[ks] = *(const bx8*)(Wg + 32 * ks); fQ[ks] = *(const bx8*)(Qg + 32 * ks); fU[ks] = *(const v2u*)(Ug + ks * 16 * 64); }
#pragma unroll
    for (int ks = 0; ks < 2; ++ks) { fI[ks] = *(const bx8*)(Ig + 32 * ks); fK[ks] = *(const bx8*)(Kg + 32 * ks); }
    f32x4 S[8], gn[4];
#pragma unroll
    for (int t = 0; t < 8; ++t) S[t] = (f32x4){0.f, 0.f, 0.f, 0.f};
#pragma unroll
    for (int t = 0; t < 4; ++t) gn[t] = *(const f32x4*)(F.onorm_g + 16 * (4 * dvh + t) + 4 * lq);
    __syncthreads();
    for (int n = 0; n < NCH; ++n) {
        const float dec = sDEC[n];
        const int nn = (n + 1 < NCH) ? 1 : 0;
        f32x4 pS[4], qS[4];
#pragma unroll
        for (int t = 0; t < 4; ++t) { bx8 fS[4];
#pragma unroll
            for (int ks = 0; ks < 4; ++ks) fS[ks] = *(const LAS bx8*)(sST + (16 * (4 * dvh + t) + l15) * 136 + 32 * ks + 8 * lq);
            f32x4 p = {0.f, 0.f, 0.f, 0.f}, q = {0.f, 0.f, 0.f, 0.f};
#pragma unroll
            for (int ks = 0; ks < 4; ++ks) { p = MFMA16(fW[ks], fS[ks], p); q = MFMA16(fS[ks], fQ[ks], q); }
            pS[t] = p; qS[t] = q; }
#pragma unroll
        for (int t = 0; t < 4; ++t) { const f32x4 u = {bflo(fU[t].x), bfhi(fU[t].x), bflo(fU[t].y), bfhi(fU[t].y)};
            *(LAS v2u*)(sVT + (16 * (4 * dvh + t) + l15) * 72 + 16 * ct + 4 * lq) = pack4(u - pS[t]); }
        Wg += nn * 8192; Qg += nn * 8192; Ug += nn * 8192;
#pragma unroll
        for (int ks = 0; ks < 4; ++ks) { fW[ks] = *(const bx8*)(Wg + 32 * ks); fQ[ks] = *(const bx8*)(Qg + 32 * ks); fU[ks] = *(const v2u*)(Ug + ks * 16 * 64); }
        __syncthreads();
        float ss = 0.f;
#pragma unroll
        for (int t = 0; t < 4; ++t) {
#pragma unroll
            for (int ks = 0; ks < 2; ++ks) { const bx8 fV = *(const LAS bx8*)(sVT + (16 * (4 * dvh + t) + l15) * 72 + 32 * ks + 8 * lq); qS[t] = MFMA16(fV, fI[ks], qS[t]); }
            ss += (qS[t][0] * qS[t][0] + qS[t][1] * qS[t][1]) + (qS[t][2] * qS[t][2] + qS[t][3] * qS[t][3]); }
        ss += __shfl_xor(ss, 16); ss += __shfl_xor(ss, 32);
        if (lq == 0) sSS[dvh * 64 + 16 * ct + l15] = ss;
        Ig += nn * 4096;
#pragma unroll
        for (int ks = 0; ks < 2; ++ks) fI[ks] = *(const bx8*)(Ig + 32 * ks);
#pragma unroll
        for (int t = 0; t < 8; ++t) { S[t] = S[t] * dec;
#pragma unroll
            for (int ks = 0; ks < 2; ++ks) { const bx8 fV = *(const LAS bx8*)(sVT + (16 * t + l15) * 72 + 32 * ks + 8 * lq); S[t] = MFMA16(fK[ks], fV, S[t]); }
            *(LAS v2u*)(sST + (16 * t + l15) * 136 + 16 * w + 4 * lq) = pack4(S[t]); }
        Kg += nn * 8192;
#pragma unroll
        for (int ks = 0; ks < 2; ++ks) fK[ks] = *(const bx8*)(Kg + 32 * ks);
        __syncthreads();
        const float rstd = __frsqrt_rn((sSS[16 * ct + l15] + sSS[64 + 16 * ct + l15]) * (1.0f / 128.0f) + EPS);
        bf16* orow = OR + (size_t)(b * T + n * CH + 16 * ct + l15) * D + h * 128 + 16 * 4 * dvh + 4 * lq;
#pragma unroll
        for (int t = 0; t < 4; ++t) *(v2u*)(orow + 16 * t) = pack4(qS[t] * rstd * gn[t]);
    }
    __syncthreads();
}


#define MFMA_F32(a, b, c) __builtin_amdgcn_mfma_f32_16x16x4f32(a, b, c, 0, 0, 0)
__device__ __forceinline__ void solve_block(LAS float* sA, LAS float* sT, int bi, int bj, int l15, int lq) {
    f32x4 y = {0.f, 0.f, 0.f, 0.f};
    for (int km = bj; km < bi; ++km)
#pragma unroll
        for (int kb = 0; kb < 4; ++kb) y = MFMA_F32(sA[(16 * bi + l15) * 68 + 16 * km + 4 * kb + lq], sT[(16 * km + 4 * kb + lq) * 68 + 16 * bj + l15], y);
    f32x4 z = {0.f, 0.f, 0.f, 0.f};
#pragma unroll
    for (int e = 0; e < 4; ++e) z = MFMA_F32(sT[(16 * bi + l15) * 68 + 16 * bi + 4 * lq + e], y[e], z);
#pragma unroll
    for (int e = 0; e < 4; ++e) sT[(16 * bi + 4 * lq + e) * 68 + 16 * bj + l15] = -z[e];
}
__device__ __forceinline__ void p3b_fast(Frame& F, int unit) {
    const int n = unit % NCH, bh = unit / NCH, h = bh % NH, b = bh / NH, t0 = n * CH, row0 = b * T + t0;
    const int tid = F.tid, w = F.wave, lane = F.lane, l15 = lane & 15, lq = lane >> 4;
    LAS bf16* sQ = (LAS bf16*)F.lds; LAS bf16* sK = sQ + 64 * 136; LAS bf16* sKG = sK + 64 * 136; LAS bf16* sVB = sKG + 128 * 72;
    LAS float* sA = (LAS float*)(sVB + 128 * 72); LAS float* sT = sA + 64 * 68; LAS bf16* sTb = (LAS bf16*)(sT + 64 * 68); LAS float* sgc = (LAS float*)(sTb + 64 * 72);
    const bf16* QKV = (const bf16*)(F.ws + WS_QKV); const float* BG = (const float*)(F.ws + WS_BG);
    bf16* INo = (bf16*)(F.ws + WS_IN) + (size_t)unit * 4096; bf16* UTo = (bf16*)(F.ws + WS_UT) + (size_t)unit * 8192; bf16* Wo = (bf16*)(F.ws + WS_W) + (size_t)unit * 8192;
    bf16* QDo = (bf16*)(F.ws + WS_QD) + (size_t)unit * 8192; bf16* KDTo = (bf16*)(F.ws + WS_KDT) + (size_t)unit * 8192;
    if (w == 0) {
        const float g = BG[(size_t)(row0 + lane) * 16 + 8 + h], bt = BG[(size_t)(row0 + lane) * 16 + h];
        float s = g;
#pragma unroll
        for (int o = 1; o < 64; o <<= 1) { const float t = __shfl_up(s, o); if (lane >= o) s += t; }
        const float gl = __shfl(s, 63);
        sgc[lane] = s; sgc[64 + lane] = bt; sgc[128 + lane] = __expf(s); sgc[192 + lane] = __expf(gl - s);
        if (lane == 0) ((float*)(F.ws + WS_DEC))[unit] = __expf(gl);
    }
    for (int i = tid; i < 64 * 68; i += 512) sT[i] = 0.f;
    __syncthreads();
    if (tid < 384) {
        const int rs = tid / 48, cg = tid % 48, sec = cg >> 4, c8 = (cg & 15) * 8, r0 = 8 * rs, gcol = sec * 1024 + h * 128 + c8;
        f32x4 wt[4][2];
#pragma unroll
        for (int j = 0; j < 4; ++j) { wt[j][0] = *(const f32x4*)(F.conv_qkv_w + j * NQKV + gcol); wt[j][1] = *(const f32x4*)(F.conv_qkv_w + j * NQKV + gcol + 4); }
        v4u raw[11];
#pragma unroll
        for (int i = 0; i < 11; ++i) { const int tt = t0 + r0 - 3 + i; raw[i] = (tt >= 0) ? *(const v4u*)(QKV + (size_t)(b * T + tt) * NQKV + gcol) : (v4u){0u, 0u, 0u, 0u}; }
        f32x4 o0[8], o1[8];
#pragma unroll
        for (int r = 0; r < 8; ++r) { f32x4 a0 = {0.f, 0.f, 0.f, 0.f}, a1 = a0;
#pragma unroll
            for (int j = 0; j < 4; ++j) { f32x4 x0, x1; unpack8(raw[r + j], x0, x1); a0 += wt[j][0] * x0; a1 += wt[j][1] * x1; }
#pragma unroll
            for (int e = 0; e < 4; ++e) { a0[e] = siluf_(a0[e]); a1[e] = siluf_(a1[e]); }
            float ss = (a0[0] * a0[0] + a0[1] * a0[1]) + (a0[2] * a0[2] + a0[3] * a0[3]) + (a1[0] * a1[0] + a1[1] * a1[1]) + (a1[2] * a1[2] + a1[3] * a1[3]);
            ss += __shfl_xor(ss, 1); ss += __shfl_xor(ss, 2); ss += __shfl_xor(ss, 4); ss += __shfl_xor(ss, 8);
            const float sc = (sec == 2) ? 1.0f : __frsqrt_rn(ss + EPS) * (sec == 0 ? 0.08838834764831845f : 1.0f);
            o0[r] = a0 * sc; o1[r] = a1 * sc; }
        if (sec == 0) {
#pragma unroll
            for (int r = 0; r < 8; ++r) { *(LAS v4u*)(sQ + (r0 + r) * 136 + c8) = pack8(o0[r], o1[r]); const float eg = sgc[128 + r0 + r];
                *(v4u*)(QDo + (r0 + r) * 128 + c8) = pack8(o0[r] * eg, o1[r] * eg); }
        } else if (sec == 1) {
            float fk[8], fd[8];
#pragma unroll
            for (int r = 0; r < 8; ++r) { *(LAS v4u*)(sK + (r0 + r) * 136 + c8) = pack8(o0[r], o1[r]); fk[r] = sgc[64 + r0 + r] * sgc[128 + r0 + r]; fd[r] = sgc[192 + r0 + r]; }
#pragma unroll
            for (int e = 0; e < 4; ++e) {
                { const f32x4 a = {o0[0][e] * fk[0], o0[1][e] * fk[1], o0[2][e] * fk[2], o0[3][e] * fk[3]}, bq = {o0[4][e] * fk[4], o0[5][e] * fk[5], o0[6][e] * fk[6], o0[7][e] * fk[7]};
                  *(LAS v4u*)(sKG + (c8 + e) * 72 + r0) = pack8(a, bq);
                  const f32x4 c = {o0[0][e] * fd[0], o0[1][e] * fd[1], o0[2][e] * fd[2], o0[3][e] * fd[3]}, d = {o0[4][e] * fd[4], o0[5][e] * fd[5], o0[6][e] * fd[6], o0[7][e] * fd[7]};
                  *(v4u*)(KDTo + (c8 + e) * 64 + r0) = pack8(c, d); }
                { const f32x4 a = {o1[0][e] * fk[0], o1[1][e] * fk[1], o1[2][e] * fk[2], o1[3][e] * fk[3]}, bq = {o1[4][e] * fk[4], o1[5][e] * fk[5], o1[6][e] * fk[6], o1[7][e] * fk[7]};
                  *(LAS v4u*)(sKG + (c8 + 4 + e) * 72 + r0) = pack8(a, bq);
                  const f32x4 c = {o1[0][e] * fd[0], o1[1][e] * fd[1], o1[2][e] * fd[2], o1[3][e] * fd[3]}, d = {o1[4][e] * fd[4], o1[5][e] * fd[5], o1[6][e] * fd[6], o1[7][e] * fd[7]};
                  *(v4u*)(KDTo + (c8 + 4 + e) * 64 + r0) = pack8(c, d); }
            }
        } else {
            float fb[8];
#pragma unroll
            for (int r = 0; r < 8; ++r) fb[r] = sgc[64 + r0 + r];
#pragma unroll
            for (int e = 0; e < 4; ++e) {
                { const f32x4 a = {o0[0][e] * fb[0], o0[1][e] * fb[1], o0[2][e] * fb[2], o0[3][e] * fb[3]}, bq = {o0[4][e] * fb[4], o0[5][e] * fb[5], o0[6][e] * fb[6], o0[7][e] * fb[7]};
                  *(LAS v4u*)(sVB + (c8 + e) * 72 + r0) = pack8(a, bq); }
                { const f32x4 a = {o1[0][e] * fb[0], o1[1][e] * fb[1], o1[2][e] * fb[2], o1[3][e] * fb[3]}, bq = {o1[4][e] * fb[4], o1[5][e] * fb[5], o1[6][e] * fb[6], o1[7][e] * fb[7]};
                  *(LAS v4u*)(sVB + (c8 + 4 + e) * 72 + r0) = pack8(a, bq); }
            }
        }
    }
    __syncthreads();
    {
        const int jt = w & 3, itp = w >> 2;
        bx8 ak[4];
#pragma unroll
        for (int ks = 0; ks < 4; ++ks) ak[ks] = *(const LAS bx8*)(sK + (16 * jt + l15) * 136 + 32 * ks + 8 * lq);
#pragma unroll
        for (int ii = 0; ii < 2; ++ii) { const int it = 2 * itp + ii, ci = 16 * it + l15;
            f32x4 xk = {0.f, 0.f, 0.f, 0.f}, xq = xk;
#pragma unroll
            for (int ks = 0; ks < 4; ++ks) { const bx8 bk = *(const LAS bx8*)(sK + ci * 136 + 32 * ks + 8 * lq), bq = *(const LAS bx8*)(sQ + ci * 136 + 32 * ks + 8 * lq);
                xk = MFMA16(ak[ks], bk, xk); xq = MFMA16(ak[ks], bq, xq); }
            const float gi = sgc[ci], bi = sgc[64 + ci];
            f32x4 av, iv;
#pragma unroll
            for (int e = 0; e < 4; ++e) { const int cj = 16 * jt + 4 * lq + e; const float dec = __expf(gi - sgc[cj]);
                av[e] = (cj < ci) ? bi * xk[e] * dec : 0.f; iv[e] = (cj <= ci) ? xq[e] * dec : 0.f; }
            *(LAS f32x4*)(sA + ci * 68 + 16 * jt + 4 * lq) = av;
            *(v2u*)(INo + ci * 64 + 16 * jt + 4 * lq) = pack4(iv); }
    }
    __syncthreads();
    if (w == 0) {
        const int blk = lq, c = l15; float t[16];
#pragma unroll
        for (int i = 0; i < 16; ++i) { float s = 0.f;
#pragma unroll
            for (int jb = 0; jb < (i + 3) / 4; ++jb) { const f32x4 a4 = *(const LAS f32x4*)(sA + (16 * blk + i) * 68 + 16 * blk + 4 * jb);
#pragma unroll
                for (int e = 0; e < 4; ++e) if (4 * jb + e < i) s -= a4[e] * t[4 * jb + e]; }
            t[i] = (i == c) ? 1.0f : s;
            sT[(16 * blk + i) * 68 + 16 * blk + c] = t[i]; }
    }
    __syncthreads();
    if (w < 3) solve_block(sA, sT, w + 1, w, l15, lq);
    __syncthreads();
    if (w < 2) solve_block(sA, sT, w + 2, w, l15, lq);
    __syncthreads();
    if (w < 1) solve_block(sA, sT, 3, 0, l15, lq);
    __syncthreads();
    { const int i = tid >> 3, j8 = (tid & 7) * 8; *(LAS v4u*)(sTb + i * 72 + j8) = pack8(*(const LAS f32x4*)(sT + i * 68 + j8), *(const LAS f32x4*)(sT + i * 68 + j8 + 4)); }
    __syncthreads();
    {
        bx8 bv[2], ag[2];
#pragma unroll
        for (int ks = 0; ks < 2; ++ks) { bv[ks] = *(const LAS bx8*)(sVB + (16 * w + l15) * 72 + 32 * ks + 8 * lq); ag[ks] = *(const LAS bx8*)(sKG + (16 * w + l15) * 72 + 32 * ks + 8 * lq); }
#pragma unroll
        for (int it = 0; it < 4; ++it) { f32x4 u = {0.f, 0.f, 0.f, 0.f}, ww = u;
#pragma unroll
            for (int ks = 0; ks < 2; ++ks) { const bx8 ft = *(const LAS bx8*)(sTb + (16 * it + l15) * 72 + 32 * ks + 8 * lq); u = MFMA16(ft, bv[ks], u); ww = MFMA16(ag[ks], ft, ww); }
            *(v2u*)(UTo + (16 * w + l15) * 64 + 16 * it + 4 * lq) = pack4(u);
            *(v2u*)(Wo + (16 * it + l15) * 128 + 16 * w + 4 * lq) = pack4(ww); }
    }
    __syncthreads();
}

__device__ __forceinline__ void p8_router(Frame& F) {
    const int gw = F.vcu * NWAVES + F.wave, NGW = F.G * NWAVES;
    bf16* H2 = (bf16*)(F.ws + WS_H2); int* TOKE = (int*)(F.ws + WS_TOKE); float* TOKW = (float*)(F.ws + WS_TOKW);
    for (int m = gw; m < M; m += NGW) {
        const int b = m / T;
        const f32x4* xr = (const f32x4*)(F.out + (size_t)m * D) + F.lane;
        f32x4 v[4]; float s = 0.f;
#pragma unroll
        for (int j = 0; j < 4; ++j) { v[j] = xr[64 * j]; s += (v[j].x * v[j].x + v[j].y * v[j].y) + (v[j].z * v[j].z + v[j].w * v[j].w); }
        const float rstd = __frsqrt_rn(wave_sum(s) * (1.f / D) + EPS);
        float gl[4] = {0.f, 0.f, 0.f, 0.f};
#pragma unroll
        for (int j = 0; j < 4; ++j) { const int col = 256 * j + 4 * F.lane;
            const f32x4 g2 = *(const f32x4*)(F.norm2_g + col);
#pragma unroll
            for (int e = 0; e < 4; ++e) { v[j][e] = v[j][e] * rstd * g2[e] * (1.0f + mod_at(F, b, 4 * D + col + e)) + mod_at(F, b, 3 * D + col + e);
                const f32x4 wg = *(const f32x4*)(F.w_group + (size_t)(col + e) * 4);
#pragma unroll
                for (int q = 0; q < 4; ++q) gl[q] += v[j][e] * wg[q]; }
            *(v2u*)(H2 + (size_t)m * D + col) = (v2u){pk2(v[j][0], v[j][1]), pk2(v[j][2], v[j][3])};
        }
#pragma unroll
        for (int q = 0; q < 4; ++q) gl[q] = wave_sum(gl[q]) + F.b_group[q];
        int gs = 0; float gm = gl[0];
#pragma unroll
        for (int q = 1; q < 4; ++q) if (gl[q] > gm) { gm = gl[q]; gs = q; }
        float den = 0.f;
#pragma unroll
        for (int q = 0; q < 4; ++q) den += __expf(gl[q] - gm);
        const float pg = 1.0f / den;
        float el[8] = {0.f, 0.f, 0.f, 0.f, 0.f, 0.f, 0.f, 0.f};
#pragma unroll
        for (int j = 0; j < 4; ++j) { const int col = 256 * j + 4 * F.lane;
#pragma unroll
            for (int e = 0; e < 4; ++e) { const float* wp = F.w_expert + (size_t)(col + e) * NE + gs * 8; const f32x4 w0 = *(const f32x4*)wp, w1 = *(const f32x4*)(wp + 4);
#pragma unroll
                for (int q = 0; q < 4; ++q) { el[q] += v[j][e] * w0[q]; el[4 + q] += v[j][e] * w1[q]; } } }
#pragma unroll
        for (int q = 0; q < 8; ++q) el[q] = wave_sum(el[q]) + F.b_expert[gs * 8 + q];
        int i0 = 0; float v0 = el[0];
#pragma unroll
        for (int q = 1; q < 8; ++q) if (el[q] > v0) { v0 = el[q]; i0 = q; }
        int i1 = -1; float v1 = -3.0e38f;
#pragma unroll
        for (int q = 0; q < 8; ++q) if (q != i0 && el[q] > v1) { v1 = el[q]; i1 = q; }
        const float e1 = __expf(v1 - v0), sw = 1.0f / (1.0f + e1);
        if (F.lane == 0) {
            const int ea = gs * 8 + i0, eb = gs * 8 + i1;
            TOKE[m * 2] = ea; TOKE[m * 2 + 1] = eb; TOKW[m * 2] = pg * sw; TOKW[m * 2 + 1] = pg * e1 * sw;
            atomicAdd(F.ctl + CW_CNT + ea, 1u);
            atomicAdd(F.ctl + CW_CNT + eb, 1u);
        }
    }
}

__device__ __forceinline__ int moe_tables(Frame& F) {
    volatile LAS int* ps = (volatile LAS int*)(F.lds + MISC_OFF + 64); volatile LAS int* te = (volatile LAS int*)(F.lds + MISC_OFF + 256);
    __syncthreads();
    if (F.tid == 0) { int a = 0;
        for (int e = 0; e < NE; ++e) { const int cnt = (int)__hip_atomic_load(F.ctl + CW_CNT + e, __ATOMIC_RELAXED, __HIP_MEMORY_SCOPE_AGENT); ps[e] = a; const int nb = (cnt + 255) >> 8;
            for (int r = 0; r < nb; ++r) te[(a >> 8) + r] = e; a += nb << 8; }
        ps[32] = a; }
    __syncthreads();
    return ps[32] >> 8;
}
__device__ __forceinline__ void p9_gather(Frame& F) {
    moe_tables(F);
    volatile LAS int* ps = (volatile LAS int*)(F.lds + MISC_OFF + 64);
    const int gw = F.vcu * NWAVES + F.wave, NGW = F.G * NWAVES;
    int* ROWTOK = (int*)(F.ws + WS_ROWTOK); float* ROWW = (float*)(F.ws + WS_ROWW);
    const int* TOKE = (const int*)(F.ws + WS_TOKE); const float* TOKW = (const float*)(F.ws + WS_TOKW);
    const bf16* H2 = (const bf16*)(F.ws + WS_H2); bf16* XS = (bf16*)(F.ws + WS_XS);
    for (int e = blockIdx.x; e < NE; e += F.G) { const int cnt = (int)__hip_atomic_load(F.ctl + CW_CNT + e, __ATOMIC_RELAXED, __HIP_MEMORY_SCOPE_AGENT);
        for (int r = ps[e] + cnt + F.tid; r < ps[e + 1]; r += 512) ROWTOK[r] = -1; }
    for (int m = gw; m < M; m += NGW) {
        int pos = 0;
        if (F.lane < 2) { const int e = TOKE[m * 2 + F.lane]; pos = ps[e] + (int)atomicAdd(F.ctl + CW_CUR + e, 1u); ROWTOK[pos] = m * 2 + F.lane; ROWW[pos] = TOKW[m * 2 + F.lane]; }
        const int p0 = __shfl(pos, 0), p1 = __shfl(pos, 1);
        const v4u a = *((const v4u*)(H2 + (size_t)m * D) + F.lane), bb = *((const v4u*)(H2 + (size_t)m * D) + 64 + F.lane);
        *((v4u*)(XS + (size_t)p0 * D) + F.lane) = a; *((v4u*)(XS + (size_t)p0 * D) + 64 + F.lane) = bb;
        *((v4u*)(XS + (size_t)p1 * D) + F.lane) = a; *((v4u*)(XS + (size_t)p1 * D) + 64 + F.lane) = bb;
    }
}
__device__ __forceinline__ void p12_final(Frame& F) {
    const int gw = F.vcu * NWAVES + F.wave, NGW = F.G * NWAVES;
    const bf16* YBUF = (const bf16*)(F.ws + WS_YBUF);
    for (int m = gw; m < M; m += NGW) {
        const int b = m / T;
        f32x4* xr = (f32x4*)(F.out + (size_t)m * D) + F.lane;
        f32x4 v[4]; float s = 0.f;
#pragma unroll
        for (int j = 0; j < 4; ++j) { const int col = 256 * j + 4 * F.lane; v[j] = xr[64 * j];
            const v2u y0 = *(const v2u*)(YBUF + (size_t)(2 * m) * D + col), y1 = *(const v2u*)(YBUF + (size_t)(2 * m + 1) * D + col);
            const f32x4 ys = {bflo(y0.x) + bflo(y1.x), bfhi(y0.x) + bfhi(y1.x), bflo(y0.y) + bflo(y1.y), bfhi(y0.y) + bfhi(y1.y)};
#pragma unroll
            for (int e = 0; e < 4; ++e) v[j][e] += mod_at(F, b, 5 * D + col + e) * ys[e];
            s += (v[j].x * v[j].x + v[j].y * v[j].y) + (v[j].z * v[j].z + v[j].w * v[j].w); }
        const float rstd = __frsqrt_rn(wave_sum(s) * (1.f / D) + EPS);
#pragma unroll
        for (int j = 0; j < 4; ++j) { const f32x4 gf = *(const f32x4*)(F.normf_g + 256 * j + 4 * F.lane); xr[64 * j] = v[j] * rstd * gf; }
    }
}

constexpr int NPH = 16;
struct Args { const float* in[23]; float* out; unsigned char* ws; int ph_lo, ph_hi; };
__global__ void __launch_bounds__(NWAVES * 64, 2) fwd(Args args) {
    extern __shared__ __attribute__((aligned(16))) unsigned char lds[];
    Frame F;
    F.lds = (LAS unsigned char*)lds; F.MISC = (volatile LAS unsigned*)(F.lds + MISC_OFF);
    F.tid = threadIdx.x; F.lane = F.tid & 63; F.wave = __builtin_amdgcn_readfirstlane(F.tid >> 6);
    F.G = gridDim.x; { const int bx = blockIdx.x; F.vcu = (F.G % 8 == 0) ? (bx % 8) * (F.G / 8) + bx / 8 : bx; }
    F.ws = args.ws; F.out = args.out; F.ctl = (unsigned*)(args.ws + WS_CTL);
    F.x = args.in[0]; F.c = args.in[1]; F.w_ada = args.in[2]; F.b_ada = args.in[3]; F.norm1_g = args.in[4]; F.w_in = args.in[5]; F.conv_qkv_w = args.in[6];
    F.a_log = args.in[7]; F.dt_bias = args.in[8]; F.onorm_g = args.in[9]; F.w_proj_a = args.in[10]; F.conv_sc_w = args.in[11]; F.w_proj_b = args.in[12]; F.w_out = args.in[13];
    F.norm2_g = args.in[14]; F.w_group = args.in[15]; F.b_group = args.in[16]; F.w_expert = args.in[17]; F.b_expert = args.in[18]; F.w1 = args.in[19]; F.w3 = args.in[20];
    F.w2 = args.in[21]; F.normf_g = args.in[22];
    if (F.tid < 4) F.MISC[F.tid] = 0u;
    __syncthreads();
    const int lo = args.ph_lo, hi = args.ph_hi;
    const bool fused = (hi - lo) > 1;
    XcdBarrier bar; bar.bar = F.ctl + CW_BAR; bar.x = 0; bar.st = F.MISC;
    if (fused) bar = xcd_barrier_post(F.ctl + CW_BAR, F.MISC);
#ifndef PH_MASK
#define PH_MASK 0xFFFF
#endif
#define IN(k) (((PH_MASK >> (k)) & 1) && lo <= (k) && (k) < hi)
#define SEAM(k) do { if (IN(k) && IN((k) + 1)) xcd_barrier(bar); } while (0)
    bf16* H = (bf16*)F.out; bf16* YBP = (bf16*)F.out + (size_t)M * D;

    if (IN(0)) { p0_prologue(F); } SEAM(0);
    if (IN(1)) { p1_norm1(F); } SEAM(1);
    if (IN(2)) {
        pg8::Gemm g{H, (const bf16*)(F.ws + WS_WINA), M, 6144, D}; pg8::StaticOrder S; S.init(M, 6144, F.G, (int)blockIdx.x);
        EpiInA E{(bf16*)(F.ws + WS_QKV), (bf16*)(F.ws + WS_SB), (bf16*)(F.ws + WS_P)};
        pg8::gemm_phase<EpiInA, pg8::StaticOrder, true, true>(F.lds, g, S, E);
    } SEAM(2);
    if (IN(3)) { p3a_ybp(F); } SEAM(3);
    if (IN(4)) { for (int u = blockIdx.x; u < NUNIT; u += F.G) p3b_fast(F, u); } SEAM(4);
    if (IN(5)) {
        pg8::Gemm g{YBP, (const bf16*)(F.ws + WS_WB), M, D, D}; pg8::StaticOrder S; S.init(M, D, F.G, (int)blockIdx.x);
        EpiPlain E{(bf16*)(F.ws + WS_YB), D};
        pg8::gemm_phase<EpiPlain, pg8::StaticOrder, true, true>(F.lds, g, S, E);
    } SEAM(5);
    if (IN(6)) { p_moe_weights(F); } SEAM(6);
    if (IN(7)) { for (int it = blockIdx.x; it < NB * NH; it += F.G) p4_scan_fast(F, it); } SEAM(7);
    if (IN(8)) {
        pg8::Gemm g{H, (const bf16*)(F.ws + WS_WINB), M, 3072, D}; pg8::StaticOrder S; S.init(M, 3072, F.G, (int)blockIdx.x);
        EpiInB E{(bf16*)(F.ws + WS_OR), (bf16*)(F.ws + WS_GA), (bf16*)(F.ws + WS_GB), (const float*)(F.ws + CTL_SSQ), F.onorm_g};
        pg8::gemm_phase<EpiInB, pg8::StaticOrder, true, true>(F.lds, g, S, E);
    } SEAM(8);
    if (IN(9)) {
        pg8::Gemm g{(const bf16*)(F.ws + WS_OR), (const bf16*)(F.ws + WS_WA), M, D, D}; pg8::StaticOrder S; S.init(M, D, F.G, (int)blockIdx.x);
        EpiMerge E{(const bf16*)(F.ws + WS_GA), (const bf16*)(F.ws + WS_GB), (const bf16*)(F.ws + WS_YB), (bf16*)(F.ws + WS_GA)};
        pg8::gemm_phase<EpiMerge, pg8::StaticOrder, true, true>(F.lds, g, S, E);
    } SEAM(9);
    if (IN(10)) {
        pg8::Gemm g{(const bf16*)(F.ws + WS_GA), (const bf16*)(F.ws + WS_WO), M, D, D}; pg8::StaticOrder S; S.init(M, D, F.G, (int)blockIdx.x);
        EpiX1 E{F.x, F.out, (const float*)(F.ws + CTL_MODACC), F.b_ada};
        pg8::gemm_phase<EpiX1, pg8::StaticOrder, true, true>(F.lds, g, S, E);
    } SEAM(10);
    if (IN(11)) { p8_router(F); } SEAM(11);
    if (IN(12)) { p9_gather(F); } SEAM(12);
    if (IN(13)) {
        const int nt = moe_tables(F);
        pg8::Gemm g{(const bf16*)(F.ws + WS_XS), (const bf16*)(F.ws + WS_W13), MOE_CAP, NE * D, D};
        MoeOrder S{nt * 4, F.G, (int)blockIdx.x, (const volatile LAS int*)(F.lds + MISC_OFF + 256)};
        EpiHid E{(bf16*)(F.ws + WS_HID)};
        pg8::gemm_phase<EpiHid, MoeOrder, true, true>(F.lds, g, S, E);
    } SEAM(13);
    if (IN(14)) {
        const int nt = moe_tables(F);
        pg8::Gemm g{(const bf16*)(F.ws + WS_HID), (const bf16*)(F.ws + WS_W2), MOE_CAP, NE * D, DE};
        MoeOrder S{nt * 4, F.G, (int)blockIdx.x, (const volatile LAS int*)(F.lds + MISC_OFF + 256)};
        EpiMoeOut E{(bf16*)(F.ws + WS_YBUF), (const int*)(F.ws + WS_ROWTOK), (const float*)(F.ws + WS_ROWW)};
        pg8::gemm_phase<EpiMoeOut, MoeOrder, true, true>(F.lds, g, S, E);
    } SEAM(14);
    if (IN(15)) { p12_final(F); }
#undef IN
#undef SEAM
}

extern "C" void kernel_launch(void* const* d_in, const int* in_sizes, int n_in, void* d_out, int out_size, void* d_ws, size_t ws_size, hipStream_t stream) {
    static int grid = 0;
    if (grid == 0) {
        if (n_in != 23 || out_size != M * D || ws_size < WS_END) { fprintf(stderr, "kernel_launch: unexpected problem (n_in %d, out %d, ws %zu)\n", n_in, out_size, ws_size); grid = -1; return; }
        int dev = 0, cus = 0, per_cu = 0;
        if (hipGetDevice(&dev) != hipSuccess || hipDeviceGetAttribute(&cus, hipDeviceAttributeMultiprocessorCount, dev) != hipSuccess) { grid = -1; return; }
        if (hipFuncSetAttribute((const void*)fwd, hipFuncAttributeMaxDynamicSharedMemorySize, LDS_BYTES) != hipSuccess) { fprintf(stderr, "kernel_launch: hipFuncSetAttribute failed\n"); grid = -1; return; }
        if (hipOccupancyMaxActiveBlocksPerMultiprocessor(&per_cu, (const void*)fwd, NWAVES * 64, LDS_BYTES) != hipSuccess || per_cu < 1) { fprintf(stderr, "kernel_launch: occupancy query says %d\n", per_cu); }
        (void)hipGetLastError();
        grid = cus;
    }
    if (grid < 0) return;
    (void)hipMemsetAsync((char*)d_ws + WS_CTL, 0, CTL_ZERO_BYTES, stream);
    Args a{};
    for (int i = 0; i < 23; ++i) a.in[i] = (const float*)d_in[i];
    a.out = (float*)d_out; a.ws = (unsigned char*)d_ws;
#ifndef MK_FUSED
#define MK_FUSED 1
#endif
    if (MK_FUSED) { a.ph_lo = 0; a.ph_hi = NPH; hipLaunchKernelGGL(fwd, dim3(grid), dim3(NWAVES * 64), LDS_BYTES, stream, a); }
    else for (int p = 0; p < NPH; ++p) { a.ph_lo = p; a.ph_hi = p + 1; hipLaunchKernelGGL(fwd, dim3(grid), dim3(NWAVES * 64), LDS_BYTES, stream, a); }
}
```

```cpp
#include <hip/hip_runtime.h>
#include <cstdio>
#include <cstdint>
namespace pg8 {
#define PG8_LAS __attribute__((address_space(3)))
typedef unsigned short bf16_t;
typedef short bf16x8 __attribute__((ext_vector_type(8)));
typedef float f32x4 __attribute__((ext_vector_type(4)));
typedef unsigned u32x4 __attribute__((ext_vector_type(4)));
constexpr int BM = 256, BK = 64, HALF = 128, HTB = HALF * BK * 2  , STAGE_BYTES = 8 * HTB, NXCD = 8, WGM = 8;

__host__ __device__ __forceinline__ int lds_byte(int r, int c) { const int st = (r >> 4) * 2 + (c >> 5), rr = r & 15, cc = c & 31, ob = rr * 64 + cc * 2; return st * 1024 + (ob ^ (((ob >> 9) & 1) << 5)); }
__host__ __device__ __forceinline__ void stage_rc(int b, int& R, int& C) { const int st = b / 1024, sb = b % 1024, swz = sb ^ (((sb >> 9) & 1) << 5); R = (st >> 1) * 16 + swz / 64; C = (st & 1) * 32 + (swz % 64) / 2; }
__host__ __device__ __forceinline__ int perm32(int rho) { const int n = rho >> 4, i = rho & 15; return 8 * (i >> 2) + 4 * n + (i & 3); }

struct Unit { int pm, pn; };
struct Gemm { const bf16_t* A; const bf16_t* Bt; int M, N, K; };

struct StaticOrder {
    int nM, nN, nwg, G, c;
    __host__ __device__ void init(int M, int N, int G_, int c_) { nM = M / BM; nN = N / BM; nwg = nM * nN; G = G_; c = c_; }
    __host__ __device__ bool next(int i, Unit& u) const {
        const long L = (long)i * G + c; if (L >= nwg) return false;
        int wgid = (int)L; { const int q = nwg / NXCD, r = nwg % NXCD, xcd = wgid % NXCD, off = wgid / NXCD; wgid = (xcd < r ? xcd * (q + 1) : r * (q + 1) + (xcd - r) * q) + off; }
        const int nig = WGM * nN, gid = wgid / nig, fm = gid * WGM, gsz = (nM - fm) < WGM ? (nM - fm) : WGM;
        u.pm = fm + ((wgid % nig) % gsz); u.pn = (wgid % nig) / gsz; return true;
    }
    __device__ __forceinline__ void a_ready(const Unit&) const {}
    __device__ __forceinline__ void done(const Unit&) const {}
};

typedef float f32x2_cv __attribute__((ext_vector_type(2)));
typedef __bf16 bf16x2_cv __attribute__((ext_vector_type(2)));
__device__ __forceinline__ unsigned cvt_pk_bf16(float lo, float hi) { const f32x2_cv v = {lo, hi}; return __builtin_bit_cast(unsigned, __builtin_convertvector(v, bf16x2_cv)); }
template <class Epi, class Sched, bool ALIGN_EPI = false, bool SP2 = false>
__device__ __forceinline__ void gemm_phase(PG8_LAS unsigned char* lds, const Gemm g, const Sched& S, const Epi& E) {
    const int tid = threadIdx.x, wid = __builtin_amdgcn_readfirstlane(tid >> 6), lane = tid & 63, wr = wid >> 2, wc = wid & 3, fr = lane & 15, fq = lane >> 4;
    const int K = g.K, nt = K / BK;
    unsigned voffA[2], voffB[2];
#pragma unroll
    for (int i = 0; i < 2; ++i) { int R, C; stage_rc(tid * 16 + i * 8192, R, C); const int Rb = Epi::PERM ? ((R & ~31) + perm32(R & 31)) : R;
        voffA[i] = (unsigned)(R * K + C) * 2u; voffB[i] = (unsigned)(Rb * K + C) * 2u; }
    const size_t kstep = (size_t)(BK * 2);
    const size_t hstep = (size_t)HALF * K * 2;
    const size_t tstep = 2 * hstep;
    const unsigned ldsw = (unsigned)wid * 1024u;
    const int aoff = lds_byte(wr * 64 + fr, fq * 8), boff = lds_byte(wc * 32 + fr, fq * 8);
#define PG8_SA(b, h) (((b) * 2 + (h)) * HTB)
#define PG8_SB(b, h) ((4 + (b) * 2 + (h)) * HTB)
#define PG8_STAGE(bufoff, gbase, voff) do { _Pragma("unroll") for (int _i = 0; _i < 2; ++_i) \
        __builtin_amdgcn_global_load_lds((const unsigned*)((const char*)(gbase) + (voff)[_i]), (PG8_LAS unsigned*)(lds + (bufoff) + ldsw + _i * 8192), 16, 0, 0); } while (0)
#define PG8_LDA(dst, b, h) do { _Pragma("unroll") for (int m = 0; m < 4; ++m) _Pragma("unroll") for (int k = 0; k < 2; ++k) dst[m][k] = *(const PG8_LAS bf16x8*)(lds + PG8_SA(b, h) + aoff + m * 2048 + k * 1024); } while (0)
#define PG8_LDB(dst, b, h) do { _Pragma("unroll") for (int n = 0; n < 2; ++n) _Pragma("unroll") for (int k = 0; k < 2; ++k) dst[n][k] = *(const PG8_LAS bf16x8*)(lds + PG8_SB(b, h) + boff + n * 2048 + k * 1024); } while (0)
#define PG8_MMA(ai, bj, At, Bt) do { __builtin_amdgcn_s_setprio(1); _Pragma("unroll") for (int m = 0; m < 4; ++m) _Pragma("unroll") for (int n = 0; n < 2; ++n) _Pragma("unroll") for (int k = 0; k < 2; ++k) \
        acc[ai][bj][m][n] = __builtin_amdgcn_mfma_f32_16x16x32_bf16(Bt[n][k], At[m][k], acc[ai][bj][m][n], 0, 0, 0); __builtin_amdgcn_s_setprio(0); } while (0)
#define PG8_WAIT_V(n) asm volatile("s_waitcnt vmcnt(" #n ")" ::: "memory")
#define PG8_WAIT_L(n) asm volatile("s_waitcnt lgkmcnt(" #n ")" ::: "memory")
#define PG8_BAR __builtin_amdgcn_s_barrier()
#define PG8_SCHED __builtin_amdgcn_sched_barrier(0)
    Unit cur, nxt; int ui = 0;
    if (!S.next(0, cur)) return;
    f32x4 acc[2][2][4][2];
#pragma unroll
    for (int a = 0; a < 2; ++a)
#pragma unroll
        for (int b = 0; b < 2; ++b)
#pragma unroll
            for (int m = 0; m < 4; ++m)
#pragma unroll
                for (int n = 0; n < 2; ++n) acc[a][b][m][n] = (f32x4){0.f, 0.f, 0.f, 0.f};
    bf16x8 At[4][2], B0[2][2], B1[2][2];
    const char* cA = (const char*)g.A + (size_t)cur.pm * tstep; const char* cB = (const char*)g.Bt + (size_t)cur.pn * tstep;
    S.a_ready(cur);
    if constexpr (SP2) {
        PG8_STAGE(PG8_SB(0, 0), cB, voffB); PG8_STAGE(PG8_SB(0, 1), cB + hstep, voffB); PG8_STAGE(PG8_SA(0, 0), cA, voffA); PG8_STAGE(PG8_SA(0, 1), cA + hstep, voffA);
        if (wr == 1) PG8_BAR;
        PG8_WAIT_V(2); PG8_BAR;
        PG8_STAGE(PG8_SB(1, 0), cB + kstep, voffB); PG8_STAGE(PG8_SA(1, 0), cA + kstep, voffA); PG8_STAGE(PG8_SB(1, 1), cB + hstep + kstep, voffB);
        PG8_WAIT_V(6); PG8_BAR;
    } else {
        PG8_STAGE(PG8_SB(0, 0), cB, voffB); PG8_STAGE(PG8_SA(0, 0), cA, voffA); PG8_STAGE(PG8_SB(0, 1), cB + hstep, voffB); PG8_STAGE(PG8_SA(0, 1), cA + hstep, voffA);
        if (wr == 1) PG8_BAR;
        PG8_WAIT_V(4); PG8_BAR;
        PG8_STAGE(PG8_SB(1, 0), cB + kstep, voffB); PG8_STAGE(PG8_SA(1, 0), cA + kstep, voffA); PG8_STAGE(PG8_SB(1, 1), cB + hstep + kstep, voffB);
        PG8_WAIT_V(6); PG8_BAR;
    }
    for (;;) {
        const bool has_next = S.next(ui + 1, nxt);
        const char* nA = has_next ? (const char*)g.A + (size_t)nxt.pm * tstep : cA; const char* nB = has_next ? (const char*)g.Bt + (size_t)nxt.pn * tstep : cB;
        for (int t = 0; t < nt; t += 2) {
            const bool last = (t == nt - 2);
            const char* a1 = cA + (size_t)(t + 1) * kstep;
            const char* a2 = last ? nA : cA + (size_t)(t + 2) * kstep; const char* b2 = last ? nB : cB + (size_t)(t + 2) * kstep;
            const char* a3 = a2 + kstep; const char* b3 = b2 + kstep;
            if (last && has_next) S.a_ready(nxt);
            if constexpr (SP2) {
            PG8_LDB(B0, 0, 0); PG8_LDB(B1, 0, 1); PG8_SCHED; PG8_LDA(At, 0, 0); PG8_STAGE(PG8_SA(1, 1), a1 + hstep, voffA);
            PG8_WAIT_V(8); PG8_WAIT_L(0); PG8_BAR; PG8_MMA(0, 0, At, B0); PG8_MMA(0, 1, At, B1); PG8_BAR; PG8_SCHED;
            PG8_LDA(At, 0, 1); PG8_STAGE(PG8_SB(0, 0), b2, voffB); PG8_STAGE(PG8_SB(0, 1), b2 + hstep, voffB); PG8_STAGE(PG8_SA(0, 0), a2, voffA);
            PG8_WAIT_V(8); PG8_WAIT_L(0); PG8_BAR; PG8_MMA(1, 0, At, B0); PG8_MMA(1, 1, At, B1); PG8_BAR; PG8_SCHED;
            PG8_LDB(B0, 1, 0); PG8_LDB(B1, 1, 1); PG8_SCHED; PG8_LDA(At, 1, 0); PG8_STAGE(PG8_SA(0, 1), a2 + hstep, voffA);
            PG8_WAIT_V(8); PG8_WAIT_L(0); PG8_BAR; PG8_MMA(0, 0, At, B0); PG8_MMA(0, 1, At, B1); PG8_BAR; PG8_SCHED;
            PG8_LDA(At, 1, 1); PG8_STAGE(PG8_SB(1, 0), b3, voffB); PG8_STAGE(PG8_SB(1, 1), b3 + hstep, voffB); PG8_STAGE(PG8_SA(1, 0), a3, voffA);
            PG8_WAIT_V(8); PG8_WAIT_L(0); PG8_BAR; PG8_MMA(1, 0, At, B0); PG8_MMA(1, 1, At, B1); PG8_BAR; PG8_SCHED;
            } else {
            PG8_LDB(B0, 0, 0); PG8_SCHED; PG8_LDA(At, 0, 0); PG8_STAGE(PG8_SA(1, 1), a1 + hstep, voffA);
            PG8_WAIT_L(8); PG8_BAR; PG8_WAIT_L(0); PG8_MMA(0, 0, At, B0); PG8_BAR; PG8_SCHED;
            PG8_LDB(B1, 0, 1); PG8_STAGE(PG8_SB(0, 0), b2, voffB);
            PG8_BAR; PG8_WAIT_L(0); PG8_MMA(0, 1, At, B1); PG8_BAR;
            PG8_LDA(At, 0, 1); PG8_STAGE(PG8_SA(0, 0), a2, voffA);
            PG8_BAR; PG8_WAIT_L(0); PG8_MMA(1, 0, At, B0); PG8_BAR; PG8_SCHED;
            PG8_STAGE(PG8_SB(0, 1), b2 + hstep, voffB);
            PG8_WAIT_V(6); PG8_BAR; PG8_MMA(1, 1, At, B1); PG8_BAR;
            PG8_LDB(B0, 1, 0); PG8_SCHED; PG8_LDA(At, 1, 0); PG8_STAGE(PG8_SA(0, 1), a2 + hstep, voffA);
            PG8_WAIT_L(8); PG8_BAR; PG8_WAIT_L(0); PG8_MMA(0, 0, At, B0); PG8_BAR; PG8_SCHED;
            PG8_LDB(B1, 1, 1); PG8_STAGE(PG8_SB(1, 0), b3, voffB);
            PG8_BAR; PG8_WAIT_L(0); PG8_MMA(0, 1, At, B1); PG8_BAR;
            PG8_LDA(At, 1, 1); PG8_STAGE(PG8_SA(1, 0), a3, voffA);
            PG8_BAR; PG8_WAIT_L(0); PG8_MMA(1, 0, At, B0); PG8_BAR; PG8_SCHED;
            PG8_STAGE(PG8_SB(1, 1), b3 + hstep, voffB);
            PG8_WAIT_V(6); PG8_BAR; PG8_MMA(1, 1, At, B1); PG8_BAR;
            }
        }
        if constexpr (ALIGN_EPI) { if (wr == 0) PG8_BAR; }
        if constexpr (!Epi::AFTER_DRAIN) { E(acc, cur, wr, wc, fr, fq); S.done(cur); }
        if (!has_next) break;
#pragma unroll
        for (int a = 0; a < 2; ++a)
#pragma unroll
            for (int b = 0; b < 2; ++b)
#pragma unroll
                for (int m = 0; m < 4; ++m)
#pragma unroll
                    for (int n = 0; n < 2; ++n) acc[a][b][m][n] = (f32x4){0.f, 0.f, 0.f, 0.f};
        cur = nxt; cA = nA; cB = nB; ++ui;
        if constexpr (ALIGN_EPI) { if (wr == 1) PG8_BAR; }
    }
    PG8_WAIT_V(0);
    if constexpr (!ALIGN_EPI) { if (wr == 0) PG8_BAR; }
    PG8_BAR;
    if constexpr (Epi::AFTER_DRAIN) { E.fused(acc, cur, wr, wc, fr, fq, lds, wid, lane); S.done(cur); }
#undef PG8_SA
#undef PG8_SB
#undef PG8_STAGE
#undef PG8_LDA
#undef PG8_LDB
#undef PG8_MMA
#undef PG8_WAIT_V
#undef PG8_WAIT_L
#undef PG8_BAR
#undef PG8_SCHED
}
}

constexpr int NB = 2, T = 8192, D = 1024, M = NB * T;
constexpr int NH = 8, DK = 128, DV = 128, CH = 64, NCH = T / CH;
constexpr int NQKV = 3072, IN_TOTAL = 9232;
constexpr int NE = 32, EPG = 8, NGRP = 4, DE = 512;
constexpr int NUNIT = NB * NH * NCH;
constexpr float EPS = 1e-6f;
constexpr int MOE_CAP = 40960;
constexpr int NWAVES = 8;

constexpr size_t MiB = 1u << 20;
constexpr size_t WS_CTL = 0, CTL_ZERO_BYTES = 1 * MiB;
constexpr size_t WS_BG = 1 * MiB;
constexpr size_t WS_TOKE = 2 * MiB;
constexpr size_t WS_TOKW = WS_TOKE + 128 * 1024;
constexpr size_t WS_ROWTOK = WS_TOKE + 256 * 1024;
constexpr size_t WS_ROWW = WS_TOKE + 512 * 1024;
constexpr size_t WS_DEC = 3 * MiB;
constexpr size_t WS_WINA = 4 * MiB;
constexpr size_t WS_IN = 4 * MiB;
constexpr size_t WS_WINB = 20 * MiB;
constexpr size_t WS_WA = 27 * MiB, WS_WB = 29 * MiB, WS_WO = 31 * MiB;
constexpr size_t WS_QKV = 33 * MiB;
constexpr size_t WS_W13 = 33 * MiB;
constexpr size_t WS_W2 = 97 * MiB;
constexpr size_t WS_SB = 129 * MiB, WS_YB = 129 * MiB;
constexpr size_t WS_P = 161 * MiB, WS_OR = 161 * MiB;
constexpr size_t WS_UT = 193 * MiB, WS_W = 225 * MiB, WS_QD = 257 * MiB, WS_KDT = 289 * MiB;
constexpr size_t WS_GA = 193 * MiB, WS_GB = 225 * MiB;
constexpr size_t WS_H2 = 257 * MiB;
constexpr size_t WS_XS = 129 * MiB;
constexpr size_t WS_HID = 209 * MiB;
constexpr size_t WS_YBUF = 129 * MiB;
constexpr size_t WS_PHI = 33 * MiB;
constexpr size_t WS_LSEG = 41 * MiB;
constexpr size_t WS_SST = 57 * MiB;
constexpr size_t WS_END = 321 * MiB;
constexpr int CW_TMO = 0, CW_BAR = 4096, CW_CNT = 8192, CW_CUR = 8192 + 64;
constexpr size_t CTL_MODACC = 64 * 1024;
constexpr size_t CTL_SSQ = 128 * 1024;
constexpr int LDS_BYTES = 163840, MISC_OFF = LDS_BYTES - 2048;

#define GAS __attribute__((address_space(1)))
#define LAS __attribute__((address_space(3)))
typedef unsigned short bf16;
typedef unsigned v4u __attribute__((ext_vector_type(4)));
typedef unsigned v2u __attribute__((ext_vector_type(2)));
typedef float f32x4 __attribute__((ext_vector_type(4)));
#define LDS_WAIT() asm volatile("s_waitcnt lgkmcnt(0)" ::: "memory")
__device__ __forceinline__ unsigned f2bf(float f) { unsigned u = __builtin_bit_cast(unsigned, f); return (u + 0x7fffu + ((u >> 16) & 1u)) >> 16; }
__device__ __forceinline__ unsigned pk2(float lo, float hi) { return f2bf(lo) | (f2bf(hi) << 16); }
__device__ __forceinline__ float bf2f(unsigned short b) { return __builtin_bit_cast(float, ((unsigned)b) << 16); }
__device__ __forceinline__ float bflo(unsigned w) { return __builtin_bit_cast(float, w << 16); }
__device__ __forceinline__ float bfhi(unsigned w) { return __builtin_bit_cast(float, w & 0xffff0000u); }
__device__ __forceinline__ float sigmoidf_(float x) { return 1.0f / (1.0f + __expf(-x)); }
__device__ __forceinline__ float siluf_(float x) { return x / (1.0f + __expf(-x)); }
__device__ __forceinline__ float wave_sum(float v) {
#pragma unroll
    for (int o = 1; o < 64; o <<= 1) v += __shfl_xor(v, o);
    return v;
}

#define XB_TMO      128
#define XB_XCNT(j)  (256  + 64 * (j))
#define XB_XSUB(j)  (1280 + 64 * (j))
#define XB_XGEN(j)  (2304 + 64 * (j))
#define XB_TOP      3328
#define XB_TOPGEN   3392
#define XCD_BAR_WORDS 3456
#define XB_SPIN_CAP (1u << 18)
__device__ __forceinline__ unsigned xb_ld(unsigned* p)              { return __hip_atomic_load(p, __ATOMIC_RELAXED, __HIP_MEMORY_SCOPE_AGENT); }
__device__ __forceinline__ unsigned xb_add(unsigned* p, unsigned v) { return __hip_atomic_fetch_add(p, v, __ATOMIC_RELAXED, __HIP_MEMORY_SCOPE_AGENT); }
__device__ __forceinline__ unsigned xb_xcc_id() { return (unsigned)__builtin_amdgcn_s_getreg((3 << 11) | 20) & 0xFu; }
#define XB_SPIN(cond, bar) do { unsigned _sp = 0; while (cond) { __builtin_amdgcn_s_sleep(1); \
    if ((++_sp & 255u) == 0u) { if (xb_ld(&(bar)[XB_TMO])) break; if (_sp > XB_SPIN_CAP) { atomicAdd(&(bar)[XB_TMO], 1u); break; } } } } while (0)
struct XcdBarrier { unsigned* bar; unsigned x; volatile LAS unsigned* st; };
__device__ __forceinline__ XcdBarrier xcd_barrier_post(unsigned* bar, volatile LAS unsigned* st) {
    XcdBarrier b; b.bar = bar; b.x = xb_xcc_id(); b.st = st;
    if (threadIdx.x == 0) (void)xb_add(&bar[XB_XCNT(b.x)], 1u);
    return b;
}
__device__ __forceinline__ void xcd_barrier_complete(unsigned* bar, unsigned x, unsigned& nloc, unsigned& nx) {
    const unsigned G = gridDim.x * gridDim.y * gridDim.z;
    unsigned sum, cnt, mine, sp = 0u;
    for (;;) {
        sum = 0u; cnt = 0u; mine = 0u;
#pragma unroll
        for (unsigned j = 0; j < 16; ++j) { const unsigned c = xb_ld(&bar[XB_XCNT(j)]); sum += c; cnt += (c > 0u) ? 1u : 0u; mine = (j == x) ? c : mine; }
        if (sum == G) break;
        __builtin_amdgcn_s_sleep(1);
        if ((++sp & 255u) == 0u) { if (xb_ld(&bar[XB_TMO])) break; if (sp > XB_SPIN_CAP) { atomicAdd(&bar[XB_TMO], 1u); break; } }
    }
    nloc = mine > 0u ? mine : 1u; nx = cnt > 0u ? cnt : 1u;
}
__device__ __forceinline__ void xcd_barrier(const XcdBarrier& b) {
    asm volatile("s_waitcnt vmcnt(0)" ::: "memory");
    __syncthreads();
    if (threadIdx.x == 0) {
        unsigned* bar = b.bar;
        __builtin_amdgcn_s_waitcnt(0);
        unsigned nloc = b.st[0], nx = b.st[1];
        if (nloc == 0u) { xcd_barrier_complete(bar, b.x, nloc, nx); b.st[0] = nloc; b.st[1] = nx; }
        const unsigned old = xb_add(&bar[XB_XSUB(b.x)], 1u);
        const unsigned gen = old / nloc;
        if (old + 1u == (gen + 1u) * nloc) {
            __builtin_amdgcn_fence(__ATOMIC_RELEASE, "agent");
            asm volatile("s_waitcnt vmcnt(0)" ::: "memory");
            const unsigned og = xb_add(&bar[XB_TOP], 1u);
            const unsigned tg = og / nx;
            if (og + 1u == (tg + 1u) * nx) xb_add(&bar[XB_TOPGEN], 1u);
            else XB_SPIN(xb_ld(&bar[XB_TOPGEN]) == tg, bar);
            __builtin_amdgcn_fence(__ATOMIC_ACQUIRE, "agent");
            xb_add(&bar[XB_XGEN(b.x)], 1u);
            asm volatile("s_waitcnt vmcnt(0)" ::: "memory");
        } else {
            XB_SPIN(xb_ld(&bar[XB_XGEN(b.x)]) == gen, bar);
            __builtin_amdgcn_fence(__ATOMIC_ACQUIRE, "agent");
            asm volatile("s_waitcnt vmcnt(0)" ::: "memory");
        }
    }
    __syncthreads();
}

struct Frame {
    LAS unsigned char* lds;
    volatile LAS unsigned* MISC;
    unsigned* ctl;
    int tid, lane, wave, vcu, G;
    const float *x, *c, *w_ada, *b_ada, *norm1_g, *w_in, *conv_qkv_w, *a_log, *dt_bias, *onorm_g, *w_proj_a, *conv_sc_w, *w_proj_b, *w_out,
                *norm2_g, *w_group, *b_group, *w_expert, *b_expert, *w1, *w3, *w2, *normf_g;
    float* out; unsigned char* ws;
};
__device__ __forceinline__ float mod_at(const Frame& F, int b, int idx) {
    return ((const float*)(F.ws + CTL_MODACC))[b * 6144 + idx];
}

using pg8::Unit; using pg8::cvt_pk_bf16;
__device__ __forceinline__ v4u pack8(const f32x4 a, const f32x4 b) { v4u w; w.x = cvt_pk_bf16(a[0], a[1]); w.y = cvt_pk_bf16(a[2], a[3]); w.z = cvt_pk_bf16(b[0], b[1]); w.w = cvt_pk_bf16(b[2], b[3]); return w; }
__device__ __forceinline__ void unpack8(const v4u w, f32x4& a, f32x4& b) { a = (f32x4){bflo(w.x), bfhi(w.x), bflo(w.y), bfhi(w.y)}; b = (f32x4){bflo(w.z), bfhi(w.z), bflo(w.w), bfhi(w.w)}; }

struct EpiInA {
    static constexpr bool PERM = true, AFTER_DRAIN = false;
    bf16 *QKV, *SB, *P;
    __device__ __forceinline__ void operator()(const f32x4 (&acc)[2][2][4][2], const Unit& u, int wr, int wc, int fr, int fq) const {
        const int row0 = u.pm * 256 + wr * 64 + fr;
        if (u.pn < 16) {
            bf16* base; int ldc, colt;
            if (u.pn < 12) { base = QKV; ldc = NQKV; colt = u.pn * 256; } else { base = SB; ldc = D; colt = (u.pn - 12) * 256; }
            const int col0 = colt + wc * 32 + 8 * fq;
#pragma unroll
            for (int ai = 0; ai < 2; ++ai)
#pragma unroll
                for (int m = 0; m < 4; ++m) { bf16* rowp = base + (size_t)(row0 + ai * 128 + m * 16) * ldc + col0;
#pragma unroll
                    for (int bj = 0; bj < 2; ++bj) *(v4u*)(rowp + bj * 128) = pack8(acc[ai][bj][m][0], acc[ai][bj][m][1]); }
        } else {
            const int col0 = (u.pn - 16) * 128 + wc * 32 + 8 * fq;
#pragma unroll
            for (int ai = 0; ai < 2; ++ai)
#pragma unroll
                for (int m = 0; m < 4; ++m) { bf16* rowp = P + (size_t)(row0 + ai * 128 + m * 16) * D + col0;
                    *(v4u*)rowp = pack8(acc[ai][0][m][0] * acc[ai][1][m][0], acc[ai][0][m][1] * acc[ai][1][m][1]); }
        }
    }
};
struct EpiInB {
    static constexpr bool PERM = true, AFTER_DRAIN = false;
    bf16 *OG, *GA, *GB; const float* SSQ; const float* onorm_g;
    __device__ __forceinline__ void operator()(const f32x4 (&acc)[2][2][4][2], const Unit& u, int wr, int wc, int fr, int fq) const {
        const int row0 = u.pm * 256 + wr * 64 + fr;
        if (u.pn < 4) {
            const int col0 = u.pn * 256 + wc * 32 + 8 * fq;
#pragma unroll
            for (int ai = 0; ai < 2; ++ai)
#pragma unroll
                for (int m = 0; m < 4; ++m) { const int row = row0 + ai * 128 + m * 16;
#pragma unroll
                    for (int bj = 0; bj < 2; ++bj) { const int col = col0 + bj * 128; bf16* p = OG + (size_t)row * D + col;
                        f32x4 o0, o1; unpack8(*(const v4u*)p, o0, o1);
                        f32x4 z0 = acc[ai][bj][m][0], z1 = acc[ai][bj][m][1];
#pragma unroll
                        for (int j = 0; j < 4; ++j) { z0[j] = siluf_(z0[j]) * o0[j]; z1[j] = siluf_(z1[j]) * o1[j]; }
                        *(v4u*)p = pack8(z0, z1); } }
        } else {
            bf16* base = (u.pn < 8) ? GA : GB; const int col0 = (u.pn & 3) * 256 + wc * 32 + 8 * fq;
#pragma unroll
            for (int ai = 0; ai < 2; ++ai)
#pragma unroll
                for (int m = 0; m < 4; ++m) { bf16* rowp = base + (size_t)(row0 + ai * 128 + m * 16) * D + col0;
#pragma unroll
                    for (int bj = 0; bj < 2; ++bj) { f32x4 a = acc[ai][bj][m][0], b = acc[ai][bj][m][1];
#pragma unroll
                        for (int j = 0; j < 4; ++j) { a[j] = sigmoidf_(a[j]); b[j] = sigmoidf_(b[j]); }
                        *(v4u*)(rowp + bj * 128) = pack8(a, b); } }
        }
    }
};
struct EpiPlain {
    static constexpr bool PERM = true, AFTER_DRAIN = false;
    bf16* O; int ldc;
    __device__ __forceinline__ void operator()(const f32x4 (&acc)[2][2][4][2], const Unit& u, int wr, int wc, int fr, int fq) const {
        const int row0 = u.pm * 256 + wr * 64 + fr, col0 = u.pn * 256 + wc * 32 + 8 * fq;
#pragma unroll
        for (int ai = 0; ai < 2; ++ai)
#pragma unroll
            for (int m = 0; m < 4; ++m) { bf16* rowp = O + (size_t)(row0 + ai * 128 + m * 16) * ldc + col0;
#pragma unroll
                for (int bj = 0; bj < 2; ++bj) *(v4u*)(rowp + bj * 128) = pack8(acc[ai][bj][m][0], acc[ai][bj][m][1]); }
    }
};
struct EpiMerge {
    static constexpr bool PERM = true, AFTER_DRAIN = false;
    const bf16 *GA, *GB, *YB; bf16* MG;
    __device__ __forceinline__ void operator()(const f32x4 (&acc)[2][2][4][2], const Unit& u, int wr, int wc, int fr, int fq) const {
        const int row0 = u.pm * 256 + wr * 64 + fr, col0 = u.pn * 256 + wc * 32 + 8 * fq;
#pragma unroll
        for (int ai = 0; ai < 2; ++ai)
#pragma unroll
            for (int m = 0; m < 4; ++m) { const size_t off = (size_t)(row0 + ai * 128 + m * 16) * D + col0;
#pragma unroll
                for (int bj = 0; bj < 2; ++bj) { f32x4 a0, a1, b0, b1, y0, y1;
                    unpack8(*(const v4u*)(GA + off + bj * 128), a0, a1); unpack8(*(const v4u*)(GB + off + bj * 128), b0, b1); unpack8(*(const v4u*)(YB + off + bj * 128), y0, y1);
                    *(v4u*)(MG + off + bj * 128) = pack8(a0 * acc[ai][bj][m][0] + b0 * y0, a1 * acc[ai][bj][m][1] + b1 * y1); } }
    }
};
struct EpiX1 {
    static constexpr bool PERM = true, AFTER_DRAIN = false;
    const float* X; float* X1; const float* modacc; const float* b_ada;
    __device__ __forceinline__ void operator()(const f32x4 (&acc)[2][2][4][2], const Unit& u, int wr, int wc, int fr, int fq) const {
        const int row0 = u.pm * 256 + wr * 64 + fr, col0 = u.pn * 256 + wc * 32 + 8 * fq, b = u.pm >> 5;
        f32x4 gt[2][2];
#pragma unroll
        for (int bj = 0; bj < 2; ++bj)
#pragma unroll
            for (int n = 0; n < 2; ++n) gt[bj][n] = *(const f32x4*)(modacc + b * 6144 + 2048 + col0 + bj * 128 + 4 * n);
#pragma unroll
        for (int ai = 0; ai < 2; ++ai)
#pragma unroll
            for (int m = 0; m < 4; ++m) { const size_t off = (size_t)(row0 + ai * 128 + m * 16) * D + col0;
#pragma unroll
                for (int bj = 0; bj < 2; ++bj)
#pragma unroll
                    for (int n = 0; n < 2; ++n) { const f32x4 xv = *(const f32x4*)(X + off + bj * 128 + 4 * n);
                        *(f32x4*)(X1 + off + bj * 128 + 4 * n) = xv + gt[bj][n] * acc[ai][bj][m][n]; } }
    }
};
struct EpiHid {
    static constexpr bool PERM = true, AFTER_DRAIN = false;
    bf16* HID;
    __device__ __forceinline__ void operator()(const f32x4 (&acc)[2][2][4][2], const Unit& u, int wr, int wc, int fr, int fq) const {
        const int row0 = u.pm * 256 + wr * 64 + fr, col0 = (u.pn & 3) * 128 + wc * 32 + 8 * fq;
#pragma unroll
        for (int ai = 0; ai < 2; ++ai)
#pragma unroll
            for (int m = 0; m < 4; ++m) { f32x4 a = acc[ai][0][m][0], b = acc[ai][0][m][1];
#pragma unroll
                for (int j = 0; j < 4; ++j) { a[j] = siluf_(a[j]) * acc[ai][1][m][0][j]; b[j] = siluf_(b[j]) * acc[ai][1][m][1][j]; }
                *(v4u*)(HID + (size_t)(row0 + ai * 128 + m * 16) * DE + col0) = pack8(a, b); }
    }
};
struct EpiMoeOut {
    static constexpr bool PERM = true, AFTER_DRAIN = false;
    bf16* YBUF; const int* ROWTOK; const float* ROWW;
    __device__ __forceinline__ void operator()(const f32x4 (&acc)[2][2][4][2], const Unit& u, int wr, int wc, int fr, int fq) const {
        const int row0 = u.pm * 256 + wr * 64 + fr, col0 = (u.pn & 3) * 256 + wc * 32 + 8 * fq;
#pragma unroll
        for (int ai = 0; ai < 2; ++ai)
#pragma unroll
            for (int m = 0; m < 4; ++m) { const int r = row0 + ai * 128 + m * 16; const int tk = ROWTOK[r];
                if (tk >= 0) { const float w = ROWW[r]; bf16* rowp = YBUF + (size_t)tk * D + col0;
#pragma unroll
                    for (int bj = 0; bj < 2; ++bj) *(v4u*)(rowp + bj * 128) = pack8(acc[ai][bj][m][0] * w, acc[ai][bj][m][1] * w); } }
    }
};
struct MoeOrder {
    int n4, G, c; const volatile LAS int* tile_e;
    __device__ __forceinline__ bool next(int i, Unit& u) const { const int L = i * G + c; if (L >= n4) return false; const int rb = L >> 2; u.pm = rb; u.pn = tile_e[rb] * 4 + (L & 3); return true; }
    __device__ __forceinline__ void a_ready(const Unit&) const {}
    __device__ __forceinline__ void done(const Unit&) const {}
};

__device__ __forceinline__ void transpose_item(const float* W, int ldw, int src_col0, int k0, bf16* WT, int dst_row0, int K, LAS float* scr, int lane) {
#pragma unroll 8
    for (int i = 0; i < 32; ++i) { const int kk = 2 * i + (lane >> 5); scr[kk * 33 + (lane & 31)] = W[(size_t)(k0 + kk) * ldw + src_col0 + (lane & 31)]; }
    LDS_WAIT(); asm volatile("" ::: "memory");
    const int c = lane & 7;
#pragma unroll
    for (int j = 0; j < 4; ++j) { const int n = (lane >> 3) + 8 * j; const LAS float* s = scr + (8 * c) * 33 + n;
        v4u o; o.x = pk2(s[0 * 33], s[1 * 33]); o.y = pk2(s[2 * 33], s[3 * 33]); o.z = pk2(s[4 * 33], s[5 * 33]); o.w = pk2(s[6 * 33], s[7 * 33]);
        *(v4u*)(WT + (size_t)(dst_row0 + n) * K + k0 + 8 * c) = o; }
    LDS_WAIT(); asm volatile("" ::: "memory");
}
__device__ __forceinline__ int win_src_col(int d0) {
    if (d0 < 3072) return d0;
    if (d0 < 4096) return 4112 + (d0 - 3072);
    if (d0 < 6144) { const int j = (d0 - 4096) >> 8, r = (d0 - 4096) & 255; return (r < 128 ? 5136 + r : 6160 + (r - 128)) + 128 * j; }
    if (d0 < 7168) return 3072 + (d0 - 6144);
    if (d0 < 8192) return 7184 + (d0 - 7168);
    return 8208 + (d0 - 8192);
}

__device__ __forceinline__ void p0_prologue(Frame& F) {
    LAS float* sC = (LAS float*)(F.lds + 8 * 8448);
    for (int i = F.tid; i < 2 * D; i += 512) sC[i] = siluf_(F.c[i]);
    __syncthreads();
    const int gw = F.vcu * NWAVES + F.wave, NGW = F.G * NWAVES;
    float* modv = (float*)(F.ws + CTL_MODACC);
    LAS float* sPart = sC + 2 * D;
    for (int cg = blockIdx.x; cg < 96; cg += F.G) {
        const int col = cg * 64 + F.lane, k0 = F.wave * 128;
        float a0 = 0.f, a1 = 0.f;
#pragma unroll 16
        for (int k = 0; k < 128; ++k) { const float wv = F.w_ada[(size_t)(k0 + k) * 6144 + col]; a0 += sC[k0 + k] * wv; a1 += sC[D + k0 + k] * wv; }
        sPart[F.wave * 128 + F.lane] = a0; sPart[F.wave * 128 + 64 + F.lane] = a1;
        __syncthreads();
        if (F.wave < 2) { float t = 0.f;
#pragma unroll
            for (int q = 0; q < 8; ++q) t += sPart[q * 128 + F.wave * 64 + F.lane];
            modv[F.wave * 6144 + col] = t + F.b_ada[col]; }
        __syncthreads();
    }
    LAS float* scr = (LAS float*)(F.lds + F.wave * 8448);
    constexpr int I_IN = 288 * 16, I_SQ = 32 * 16;
    for (int it = gw; it < I_IN + 3 * I_SQ; it += NGW) {
        int r = it;
        if (r < I_IN) { const int dg = r % 288, kb = r / 288, d0 = dg * 32; bf16* dst = (d0 < 6144) ? (bf16*)(F.ws + WS_WINA) : (bf16*)(F.ws + WS_WINB);
            transpose_item(F.w_in, IN_TOTAL, win_src_col(d0), kb * 64, dst, d0 < 6144 ? d0 : d0 - 6144, D, scr, F.lane); continue; }
        r -= I_IN;
        if (r < I_SQ) { transpose_item(F.w_proj_a, D, (r % 32) * 32, (r / 32) * 64, (bf16*)(F.ws + WS_WA), (r % 32) * 32, D, scr, F.lane); continue; } r -= I_SQ;
        if (r < I_SQ) { transpose_item(F.w_proj_b, D, (r % 32) * 32, (r / 32) * 64, (bf16*)(F.ws + WS_WB), (r % 32) * 32, D, scr, F.lane); continue; } r -= I_SQ;
        transpose_item(F.w_out, D, (r % 32) * 32, (r / 32) * 64, (bf16*)(F.ws + WS_WO), (r % 32) * 32, D, scr, F.lane);
    }
}
__device__ __forceinline__ void p_moe_weights(Frame& F) {
    LAS float* scr = (LAS float*)(F.lds + F.wave * 8448);
    const int gw = F.vcu * NWAVES + F.wave, NGW = F.G * NWAVES;
    constexpr int I13 = NE * 32 * 16, I2 = NE * 32 * 8;
    for (int it = gw; it < I13 + I2; it += NGW) {
        if (it < I13) { const int e = it / 512, r = it % 512, dg = r % 32, kb = r / 32, d0 = dg * 32, j = d0 >> 8, rr = d0 & 255;
            if (rr < 128) transpose_item(F.w1 + (size_t)e * D * DE, DE, 128 * j + (rr & 127), kb * 64, (bf16*)(F.ws + WS_W13) + (size_t)e * D * D, d0, D, scr, F.lane);
            else          transpose_item(F.w3 + (size_t)e * D * DE, DE, 128 * j + (rr & 127), kb * 64, (bf16*)(F.ws + WS_W13) + (size_t)e * D * D, d0, D, scr, F.lane);
        } else { const int r2 = it - I13, e = r2 / 256, r = r2 % 256, dg = r % 32, kb = r / 32;
            transpose_item(F.w2 + (size_t)e * DE * D, D, dg * 32, kb * 64, (bf16*)(F.ws + WS_W2) + (size_t)e * D * DE, dg * 32, DE, scr, F.lane); }
    }
}

__device__ __forceinline__ void p1_norm1(Frame& F) {
    LAS float* sBA = (LAS float*)F.lds;
    for (int i = F.tid; i < 16 * D; i += 512) { const int k = i >> 4, o = i & 15; sBA[o * D + k] = F.w_in[(size_t)k * IN_TOTAL + 4096 + o]; }
    __syncthreads();
    const int gw = F.vcu * NWAVES + F.wave, NGW = F.G * NWAVES;
    bf16* H = (bf16*)F.out; float* BG = (float*)(F.ws + WS_BG);
    for (int m = gw; m < M; m += NGW) {
        const int b = m / T;
        const f32x4* xr = (const f32x4*)(F.x + (size_t)m * D) + F.lane;
        f32x4 v[4]; float s = 0.f;
#pragma unroll
        for (int j = 0; j < 4; ++j) { v[j] = xr[64 * j]; s += (v[j].x * v[j].x + v[j].y * v[j].y) + (v[j].z * v[j].z + v[j].w * v[j].w); }
        const float rstd = __frsqrt_rn(wave_sum(s) * (1.f / D) + EPS);
        f32x4 hv[4];
#pragma unroll
        for (int j = 0; j < 4; ++j) { const int col = 256 * j + 4 * F.lane;
            const f32x4 g1 = *(const f32x4*)(F.norm1_g + col);
#pragma unroll
            for (int e = 0; e < 4; ++e) hv[j][e] = v[j][e] * rstd * g1[e] * (1.0f + mod_at(F, b, D + col + e)) + mod_at(F, b, col + e);
            *(v2u*)(H + (size_t)m * D + col) = (v2u){pk2(hv[j][0], hv[j][1]), pk2(hv[j][2], hv[j][3])};
        }
        float val = 0.f;
#pragma unroll 2
        for (int o = 0; o < 16; ++o) { float p = 0.f;
#pragma unroll
            for (int j = 0; j < 4; ++j) { const f32x4 w = *(const LAS f32x4*)(sBA + o * D + 256 * j + 4 * F.lane); p += (hv[j][0] * w[0] + hv[j][1] * w[1]) + (hv[j][2] * w[2] + hv[j][3] * w[3]); }
            p = wave_sum(p); val = (F.lane == o) ? p : val; }
        if (F.lane < 16) {
            float r;
            if (F.lane < 8) r = sigmoidf_(val);
            else { const int hh = F.lane - 8; const float xx = val + F.dt_bias[hh]; const float sp = xx > 20.f ? xx : log1pf(__expf(xx)); r = -__expf(F.a_log[hh]) * sp; }
            BG[(size_t)m * 16 + F.lane] = r;
        }
    }
}

__device__ __forceinline__ void p3a_ybp(Frame& F) {
    const bf16* SB = (const bf16*)(F.ws + WS_SB); const bf16* P = (const bf16*)(F.ws + WS_P); bf16* YBP = (bf16*)F.out + (size_t)M * D;
    const size_t total = (size_t)M * (D / 8);
    for (size_t i = (size_t)blockIdx.x * 512 + F.tid; i < total; i += (size_t)F.G * 512) {
        const int m = (int)(i >> 7), c8 = (int)(i & 127) * 8, t = m % T;
        f32x4 a0 = {0.f, 0.f, 0.f, 0.f}, a1 = a0;
#pragma unroll
        for (int j = 0; j < 3; ++j) { const int tt = t - 2 + j;
            if (tt >= 0) { f32x4 p0, p1; unpack8(*(const v4u*)(P + (size_t)(m - 2 + j) * D + c8), p0, p1);
                a0 += *(const f32x4*)(F.conv_sc_w + j * D + c8) * p0; a1 += *(const f32x4*)(F.conv_sc_w + j * D + c8 + 4) * p1; } }
        f32x4 s0, s1; unpack8(*(const v4u*)(SB + (size_t)m * D + c8), s0, s1);
        *(v4u*)(YBP + (size_t)m * D + c8) = pack8(s0 * a0, s1 * a1);
    }
}

__device__ __forceinline__ void p3b_chunk(Frame& F, int unit) {
    const int n = unit % NCH, bh = unit / NCH, h = bh % NH, b = bh / NH, t0 = n * CH, row0 = b * T + t0;
    LAS float* sq = (LAS float*)F.lds; LAS float* sk = sq + 64 * 129; LAS float* sv = sk + 64 * 129; LAS float* sA = sv + 64 * 129; LAS float* sT = sA + 64 * 65;
    LAS float* sgc = sT + 64 * 65; LAS float* sbeta = sgc + 64;
    const bf16* QKV = (const bf16*)(F.ws + WS_QKV); const float* BG = (const float*)(F.ws + WS_BG);
    for (int idx = F.tid; idx < 3 * 64 * 128; idx += 512) {
        const int sec = idx >> 13, r = (idx >> 7) & 63, c = idx & 127, gcol = sec * 1024 + h * 128 + c;
        float a = 0.f;
#pragma unroll
        for (int j = 0; j < 4; ++j) { const int tt = t0 + r - 3 + j; if (tt >= 0) a += F.conv_qkv_w[j * NQKV + gcol] * bf2f(QKV[(size_t)(b * T + tt) * NQKV + gcol]); }
        sq[sec * (64 * 129) + r * 129 + c] = siluf_(a);
    }
    if (F.tid < 64) { sgc[F.tid] = BG[(size_t)(row0 + F.tid) * 16 + 8 + h]; sbeta[F.tid] = BG[(size_t)(row0 + F.tid) * 16 + h]; }
    __syncthreads();
    for (int r = F.wave * 8; r < F.wave * 8 + 8; ++r) {
        const float q0 = sq[r * 129 + F.lane], q1 = sq[r * 129 + 64 + F.lane], k0 = sk[r * 129 + F.lane], k1 = sk[r * 129 + 64 + F.lane];
        const float qs = __frsqrt_rn(wave_sum(q0 * q0 + q1 * q1) + EPS) * 0.08838834764831845f, ks = __frsqrt_rn(wave_sum(k0 * k0 + k1 * k1) + EPS);
        sq[r * 129 + F.lane] = q0 * qs; sq[r * 129 + 64 + F.lane] = q1 * qs; sk[r * 129 + F.lane] = k0 * ks; sk[r * 129 + 64 + F.lane] = k1 * ks;
    }
    if (F.tid == 0) { float a = 0.f; for (int i = 0; i < 64; ++i) { a += sgc[i]; sgc[i] = a; } }
    __syncthreads();
    bf16* INo = (bf16*)(F.ws + WS_IN) + (size_t)unit * 4096;
    for (int idx = F.tid; idx < 4096; idx += 512) {
        const int i = idx >> 6, j = idx & 63; float av = 0.f, iv = 0.f;
        if (j <= i) { float dkk = 0.f, dqk = 0.f;
            for (int d = 0; d < 128; ++d) { const float kj = sk[j * 129 + d]; dkk += sk[i * 129 + d] * kj; dqk += sq[i * 129 + d] * kj; }
            const float dec = __expf(sgc[i] - sgc[j]); iv = dqk * dec; av = (j < i) ? sbeta[i] * dkk * dec : 0.f; }
        sA[i * 65 + j] = av; INo[idx] = (bf16)f2bf(iv);
    }
    __syncthreads();
    if (F.tid < 64) { const int c = F.tid;
        for (int i = 0; i < 64; ++i) { float t = 0.f;
            for (int j = 0; j < i; ++j) t -= sA[i * 65 + j] * sT[j * 65 + c];
            sT[i * 65 + c] = (i == c) ? 1.0f : ((i < c) ? 0.f : t); } }
    __syncthreads();
    bf16* UTo = (bf16*)(F.ws + WS_UT) + (size_t)unit * 8192; bf16* Wo = (bf16*)(F.ws + WS_W) + (size_t)unit * 8192;
    bf16* QDo = (bf16*)(F.ws + WS_QD) + (size_t)unit * 8192; bf16* KDTo = (bf16*)(F.ws + WS_KDT) + (size_t)unit * 8192;
    const float glast = sgc[63];
    for (int idx = F.tid; idx < 8192; idx += 512) {
        { const int dv = idx >> 6, i = idx & 63; float u = 0.f;
          for (int j = 0; j <= i; ++j) u += sT[i * 65 + j] * sbeta[j] * sv[j * 129 + dv];
          UTo[idx] = (bf16)f2bf(u);
          KDTo[idx] = (bf16)f2bf(sk[i * 129 + dv] * __expf(glast - sgc[i])); }
        { const int i = idx >> 7, dk = idx & 127; float w = 0.f;
          for (int j = 0; j <= i; ++j) w += sT[i * 65 + j] * sbeta[j] * __expf(sgc[j]) * sk[j * 129 + dk];
          Wo[idx] = (bf16)f2bf(w);
          QDo[idx] = (bf16)f2bf(sq[i * 129 + dk] * __expf(sgc[i])); }
    }
    if (F.tid == 0) ((float*)(F.ws + WS_DEC))[unit] = __expf(glast);
    __syncthreads();
}

__device__ __forceinline__ void p4_scan(Frame& F, int item) {
    const int bh = item >> 2, sl = item & 3, h = bh % NH, b = bh / NH;
    LAS float* sS = (LAS float*)F.lds;
    LAS float* sV = sS + 128 * 33;
    LAS bf16* sW = (LAS bf16*)(sV + 64 * 33);
    LAS bf16* sQ = sW + 64 * 136;
    LAS bf16* sK = sQ + 64 * 136;
    LAS bf16* sI = sK + 128 * 72;
    for (int i = F.tid; i < 128 * 33; i += 512) sS[i] = 0.f;
    bf16* OR = (bf16*)(F.ws + WS_OR); float* SSQ = (float*)(F.ws + CTL_SSQ);
    const int c = F.tid >> 3, d4 = (F.tid & 7) * 4, dk2 = F.tid >> 2, d8 = (F.tid & 3) * 8;
    for (int n = 0; n < NCH; ++n) {
        const int unit = bh * NCH + n;
        const bf16* Wg = (const bf16*)(F.ws + WS_W) + (size_t)unit * 8192; const bf16* Qg = (const bf16*)(F.ws + WS_QD) + (size_t)unit * 8192;
        const bf16* Kg = (const bf16*)(F.ws + WS_KDT) + (size_t)unit * 8192; const bf16* Ig = (const bf16*)(F.ws + WS_IN) + (size_t)unit * 4096;
        const bf16* Ug = (const bf16*)(F.ws + WS_UT) + (size_t)unit * 8192;
        __syncthreads();
        for (int i = F.tid; i < 1024; i += 512) { const int r = i >> 4, c8 = (i & 15) * 8;
            *(LAS v4u*)(sW + r * 136 + c8) = *(const v4u*)(Wg + r * 128 + c8); *(LAS v4u*)(sQ + r * 136 + c8) = *(const v4u*)(Qg + r * 128 + c8); }
        for (int i = F.tid; i < 1024; i += 512) { const int r = i >> 3, c8 = (i & 7) * 8; *(LAS v4u*)(sK + r * 72 + c8) = *(const v4u*)(Kg + r * 64 + c8); }
        { const int r = F.tid >> 3, c8 = (F.tid & 7) * 8; *(LAS v4u*)(sI + r * 72 + c8) = *(const v4u*)(Ig + r * 64 + c8); }
        const float dec = ((const float*)(F.ws + WS_DEC))[unit];
        __syncthreads();
        float pS[4] = {0.f, 0.f, 0.f, 0.f}, qS[4] = {0.f, 0.f, 0.f, 0.f};
        for (int dk = 0; dk < 128; ++dk) { const float wv = bf2f(sW[c * 136 + dk]), qv = bf2f(sQ[c * 136 + dk]);
#pragma unroll
            for (int e = 0; e < 4; ++e) { const float s = sS[dk * 33 + d4 + e]; pS[e] += wv * s; qS[e] += qv * s; } }
        float vn[4];
#pragma unroll
        for (int e = 0; e < 4; ++e) { vn[e] = bf2f(Ug[(sl * 32 + d4 + e) * 64 + c]) - pS[e]; sV[c * 33 + d4 + e] = vn[e]; }
        __syncthreads();
        float o[4] = {qS[0], qS[1], qS[2], qS[3]};
        for (int j = 0; j < 64; ++j) { const float iv = bf2f(sI[c * 72 + j]);
#pragma unroll
            for (int e = 0; e < 4; ++e) o[e] += iv * sV[j * 33 + d4 + e]; }
        const int row = b * T + n * CH + c;
        *(v2u*)(OR + (size_t)row * D + h * 128 + sl * 32 + d4) = (v2u){pk2(o[0], o[1]), pk2(o[2], o[3])};
        float ss = (o[0] * o[0] + o[1] * o[1]) + (o[2] * o[2] + o[3] * o[3]);
        ss += __shfl_xor(ss, 1); ss += __shfl_xor(ss, 2); ss += __shfl_xor(ss, 4);
        if ((F.tid & 7) == 0) atomicAdd(SSQ + (size_t)row * 8 + h, ss);
        float sn[8];
#pragma unroll
        for (int e = 0; e < 8; ++e) sn[e] = dec * sS[dk2 * 33 + d8 + e];
        for (int cc = 0; cc < 64; ++cc) { const float kv = bf2f(sK[dk2 * 72 + cc]);
#pragma unroll
            for (int e = 0; e < 8; ++e) sn[e] += kv * sV[cc * 33 + d8 + e]; }
        __syncthreads();
#pragma unroll
        for (int e = 0; e < 8; ++e) sS[dk2 * 33 + d8 + e] = sn[e];
    }
    __syncthreads();
}


typedef pg8::bf16x8 bx8;
#define MFMA16(a, b, c) __builtin_amdgcn_mfma_f32_16x16x32_bf16(a, b, c, 0, 0, 0)
__device__ __forceinline__ v2u pack4(const f32x4 a) { v2u r; r.x = cvt_pk_bf16(a[0], a[1]); r.y = cvt_pk_bf16(a[2], a[3]); return r; }
__device__ __forceinline__ void p4_scan_fast(Frame& F, int bh) {
    const int h = bh % NH, b = bh / NH, w = F.wave, l15 = F.lane & 15, lq = F.lane >> 4, ct = w >> 1, dvh = w & 1;
    LAS bf16* sST = (LAS bf16*)F.lds;
    LAS bf16* sVT = sST + 128 * 136;
    LAS float* sSS = (LAS float*)(sVT + 128 * 72);
    LAS float* sDEC = sSS + 128;
    if (F.tid < NCH) sDEC[F.tid] = ((const float*)(F.ws + WS_DEC))[bh * NCH + F.tid];
    for (int i = F.tid; i < 128 * 136 / 2; i += 512) ((LAS unsigned*)sST)[i] = 0u;
    const bf16* Wg = (const bf16*)(F.ws + WS_W) + (size_t)bh * NCH * 8192 + (16 * ct + l15) * 128 + 8 * lq;
    const bf16* Qg = (const bf16*)(F.ws + WS_QD) + (size_t)bh * NCH * 8192 + (16 * ct + l15) * 128 + 8 * lq;
    const bf16* Ig = (const bf16*)(F.ws + WS_IN) + (size_t)bh * NCH * 4096 + (16 * ct + l15) * 64 + 8 * lq;
    const bf16* Kg = (const bf16*)(F.ws + WS_KDT) + (size_t)bh * NCH * 8192 + (16 * w + l15) * 64 + 8 * lq;
    const bf16* Ug = (const bf16*)(F.ws + WS_UT) + (size_t)bh * NCH * 8192 + (16 * 4 * dvh + l15) * 64 + 16 * ct + 4 * lq;
    bf16* OR = (bf16*)(F.ws + WS_OR);
    bx8 fW[4], fQ[4], fI[2], fK[2]; v2u fU[4];
#pragma unroll
    for (int ks = 0; ks < 4; ++ks) { fW[ks] = *(const bx8*)(Wg + 32 * ks); fQ[ks] = *(const bx8*)(Qg + 32 * ks); fU[ks] = *(const v2u*)(Ug + ks * 16 * 64); }
#pragma unroll
    for (int ks = 0; ks < 2; ++ks) { fI[ks] = *(const bx8*)(Ig + 32 * ks); fK[ks] = *(const bx8*)(Kg + 32 * ks); }
    f32x4 S[8], gn[4];
#pragma unroll
    for (int t = 0; t < 8; ++t) S[t] = (f32x4){0.f, 0.f, 0.f, 0.f};
#pragma unroll
    for (int t = 0; t < 4; ++t) gn[t] = *(const f32x4*)(F.onorm_g + 16 * (4 * dvh + t) + 4 * lq);
    __syncthreads();
    for (int n = 0; n < NCH; ++n) {
        const float dec = sDEC[n];
        const int nn = (n + 1 < NCH) ? 1 : 0;
        f32x4 pS[4], qS[4];
#pragma unroll
        for (int t = 0; t < 4; ++t) { bx8 fS[4];
#pragma unroll
            for (int ks = 0; ks < 4; ++ks) fS[ks] = *(const LAS bx8*)(sST + (16 * (4 * dvh + t) + l15) * 136 + 32 * ks + 8 * lq);
            f32x4 p = {0.f, 0.f, 0.f, 0.f}, q = {0.f, 0.f, 0.f, 0.f};
#pragma unroll
            for (int ks = 0; ks < 4; ++ks) { p = MFMA16(fW[ks], fS[ks], p); q = MFMA16(fS[ks], fQ[ks], q); }
            pS[t] = p; qS[t] = q; }
#pragma unroll
        for (int t = 0; t < 4; ++t) { const f32x4 u = {bflo(fU[t].x), bfhi(fU[t].x), bflo(fU[t].y), bfhi(fU[t].y)};
            *(LAS v2u*)(sVT + (16 * (4 * dvh + t) + l15) * 72 + 16 * ct + 4 * lq) = pack4(u - pS[t]); }
        Wg += nn * 8192; Qg += nn * 8192; Ug += nn * 8192;
#pragma unroll
        for (int ks = 0; ks < 4; ++ks) { fW[ks] = *(const bx8*)(Wg + 32 * ks); fQ[ks] = *(const bx8*)(Qg + 32 * ks); fU[ks] = *(const v2u*)(Ug + ks * 16 * 64); }
        __syncthreads();
        float ss = 0.f;
#pragma unroll
        for (int t = 0; t < 4; ++t) {
#pragma unroll
            for (int ks = 0; ks < 2; ++ks) { const bx8 fV = *(const LAS bx8*)(sVT + (16 * (4 * dvh + t) + l15) * 72 + 32 * ks + 8 * lq); qS[t] = MFMA16(fV, fI[ks], qS[t]); }
            ss += (qS[t][0] * qS[t][0] + qS[t][1] * qS[t][1]) + (qS[t][2] * qS[t][2] + qS[t][3] * qS[t][3]); }
        ss += __shfl_xor(ss, 16); ss += __shfl_xor(ss, 32);
        if (lq == 0) sSS[dvh * 64 + 16 * ct + l15] = ss;
        Ig += nn * 4096;
#pragma unroll
        for (int ks = 0; ks < 2; ++ks) fI[ks] = *(const bx8*)(Ig + 32 * ks);
#pragma unroll
        for (int t = 0; t < 8; ++t) { S[t] = S[t] * dec;
#pragma unroll
            for (int ks = 0; ks < 2; ++ks) { const bx8 fV = *(const LAS bx8*)(sVT + (16 * t + l15) * 72 + 32 * ks + 8 * lq); S[t] = MFMA16(fK[ks], fV, S[t]); }
            *(LAS v2u*)(sST + (16 * t + l15) * 136 + 16 * w + 4 * lq) = pack4(S[t]); }
        Kg += nn * 8192;
#pragma unroll
        for (int ks = 0; ks < 2; ++ks) fK[ks] = *(const bx8*)(Kg + 32 * ks);
        __syncthreads();
        const float rstd = __frsqrt_rn((sSS[16 * ct + l15] + sSS[64 + 16 * ct + l15]) * (1.0f / 128.0f) + EPS);
        bf16* orow = OR + (size_t)(b * T + n * CH + 16 * ct + l15) * D + h * 128 + 16 * 4 * dvh + 4 * lq;
#pragma unroll
        for (int t = 0; t < 4; ++t) *(v2u*)(orow + 16 * t) = pack4(qS[t] * rstd * gn[t]);
    }
    __syncthreads();
}


#define MFMA_F32(a, b, c) __builtin_amdgcn_mfma_f32_16x16x4f32(a, b, c, 0, 0, 0)
__device__ __forceinline__ void solve_block(LAS float* sA, LAS float* sT, int bi, int bj, int l15, int lq) {
    f32x4 y = {0.f, 0.f, 0.f, 0.f};
    for (int km = bj; km < bi; ++km)
#pragma unroll
        for (int kb = 0; kb < 4; ++kb) y = MFMA_F32(sA[(16 * bi + l15) * 68 + 16 * km + 4 * kb + lq], sT[(16 * km + 4 * kb + lq) * 68 + 16 * bj + l15], y);
    f32x4 z = {0.f, 0.f, 0.f, 0.f};
#pragma unroll
    for (int e = 0; e < 4; ++e) z = MFMA_F32(sT[(16 * bi + l15) * 68 + 16 * bi + 4 * lq + e], y[e], z);
#pragma unroll
    for (int e = 0; e < 4; ++e) sT[(16 * bi + 4 * lq + e) * 68 + 16 * bj + l15] = -z[e];
}
__device__ __forceinline__ void p3b_fast(Frame& F, int unit) {
    const int n = unit % NCH, bh = unit / NCH, h = bh % NH, b = bh / NH, t0 = n * CH, row0 = b * T + t0;
    const int tid = F.tid, w = F.wave, lane = F.lane, l15 = lane & 15, lq = lane >> 4;
    LAS bf16* sQ = (LAS bf16*)F.lds; LAS bf16* sK = sQ + 64 * 136; LAS bf16* sKG = sK + 64 * 136; LAS bf16* sVB = sKG + 128 * 72;
    LAS float* sA = (LAS float*)(sVB + 128 * 72); LAS float* sT = sA + 64 * 68; LAS bf16* sTb = (LAS bf16*)(sT + 64 * 68); LAS float* sgc = (LAS float*)(sTb + 64 * 72);
    const bf16* QKV = (const bf16*)(F.ws + WS_QKV); const float* BG = (const float*)(F.ws + WS_BG);
    bf16* INo = (bf16*)(F.ws + WS_IN) + (size_t)unit * 4096; bf16* UTo = (bf16*)(F.ws + WS_UT) + (size_t)unit * 8192; bf16* Wo = (bf16*)(F.ws + WS_W) + (size_t)unit * 8192;
    bf16* QDo = (bf16*)(F.ws + WS_QD) + (size_t)unit * 8192; bf16* KDTo = (bf16*)(F.ws + WS_KDT) + (size_t)unit * 8192;
    if (w == 0) {
        const float g = BG[(size_t)(row0 + lane) * 16 + 8 + h], bt = BG[(size_t)(row0 + lane) * 16 + h];
        float s = g;
#pragma unroll
        for (int o = 1; o < 64; o <<= 1) { const float t = __shfl_up(s, o); if (lane >= o) s += t; }
        const float gl = __shfl(s, 63);
        sgc[lane] = s; sgc[64 + lane] = bt; sgc[128 + lane] = __expf(s); sgc[192 + lane] = __expf(gl - s);
        if (lane == 0) ((float*)(F.ws + WS_DEC))[unit] = __expf(gl);
    }
    for (int i = tid; i < 64 * 68; i += 512) sT[i] = 0.f;
    __syncthreads();
    if (tid < 384) {
        const int rs = tid / 48, cg = tid % 48, sec = cg >> 4, c8 = (cg & 15) * 8, r0 = 8 * rs, gcol = sec * 1024 + h * 128 + c8;
        f32x4 wt[4][2];
#pragma unroll
        for (int j = 0; j < 4; ++j) { wt[j][0] = *(const f32x4*)(F.conv_qkv_w + j * NQKV + gcol); wt[j][1] = *(const f32x4*)(F.conv_qkv_w + j * NQKV + gcol + 4); }
        v4u raw[11];
#pragma unroll
        for (int i = 0; i < 11; ++i) { const int tt = t0 + r0 - 3 + i; raw[i] = (tt >= 0) ? *(const v4u*)(QKV + (size_t)(b * T + tt) * NQKV + gcol) : (v4u){0u, 0u, 0u, 0u}; }
        f32x4 o0[8], o1[8];
#pragma unroll
        for (int r = 0; r < 8; ++r) { f32x4 a0 = {0.f, 0.f, 0.f, 0.f}, a1 = a0;
#pragma unroll
            for (int j = 0; j < 4; ++j) { f32x4 x0, x1; unpack8(raw[r + j], x0, x1); a0 += wt[j][0] * x0; a1 += wt[j][1] * x1; }
#pragma unroll
            for (int e = 0; e < 4; ++e) { a0[e] = siluf_(a0[e]); a1[e] = siluf_(a1[e]); }
            float ss = (a0[0] * a0[0] + a0[1] * a0[1]) + (a0[2] * a0[2] + a0[3] * a0[3]) + (a1[0] * a1[0] + a1[1] * a1[1]) + (a1[2] * a1[2] + a1[3] * a1[3]);
            ss += __shfl_xor(ss, 1); ss += __shfl_xor(ss, 2); ss += __shfl_xor(ss, 4); ss += __shfl_xor(ss, 8);
            const float sc = (sec == 2) ? 1.0f : __frsqrt_rn(ss + EPS) * (sec == 0 ? 0.08838834764831845f : 1.0f);
            o0[r] = a0 * sc; o1[r] = a1 * sc; }
        if (sec == 0) {
#pragma unroll
            for (int r = 0; r < 8; ++r) { *(LAS v4u*)(sQ + (r0 + r) * 136 + c8) = pack8(o0[r], o1[r]); const float eg = sgc[128 + r0 + r];
                *(v4u*)(QDo + (r0 + r) * 128 + c8) = pack8(o0[r] * eg, o1[r] * eg); }
        } else if (sec == 1) {
            float fk[8], fd[8];
#pragma unroll
            for (int r = 0; r < 8; ++r) { *(LAS v4u*)(sK + (r0 + r) * 136 + c8) = pack8(o0[r], o1[r]); fk[r] = sgc[64 + r0 + r] * sgc[128 + r0 + r]; fd[r] = sgc[192 + r0 + r]; }
#pragma unroll
            for (int e = 0; e < 4; ++e) {
                { const f32x4 a = {o0[0][e] * fk[0], o0[1][e] * fk[1], o0[2][e] * fk[2], o0[3][e] * fk[3]}, bq = {o0[4][e] * fk[4], o0[5][e] * fk[5], o0[6][e] * fk[6], o0[7][e] * fk[7]};
                  *(LAS v4u*)(sKG + (c8 + e) * 72 + r0) = pack8(a, bq);
                  const f32x4 c = {o0[0][e] * fd[0], o0[1][e] * fd[1], o0[2][e] * fd[2], o0[3][e] * fd[3]}, d = {o0[4][e] * fd[4], o0[5][e] * fd[5], o0[6][e] * fd[6], o0[7][e] * fd[7]};
                  *(v4u*)(KDTo + (c8 + e) * 64 + r0) = pack8(c, d); }
                { const f32x4 a = {o1[0][e] * fk[0], o1[1][e] * fk[1], o1[2][e] * fk[2], o1[3][e] * fk[3]}, bq = {o1[4][e] * fk[4], o1[5][e] * fk[5], o1[6][e] * fk[6], o1[7][e] * fk[7]};
                  *(LAS v4u*)(sKG + (c8 + 4 + e) * 72 + r0) = pack8(a, bq);
                  const f32x4 c = {o1[0][e] * fd[0], o1[1][e] * fd[1], o1[2][e] * fd[2], o1[3][e] * fd[3]}, d = {o1[4][e] * fd[4], o1[5][e] * fd[5], o1[6][e] * fd[6], o1[7][e] * fd[7]};
                  *(v4u*)(KDTo + (c8 + 4 + e) * 64 + r0) = pack8(c, d); }
            }
        } else {
            float fb[8];
#pragma unroll
            for (int r = 0; r < 8; ++r) fb[r] = sgc[64 + r0 + r];
#pragma unroll
            for (int e = 0; e < 4; ++e) {
                { const f32x4 a = {o0[0][e] * fb[0], o0[1][e] * fb[1], o0[2][e] * fb[2], o0[3][e] * fb[3]}, bq = {o0[4][e] * fb[4], o0[5][e] * fb[5], o0[6][e] * fb[6], o0[7][e] * fb[7]};
                  *(LAS v4u*)(sVB + (c8 + e) * 72 + r0) = pack8(a, bq); }
                { const f32x4 a = {o1[0][e] * fb[0], o1[1][e] * fb[1], o1[2][e] * fb[2], o1[3][e] * fb[3]}, bq = {o1[4][e] * fb[4], o1[5][e] * fb[5], o1[6][e] * fb[6], o1[7][e] * fb[7]};
                  *(LAS v4u*)(sVB + (c8 + 4 + e) * 72 + r0) = pack8(a, bq); }
            }
        }
    }
    __syncthreads();
    {
        const int jt = w & 3, itp = w >> 2;
        bx8 ak[4];
#pragma unroll
        for (int ks = 0; ks < 4; ++ks) ak[ks] = *(const LAS bx8*)(sK + (16 * jt + l15) * 136 + 32 * ks + 8 * lq);
#pragma unroll
        for (int ii = 0; ii < 2; ++ii) { const int it = 2 * itp + ii, ci = 16 * it + l15;
            f32x4 xk = {0.f, 0.f, 0.f, 0.f}, xq = xk;
#pragma unroll
            for (int ks = 0; ks < 4; ++ks) { const bx8 bk = *(const LAS bx8*)(sK + ci * 136 + 32 * ks + 8 * lq), bq = *(const LAS bx8*)(sQ + ci * 136 + 32 * ks + 8 * lq);
                xk = MFMA16(ak[ks], bk, xk); xq = MFMA16(ak[ks], bq, xq); }
            const float gi = sgc[ci], bi = sgc[64 + ci];
            f32x4 av, iv;
#pragma unroll
            for (int e = 0; e < 4; ++e) { const int cj = 16 * jt + 4 * lq + e; const float dec = __expf(gi - sgc[cj]);
                av[e] = (cj < ci) ? bi * xk[e] * dec : 0.f; iv[e] = (cj <= ci) ? xq[e] * dec : 0.f; }
            *(LAS f32x4*)(sA + ci * 68 + 16 * jt + 4 * lq) = av;
            *(v2u*)(INo + ci * 64 + 16 * jt + 4 * lq) = pack4(iv); }
    }
    __syncthreads();
    if (w == 0) {
        const int blk = lq, c = l15; float t[16];
#pragma unroll
        for (int i = 0; i < 16; ++i) { float s = 0.f;
#pragma unroll
            for (int jb = 0; jb < (i + 3) / 4; ++jb) { const f32x4 a4 = *(const LAS f32x4*)(sA + (16 * blk + i) * 68 + 16 * blk + 4 * jb);
#pragma unroll
                for (int e = 0; e < 4; ++e) if (4 * jb + e < i) s -= a4[e] * t[4 * jb + e]; }
            t[i] = (i == c) ? 1.0f : s;
            sT[(16 * blk + i) * 68 + 16 * blk + c] = t[i]; }
    }
    __syncthreads();
    if (w < 3) solve_block(sA, sT, w + 1, w, l15, lq);
    __syncthreads();
    if (w < 2) solve_block(sA, sT, w + 2, w, l15, lq);
    __syncthreads();
    if (w < 1) solve_block(sA, sT, 3, 0, l15, lq);
    __syncthreads();
    { const int i = tid >> 3, j8 = (tid & 7) * 8; *(LAS v4u*)(sTb + i * 72 + j8) = pack8(*(const LAS f32x4*)(sT + i * 68 + j8), *(const LAS f32x4*)(sT + i * 68 + j8 + 4)); }
    __syncthreads();
    {
        bx8 bv[2], ag[2];
#pragma unroll
        for (int ks = 0; ks < 2; ++ks) { bv[ks] = *(const LAS bx8*)(sVB + (16 * w + l15) * 72 + 32 * ks + 8 * lq); ag[ks] = *(const LAS bx8*)(sKG + (16 * w + l15) * 72 + 32 * ks + 8 * lq); }
#pragma unroll
        for (int it = 0; it < 4; ++it) { f32x4 u = {0.f, 0.f, 0.f, 0.f}, ww = u;
#pragma unroll
            for (int ks = 0; ks < 2; ++ks) { const bx8 ft = *(const LAS bx8*)(sTb + (16 * it + l15) * 72 + 32 * ks + 8 * lq); u = MFMA16(ft, bv[ks], u); ww = MFMA16(ag[ks], ft, ww); }
            *(v2u*)(UTo + (16 * w + l15) * 64 + 16 * it + 4 * lq) = pack4(u);
            *(v2u*)(Wo + (16 * it + l15) * 128 + 16 * w + 4 * lq) = pack4(ww); }
    }
    __syncthreads();
}


__device__ __forceinline__ void p4a_seg(Frame& F, int seg) {
    const int w = F.wave, l15 = F.lane & 15, lq = F.lane >> 4, ct = w >> 1, ch = w & 1;
    const int bh = seg >> 4, g = seg & 15, unit0 = bh * NCH + 8 * g;
    LAS bf16* sST = (LAS bf16*)F.lds;
    LAS bf16* sVT = sST + 256 * 136;
    LAS float* sDEC = (LAS float*)(sVT + 256 * 72);
    if (F.tid < 8) sDEC[F.tid] = ((const float*)(F.ws + WS_DEC))[unit0 + F.tid];
    for (int i = F.tid; i < 256 * 136 / 2; i += 512) ((LAS unsigned*)sST)[i] = 0u;
    __syncthreads();
    if (F.tid < 128) sST[F.tid * 136 + F.tid] = (bf16)0x3F80;
    f32x4 ST[16];
#pragma unroll
    for (int t = 0; t < 16; ++t)
#pragma unroll
        for (int e = 0; e < 4; ++e) ST[t][e] = (t == w && l15 == 4 * lq + e) ? 1.0f : 0.0f;
    const bf16* Wg = (const bf16*)(F.ws + WS_W) + (size_t)unit0 * 8192 + (16 * ct + l15) * 128 + 8 * lq;
    const bf16* Kg = (const bf16*)(F.ws + WS_KDT) + (size_t)unit0 * 8192 + (16 * w + l15) * 64 + 8 * lq;
    const bf16* Ug = (const bf16*)(F.ws + WS_UT) + (size_t)unit0 * 8192 + l15 * 64 + 16 * ct + 4 * lq;
    bx8 fW[4], fK[2]; v2u fU[8];
#pragma unroll
    for (int ks = 0; ks < 4; ++ks) fW[ks] = *(const bx8*)(Wg + 32 * ks);
#pragma unroll
    for (int ks = 0; ks < 2; ++ks) fK[ks] = *(const bx8*)(Kg + 32 * ks);
#pragma unroll
    for (int t = 0; t < 8; ++t) fU[t] = ch ? *(const v2u*)(Ug + t * 16 * 64) : (v2u){0u, 0u};
    __syncthreads();
    for (int sI = 0; sI < 8; ++sI) {
        const float dec = sDEC[sI];
        const int nn = (sI < 7) ? 1 : 0;
#pragma unroll
        for (int t = 0; t < 8; ++t) { const int Tc = 8 * ch + t; f32x4 p = {0.f, 0.f, 0.f, 0.f};
#pragma unroll
            for (int ks = 0; ks < 4; ++ks) { const bx8 fS = *(const LAS bx8*)(sST + (16 * Tc + l15) * 136 + 32 * ks + 8 * lq); p = MFMA16(fW[ks], fS, p); }
            const f32x4 u = {bflo(fU[t].x), bfhi(fU[t].x), bflo(fU[t].y), bfhi(fU[t].y)};
            *(LAS v2u*)(sVT + (16 * Tc + l15) * 72 + 16 * ct + 4 * lq) = pack4(u - p); }
        Wg += nn * 8192; Ug += nn * 8192;
#pragma unroll
        for (int ks = 0; ks < 4; ++ks) fW[ks] = *(const bx8*)(Wg + 32 * ks);
#pragma unroll
        for (int t = 0; t < 8; ++t) fU[t] = ch ? *(const v2u*)(Ug + t * 16 * 64) : (v2u){0u, 0u};
        __syncthreads();
#pragma unroll
        for (int t = 0; t < 16; ++t) { ST[t] = ST[t] * dec;
#pragma unroll
            for (int ks = 0; ks < 2; ++ks) { const bx8 fV = *(const LAS bx8*)(sVT + (16 * t + l15) * 72 + 32 * ks + 8 * lq); ST[t] = MFMA16(fK[ks], fV, ST[t]); }
            *(LAS v2u*)(sST + (16 * t + l15) * 136 + 16 * w + 4 * lq) = pack4(ST[t]); }
        Kg += nn * 8192;
#pragma unroll
        for (int ks = 0; ks < 2; ++ks) fK[ks] = *(const bx8*)(Kg + 32 * ks);
        __syncthreads();
    }
    bf16* PHI = (bf16*)(F.ws + WS_PHI) + (size_t)seg * 16384;
#pragma unroll
    for (int t = 0; t < 8; ++t)
#pragma unroll
        for (int e = 0; e < 4; ++e) PHI[(16 * w + 4 * lq + e) * 128 + 16 * t + l15] = (bf16)f2bf(ST[t][e]);
    f32x4* LS = (f32x4*)(F.ws + WS_LSEG) + ((size_t)(seg * 8 + w) * 8) * 64 + F.lane;
#pragma unroll
    for (int t = 0; t < 8; ++t) LS[t * 64] = ST[8 + t];
}
__device__ __forceinline__ void p4b_fold(Frame& F, int item) {
    const int w = F.wave, l15 = F.lane & 15, lq = F.lane >> 4, bh = item >> 2, dvs = item & 3;
    LAS bf16* sS = (LAS bf16*)F.lds;
    for (int i = F.tid; i < 32 * 136 / 2; i += 512) ((LAS unsigned*)sS)[i] = 0u;
    const bf16* Pg = (const bf16*)(F.ws + WS_PHI) + (size_t)(bh * 16) * 16384 + (16 * w + l15) * 128 + 8 * lq;
    const f32x4* Lg = (const f32x4*)(F.ws + WS_LSEG) + ((size_t)(bh * 16 * 8 + w) * 8 + 2 * dvs) * 64 + F.lane;
    f32x4* So = (f32x4*)(F.ws + WS_SST) + ((size_t)((bh * 16 + 1) * 8 + w) * 8 + 2 * dvs) * 64 + F.lane;
    bx8 fP[4]; f32x4 L[2];
#pragma unroll
    for (int ks = 0; ks < 4; ++ks) fP[ks] = *(const bx8*)(Pg + 32 * ks);
    L[0] = Lg[0]; L[1] = Lg[64];
    __syncthreads();
    for (int g = 0; g < 15; ++g) {
        f32x4 Sn[2];
#pragma unroll
        for (int t = 0; t < 2; ++t) { f32x4 acc = L[t];
#pragma unroll
            for (int ks = 0; ks < 4; ++ks) { const bx8 fS = *(const LAS bx8*)(sS + (16 * t + l15) * 136 + 32 * ks + 8 * lq); acc = MFMA16(fP[ks], fS, acc); }
            Sn[t] = acc; }
        const int nn = (g < 14) ? 1 : 0;
        Pg += nn * 16384; Lg += nn * 8 * 8 * 64;
#pragma unroll
        for (int ks = 0; ks < 4; ++ks) fP[ks] = *(const bx8*)(Pg + 32 * ks);
        L[0] = Lg[0]; L[1] = Lg[64];
        __syncthreads();
#pragma unroll
        for (int t = 0; t < 2; ++t) { *(LAS v2u*)(sS + (16 * t + l15) * 136 + 16 * w + 4 * lq) = pack4(Sn[t]); So[t * 64] = Sn[t]; }
        So += 8 * 8 * 64;
        __syncthreads();
    }
}
__device__ __forceinline__ void p4c_seg(Frame& F, int seg) {
    const int bh = seg >> 4, g = seg & 15, unit0 = bh * NCH + 8 * g;
    const int h = bh % NH, b = bh / NH, w = F.wave, l15 = F.lane & 15, lq = F.lane >> 4, ct = w >> 1, dvh = w & 1;
    LAS bf16* sST = (LAS bf16*)F.lds;
    LAS bf16* sVT = sST + 128 * 136;
    LAS float* sSS = (LAS float*)(sVT + 128 * 72);
    LAS float* sDEC = sSS + 128;
    if (F.tid < 8) sDEC[F.tid] = ((const float*)(F.ws + WS_DEC))[unit0 + F.tid];
    f32x4 S[8], gn[4];
    { const f32x4* Sg = (const f32x4*)(F.ws + WS_SST) + ((size_t)(seg * 8 + w) * 8) * 64 + F.lane;
#pragma unroll
      for (int t = 0; t < 8; ++t) { S[t] = (g == 0) ? (f32x4){0.f, 0.f, 0.f, 0.f} : Sg[t * 64];
          *(LAS v2u*)(sST + (16 * t + l15) * 136 + 16 * w + 4 * lq) = pack4(S[t]); } }
    const bf16* Wg = (const bf16*)(F.ws + WS_W) + (size_t)unit0 * 8192 + (16 * ct + l15) * 128 + 8 * lq;
    const bf16* Qg = (const bf16*)(F.ws + WS_QD) + (size_t)unit0 * 8192 + (16 * ct + l15) * 128 + 8 * lq;
    const bf16* Ig = (const bf16*)(F.ws + WS_IN) + (size_t)unit0 * 4096 + (16 * ct + l15) * 64 + 8 * lq;
    const bf16* Kg = (const bf16*)(F.ws + WS_KDT) + (size_t)unit0 * 8192 + (16 * w + l15) * 64 + 8 * lq;
    const bf16* Ug = (const bf16*)(F.ws + WS_UT) + (size_t)unit0 * 8192 + (16 * 4 * dvh + l15) * 64 + 16 * ct + 4 * lq;
    bf16* OR = (bf16*)(F.ws + WS_OR);
    bx8 fW[4], fQ[4], fI[2], fK[2]; v2u fU[4];
#pragma unroll
    for (int ks = 0; ks < 4; ++ks) { fW[ks] = *(const bx8*)(Wg + 32 * ks); fQ[ks] = *(const bx8*)(Qg + 32 * ks); fU[ks] = *(const v2u*)(Ug + ks * 16 * 64); }
#pragma unroll
    for (int ks = 0; ks < 2; ++ks) { fI[ks] = *(const bx8*)(Ig + 32 * ks); fK[ks] = *(const bx8*)(Kg + 32 * ks); }
#pragma unroll
    for (int t = 0; t < 4; ++t) gn[t] = *(const f32x4*)(F.onorm_g + 16 * (4 * dvh + t) + 4 * lq);
    __syncthreads();
    for (int sI = 0; sI < 8; ++sI) {
        const float dec = sDEC[sI];
        const int nn = (sI < 7) ? 1 : 0;
        f32x4 pS[4], qS[4];
#pragma unroll
        for (int t = 0; t < 4; ++t) { bx8 fS[4];
#pragma unroll
            for (int ks = 0; ks < 4; ++ks) fS[ks] = *(const LAS bx8*)(sST + (16 * (4 * dvh + t) + l15) * 136 + 32 * ks + 8 * lq);
            f32x4 p = {0.f, 0.f, 0.f, 0.f}, q = {0.f, 0.f, 0.f, 0.f};
#pragma unroll
            for (int ks = 0; ks < 4; ++ks) { p = MFMA16(fW[ks], fS[ks], p); q = MFMA16(fS[ks], fQ[ks], q); }
            pS[t] = p; qS[t] = q; }
#pragma unroll
        for (int t = 0; t < 4; ++t) { const f32x4 u = {bflo(fU[t].x), bfhi(fU[t].x), bflo(fU[t].y), bfhi(fU[t].y)};
            *(LAS v2u*)(sVT + (16 * (4 * dvh + t) + l15) * 72 + 16 * ct + 4 * lq) = pack4(u - pS[t]); }
        Wg += nn * 8192; Qg += nn * 8192; Ug += nn * 8192;
#pragma unroll
        for (int ks = 0; ks < 4; ++ks) { fW[ks] = *(const bx8*)(Wg + 32 * ks); fQ[ks] = *(const bx8*)(Qg + 32 * ks); fU[ks] = *(const v2u*)(Ug + ks * 16 * 64); }
        __syncthreads();
        float ss = 0.f;
#pragma unroll
        for (int t = 0; t < 4; ++t) {
#pragma unroll
            for (int ks = 0; ks < 2; ++ks) { const bx8 fV = *(const LAS bx8*)(sVT + (16 * (4 * dvh + t) + l15) * 72 + 32 * ks + 8 * lq); qS[t] = MFMA16(fV, fI[ks], qS[t]); }
            ss += (qS[t][0] * qS[t][0] + qS[t][1] * qS[t][1]) + (qS[t][2] * qS[t][2] + qS[t][3] * qS[t][3]); }
        ss += __shfl_xor(ss, 16); ss += __shfl_xor(ss, 32);
        if (lq == 0) sSS[dvh * 64 + 16 * ct + l15] = ss;
        Ig += nn * 4096;
#pragma unroll
        for (int ks = 0; ks < 2; ++ks) fI[ks] = *(const bx8*)(Ig + 32 * ks);
#pragma unroll
        for (int t = 0; t < 8; ++t) { S[t] = S[t] * dec;
#pragma unroll
            for (int ks = 0; ks < 2; ++ks) { const bx8 fV = *(const LAS bx8*)(sVT + (16 * t + l15) * 72 + 32 * ks + 8 * lq); S[t] = MFMA16(fK[ks], fV, S[t]); }
            *(LAS v2u*)(sST + (16 * t + l15) * 136 + 16 * w + 4 * lq) = pack4(S[t]); }
        Kg += nn * 8192;
#pragma unroll
        for (int ks = 0; ks < 2; ++ks) fK[ks] = *(const bx8*)(Kg + 32 * ks);
        __syncthreads();
        const float rstd = __frsqrt_rn((sSS[16 * ct + l15] + sSS[64 + 16 * ct + l15]) * (1.0f / 128.0f) + EPS);
        bf16* orow = OR + (size_t)(b * T + (8 * g + sI) * CH + 16 * ct + l15) * D + h * 128 + 16 * 4 * dvh + 4 * lq;
#pragma unroll
        for (int t = 0; t < 4; ++t) *(v2u*)(orow + 16 * t) = pack4(qS[t] * rstd * gn[t]);
    }
    __syncthreads();
}

__device__ __forceinline__ void p8_router(Frame& F) {
    const int gw = F.vcu * NWAVES + F.wave, NGW = F.G * NWAVES;
    bf16* H2 = (bf16*)(F.ws + WS_H2); int* TOKE = (int*)(F.ws + WS_TOKE); float* TOKW = (float*)(F.ws + WS_TOKW);
    for (int m = gw; m < M; m += NGW) {
        const int b = m / T;
        const f32x4* xr = (const f32x4*)(F.out + (size_t)m * D) + F.lane;
        f32x4 v[4]; float s = 0.f;
#pragma unroll
        for (int j = 0; j < 4; ++j) { v[j] = xr[64 * j]; s += (v[j].x * v[j].x + v[j].y * v[j].y) + (v[j].z * v[j].z + v[j].w * v[j].w); }
        const float rstd = __frsqrt_rn(wave_sum(s) * (1.f / D) + EPS);
        float gl[4] = {0.f, 0.f, 0.f, 0.f};
#pragma unroll
        for (int j = 0; j < 4; ++j) { const int col = 256 * j + 4 * F.lane;
            const f32x4 g2 = *(const f32x4*)(F.norm2_g + col);
#pragma unroll
            for (int e = 0; e < 4; ++e) { v[j][e] = v[j][e] * rstd * g2[e] * (1.0f + mod_at(F, b, 4 * D + col + e)) + mod_at(F, b, 3 * D + col + e);
                const f32x4 wg = *(const f32x4*)(F.w_group + (size_t)(col + e) * 4);
#pragma unroll
                for (int q = 0; q < 4; ++q) gl[q] += v[j][e] * wg[q]; }
            *(v2u*)(H2 + (size_t)m * D + col) = (v2u){pk2(v[j][0], v[j][1]), pk2(v[j][2], v[j][3])};
        }
#pragma unroll
        for (int q = 0; q < 4; ++q) gl[q] = wave_sum(gl[q]) + F.b_group[q];
        int gs = 0; float gm = gl[0];
#pragma unroll
        for (int q = 1; q < 4; ++q) if (gl[q] > gm) { gm = gl[q]; gs = q; }
        float den = 0.f;
#pragma unroll
        for (int q = 0; q < 4; ++q) den += __expf(gl[q] - gm);
        const float pg = 1.0f / den;
        float el[8] = {0.f, 0.f, 0.f, 0.f, 0.f, 0.f, 0.f, 0.f};
#pragma unroll
        for (int j = 0; j < 4; ++j) { const int col = 256 * j + 4 * F.lane;
#pragma unroll
            for (int e = 0; e < 4; ++e) { const float* wp = F.w_expert + (size_t)(col + e) * NE + gs * 8; const f32x4 w0 = *(const f32x4*)wp, w1 = *(const f32x4*)(wp + 4);
#pragma unroll
                for (int q = 0; q < 4; ++q) { el[q] += v[j][e] * w0[q]; el[4 + q] += v[j][e] * w1[q]; } } }
#pragma unroll
        for (int q = 0; q < 8; ++q) el[q] = wave_sum(el[q]) + F.b_expert[gs * 8 + q];
        int i0 = 0; float v0 = el[0];
#pragma unroll
        for (int q = 1; q < 8; ++q) if (el[q] > v0) { v0 = el[q]; i0 = q; }
        int i1 = -1; float v1 = -3.0e38f;
#pragma unroll
        for (int q = 0; q < 8; ++q) if (q != i0 && el[q] > v1) { v1 = el[q]; i1 = q; }
        const float e1 = __expf(v1 - v0), sw = 1.0f / (1.0f + e1);
        if (F.lane == 0) {
            const int ea = gs * 8 + i0, eb = gs * 8 + i1;
            TOKE[m * 2] = ea; TOKE[m * 2 + 1] = eb; TOKW[m * 2] = pg * sw; TOKW[m * 2 + 1] = pg * e1 * sw;
            atomicAdd(F.ctl + CW_CNT + ea, 1u);
            atomicAdd(F.ctl + CW_CNT + eb, 1u);
        }
    }
}

__device__ __forceinline__ int moe_tables(Frame& F) {
    volatile LAS int* ps = (volatile LAS int*)(F.lds + MISC_OFF + 64); volatile LAS int* te = (volatile LAS int*)(F.lds + MISC_OFF + 256);
    __syncthreads();
    if (F.tid == 0) { int a = 0;
        for (int e = 0; e < NE; ++e) { const int cnt = (int)__hip_atomic_load(F.ctl + CW_CNT + e, __ATOMIC_RELAXED, __HIP_MEMORY_SCOPE_AGENT); ps[e] = a; const int nb = (cnt + 255) >> 8;
            for (int r = 0; r < nb; ++r) te[(a >> 8) + r] = e; a += nb << 8; }
        ps[32] = a; }
    __syncthreads();
    return ps[32] >> 8;
}
__device__ __forceinline__ void p9_gather(Frame& F) {
    moe_tables(F);
    volatile LAS int* ps = (volatile LAS int*)(F.lds + MISC_OFF + 64);
    const int gw = F.vcu * NWAVES + F.wave, NGW = F.G * NWAVES;
    int* ROWTOK = (int*)(F.ws + WS_ROWTOK); float* ROWW = (float*)(F.ws + WS_ROWW);
    const int* TOKE = (const int*)(F.ws + WS_TOKE); const float* TOKW = (const float*)(F.ws + WS_TOKW);
    const bf16* H2 = (const bf16*)(F.ws + WS_H2); bf16* XS = (bf16*)(F.ws + WS_XS);
    for (int e = blockIdx.x; e < NE; e += F.G) { const int cnt = (int)__hip_atomic_load(F.ctl + CW_CNT + e, __ATOMIC_RELAXED, __HIP_MEMORY_SCOPE_AGENT);
        for (int r = ps[e] + cnt + F.tid; r < ps[e + 1]; r += 512) ROWTOK[r] = -1; }
    for (int m = gw; m < M; m += NGW) {
        int pos = 0;
        if (F.lane < 2) { const int e = TOKE[m * 2 + F.lane]; pos = ps[e] + (int)atomicAdd(F.ctl + CW_CUR + e, 1u); ROWTOK[pos] = m * 2 + F.lane; ROWW[pos] = TOKW[m * 2 + F.lane]; }
        const int p0 = __shfl(pos, 0), p1 = __shfl(pos, 1);
        const v4u a = *((const v4u*)(H2 + (size_t)m * D) + F.lane), bb = *((const v4u*)(H2 + (size_t)m * D) + 64 + F.lane);
        *((v4u*)(XS + (size_t)p0 * D) + F.lane) = a; *((v4u*)(XS + (size_t)p0 * D) + 64 + F.lane) = bb;
        *((v4u*)(XS + (size_t)p1 * D) + F.lane) = a; *((v4u*)(XS + (size_t)p1 * D) + 64 + F.lane) = bb;
    }
}
__device__ __forceinline__ void p12_final(Frame& F) {
    const int gw = F.vcu * NWAVES + F.wave, NGW = F.G * NWAVES;
    const bf16* YBUF = (const bf16*)(F.ws + WS_YBUF);
    for (int m = gw; m < M; m += NGW) {
        const int b = m / T;
        f32x4* xr = (f32x4*)(F.out + (size_t)m * D) + F.lane;
        f32x4 v[4]; float s = 0.f;
#pragma unroll
        for (int j = 0; j < 4; ++j) { const int col = 256 * j + 4 * F.lane; v[j] = xr[64 * j];
            const v2u y0 = *(const v2u*)(YBUF + (size_t)(2 * m) * D + col), y1 = *(const v2u*)(YBUF + (size_t)(2 * m + 1) * D + col);
            const f32x4 ys = {bflo(y0.x) + bflo(y1.x), bfhi(y0.x) + bfhi(y1.x), bflo(y0.y) + bflo(y1.y), bfhi(y0.y) + bfhi(y1.y)};
#pragma unroll
            for (int e = 0; e < 4; ++e) v[j][e] += mod_at(F, b, 5 * D + col + e) * ys[e];
            s += (v[j].x * v[j].x + v[j].y * v[j].y) + (v[j].z * v[j].z + v[j].w * v[j].w); }
        const float rstd = __frsqrt_rn(wave_sum(s) * (1.f / D) + EPS);
#pragma unroll
        for (int j = 0; j < 4; ++j) { const f32x4 gf = *(const f32x4*)(F.normf_g + 256 * j + 4 * F.lane); xr[64 * j] = v[j] * rstd * gf; }
    }
}

constexpr int NPH = 18;
struct Args { const float* in[23]; float* out; unsigned char* ws; int ph_lo, ph_hi; };
__global__ void __launch_bounds__(NWAVES * 64, 2) fwd(Args args) {
    extern __shared__ __attribute__((aligned(16))) unsigned char lds[];
    Frame F;
    F.lds = (LAS unsigned char*)lds; F.MISC = (volatile LAS unsigned*)(F.lds + MISC_OFF);
    F.tid = threadIdx.x; F.lane = F.tid & 63; F.wave = __builtin_amdgcn_readfirstlane(F.tid >> 6);
    F.G = gridDim.x; { const int bx = blockIdx.x; F.vcu = (F.G % 8 == 0) ? (bx % 8) * (F.G / 8) + bx / 8 : bx; }
    F.ws = args.ws; F.out = args.out; F.ctl = (unsigned*)(args.ws + WS_CTL);
    F.x = args.in[0]; F.c = args.in[1]; F.w_ada = args.in[2]; F.b_ada = args.in[3]; F.norm1_g = args.in[4]; F.w_in = args.in[5]; F.conv_qkv_w = args.in[6];
    F.a_log = args.in[7]; F.dt_bias = args.in[8]; F.onorm_g = args.in[9]; F.w_proj_a = args.in[10]; F.conv_sc_w = args.in[11]; F.w_proj_b = args.in[12]; F.w_out = args.in[13];
    F.norm2_g = args.in[14]; F.w_group = args.in[15]; F.b_group = args.in[16]; F.w_expert = args.in[17]; F.b_expert = args.in[18]; F.w1 = args.in[19]; F.w3 = args.in[20];
    F.w2 = args.in[21]; F.normf_g = args.in[22];
    if (F.tid < 4) F.MISC[F.tid] = 0u;
    __syncthreads();
    const int lo = args.ph_lo, hi = args.ph_hi;
    const bool fused = (hi - lo) > 1;
    XcdBarrier bar; bar.bar = F.ctl + CW_BAR; bar.x = 0; bar.st = F.MISC;
    if (fused) bar = xcd_barrier_post(F.ctl + CW_BAR, F.MISC);
#ifndef PH_MASK
#define PH_MASK 0xFFFFFFFFu
#endif
#define IN(k) (((PH_MASK >> (k)) & 1) && lo <= (k) && (k) < hi)
#define SEAM(k) do { if (IN(k) && IN((k) + 1)) xcd_barrier(bar); } while (0)
    bf16* H = (bf16*)F.out; bf16* YBP = (bf16*)F.out + (size_t)M * D;

    if (IN(0)) { p0_prologue(F); } SEAM(0);
    if (IN(1)) { p1_norm1(F); } SEAM(1);
    if (IN(2)) {
        pg8::Gemm g{H, (const bf16*)(F.ws + WS_WINA), M, 6144, D}; pg8::StaticOrder S; S.init(M, 6144, F.G, (int)blockIdx.x);
        EpiInA E{(bf16*)(F.ws + WS_QKV), (bf16*)(F.ws + WS_SB), (bf16*)(F.ws + WS_P)};
        pg8::gemm_phase<EpiInA, pg8::StaticOrder, true, true>(F.lds, g, S, E);
    } SEAM(2);
    if (IN(3)) { p3a_ybp(F); } SEAM(3);
    if (IN(4)) { for (int u = blockIdx.x; u < NUNIT; u += F.G) p3b_fast(F, u); } SEAM(4);
    if (IN(5)) {
        pg8::Gemm g{YBP, (const bf16*)(F.ws + WS_WB), M, D, D}; pg8::StaticOrder S; S.init(M, D, F.G, (int)blockIdx.x);
        EpiPlain E{(bf16*)(F.ws + WS_YB), D};
        pg8::gemm_phase<EpiPlain, pg8::StaticOrder, true, true>(F.lds, g, S, E);
    } SEAM(5);
    if (IN(6)) { for (int it = blockIdx.x; it < NB * NH * 16; it += F.G) p4a_seg(F, it); } SEAM(6);
    if (IN(7)) { for (int it = blockIdx.x; it < NB * NH * 4; it += F.G) p4b_fold(F, it); } SEAM(7);
    if (IN(8)) { for (int it = blockIdx.x; it < NB * NH * 16; it += F.G) p4c_seg(F, it); } SEAM(8);
    if (IN(9)) { p_moe_weights(F); } SEAM(9);
    if (IN(10)) {
        pg8::Gemm g{H, (const bf16*)(F.ws + WS_WINB), M, 3072, D}; pg8::StaticOrder S; S.init(M, 3072, F.G, (int)blockIdx.x);
        EpiInB E{(bf16*)(F.ws + WS_OR), (bf16*)(F.ws + WS_GA), (bf16*)(F.ws + WS_GB), (const float*)(F.ws + CTL_SSQ), F.onorm_g};
        pg8::gemm_phase<EpiInB, pg8::StaticOrder, true, true>(F.lds, g, S, E);
    } SEAM(10);
    if (IN(11)) {
        pg8::Gemm g{(const bf16*)(F.ws + WS_OR), (const bf16*)(F.ws + WS_WA), M, D, D}; pg8::StaticOrder S; S.init(M, D, F.G, (int)blockIdx.x);
        EpiMerge E{(const bf16*)(F.ws + WS_GA), (const bf16*)(F.ws + WS_GB), (const bf16*)(F.ws + WS_YB), (bf16*)(F.ws + WS_GA)};
        pg8::gemm_phase<EpiMerge, pg8::StaticOrder, true, true>(F.lds, g, S, E);
    } SEAM(11);
    if (IN(12)) {
        pg8::Gemm g{(const bf16*)(F.ws + WS_GA), (const bf16*)(F.ws + WS_WO), M, D, D}; pg8::StaticOrder S; S.init(M, D, F.G, (int)blockIdx.x);
        EpiX1 E{F.x, F.out, (const float*)(F.ws + CTL_MODACC), F.b_ada};
        pg8::gemm_phase<EpiX1, pg8::StaticOrder, true, true>(F.lds, g, S, E);
    } SEAM(12);
    if (IN(13)) { p8_router(F); } SEAM(13);
    if (IN(14)) { p9_gather(F); } SEAM(14);
    if (IN(15)) {
        const int nt = moe_tables(F);
        pg8::Gemm g{(const bf16*)(F.ws + WS_XS), (const bf16*)(F.ws + WS_W13), MOE_CAP, NE * D, D};
        MoeOrder S{nt * 4, F.G, (int)blockIdx.x, (const volatile LAS int*)(F.lds + MISC_OFF + 256)};
        EpiHid E{(bf16*)(F.ws + WS_HID)};
        pg8::gemm_phase<EpiHid, MoeOrder, true, true>(F.lds, g, S, E);
    } SEAM(15);
    if (IN(16)) {
        const int nt = moe_tables(F);
        pg8::Gemm g{(const bf16*)(F.ws + WS_HID), (const bf16*)(F.ws + WS_W2), MOE_CAP, NE * D, DE};
        MoeOrder S{nt * 4, F.G, (int)blockIdx.x, (const volatile LAS int*)(F.lds + MISC_OFF + 256)};
        EpiMoeOut E{(bf16*)(F.ws + WS_YBUF), (const int*)(F.ws + WS_ROWTOK), (const float*)(F.ws + WS_ROWW)};
        pg8::gemm_phase<EpiMoeOut, MoeOrder, true, true>(F.lds, g, S, E);
    } SEAM(16);
    if (IN(17)) { p12_final(F); }
#undef IN
#undef SEAM
}

extern "C" void kernel_launch(void* const* d_in, const int* in_sizes, int n_in, void* d_out, int out_size, void* d_ws, size_t ws_size, hipStream_t stream) {
    static int grid = 0;
    if (grid == 0) {
        if (n_in != 23 || out_size != M * D || ws_size < WS_END) { fprintf(stderr, "kernel_launch: unexpected problem (n_in %d, out %d, ws %zu)\n", n_in, out_size, ws_size); grid = -1; return; }
        int dev = 0, cus = 0, per_cu = 0;
        if (hipGetDevice(&dev) != hipSuccess || hipDeviceGetAttribute(&cus, hipDeviceAttributeMultiprocessorCount, dev) != hipSuccess) { grid = -1; return; }
        if (hipFuncSetAttribute((const void*)fwd, hipFuncAttributeMaxDynamicSharedMemorySize, LDS_BYTES) != hipSuccess) { fprintf(stderr, "kernel_launch: hipFuncSetAttribute failed\n"); grid = -1; return; }
        if (hipOccupancyMaxActiveBlocksPerMultiprocessor(&per_cu, (const void*)fwd, NWAVES * 64, LDS_BYTES) != hipSuccess || per_cu < 1) { fprintf(stderr, "kernel_launch: occupancy query says %d\n", per_cu); }
        (void)hipGetLastError();
        grid = cus;
    }
    if (grid < 0) return;
    (void)hipMemsetAsync((char*)d_ws + WS_CTL, 0, CTL_ZERO_BYTES, stream);
    Args a{};
    for (int i = 0; i < 23; ++i) a.in[i] = (const float*)d_in[i];
    a.out = (float*)d_out; a.ws = (unsigned char*)d_ws;
#ifndef MK_FUSED
#define MK_FUSED 1
#endif
#ifdef PROBE_DUP
    { const int cuts[4] = {0, PROBE_DUP + 1, PROBE_DUP, NPH}; const int ends[3] = {PROBE_DUP + 1, PROBE_DUP + 1, NPH};
      for (int li = 0; li < 3; ++li) { a.ph_lo = (li == 0) ? 0 : (li == 1 ? PROBE_DUP : PROBE_DUP + 1); a.ph_hi = ends[li]; (void)cuts;
          hipMemsetAsync((char*)d_ws + WS_CTL + CW_BAR * 4, 0, XCD_BAR_WORDS * 4, stream);
          if (a.ph_lo < a.ph_hi) hipLaunchKernelGGL(fwd, dim3(grid), dim3(NWAVES * 64), LDS_BYTES, stream, a); } return; }
#endif
    if (MK_FUSED) { a.ph_lo = 0; a.ph_hi = NPH; hipLaunchKernelGGL(fwd, dim3(grid), dim3(NWAVES * 64), LDS_BYTES, stream, a); }
    else for (int p = 0; p < NPH; ++p) { a.ph_lo = p; a.ph_hi = p + 1; hipLaunchKernelGGL(fwd, dim3(grid), dim3(NWAVES * 64), LDS_BYTES, stream, a); }
}
```

```cpp
#include <hip/hip_runtime.h>
#include <cstdio>
#include <cstdint>
namespace pg8 {
#define PG8_LAS __attribute__((address_space(3)))
typedef unsigned short bf16_t;
typedef short bf16x8 __attribute__((ext_vector_type(8)));
typedef float f32x4 __attribute__((ext_vector_type(4)));
typedef unsigned u32x4 __attribute__((ext_vector_type(4)));
constexpr int BM = 256, BK = 64, HALF = 128, HTB = HALF * BK * 2  , STAGE_BYTES = 8 * HTB, NXCD = 8, WGM = 8;

__host__ __device__ __forceinline__ int lds_byte(int r, int c) { const int st = (r >> 4) * 2 + (c >> 5), rr = r & 15, cc = c & 31, ob = rr * 64 + cc * 2; return st * 1024 + (ob ^ (((ob >> 9) & 1) << 5)); }
__host__ __device__ __forceinline__ void stage_rc(int b, int& R, int& C) { const int st = b / 1024, sb = b % 1024, swz = sb ^ (((sb >> 9) & 1) << 5); R = (st >> 1) * 16 + swz / 64; C = (st & 1) * 32 + (swz % 64) / 2; }
__host__ __device__ __forceinline__ int perm32(int rho) { const int n = rho >> 4, i = rho & 15; return 8 * (i >> 2) + 4 * n + (i & 3); }

struct Unit { int pm, pn; };
struct Gemm { const bf16_t* A; const bf16_t* Bt; int M, N, K; };

struct StaticOrder {
    int nM, nN, nwg, G, c;
    __host__ __device__ void init(int M, int N, int G_, int c_) { nM = M / BM; nN = N / BM; nwg = nM * nN; G = G_; c = c_; }
    __host__ __device__ bool next(int i, Unit& u) const {
        const long L = (long)i * G + c; if (L >= nwg) return false;
        int wgid = (int)L; { const int q = nwg / NXCD, r = nwg % NXCD, xcd = wgid % NXCD, off = wgid / NXCD; wgid = (xcd < r ? xcd * (q + 1) : r * (q + 1) + (xcd - r) * q) + off; }
        const int nig = WGM * nN, gid = wgid / nig, fm = gid * WGM, gsz = (nM - fm) < WGM ? (nM - fm) : WGM;
        u.pm = fm + ((wgid % nig) % gsz); u.pn = (wgid % nig) / gsz; return true;
    }
    __device__ __forceinline__ void a_ready(const Unit&) const {}
    __device__ __forceinline__ void done(const Unit&) const {}
};

typedef float f32x2_cv __attribute__((ext_vector_type(2)));
typedef __bf16 bf16x2_cv __attribute__((ext_vector_type(2)));
__device__ __forceinline__ unsigned cvt_pk_bf16(float lo, float hi) { const f32x2_cv v = {lo, hi}; return __builtin_bit_cast(unsigned, __builtin_convertvector(v, bf16x2_cv)); }
template <class Epi, class Sched, bool ALIGN_EPI = false, bool SP2 = false>
__device__ __forceinline__ void gemm_phase(PG8_LAS unsigned char* lds, const Gemm g, const Sched& S, const Epi& E) {
    const int tid = threadIdx.x, wid = __builtin_amdgcn_readfirstlane(tid >> 6), lane = tid & 63, wr = wid >> 2, wc = wid & 3, fr = lane & 15, fq = lane >> 4;
    const int K = g.K, nt = K / BK;
    unsigned voffA[2], voffB[2];
#pragma unroll
    for (int i = 0; i < 2; ++i) { int R, C; stage_rc(tid * 16 + i * 8192, R, C); const int Rb = Epi::PERM ? ((R & ~31) + perm32(R & 31)) : R;
        voffA[i] = (unsigned)(R * K + C) * 2u; voffB[i] = (unsigned)(Rb * K + C) * 2u; }
    const size_t kstep = (size_t)(BK * 2);
    const size_t hstep = (size_t)HALF * K * 2;
    const size_t tstep = 2 * hstep;
    const unsigned ldsw = (unsigned)wid * 1024u;
    const int aoff = lds_byte(wr * 64 + fr, fq * 8), boff = lds_byte(wc * 32 + fr, fq * 8);
#define PG8_SA(b, h) (((b) * 2 + (h)) * HTB)
#define PG8_SB(b, h) ((4 + (b) * 2 + (h)) * HTB)
#define PG8_STAGE(bufoff, gbase, voff) do { _Pragma("unroll") for (int _i = 0; _i < 2; ++_i) \
        __builtin_amdgcn_global_load_lds((const unsigned*)((const char*)(gbase) + (voff)[_i]), (PG8_LAS unsigned*)(lds + (bufoff) + ldsw + _i * 8192), 16, 0, 0); } while (0)
#define PG8_LDA(dst, b, h) do { _Pragma("unroll") for (int m = 0; m < 4; ++m) _Pragma("unroll") for (int k = 0; k < 2; ++k) dst[m][k] = *(const PG8_LAS bf16x8*)(lds + PG8_SA(b, h) + aoff + m * 2048 + k * 1024); } while (0)
#define PG8_LDB(dst, b, h) do { _Pragma("unroll") for (int n = 0; n < 2; ++n) _Pragma("unroll") for (int k = 0; k < 2; ++k) dst[n][k] = *(const PG8_LAS bf16x8*)(lds + PG8_SB(b, h) + boff + n * 2048 + k * 1024); } while (0)
#define PG8_MMA(ai, bj, At, Bt) do { __builtin_amdgcn_s_setprio(1); _Pragma("unroll") for (int m = 0; m < 4; ++m) _Pragma("unroll") for (int n = 0; n < 2; ++n) _Pragma("unroll") for (int k = 0; k < 2; ++k) \
        acc[ai][bj][m][n] = __builtin_amdgcn_mfma_f32_16x16x32_bf16(Bt[n][k], At[m][k], acc[ai][bj][m][n], 0, 0, 0); __builtin_amdgcn_s_setprio(0); } while (0)
#define PG8_WAIT_V(n) asm volatile("s_waitcnt vmcnt(" #n ")" ::: "memory")
#define PG8_WAIT_L(n) asm volatile("s_waitcnt lgkmcnt(" #n ")" ::: "memory")
#define PG8_BAR __builtin_amdgcn_s_barrier()
#define PG8_SCHED __builtin_amdgcn_sched_barrier(0)
    Unit cur, nxt; int ui = 0;
    if (!S.next(0, cur)) return;
    f32x4 acc[2][2][4][2];
#pragma unroll
    for (int a = 0; a < 2; ++a)
#pragma unroll
        for (int b = 0; b < 2; ++b)
#pragma unroll
            for (int m = 0; m < 4; ++m)
#pragma unroll
                for (int n = 0; n < 2; ++n) acc[a][b][m][n] = (f32x4){0.f, 0.f, 0.f, 0.f};
    bf16x8 At[4][2], B0[2][2], B1[2][2];
    const char* cA = (const char*)g.A + (size_t)cur.pm * tstep; const char* cB = (const char*)g.Bt + (size_t)cur.pn * tstep;
    S.a_ready(cur);
    if constexpr (SP2) {
        PG8_STAGE(PG8_SB(0, 0), cB, voffB); PG8_STAGE(PG8_SB(0, 1), cB + hstep, voffB); PG8_STAGE(PG8_SA(0, 0), cA, voffA); PG8_STAGE(PG8_SA(0, 1), cA + hstep, voffA);
        if (wr == 1) PG8_BAR;
        PG8_WAIT_V(2); PG8_BAR;
        PG8_STAGE(PG8_SB(1, 0), cB + kstep, voffB); PG8_STAGE(PG8_SA(1, 0), cA + kstep, voffA); PG8_STAGE(PG8_SB(1, 1), cB + hstep + kstep, voffB);
        PG8_WAIT_V(6); PG8_BAR;
    } else {
        PG8_STAGE(PG8_SB(0, 0), cB, voffB); PG8_STAGE(PG8_SA(0, 0), cA, voffA); PG8_STAGE(PG8_SB(0, 1), cB + hstep, voffB); PG8_STAGE(PG8_SA(0, 1), cA + hstep, voffA);
        if (wr == 1) PG8_BAR;
        PG8_WAIT_V(4); PG8_BAR;
        PG8_STAGE(PG8_SB(1, 0), cB + kstep, voffB); PG8_STAGE(PG8_SA(1, 0), cA + kstep, voffA); PG8_STAGE(PG8_SB(1, 1), cB + hstep + kstep, voffB);
        PG8_WAIT_V(6); PG8_BAR;
    }
    for (;;) {
        const bool has_next = S.next(ui + 1, nxt);
        const char* nA = has_next ? (const char*)g.A + (size_t)nxt.pm * tstep : cA; const char* nB = has_next ? (const char*)g.Bt + (size_t)nxt.pn * tstep : cB;
        for (int t = 0; t < nt; t += 2) {
            const bool last = (t == nt - 2);
            const char* a1 = cA + (size_t)(t + 1) * kstep;
            const char* a2 = last ? nA : cA + (size_t)(t + 2) * kstep; const char* b2 = last ? nB : cB + (size_t)(t + 2) * kstep;
            const char* a3 = a2 + kstep; const char* b3 = b2 + kstep;
            if (last && has_next) S.a_ready(nxt);
            if constexpr (SP2) {
            PG8_LDB(B0, 0, 0); PG8_LDB(B1, 0, 1); PG8_SCHED; PG8_LDA(At, 0, 0); PG8_STAGE(PG8_SA(1, 1), a1 + hstep, voffA);
            PG8_WAIT_V(8); PG8_WAIT_L(0); PG8_BAR; PG8_MMA(0, 0, At, B0); PG8_MMA(0, 1, At, B1); PG8_BAR; PG8_SCHED;
            PG8_LDA(At, 0, 1); PG8_STAGE(PG8_SB(0, 0), b2, voffB); PG8_STAGE(PG8_SB(0, 1), b2 + hstep, voffB); PG8_STAGE(PG8_SA(0, 0), a2, voffA);
            PG8_WAIT_V(8); PG8_WAIT_L(0); PG8_BAR; PG8_MMA(1, 0, At, B0); PG8_MMA(1, 1, At, B1); PG8_BAR; PG8_SCHED;
            PG8_LDB(B0, 1, 0); PG8_LDB(B1, 1, 1); PG8_SCHED; PG8_LDA(At, 1, 0); PG8_STAGE(PG8_SA(0, 1), a2 + hstep, voffA);
            PG8_WAIT_V(8); PG8_WAIT_L(0); PG8_BAR; PG8_MMA(0, 0, At, B0); PG8_MMA(0, 1, At, B1); PG8_BAR; PG8_SCHED;
            PG8_LDA(At, 1, 1); PG8_STAGE(PG8_SB(1, 0), b3, voffB); PG8_STAGE(PG8_SB(1, 1), b3 + hstep, voffB); PG8_STAGE(PG8_SA(1, 0), a3, voffA);
            PG8_WAIT_V(8); PG8_WAIT_L(0); PG8_BAR; PG8_MMA(1, 0, At, B0); PG8_MMA(1, 1, At, B1); PG8_BAR; PG8_SCHED;
            } else {
            PG8_LDB(B0, 0, 0); PG8_SCHED; PG8_LDA(At, 0, 0); PG8_STAGE(PG8_SA(1, 1), a1 + hstep, voffA);
            PG8_WAIT_L(8); PG8_BAR; PG8_WAIT_L(0); PG8_MMA(0, 0, At, B0); PG8_BAR; PG8_SCHED;
            PG8_LDB(B1, 0, 1); PG8_STAGE(PG8_SB(0, 0), b2, voffB);
            PG8_BAR; PG8_WAIT_L(0); PG8_MMA(0, 1, At, B1); PG8_BAR;
            PG8_LDA(At, 0, 1); PG8_STAGE(PG8_SA(0, 0), a2, voffA);
            PG8_BAR; PG8_WAIT_L(0); PG8_MMA(1, 0, At, B0); PG8_BAR; PG8_SCHED;
            PG8_STAGE(PG8_SB(0, 1), b2 + hstep, voffB);
            PG8_WAIT_V(6); PG8_BAR; PG8_MMA(1, 1, At, B1); PG8_BAR;
            PG8_LDB(B0, 1, 0); PG8_SCHED; PG8_LDA(At, 1, 0); PG8_STAGE(PG8_SA(0, 1), a2 + hstep, voffA);
            PG8_WAIT_L(8); PG8_BAR; PG8_WAIT_L(0); PG8_MMA(0, 0, At, B0); PG8_BAR; PG8_SCHED;
            PG8_LDB(B1, 1, 1); PG8_STAGE(PG8_SB(1, 0), b3, voffB);
            PG8_BAR; PG8_WAIT_L(0); PG8_MMA(0, 1, At, B1); PG8_BAR;
            PG8_LDA(At, 1, 1); PG8_STAGE(PG8_SA(1, 0), a3, voffA);
            PG8_BAR; PG8_WAIT_L(0); PG8_MMA(1, 0, At, B0); PG8_BAR; PG8_SCHED;
            PG8_STAGE(PG8_SB(1, 1), b3 + hstep, voffB);
            PG8_WAIT_V(6); PG8_BAR; PG8_MMA(1, 1, At, B1); PG8_BAR;
            }
        }
        if constexpr (ALIGN_EPI) { if (wr == 0) PG8_BAR; }
        if constexpr (!Epi::AFTER_DRAIN) { E(acc, cur, wr, wc, fr, fq); S.done(cur); }
        if (!has_next) break;
#pragma unroll
        for (int a = 0; a < 2; ++a)
#pragma unroll
            for (int b = 0; b < 2; ++b)
#pragma unroll
                for (int m = 0; m < 4; ++m)
#pragma unroll
                    for (int n = 0; n < 2; ++n) acc[a][b][m][n] = (f32x4){0.f, 0.f, 0.f, 0.f};
        cur = nxt; cA = nA; cB = nB; ++ui;
        if constexpr (ALIGN_EPI) { if (wr == 1) PG8_BAR; }
    }
    PG8_WAIT_V(0);
    if constexpr (!ALIGN_EPI) { if (wr == 0) PG8_BAR; }
    PG8_BAR;
    if constexpr (Epi::AFTER_DRAIN) { E.fused(acc, cur, wr, wc, fr, fq, lds, wid, lane); S.done(cur); }
#undef PG8_SA
#undef PG8_SB
#undef PG8_STAGE
#undef PG8_LDA
#undef PG8_LDB
#undef PG8_MMA
#undef PG8_WAIT_V
#undef PG8_WAIT_L
#undef PG8_BAR
#undef PG8_SCHED
}
}

constexpr int NB = 2, T = 8192, D = 1024, M = NB * T;
constexpr int NH = 8, DK = 128, DV = 128, CH = 64, NCH = T / CH;
constexpr int NQKV = 3072, IN_TOTAL = 9232;
constexpr int NE = 32, EPG = 8, NGRP = 4, DE = 512;
constexpr int NUNIT = NB * NH * NCH;
constexpr float EPS = 1e-6f;
constexpr int MOE_CAP = 40960;
constexpr int NWAVES = 8;

constexpr size_t MiB = 1u << 20;
constexpr size_t WS_CTL = 0, CTL_ZERO_BYTES = 1 * MiB;
constexpr size_t WS_BG = 1 * MiB;
constexpr size_t WS_TOKE = 2 * MiB;
constexpr size_t WS_TOKW = WS_TOKE + 128 * 1024;
constexpr size_t WS_ROWTOK = WS_TOKE + 256 * 1024;
constexpr size_t WS_ROWW = WS_TOKE + 512 * 1024;
constexpr size_t WS_DEC = 3 * MiB;
constexpr size_t WS_WGHIST = 3 * MiB + 64 * 1024;
constexpr size_t WS_WINA = 4 * MiB;
constexpr size_t WS_IN = 4 * MiB;
constexpr size_t WS_WINB = 20 * MiB;
constexpr size_t WS_WA = 27 * MiB, WS_WB = 29 * MiB, WS_WO = 31 * MiB;
constexpr size_t WS_QKV = 33 * MiB;
constexpr size_t WS_W13 = 33 * MiB;
constexpr size_t WS_W2 = 97 * MiB;
constexpr size_t WS_SB = 129 * MiB, WS_YB = 129 * MiB;
constexpr size_t WS_P = 161 * MiB, WS_OR = 161 * MiB;
constexpr size_t WS_UT = 193 * MiB, WS_W = 225 * MiB, WS_QD = 257 * MiB, WS_KDT = 289 * MiB;
constexpr size_t WS_GA = 193 * MiB, WS_GB = 225 * MiB;
constexpr size_t WS_H2 = 257 * MiB;
constexpr size_t WS_XS = 129 * MiB;
constexpr size_t WS_HID = 209 * MiB;
constexpr size_t WS_YBUF = 129 * MiB;
constexpr size_t WS_PHI = 33 * MiB;
constexpr size_t WS_LSEG = 41 * MiB;
constexpr size_t WS_SST = 57 * MiB;
constexpr size_t WS_END = 321 * MiB;
constexpr int CW_TMO = 0, CW_BAR = 4096, CW_CNT = 8192, CW_CUR = 8192 + 64;
constexpr size_t CTL_MODACC = 64 * 1024;
constexpr size_t CTL_SSQ = 128 * 1024;
constexpr int LDS_BYTES = 163840, MISC_OFF = LDS_BYTES - 2048;

#define GAS __attribute__((address_space(1)))
#define LAS __attribute__((address_space(3)))
typedef unsigned short bf16;
typedef unsigned v4u __attribute__((ext_vector_type(4)));
typedef unsigned v2u __attribute__((ext_vector_type(2)));
typedef float f32x4 __attribute__((ext_vector_type(4)));
#define LDS_WAIT() asm volatile("s_waitcnt lgkmcnt(0)" ::: "memory")
__device__ __forceinline__ unsigned f2bf(float f) { unsigned u = __builtin_bit_cast(unsigned, f); return (u + 0x7fffu + ((u >> 16) & 1u)) >> 16; }
__device__ __forceinline__ unsigned pk2(float lo, float hi) { return f2bf(lo) | (f2bf(hi) << 16); }
__device__ __forceinline__ float bf2f(unsigned short b) { return __builtin_bit_cast(float, ((unsigned)b) << 16); }
__device__ __forceinline__ float bflo(unsigned w) { return __builtin_bit_cast(float, w << 16); }
__device__ __forceinline__ float bfhi(unsigned w) { return __builtin_bit_cast(float, w & 0xffff0000u); }
__device__ __forceinline__ float sigmoidf_(float x) { return 1.0f / (1.0f + __expf(-x)); }
__device__ __forceinline__ float siluf_(float x) { return x / (1.0f + __expf(-x)); }
__device__ __forceinline__ float wave_sum(float v) {
#pragma unroll
    for (int o = 1; o < 64; o <<= 1) v += __shfl_xor(v, o);
    return v;
}

#define XB_TMO      128
#define XB_XCNT(j)  (256  + 64 * (j))
#define XB_XSUB(j)  (1280 + 64 * (j))
#define XB_XGEN(j)  (2304 + 64 * (j))
#define XB_TOP      3328
#define XB_TOPGEN   3392
#define XCD_BAR_WORDS 3456
#define XB_SPIN_CAP (1u << 18)
__device__ __forceinline__ unsigned xb_ld(unsigned* p)              { return __hip_atomic_load(p, __ATOMIC_RELAXED, __HIP_MEMORY_SCOPE_AGENT); }
__device__ __forceinline__ unsigned xb_add(unsigned* p, unsigned v) { return __hip_atomic_fetch_add(p, v, __ATOMIC_RELAXED, __HIP_MEMORY_SCOPE_AGENT); }
__device__ __forceinline__ unsigned xb_xcc_id() { return (unsigned)__builtin_amdgcn_s_getreg((3 << 11) | 20) & 0xFu; }
#define XB_SPIN(cond, bar) do { unsigned _sp = 0; while (cond) { __builtin_amdgcn_s_sleep(1); \
    if ((++_sp & 255u) == 0u) { if (xb_ld(&(bar)[XB_TMO])) break; if (_sp > XB_SPIN_CAP) { atomicAdd(&(bar)[XB_TMO], 1u); break; } } } } while (0)
struct XcdBarrier { unsigned* bar; unsigned x; volatile LAS unsigned* st; };
__device__ __forceinline__ XcdBarrier xcd_barrier_post(unsigned* bar, volatile LAS unsigned* st) {
    XcdBarrier b; b.bar = bar; b.x = xb_xcc_id(); b.st = st;
    if (threadIdx.x == 0) (void)xb_add(&bar[XB_XCNT(b.x)], 1u);
    return b;
}
__device__ __forceinline__ void xcd_barrier_complete(unsigned* bar, unsigned x, unsigned& nloc, unsigned& nx) {
    const unsigned G = gridDim.x * gridDim.y * gridDim.z;
    unsigned sum, cnt, mine, sp = 0u;
    for (;;) {
        sum = 0u; cnt = 0u; mine = 0u;
#pragma unroll
        for (unsigned j = 0; j < 16; ++j) { const unsigned c = xb_ld(&bar[XB_XCNT(j)]); sum += c; cnt += (c > 0u) ? 1u : 0u; mine = (j == x) ? c : mine; }
        if (sum == G) break;
        __builtin_amdgcn_s_sleep(1);
        if ((++sp & 255u) == 0u) { if (xb_ld(&bar[XB_TMO])) break; if (sp > XB_SPIN_CAP) { atomicAdd(&bar[XB_TMO], 1u); break; } }
    }
    nloc = mine > 0u ? mine : 1u; nx = cnt > 0u ? cnt : 1u;
}
__device__ __forceinline__ void xcd_barrier(const XcdBarrier& b) {
    asm volatile("s_waitcnt vmcnt(0)" ::: "memory");
    __syncthreads();
    if (threadIdx.x == 0) {
        unsigned* bar = b.bar;
        __builtin_amdgcn_s_waitcnt(0);
        unsigned nloc = b.st[0], nx = b.st[1];
        if (nloc == 0u) { xcd_barrier_complete(bar, b.x, nloc, nx); b.st[0] = nloc; b.st[1] = nx; }
        const unsigned old = xb_add(&bar[XB_XSUB(b.x)], 1u);
        const unsigned gen = old / nloc;
        if (old + 1u == (gen + 1u) * nloc) {
            __builtin_amdgcn_fence(__ATOMIC_RELEASE, "agent");
            asm volatile("s_waitcnt vmcnt(0)" ::: "memory");
            const unsigned og = xb_add(&bar[XB_TOP], 1u);
            const unsigned tg = og / nx;
            if (og + 1u == (tg + 1u) * nx) xb_add(&bar[XB_TOPGEN], 1u);
            else XB_SPIN(xb_ld(&bar[XB_TOPGEN]) == tg, bar);
            __builtin_amdgcn_fence(__ATOMIC_ACQUIRE, "agent");
            xb_add(&bar[XB_XGEN(b.x)], 1u);
            asm volatile("s_waitcnt vmcnt(0)" ::: "memory");
        } else {
            XB_SPIN(xb_ld(&bar[XB_XGEN(b.x)]) == gen, bar);
            __builtin_amdgcn_fence(__ATOMIC_ACQUIRE, "agent");
            asm volatile("s_waitcnt vmcnt(0)" ::: "memory");
        }
    }
    __syncthreads();
}

struct Frame {
    LAS unsigned char* lds;
    volatile LAS unsigned* MISC;
    unsigned* ctl;
    int tid, lane, wave, vcu, G;
    const float *x, *c, *w_ada, *b_ada, *norm1_g, *w_in, *conv_qkv_w, *a_log, *dt_bias, *onorm_g, *w_proj_a, *conv_sc_w, *w_proj_b, *w_out,
                *norm2_g, *w_group, *b_group, *w_expert, *b_expert, *w1, *w3, *w2, *normf_g;
    float* out; unsigned char* ws;
};
__device__ __forceinline__ float mod_at(const Frame& F, int b, int idx) {
    return ((const float*)(F.ws + CTL_MODACC))[b * 6144 + idx];
}

using pg8::Unit; using pg8::cvt_pk_bf16;
__device__ __forceinline__ v4u pack8(const f32x4 a, const f32x4 b) { v4u w; w.x = cvt_pk_bf16(a[0], a[1]); w.y = cvt_pk_bf16(a[2], a[3]); w.z = cvt_pk_bf16(b[0], b[1]); w.w = cvt_pk_bf16(b[2], b[3]); return w; }
__device__ __forceinline__ void unpack8(const v4u w, f32x4& a, f32x4& b) { a = (f32x4){bflo(w.x), bfhi(w.x), bflo(w.y), bfhi(w.y)}; b = (f32x4){bflo(w.z), bfhi(w.z), bflo(w.w), bfhi(w.w)}; }

struct EpiInA {
    static constexpr bool PERM = true, AFTER_DRAIN = false;
    bf16 *QKV, *SB, *P;
    __device__ __forceinline__ void operator()(const f32x4 (&acc)[2][2][4][2], const Unit& u, int wr, int wc, int fr, int fq) const {
        const int row0 = u.pm * 256 + wr * 64 + fr;
        if (u.pn < 16) {
            bf16* base; int ldc, colt;
            if (u.pn < 12) { base = QKV; ldc = NQKV; colt = u.pn * 256; } else { base = SB; ldc = D; colt = (u.pn - 12) * 256; }
            const int col0 = colt + wc * 32 + 8 * fq;
#pragma unroll
            for (int ai = 0; ai < 2; ++ai)
#pragma unroll
                for (int m = 0; m < 4; ++m) { bf16* rowp = base + (size_t)(row0 + ai * 128 + m * 16) * ldc + col0;
#pragma unroll
                    for (int bj = 0; bj < 2; ++bj) *(v4u*)(rowp + bj * 128) = pack8(acc[ai][bj][m][0], acc[ai][bj][m][1]); }
        } else {
            const int col0 = (u.pn - 16) * 128 + wc * 32 + 8 * fq;
#pragma unroll
            for (int ai = 0; ai < 2; ++ai)
#pragma unroll
                for (int m = 0; m < 4; ++m) { bf16* rowp = P + (size_t)(row0 + ai * 128 + m * 16) * D + col0;
                    *(v4u*)rowp = pack8(acc[ai][0][m][0] * acc[ai][1][m][0], acc[ai][0][m][1] * acc[ai][1][m][1]); }
        }
    }
};
struct EpiInB {
    static constexpr bool PERM = true, AFTER_DRAIN = false;
    bf16 *OG, *GA, *GB; const float* SSQ; const float* onorm_g;
    __device__ __forceinline__ void operator()(const f32x4 (&acc)[2][2][4][2], const Unit& u, int wr, int wc, int fr, int fq) const {
        const int row0 = u.pm * 256 + wr * 64 + fr;
        if (u.pn < 4) {
            const int col0 = u.pn * 256 + wc * 32 + 8 * fq;
#pragma unroll
            for (int ai = 0; ai < 2; ++ai)
#pragma unroll
                for (int m = 0; m < 4; ++m) { const int row = row0 + ai * 128 + m * 16;
#pragma unroll
                    for (int bj = 0; bj < 2; ++bj) { const int col = col0 + bj * 128; bf16* p = OG + (size_t)row * D + col;
                        f32x4 o0, o1; unpack8(*(const v4u*)p, o0, o1);
                        f32x4 z0 = acc[ai][bj][m][0], z1 = acc[ai][bj][m][1];
#pragma unroll
                        for (int j = 0; j < 4; ++j) { z0[j] = siluf_(z0[j]) * o0[j]; z1[j] = siluf_(z1[j]) * o1[j]; }
                        *(v4u*)p = pack8(z0, z1); } }
        } else {
            bf16* base = (u.pn < 8) ? GA : GB; const int col0 = (u.pn & 3) * 256 + wc * 32 + 8 * fq;
#pragma unroll
            for (int ai = 0; ai < 2; ++ai)
#pragma unroll
                for (int m = 0; m < 4; ++m) { bf16* rowp = base + (size_t)(row0 + ai * 128 + m * 16) * D + col0;
#pragma unroll
                    for (int bj = 0; bj < 2; ++bj) { f32x4 a = acc[ai][bj][m][0], b = acc[ai][bj][m][1];
#pragma unroll
                        for (int j = 0; j < 4; ++j) { a[j] = sigmoidf_(a[j]); b[j] = sigmoidf_(b[j]); }
                        *(v4u*)(rowp + bj * 128) = pack8(a, b); } }
        }
    }
};
struct EpiPlain {
    static constexpr bool PERM = true, AFTER_DRAIN = false;
    bf16* O; int ldc;
    __device__ __forceinline__ void operator()(const f32x4 (&acc)[2][2][4][2], const Unit& u, int wr, int wc, int fr, int fq) const {
        const int row0 = u.pm * 256 + wr * 64 + fr, col0 = u.pn * 256 + wc * 32 + 8 * fq;
#pragma unroll
        for (int ai = 0; ai < 2; ++ai)
#pragma unroll
            for (int m = 0; m < 4; ++m) { bf16* rowp = O + (size_t)(row0 + ai * 128 + m * 16) * ldc + col0;
#pragma unroll
                for (int bj = 0; bj < 2; ++bj) *(v4u*)(rowp + bj * 128) = pack8(acc[ai][bj][m][0], acc[ai][bj][m][1]); }
    }
};
struct EpiMerge {
    static constexpr bool PERM = true, AFTER_DRAIN = false;
    const bf16 *GA, *GB, *YB; bf16* MG;
    __device__ __forceinline__ void operator()(const f32x4 (&acc)[2][2][4][2], const Unit& u, int wr, int wc, int fr, int fq) const {
        const int row0 = u.pm * 256 + wr * 64 + fr, col0 = u.pn * 256 + wc * 32 + 8 * fq;
#pragma unroll
        for (int ai = 0; ai < 2; ++ai)
#pragma unroll
            for (int m = 0; m < 4; ++m) { const size_t off = (size_t)(row0 + ai * 128 + m * 16) * D + col0;
#pragma unroll
                for (int bj = 0; bj < 2; ++bj) { f32x4 a0, a1, b0, b1, y0, y1;
                    unpack8(*(const v4u*)(GA + off + bj * 128), a0, a1); unpack8(*(const v4u*)(GB + off + bj * 128), b0, b1); unpack8(*(const v4u*)(YB + off + bj * 128), y0, y1);
                    *(v4u*)(MG + off + bj * 128) = pack8(a0 * acc[ai][bj][m][0] + b0 * y0, a1 * acc[ai][bj][m][1] + b1 * y1); } }
    }
};
struct EpiX1 {
    static constexpr bool PERM = true, AFTER_DRAIN = false;
    const float* X; float* X1; const float* modacc; const float* b_ada;
    __device__ __forceinline__ void operator()(const f32x4 (&acc)[2][2][4][2], const Unit& u, int wr, int wc, int fr, int fq) const {
        const int row0 = u.pm * 256 + wr * 64 + fr, col0 = u.pn * 256 + wc * 32 + 8 * fq, b = u.pm >> 5;
        f32x4 gt[2][2];
#pragma unroll
        for (int bj = 0; bj < 2; ++bj)
#pragma unroll
            for (int n = 0; n < 2; ++n) gt[bj][n] = *(const f32x4*)(modacc + b * 6144 + 2048 + col0 + bj * 128 + 4 * n);
#pragma unroll
        for (int ai = 0; ai < 2; ++ai)
#pragma unroll
            for (int m = 0; m < 4; ++m) { const size_t off = (size_t)(row0 + ai * 128 + m * 16) * D + col0;
#pragma unroll
                for (int bj = 0; bj < 2; ++bj)
#pragma unroll
                    for (int n = 0; n < 2; ++n) { const f32x4 xv = *(const f32x4*)(X + off + bj * 128 + 4 * n);
                        *(f32x4*)(X1 + off + bj * 128 + 4 * n) = xv + gt[bj][n] * acc[ai][bj][m][n]; } }
    }
};
struct EpiHid {
    static constexpr bool PERM = true, AFTER_DRAIN = false;
    bf16* HID;
    __device__ __forceinline__ void operator()(const f32x4 (&acc)[2][2][4][2], const Unit& u, int wr, int wc, int fr, int fq) const {
        const int row0 = u.pm * 256 + wr * 64 + fr, col0 = (u.pn & 3) * 128 + wc * 32 + 8 * fq;
#pragma unroll
        for (int ai = 0; ai < 2; ++ai)
#pragma unroll
            for (int m = 0; m < 4; ++m) { f32x4 a = acc[ai][0][m][0], b = acc[ai][0][m][1];
#pragma unroll
                for (int j = 0; j < 4; ++j) { a[j] = siluf_(a[j]) * acc[ai][1][m][0][j]; b[j] = siluf_(b[j]) * acc[ai][1][m][1][j]; }
                *(v4u*)(HID + (size_t)(row0 + ai * 128 + m * 16) * DE + col0) = pack8(a, b); }
    }
};
struct EpiMoeOut {
    static constexpr bool PERM = true, AFTER_DRAIN = false;
    bf16* YBUF; const int* ROWTOK; const float* ROWW;
    __device__ __forceinline__ void operator()(const f32x4 (&acc)[2][2][4][2], const Unit& u, int wr, int wc, int fr, int fq) const {
        const int row0 = u.pm * 256 + wr * 64 + fr, col0 = (u.pn & 3) * 256 + wc * 32 + 8 * fq;
#pragma unroll
        for (int ai = 0; ai < 2; ++ai)
#pragma unroll
            for (int m = 0; m < 4; ++m) { const int r = row0 + ai * 128 + m * 16; const int tk = ROWTOK[r];
                if (tk >= 0) { const float w = ROWW[r]; bf16* rowp = YBUF + (size_t)tk * D + col0;
#pragma unroll
                    for (int bj = 0; bj < 2; ++bj) *(v4u*)(rowp + bj * 128) = pack8(acc[ai][bj][m][0] * w, acc[ai][bj][m][1] * w); } }
    }
};
struct MoeOrder {
    int n4, G, c; const volatile LAS int* tile_e;
    __device__ __forceinline__ bool next(int i, Unit& u) const { const int L = i * G + c; if (L >= n4) return false; const int rb = L >> 2; u.pm = rb; u.pn = tile_e[rb] * 4 + (L & 3); return true; }
    __device__ __forceinline__ void a_ready(const Unit&) const {}
    __device__ __forceinline__ void done(const Unit&) const {}
};

__device__ __forceinline__ void transpose_item(const float* W, int ldw, int src_col0, int k0, bf16* WT, int dst_row0, int K, LAS float* scr, int lane) {
#pragma unroll 8
    for (int i = 0; i < 32; ++i) { const int kk = 2 * i + (lane >> 5); scr[kk * 33 + (lane & 31)] = W[(size_t)(k0 + kk) * ldw + src_col0 + (lane & 31)]; }
    LDS_WAIT(); asm volatile("" ::: "memory");
    const int c = lane & 7;
#pragma unroll
    for (int j = 0; j < 4; ++j) { const int n = (lane >> 3) + 8 * j; const LAS float* s = scr + (8 * c) * 33 + n;
        v4u o; o.x = pk2(s[0 * 33], s[1 * 33]); o.y = pk2(s[2 * 33], s[3 * 33]); o.z = pk2(s[4 * 33], s[5 * 33]); o.w = pk2(s[6 * 33], s[7 * 33]);
        *(v4u*)(WT + (size_t)(dst_row0 + n) * K + k0 + 8 * c) = o; }
    LDS_WAIT(); asm volatile("" ::: "memory");
}
__device__ __forceinline__ int win_src_col(int d0) {
    if (d0 < 3072) return d0;
    if (d0 < 4096) return 4112 + (d0 - 3072);
    if (d0 < 6144) { const int j = (d0 - 4096) >> 8, r = (d0 - 4096) & 255; return (r < 128 ? 5136 + r : 6160 + (r - 128)) + 128 * j; }
    if (d0 < 7168) return 3072 + (d0 - 6144);
    if (d0 < 8192) return 7184 + (d0 - 7168);
    return 8208 + (d0 - 8192);
}

__device__ __forceinline__ void p0_prologue(Frame& F) {
    LAS float* sC = (LAS float*)(F.lds + 8 * 8448);
    for (int i = F.tid; i < 2 * D; i += 512) sC[i] = siluf_(F.c[i]);
    __syncthreads();
    const int gw = F.vcu * NWAVES + F.wave, NGW = F.G * NWAVES;
    float* modv = (float*)(F.ws + CTL_MODACC);
    LAS float* sPart = sC + 2 * D;
    for (int cg = blockIdx.x; cg < 96; cg += F.G) {
        const int col = cg * 64 + F.lane, k0 = F.wave * 128;
        float a0 = 0.f, a1 = 0.f;
#pragma unroll 16
        for (int k = 0; k < 128; ++k) { const float wv = F.w_ada[(size_t)(k0 + k) * 6144 + col]; a0 += sC[k0 + k] * wv; a1 += sC[D + k0 + k] * wv; }
        sPart[F.wave * 128 + F.lane] = a0; sPart[F.wave * 128 + 64 + F.lane] = a1;
        __syncthreads();
        if (F.wave < 2) { float t = 0.f;
#pragma unroll
            for (int q = 0; q < 8; ++q) t += sPart[q * 128 + F.wave * 64 + F.lane];
            modv[F.wave * 6144 + col] = t + F.b_ada[col]; }
        __syncthreads();
    }
    LAS float* scr = (LAS float*)(F.lds + F.wave * 8448);
    constexpr int I_IN = 288 * 16, I_SQ = 32 * 16;
    for (int it = gw; it < I_IN + 3 * I_SQ; it += NGW) {
        int r = it;
        if (r < I_IN) { const int dg = r % 288, kb = r / 288, d0 = dg * 32; bf16* dst = (d0 < 6144) ? (bf16*)(F.ws + WS_WINA) : (bf16*)(F.ws + WS_WINB);
            transpose_item(F.w_in, IN_TOTAL, win_src_col(d0), kb * 64, dst, d0 < 6144 ? d0 : d0 - 6144, D, scr, F.lane); continue; }
        r -= I_IN;
        if (r < I_SQ) { transpose_item(F.w_proj_a, D, (r % 32) * 32, (r / 32) * 64, (bf16*)(F.ws + WS_WA), (r % 32) * 32, D, scr, F.lane); continue; } r -= I_SQ;
        if (r < I_SQ) { transpose_item(F.w_proj_b, D, (r % 32) * 32, (r / 32) * 64, (bf16*)(F.ws + WS_WB), (r % 32) * 32, D, scr, F.lane); continue; } r -= I_SQ;
        transpose_item(F.w_out, D, (r % 32) * 32, (r / 32) * 64, (bf16*)(F.ws + WS_WO), (r % 32) * 32, D, scr, F.lane);
    }
}
__device__ __forceinline__ void p_moe_weights(Frame& F) {
    LAS float* scr = (LAS float*)(F.lds + F.wave * 8448);
    const int gw = F.vcu * NWAVES + F.wave, NGW = F.G * NWAVES;
    constexpr int I13 = NE * 32 * 16, I2 = NE * 32 * 8;
    for (int it = gw; it < I13 + I2; it += NGW) {
        if (it < I13) { const int e = it / 512, r = it % 512, dg = r % 32, kb = r / 32, d0 = dg * 32, j = d0 >> 8, rr = d0 & 255;
            if (rr < 128) transpose_item(F.w1 + (size_t)e * D * DE, DE, 128 * j + (rr & 127), kb * 64, (bf16*)(F.ws + WS_W13) + (size_t)e * D * D, d0, D, scr, F.lane);
            else          transpose_item(F.w3 + (size_t)e * D * DE, DE, 128 * j + (rr & 127), kb * 64, (bf16*)(F.ws + WS_W13) + (size_t)e * D * D, d0, D, scr, F.lane);
        } else { const int r2 = it - I13, e = r2 / 256, r = r2 % 256, dg = r % 32, kb = r / 32;
            transpose_item(F.w2 + (size_t)e * DE * D, D, dg * 32, kb * 64, (bf16*)(F.ws + WS_W2) + (size_t)e * D * DE, dg * 32, DE, scr, F.lane); }
    }
}

__device__ __forceinline__ void p1_norm1(Frame& F) {
    LAS float* sBA = (LAS float*)F.lds;
    for (int i = F.tid; i < 16 * D; i += 512) { const int k = i >> 4, o = i & 15; sBA[o * D + k] = F.w_in[(size_t)k * IN_TOTAL + 4096 + o]; }
    __syncthreads();
    const int gw = blockIdx.x * NWAVES + F.wave, RPW = M / (F.G * NWAVES);
    bf16* H = (bf16*)F.out; float* BG = (float*)(F.ws + WS_BG);
    f32x4 gsc[4], gsh[4];
    { const int b = (gw * RPW) / T;
#pragma unroll
      for (int j = 0; j < 4; ++j) { const int col = 256 * j + 4 * F.lane; const f32x4 g1 = *(const f32x4*)(F.norm1_g + col);
          gsc[j] = g1 * (1.0f + *(const f32x4*)((const float*)(F.ws + CTL_MODACC) + b * 6144 + D + col)); gsh[j] = *(const f32x4*)((const float*)(F.ws + CTL_MODACC) + b * 6144 + col); } }
    for (int m = gw * RPW; m < (gw + 1) * RPW; ++m) {
        const f32x4* xr = (const f32x4*)(F.x + (size_t)m * D) + F.lane;
        f32x4 v[4]; float s = 0.f;
#pragma unroll
        for (int j = 0; j < 4; ++j) { v[j] = xr[64 * j]; s += (v[j].x * v[j].x + v[j].y * v[j].y) + (v[j].z * v[j].z + v[j].w * v[j].w); }
        const float rstd = __frsqrt_rn(wave_sum(s) * (1.f / D) + EPS);
        f32x4 hv[4];
#pragma unroll
        for (int j = 0; j < 4; ++j) { const int col = 256 * j + 4 * F.lane;
            hv[j] = v[j] * rstd * gsc[j] + gsh[j];
            *(v2u*)(H + (size_t)m * D + col) = (v2u){pk2(hv[j][0], hv[j][1]), pk2(hv[j][2], hv[j][3])};
        }
        float val = 0.f;
#pragma unroll 2
        for (int o = 0; o < 16; ++o) { float p = 0.f;
#pragma unroll
            for (int j = 0; j < 4; ++j) { const f32x4 w = *(const LAS f32x4*)(sBA + o * D + 256 * j + 4 * F.lane); p += (hv[j][0] * w[0] + hv[j][1] * w[1]) + (hv[j][2] * w[2] + hv[j][3] * w[3]); }
            p = wave_sum(p); val = (F.lane == o) ? p : val; }
        if (F.lane < 16) {
            float r;
            if (F.lane < 8) r = sigmoidf_(val);
            else { const int hh = F.lane - 8; const float xx = val + F.dt_bias[hh]; const float sp = xx > 20.f ? xx : log1pf(__expf(xx)); r = -__expf(F.a_log[hh]) * sp; }
            BG[(size_t)m * 16 + F.lane] = r;
        }
    }
}

__device__ __forceinline__ void p3a_ybp(Frame& F) {
    const bf16* SB = (const bf16*)(F.ws + WS_SB); const bf16* P = (const bf16*)(F.ws + WS_P); bf16* YBP = (bf16*)F.out + (size_t)M * D;
    const size_t total = (size_t)M * (D / 8);
    for (size_t i = (size_t)blockIdx.x * 512 + F.tid; i < total; i += (size_t)F.G * 512) {
        const int m = (int)(i >> 7), c8 = (int)(i & 127) * 8, t = m % T;
        f32x4 a0 = {0.f, 0.f, 0.f, 0.f}, a1 = a0;
#pragma unroll
        for (int j = 0; j < 3; ++j) { const int tt = t - 2 + j;
            if (tt >= 0) { f32x4 p0, p1; unpack8(*(const v4u*)(P + (size_t)(m - 2 + j) * D + c8), p0, p1);
                a0 += *(const f32x4*)(F.conv_sc_w + j * D + c8) * p0; a1 += *(const f32x4*)(F.conv_sc_w + j * D + c8 + 4) * p1; } }
        f32x4 s0, s1; unpack8(*(const v4u*)(SB + (size_t)m * D + c8), s0, s1);
        *(v4u*)(YBP + (size_t)m * D + c8) = pack8(s0 * a0, s1 * a1);
    }
}

__device__ __forceinline__ void p3b_chunk(Frame& F, int unit) {
    const int n = unit % NCH, bh = unit / NCH, h = bh % NH, b = bh / NH, t0 = n * CH, row0 = b * T + t0;
    LAS float* sq = (LAS float*)F.lds; LAS float* sk = sq + 64 * 129; LAS float* sv = sk + 64 * 129; LAS float* sA = sv + 64 * 129; LAS float* sT = sA + 64 * 65;
    LAS float* sgc = sT + 64 * 65; LAS float* sbeta = sgc + 64;
    const bf16* QKV = (const bf16*)(F.ws + WS_QKV); const float* BG = (const float*)(F.ws + WS_BG);
    for (int idx = F.tid; idx < 3 * 64 * 128; idx += 512) {
        const int sec = idx >> 13, r = (idx >> 7) & 63, c = idx & 127, gcol = sec * 1024 + h * 128 + c;
        float a = 0.f;
#pragma unroll
        for (int j = 0; j < 4; ++j) { const int tt = t0 + r - 3 + j; if (tt >= 0) a += F.conv_qkv_w[j * NQKV + gcol] * bf2f(QKV[(size_t)(b * T + tt) * NQKV + gcol]); }
        sq[sec * (64 * 129) + r * 129 + c] = siluf_(a);
    }
    if (F.tid < 64) { sgc[F.tid] = BG[(size_t)(row0 + F.tid) * 16 + 8 + h]; sbeta[F.tid] = BG[(size_t)(row0 + F.tid) * 16 + h]; }
    __syncthreads();
    for (int r = F.wave * 8; r < F.wave * 8 + 8; ++r) {
        const float q0 = sq[r * 129 + F.lane], q1 = sq[r * 129 + 64 + F.lane], k0 = sk[r * 129 + F.lane], k1 = sk[r * 129 + 64 + F.lane];
        const float qs = __frsqrt_rn(wave_sum(q0 * q0 + q1 * q1) + EPS) * 0.08838834764831845f, ks = __frsqrt_rn(wave_sum(k0 * k0 + k1 * k1) + EPS);
        sq[r * 129 + F.lane] = q0 * qs; sq[r * 129 + 64 + F.lane] = q1 * qs; sk[r * 129 + F.lane] = k0 * ks; sk[r * 129 + 64 + F.lane] = k1 * ks;
    }
    if (F.tid == 0) { float a = 0.f; for (int i = 0; i < 64; ++i) { a += sgc[i]; sgc[i] = a; } }
    __syncthreads();
    bf16* INo = (bf16*)(F.ws + WS_IN) + (size_t)unit * 4096;
    for (int idx = F.tid; idx < 4096; idx += 512) {
        const int i = idx >> 6, j = idx & 63; float av = 0.f, iv = 0.f;
        if (j <= i) { float dkk = 0.f, dqk = 0.f;
            for (int d = 0; d < 128; ++d) { const float kj = sk[j * 129 + d]; dkk += sk[i * 129 + d] * kj; dqk += sq[i * 129 + d] * kj; }
            const float dec = __expf(sgc[i] - sgc[j]); iv = dqk * dec; av = (j < i) ? sbeta[i] * dkk * dec : 0.f; }
        sA[i * 65 + j] = av; INo[idx] = (bf16)f2bf(iv);
    }
    __syncthreads();
    if (F.tid < 64) { const int c = F.tid;
        for (int i = 0; i < 64; ++i) { float t = 0.f;
            for (int j = 0; j < i; ++j) t -= sA[i * 65 + j] * sT[j * 65 + c];
            sT[i * 65 + c] = (i == c) ? 1.0f : ((i < c) ? 0.f : t); } }
    __syncthreads();
    bf16* UTo = (bf16*)(F.ws + WS_UT) + (size_t)unit * 8192; bf16* Wo = (bf16*)(F.ws + WS_W) + (size_t)unit * 8192;
    bf16* QDo = (bf16*)(F.ws + WS_QD) + (size_t)unit * 8192; bf16* KDTo = (bf16*)(F.ws + WS_KDT) + (size_t)unit * 8192;
    const float glast = sgc[63];
    for (int idx = F.tid; idx < 8192; idx += 512) {
        { const int dv = idx >> 6, i = idx & 63; float u = 0.f;
          for (int j = 0; j <= i; ++j) u += sT[i * 65 + j] * sbeta[j] * sv[j * 129 + dv];
          UTo[idx] = (bf16)f2bf(u);
          KDTo[idx] = (bf16)f2bf(sk[i * 129 + dv] * __expf(glast - sgc[i])); }
        { const int i = idx >> 7, dk = idx & 127; float w = 0.f;
          for (int j = 0; j <= i; ++j) w += sT[i * 65 + j] * sbeta[j] * __expf(sgc[j]) * sk[j * 129 + dk];
          Wo[idx] = (bf16)f2bf(w);
          QDo[idx] = (bf16)f2bf(sq[i * 129 + dk] * __expf(sgc[i])); }
    }
    if (F.tid == 0) ((float*)(F.ws + WS_DEC))[unit] = __expf(glast);
    __syncthreads();
}

__device__ __forceinline__ void p4_scan(Frame& F, int item) {
    const int bh = item >> 2, sl = item & 3, h = bh % NH, b = bh / NH;
    LAS float* sS = (LAS float*)F.lds;
    LAS float* sV = sS + 128 * 33;
    LAS bf16* sW = (LAS bf16*)(sV + 64 * 33);
    LAS bf16* sQ = sW + 64 * 136;
    LAS bf16* sK = sQ + 64 * 136;
    LAS bf16* sI = sK + 128 * 72;
    for (int i = F.tid; i < 128 * 33; i += 512) sS[i] = 0.f;
    bf16* OR = (bf16*)(F.ws + WS_OR); float* SSQ = (float*)(F.ws + CTL_SSQ);
    const int c = F.tid >> 3, d4 = (F.tid & 7) * 4, dk2 = F.tid >> 2, d8 = (F.tid & 3) * 8;
    for (int n = 0; n < NCH; ++n) {
        const int unit = bh * NCH + n;
        const bf16* Wg = (const bf16*)(F.ws + WS_W) + (size_t)unit * 8192; const bf16* Qg = (const bf16*)(F.ws + WS_QD) + (size_t)unit * 8192;
        const bf16* Kg = (const bf16*)(F.ws + WS_KDT) + (size_t)unit * 8192; const bf16* Ig = (const bf16*)(F.ws + WS_IN) + (size_t)unit * 4096;
        const bf16* Ug = (const bf16*)(F.ws + WS_UT) + (size_t)unit * 8192;
        __syncthreads();
        for (int i = F.tid; i < 1024; i += 512) { const int r = i >> 4, c8 = (i & 15) * 8;
            *(LAS v4u*)(sW + r * 136 + c8) = *(const v4u*)(Wg + r * 128 + c8); *(LAS v4u*)(sQ + r * 136 + c8) = *(const v4u*)(Qg + r * 128 + c8); }
        for (int i = F.tid; i < 1024; i += 512) { const int r = i >> 3, c8 = (i & 7) * 8; *(LAS v4u*)(sK + r * 72 + c8) = *(const v4u*)(Kg + r * 64 + c8); }
        { const int r = F.tid >> 3, c8 = (F.tid & 7) * 8; *(LAS v4u*)(sI + r * 72 + c8) = *(const v4u*)(Ig + r * 64 + c8); }
        const float dec = ((const float*)(F.ws + WS_DEC))[unit];
        __syncthreads();
        float pS[4] = {0.f, 0.f, 0.f, 0.f}, qS[4] = {0.f, 0.f, 0.f, 0.f};
        for (int dk = 0; dk < 128; ++dk) { const float wv = bf2f(sW[c * 136 + dk]), qv = bf2f(sQ[c * 136 + dk]);
#pragma unroll
            for (int e = 0; e < 4; ++e) { const float s = sS[dk * 33 + d4 + e]; pS[e] += wv * s; qS[e] += qv * s; } }
        float vn[4];
#pragma unroll
        for (int e = 0; e < 4; ++e) { vn[e] = bf2f(Ug[(sl * 32 + d4 + e) * 64 + c]) - pS[e]; sV[c * 33 + d4 + e] = vn[e]; }
        __syncthreads();
        float o[4] = {qS[0], qS[1], qS[2], qS[3]};
        for (int j = 0; j < 64; ++j) { const float iv = bf2f(sI[c * 72 + j]);
#pragma unroll
            for (int e = 0; e < 4; ++e) o[e] += iv * sV[j * 33 + d4 + e]; }
        const int row = b * T + n * CH + c;
        *(v2u*)(OR + (size_t)row * D + h * 128 + sl * 32 + d4) = (v2u){pk2(o[0], o[1]), pk2(o[2], o[3])};
        float ss = (o[0] * o[0] + o[1] * o[1]) + (o[2] * o[2] + o[3] * o[3]);
        ss += __shfl_xor(ss, 1); ss += __shfl_xor(ss, 2); ss += __shfl_xor(ss, 4);
        if ((F.tid & 7) == 0) atomicAdd(SSQ + (size_t)row * 8 + h, ss);
        float sn[8];
#pragma unroll
        for (int e = 0; e < 8; ++e) sn[e] = dec * sS[dk2 * 33 + d8 + e];
        for (int cc = 0; cc < 64; ++cc) { const float kv = bf2f(sK[dk2 * 72 + cc]);
#pragma unroll
            for (int e = 0; e < 8; ++e) sn[e] += kv * sV[cc * 33 + d8 + e]; }
        __syncthreads();
#pragma unroll
        for (int e = 0; e < 8; ++e) sS[dk2 * 33 + d8 + e] = sn[e];
    }
    __syncthreads();
}


typedef pg8::bf16x8 bx8;
#define MFMA16(a, b, c) __builtin_amdgcn_mfma_f32_16x16x32_bf16(a, b, c, 0, 0, 0)
__device__ __forceinline__ v2u pack4(const f32x4 a) { v2u r; r.x = cvt_pk_bf16(a[0], a[1]); r.y = cvt_pk_bf16(a[2], a[3]); return r; }
__device__ __forceinline__ void p4_scan_fast(Frame& F, int bh) {
    const int h = bh % NH, b = bh / NH, w = F.wave, l15 = F.lane & 15, lq = F.lane >> 4, ct = w >> 1, dvh = w & 1;
    LAS bf16* sST = (LAS bf16*)F.lds;
    LAS bf16* sVT = sST + 128 * 136;
    LAS float* sSS = (LAS float*)(sVT + 128 * 72);
    LAS float* sDEC = sSS + 128;
    if (F.tid < NCH) sDEC[F.tid] = ((const float*)(F.ws + WS_DEC))[bh * NCH + F.tid];
    for (int i = F.tid; i < 128 * 136 / 2; i += 512) ((LAS unsigned*)sST)[i] = 0u;
    const bf16* Wg = (const bf16*)(F.ws + WS_W) + (size_t)bh * NCH * 8192 + (16 * ct + l15) * 128 + 8 * lq;
    const bf16* Qg = (const bf16*)(F.ws + WS_QD) + (size_t)bh * NCH * 8192 + (16 * ct + l15) * 128 + 8 * lq;
    const bf16* Ig = (const bf16*)(F.ws + WS_IN) + (size_t)bh * NCH * 4096 + (16 * ct + l15) * 64 + 8 * lq;
    const bf16* Kg = (const bf16*)(F.ws + WS_KDT) + (size_t)bh * NCH * 8192 + (16 * w + l15) * 64 + 8 * lq;
    const bf16* Ug = (const bf16*)(F.ws + WS_UT) + (size_t)bh * NCH * 8192 + (16 * 4 * dvh + l15) * 64 + 16 * ct + 4 * lq;
    bf16* OR = (bf16*)(F.ws + WS_OR);
    bx8 fW[4], fQ[4], fI[2], fK[2]; v2u fU[4];
#pragma unroll
    for (int ks = 0; ks < 4; ++ks) { fW[ks] = *(const bx8*)(Wg + 32 * ks); fQ[ks] = *(const bx8*)(Qg + 32 * ks); fU[ks] = *(const v2u*)(Ug + ks * 16 * 64); }
#pragma unroll
    for (int ks = 0; ks < 2; ++ks) { fI[ks] = *(const bx8*)(Ig + 32 * ks); fK[ks] = *(const bx8*)(Kg + 32 * ks); }
    f32x4 S[8], gn[4];
#pragma unroll
    for (int t = 0; t < 8; ++t) S[t] = (f32x4){0.f, 0.f, 0.f, 0.f};
#pragma unroll
    for (int t = 0; t < 4; ++t) gn[t] = *(const f32x4*)(F.onorm_g + 16 * (4 * dvh + t) + 4 * lq);
    __syncthreads();
    for (int n = 0; n < NCH; ++n) {
        const float dec = sDEC[n];
        const int nn = (n + 1 < NCH) ? 1 : 0;
        f32x4 pS[4], qS[4];
#pragma unroll
        for (int t = 0; t < 4; ++t) { bx8 fS[4];
#pragma unroll
            for (int ks = 0; ks < 4; ++ks) fS[ks] = *(const LAS bx8*)(sST + (16 * (4 * dvh + t) + l15) * 136 + 32 * ks + 8 * lq);
            f32x4 p = {0.f, 0.f, 0.f, 0.f}, q = {0.f, 0.f, 0.f, 0.f};
#pragma unroll
            for (int ks = 0; ks < 4; ++ks) { p = MFMA16(fW[ks], fS[ks], p); q = MFMA16(fS[ks], fQ[ks], q); }
            pS[t] = p; qS[t] = q; }
#pragma unroll
        for (int t = 0; t < 4; ++t) { const f32x4 u = {bflo(fU[t].x), bfhi(fU[t].x), bflo(fU[t].y), bfhi(fU[t].y)};
            *(LAS v2u*)(sVT + (16 * (4 * dvh + t) + l15) * 72 + 16 * ct + 4 * lq) = pack4(u - pS[t]); }
        Wg += nn * 8192; Qg += nn * 8192; Ug += nn * 8192;
#pragma unroll
        for (int ks = 0; ks < 4; ++ks) { fW[ks] = *(const bx8*)(Wg + 32 * ks); fQ[ks] = *(const bx8*)(Qg + 32 * ks); fU[ks] = *(const v2u*)(Ug + ks * 16 * 64); }
        __syncthreads();
        float ss = 0.f;
#pragma unroll
        for (int t = 0; t < 4; ++t) {
#pragma unroll
            for (int ks = 0; ks < 2; ++ks) { const bx8 fV = *(const LAS bx8*)(sVT + (16 * (4 * dvh + t) + l15) * 72 + 32 * ks + 8 * lq); qS[t] = MFMA16(fV, fI[ks], qS[t]); }
            ss += (qS[t][0] * qS[t][0] + qS[t][1] * qS[t][1]) + (qS[t][2] * qS[t][2] + qS[t][3] * qS[t][3]); }
        ss += __shfl_xor(ss, 16); ss += __shfl_xor(ss, 32);
        if (lq == 0) sSS[dvh * 64 + 16 * ct + l15] = ss;
        Ig += nn * 4096;
#pragma unroll
        for (int ks = 0; ks < 2; ++ks) fI[ks] = *(const bx8*)(Ig + 32 * ks);
#pragma unroll
        for (int t = 0; t < 8; ++t) { S[t] = S[t] * dec;
#pragma unroll
            for (int ks = 0; ks < 2; ++ks) { const bx8 fV = *(const LAS bx8*)(sVT + (16 * t + l15) * 72 + 32 * ks + 8 * lq); S[t] = MFMA16(fK[ks], fV, S[t]); }
            *(LAS v2u*)(sST + (16 * t + l15) * 136 + 16 * w + 4 * lq) = pack4(S[t]); }
        Kg += nn * 8192;
#pragma unroll
        for (int ks = 0; ks < 2; ++ks) fK[ks] = *(const bx8*)(Kg + 32 * ks);
        __syncthreads();
        const float rstd = __frsqrt_rn((sSS[16 * ct + l15] + sSS[64 + 16 * ct + l15]) * (1.0f / 128.0f) + EPS);
        bf16* orow = OR + (size_t)(b * T + n * CH + 16 * ct + l15) * D + h * 128 + 16 * 4 * dvh + 4 * lq;
#pragma unroll
        for (int t = 0; t < 4; ++t) *(v2u*)(orow + 16 * t) = pack4(qS[t] * rstd * gn[t]);
    }
    __syncthreads();
}


#define MFMA_F32(a, b, c) __builtin_amdgcn_mfma_f32_16x16x4f32(a, b, c, 0, 0, 0)
__device__ __forceinline__ void solve_block(LAS float* sA, LAS float* sT, int bi, int bj, int l15, int lq) {
    f32x4 y = {0.f, 0.f, 0.f, 0.f};
    for (int km = bj; km < bi; ++km)
#pragma unroll
        for (int kb = 0; kb < 4; ++kb) y = MFMA_F32(sA[(16 * bi + l15) * 68 + 16 * km + 4 * kb + lq], sT[(16 * km + 4 * kb + lq) * 68 + 16 * bj + l15], y);
    f32x4 z = {0.f, 0.f, 0.f, 0.f};
#pragma unroll
    for (int e = 0; e < 4; ++e) z = MFMA_F32(sT[(16 * bi + l15) * 68 + 16 * bi + 4 * lq + e], y[e], z);
#pragma unroll
    for (int e = 0; e < 4; ++e) sT[(16 * bi + 4 * lq + e) * 68 + 16 * bj + l15] = -z[e];
}
__device__ __forceinline__ void p3b_fast(Frame& F, int unit) {
    const int n = unit % NCH, bh = unit / NCH, h = bh % NH, b = bh / NH, t0 = n * CH, row0 = b * T + t0;
    const int tid = F.tid, w = F.wave, lane = F.lane, l15 = lane & 15, lq = lane >> 4;
    LAS bf16* sQ = (LAS bf16*)F.lds; LAS bf16* sK = sQ + 64 * 136; LAS bf16* sKG = sK + 64 * 136; LAS bf16* sVB = sKG + 128 * 72;
    LAS float* sA = (LAS float*)(sVB + 128 * 72); LAS float* sT = sA + 64 * 68; LAS bf16* sTb = (LAS bf16*)(sT + 64 * 68); LAS float* sgc = (LAS float*)(sTb + 64 * 72);
    const bf16* QKV = (const bf16*)(F.ws + WS_QKV); const float* BG = (const float*)(F.ws + WS_BG);
    bf16* INo = (bf16*)(F.ws + WS_IN) + (size_t)unit * 4096; bf16* UTo = (bf16*)(F.ws + WS_UT) + (size_t)unit * 8192; bf16* Wo = (bf16*)(F.ws + WS_W) + (size_t)unit * 8192;
    bf16* QDo = (bf16*)(F.ws + WS_QD) + (size_t)unit * 8192; bf16* KDTo = (bf16*)(F.ws + WS_KDT) + (size_t)unit * 8192;
    if (w == 0) {
        const float g = BG[(size_t)(row0 + lane) * 16 + 8 + h], bt = BG[(size_t)(row0 + lane) * 16 + h];
        float s = g;
#pragma unroll
        for (int o = 1; o < 64; o <<= 1) { const float t = __shfl_up(s, o); if (lane >= o) s += t; }
        const float gl = __shfl(s, 63);
        sgc[lane] = s; sgc[64 + lane] = bt; sgc[128 + lane] = __expf(s); sgc[192 + lane] = __expf(gl - s);
        if (lane == 0) ((float*)(F.ws + WS_DEC))[unit] = __expf(gl);
    }
    for (int i = tid; i < 64 * 68; i += 512) sT[i] = 0.f;
    __syncthreads();
    if (tid < 384) {
        const int rs = tid / 48, cg = tid % 48, sec = cg >> 4, c8 = (cg & 15) * 8, r0 = 8 * rs, gcol = sec * 1024 + h * 128 + c8;
        f32x4 wt[4][2];
#pragma unroll
        for (int j = 0; j < 4; ++j) { wt[j][0] = *(const f32x4*)(F.conv_qkv_w + j * NQKV + gcol); wt[j][1] = *(const f32x4*)(F.conv_qkv_w + j * NQKV + gcol + 4); }
        v4u raw[11];
#pragma unroll
        for (int i = 0; i < 11; ++i) { const int tt = t0 + r0 - 3 + i; raw[i] = (tt >= 0) ? *(const v4u*)(QKV + (size_t)(b * T + tt) * NQKV + gcol) : (v4u){0u, 0u, 0u, 0u}; }
        f32x4 o0[8], o1[8];
#pragma unroll
        for (int r = 0; r < 8; ++r) { f32x4 a0 = {0.f, 0.f, 0.f, 0.f}, a1 = a0;
#pragma unroll
            for (int j = 0; j < 4; ++j) { f32x4 x0, x1; unpack8(raw[r + j], x0, x1); a0 += wt[j][0] * x0; a1 += wt[j][1] * x1; }
#pragma unroll
            for (int e = 0; e < 4; ++e) { a0[e] = siluf_(a0[e]); a1[e] = siluf_(a1[e]); }
            float ss = (a0[0] * a0[0] + a0[1] * a0[1]) + (a0[2] * a0[2] + a0[3] * a0[3]) + (a1[0] * a1[0] + a1[1] * a1[1]) + (a1[2] * a1[2] + a1[3] * a1[3]);
            ss += __shfl_xor(ss, 1); ss += __shfl_xor(ss, 2); ss += __shfl_xor(ss, 4); ss += __shfl_xor(ss, 8);
            const float sc = (sec == 2) ? 1.0f : __frsqrt_rn(ss + EPS) * (sec == 0 ? 0.08838834764831845f : 1.0f);
            o0[r] = a0 * sc; o1[r] = a1 * sc; }
        if (sec == 0) {
#pragma unroll
            for (int r = 0; r < 8; ++r) { *(LAS v4u*)(sQ + (r0 + r) * 136 + c8) = pack8(o0[r], o1[r]); const float eg = sgc[128 + r0 + r];
                *(v4u*)(QDo + (r0 + r) * 128 + c8) = pack8(o0[r] * eg, o1[r] * eg); }
        } else if (sec == 1) {
            float fk[8], fd[8];
#pragma unroll
            for (int r = 0; r < 8; ++r) { *(LAS v4u*)(sK + (r0 + r) * 136 + c8) = pack8(o0[r], o1[r]); fk[r] = sgc[64 + r0 + r] * sgc[128 + r0 + r]; fd[r] = sgc[192 + r0 + r]; }
#pragma unroll
            for (int e = 0; e < 4; ++e) {
                { const f32x4 a = {o0[0][e] * fk[0], o0[1][e] * fk[1], o0[2][e] * fk[2], o0[3][e] * fk[3]}, bq = {o0[4][e] * fk[4], o0[5][e] * fk[5], o0[6][e] * fk[6], o0[7][e] * fk[7]};
                  *(LAS v4u*)(sKG + (c8 + e) * 72 + r0) = pack8(a, bq);
                  const f32x4 c = {o0[0][e] * fd[0], o0[1][e] * fd[1], o0[2][e] * fd[2], o0[3][e] * fd[3]}, d = {o0[4][e] * fd[4], o0[5][e] * fd[5], o0[6][e] * fd[6], o0[7][e] * fd[7]};
                  *(v4u*)(KDTo + (c8 + e) * 64 + r0) = pack8(c, d); }
                { const f32x4 a = {o1[0][e] * fk[0], o1[1][e] * fk[1], o1[2][e] * fk[2], o1[3][e] * fk[3]}, bq = {o1[4][e] * fk[4], o1[5][e] * fk[5], o1[6][e] * fk[6], o1[7][e] * fk[7]};
                  *(LAS v4u*)(sKG + (c8 + 4 + e) * 72 + r0) = pack8(a, bq);
                  const f32x4 c = {o1[0][e] * fd[0], o1[1][e] * fd[1], o1[2][e] * fd[2], o1[3][e] * fd[3]}, d = {o1[4][e] * fd[4], o1[5][e] * fd[5], o1[6][e] * fd[6], o1[7][e] * fd[7]};
                  *(v4u*)(KDTo + (c8 + 4 + e) * 64 + r0) = pack8(c, d); }
            }
        } else {
            float fb[8];
#pragma unroll
            for (int r = 0; r < 8; ++r) fb[r] = sgc[64 + r0 + r];
#pragma unroll
            for (int e = 0; e < 4; ++e) {
                { const f32x4 a = {o0[0][e] * fb[0], o0[1][e] * fb[1], o0[2][e] * fb[2], o0[3][e] * fb[3]}, bq = {o0[4][e] * fb[4], o0[5][e] * fb[5], o0[6][e] * fb[6], o0[7][e] * fb[7]};
                  *(LAS v4u*)(sVB + (c8 + e) * 72 + r0) = pack8(a, bq); }
                { const f32x4 a = {o1[0][e] * fb[0], o1[1][e] * fb[1], o1[2][e] * fb[2], o1[3][e] * fb[3]}, bq = {o1[4][e] * fb[4], o1[5][e] * fb[5], o1[6][e] * fb[6], o1[7][e] * fb[7]};
                  *(LAS v4u*)(sVB + (c8 + 4 + e) * 72 + r0) = pack8(a, bq); }
            }
        }
    }
    __syncthreads();
    {
        const int jt = w & 3, itp = w >> 2;
        bx8 ak[4];
#pragma unroll
        for (int ks = 0; ks < 4; ++ks) ak[ks] = *(const LAS bx8*)(sK + (16 * jt + l15) * 136 + 32 * ks + 8 * lq);
#pragma unroll
        for (int ii = 0; ii < 2; ++ii) { const int it = 2 * itp + ii, ci = 16 * it + l15;
            f32x4 xk = {0.f, 0.f, 0.f, 0.f}, xq = xk;
#pragma unroll
            for (int ks = 0; ks < 4; ++ks) { const bx8 bk = *(const LAS bx8*)(sK + ci * 136 + 32 * ks + 8 * lq), bq = *(const LAS bx8*)(sQ + ci * 136 + 32 * ks + 8 * lq);
                xk = MFMA16(ak[ks], bk, xk); xq = MFMA16(ak[ks], bq, xq); }
            const float gi = sgc[ci], bi = sgc[64 + ci];
            f32x4 av, iv;
#pragma unroll
            for (int e = 0; e < 4; ++e) { const int cj = 16 * jt + 4 * lq + e; const float dec = __expf(gi - sgc[cj]);
                av[e] = (cj < ci) ? bi * xk[e] * dec : 0.f; iv[e] = (cj <= ci) ? xq[e] * dec : 0.f; }
            *(LAS f32x4*)(sA + ci * 68 + 16 * jt + 4 * lq) = av;
            *(v2u*)(INo + ci * 64 + 16 * jt + 4 * lq) = pack4(iv); }
    }
    __syncthreads();
    if (w == 0) {
        const int blk = lq, c = l15; float t[16];
#pragma unroll
        for (int i = 0; i < 16; ++i) { float s = 0.f;
#pragma unroll
            for (int jb = 0; jb < (i + 3) / 4; ++jb) { const f32x4 a4 = *(const LAS f32x4*)(sA + (16 * blk + i) * 68 + 16 * blk + 4 * jb);
#pragma unroll
                for (int e = 0; e < 4; ++e) if (4 * jb + e < i) s -= a4[e] * t[4 * jb + e]; }
            t[i] = (i == c) ? 1.0f : s;
            sT[(16 * blk + i) * 68 + 16 * blk + c] = t[i]; }
    }
    __syncthreads();
    if (w < 3) solve_block(sA, sT, w + 1, w, l15, lq);
    __syncthreads();
    if (w < 2) solve_block(sA, sT, w + 2, w, l15, lq);
    __syncthreads();
    if (w < 1) solve_block(sA, sT, 3, 0, l15, lq);
    __syncthreads();
    { const int i = tid >> 3, j8 = (tid & 7) * 8; *(LAS v4u*)(sTb + i * 72 + j8) = pack8(*(const LAS f32x4*)(sT + i * 68 + j8), *(const LAS f32x4*)(sT + i * 68 + j8 + 4)); }
    __syncthreads();
    {
        bx8 bv[2], ag[2];
#pragma unroll
        for (int ks = 0; ks < 2; ++ks) { bv[ks] = *(const LAS bx8*)(sVB + (16 * w + l15) * 72 + 32 * ks + 8 * lq); ag[ks] = *(const LAS bx8*)(sKG + (16 * w + l15) * 72 + 32 * ks + 8 * lq); }
#pragma unroll
        for (int it = 0; it < 4; ++it) { f32x4 u = {0.f, 0.f, 0.f, 0.f}, ww = u;
#pragma unroll
            for (int ks = 0; ks < 2; ++ks) { const bx8 ft = *(const LAS bx8*)(sTb + (16 * it + l15) * 72 + 32 * ks + 8 * lq); u = MFMA16(ft, bv[ks], u); ww = MFMA16(ag[ks], ft, ww); }
            *(v2u*)(UTo + (16 * w + l15) * 64 + 16 * it + 4 * lq) = pack4(u);
            *(v2u*)(Wo + (16 * it + l15) * 128 + 16 * w + 4 * lq) = pack4(ww); }
    }
    __syncthreads();
}


__device__ __forceinline__ void p4a_seg(Frame& F, int seg) {
    const int w = F.wave, l15 = F.lane & 15, lq = F.lane >> 4, ct = w >> 1, ch = w & 1;
    const int bh = seg >> 4, g = seg & 15, unit0 = bh * NCH + 8 * g;
    LAS bf16* sST = (LAS bf16*)F.lds;
    LAS bf16* sVT = sST + 256 * 136;
    LAS float* sDEC = (LAS float*)(sVT + 256 * 72);
    if (F.tid < 8) sDEC[F.tid] = ((const float*)(F.ws + WS_DEC))[unit0 + F.tid];
    for (int i = F.tid; i < 256 * 136 / 2; i += 512) ((LAS unsigned*)sST)[i] = 0u;
    __syncthreads();
    if (F.tid < 128) sST[F.tid * 136 + F.tid] = (bf16)0x3F80;
    f32x4 ST[16];
#pragma unroll
    for (int t = 0; t < 16; ++t)
#pragma unroll
        for (int e = 0; e < 4; ++e) ST[t][e] = (t == w && l15 == 4 * lq + e) ? 1.0f : 0.0f;
    const bf16* Wg = (const bf16*)(F.ws + WS_W) + (size_t)unit0 * 8192 + (16 * ct + l15) * 128 + 8 * lq;
    const bf16* Kg = (const bf16*)(F.ws + WS_KDT) + (size_t)unit0 * 8192 + (16 * w + l15) * 64 + 8 * lq;
    const bf16* Ug = (const bf16*)(F.ws + WS_UT) + (size_t)unit0 * 8192 + l15 * 64 + 16 * ct + 4 * lq;
    bx8 fW[4], fK[2]; v2u fU[8];
#pragma unroll
    for (int ks = 0; ks < 4; ++ks) fW[ks] = *(const bx8*)(Wg + 32 * ks);
#pragma unroll
    for (int ks = 0; ks < 2; ++ks) fK[ks] = *(const bx8*)(Kg + 32 * ks);
#pragma unroll
    for (int t = 0; t < 8; ++t) fU[t] = ch ? *(const v2u*)(Ug + t * 16 * 64) : (v2u){0u, 0u};
    __syncthreads();
    for (int sI = 0; sI < 8; ++sI) {
        const float dec = sDEC[sI];
        const int nn = (sI < 7) ? 1 : 0;
#pragma unroll
        for (int t = 0; t < 8; ++t) { const int Tc = 8 * ch + t; f32x4 p = {0.f, 0.f, 0.f, 0.f};
#pragma unroll
            for (int ks = 0; ks < 4; ++ks) { const bx8 fS = *(const LAS bx8*)(sST + (16 * Tc + l15) * 136 + 32 * ks + 8 * lq); p = MFMA16(fW[ks], fS, p); }
            const f32x4 u = {bflo(fU[t].x), bfhi(fU[t].x), bflo(fU[t].y), bfhi(fU[t].y)};
            *(LAS v2u*)(sVT + (16 * Tc + l15) * 72 + 16 * ct + 4 * lq) = pack4(u - p); }
        Wg += nn * 8192; Ug += nn * 8192;
#pragma unroll
        for (int ks = 0; ks < 4; ++ks) fW[ks] = *(const bx8*)(Wg + 32 * ks);
#pragma unroll
        for (int t = 0; t < 8; ++t) fU[t] = ch ? *(const v2u*)(Ug + t * 16 * 64) : (v2u){0u, 0u};
        __syncthreads();
#pragma unroll
        for (int t = 0; t < 16; ++t) { ST[t] = ST[t] * dec;
#pragma unroll
            for (int ks = 0; ks < 2; ++ks) { const bx8 fV = *(const LAS bx8*)(sVT + (16 * t + l15) * 72 + 32 * ks + 8 * lq); ST[t] = MFMA16(fK[ks], fV, ST[t]); }
            *(LAS v2u*)(sST + (16 * t + l15) * 136 + 16 * w + 4 * lq) = pack4(ST[t]); }
        Kg += nn * 8192;
#pragma unroll
        for (int ks = 0; ks < 2; ++ks) fK[ks] = *(const bx8*)(Kg + 32 * ks);
        __syncthreads();
    }
    bf16* PHI = (bf16*)(F.ws + WS_PHI) + (size_t)seg * 16384;
#pragma unroll
    for (int t = 0; t < 8; ++t)
#pragma unroll
        for (int e = 0; e < 4; ++e) PHI[(16 * w + 4 * lq + e) * 128 + 16 * t + l15] = (bf16)f2bf(ST[t][e]);
    f32x4* LS = (f32x4*)(F.ws + WS_LSEG) + ((size_t)(seg * 8 + w) * 8) * 64 + F.lane;
#pragma unroll
    for (int t = 0; t < 8; ++t) LS[t * 64] = ST[8 + t];
}
__device__ __forceinline__ void p4b_fold(Frame& F, int item) {
    const int w = F.wave, l15 = F.lane & 15, lq = F.lane >> 4, bh = item >> 2, dvs = item & 3;
    LAS bf16* sS = (LAS bf16*)F.lds;
    for (int i = F.tid; i < 32 * 136 / 2; i += 512) ((LAS unsigned*)sS)[i] = 0u;
    const bf16* Pg = (const bf16*)(F.ws + WS_PHI) + (size_t)(bh * 16) * 16384 + (16 * w + l15) * 128 + 8 * lq;
    const f32x4* Lg = (const f32x4*)(F.ws + WS_LSEG) + ((size_t)(bh * 16 * 8 + w) * 8 + 2 * dvs) * 64 + F.lane;
    f32x4* So = (f32x4*)(F.ws + WS_SST) + ((size_t)((bh * 16 + 1) * 8 + w) * 8 + 2 * dvs) * 64 + F.lane;
    bx8 fP[4]; f32x4 L[2];
#pragma unroll
    for (int ks = 0; ks < 4; ++ks) fP[ks] = *(const bx8*)(Pg + 32 * ks);
    L[0] = Lg[0]; L[1] = Lg[64];
    __syncthreads();
    for (int g = 0; g < 15; ++g) {
        f32x4 Sn[2];
#pragma unroll
        for (int t = 0; t < 2; ++t) { f32x4 acc = L[t];
#pragma unroll
            for (int ks = 0; ks < 4; ++ks) { const bx8 fS = *(const LAS bx8*)(sS + (16 * t + l15) * 136 + 32 * ks + 8 * lq); acc = MFMA16(fP[ks], fS, acc); }
            Sn[t] = acc; }
        const int nn = (g < 14) ? 1 : 0;
        Pg += nn * 16384; Lg += nn * 8 * 8 * 64;
#pragma unroll
        for (int ks = 0; ks < 4; ++ks) fP[ks] = *(const bx8*)(Pg + 32 * ks);
        L[0] = Lg[0]; L[1] = Lg[64];
        __syncthreads();
#pragma unroll
        for (int t = 0; t < 2; ++t) { *(LAS v2u*)(sS + (16 * t + l15) * 136 + 16 * w + 4 * lq) = pack4(Sn[t]); So[t * 64] = Sn[t]; }
        So += 8 * 8 * 64;
        __syncthreads();
    }
}
__device__ __forceinline__ void p4c_seg(Frame& F, int seg) {
    const int bh = seg >> 4, g = seg & 15, unit0 = bh * NCH + 8 * g;
    const int h = bh % NH, b = bh / NH, w = F.wave, l15 = F.lane & 15, lq = F.lane >> 4, ct = w >> 1, dvh = w & 1;
    LAS bf16* sST = (LAS bf16*)F.lds;
    LAS bf16* sVT = sST + 128 * 136;
    LAS float* sSS = (LAS float*)(sVT + 128 * 72);
    LAS float* sDEC = sSS + 128;
    if (F.tid < 8) sDEC[F.tid] = ((const float*)(F.ws + WS_DEC))[unit0 + F.tid];
    f32x4 S[8], gn[4];
    { const f32x4* Sg = (const f32x4*)(F.ws + WS_SST) + ((size_t)(seg * 8 + w) * 8) * 64 + F.lane;
#pragma unroll
      for (int t = 0; t < 8; ++t) { S[t] = (g == 0) ? (f32x4){0.f, 0.f, 0.f, 0.f} : Sg[t * 64];
          *(LAS v2u*)(sST + (16 * t + l15) * 136 + 16 * w + 4 * lq) = pack4(S[t]); } }
    const bf16* Wg = (const bf16*)(F.ws + WS_W) + (size_t)unit0 * 8192 + (16 * ct + l15) * 128 + 8 * lq;
    const bf16* Qg = (const bf16*)(F.ws + WS_QD) + (size_t)unit0 * 8192 + (16 * ct + l15) * 128 + 8 * lq;
    const bf16* Ig = (const bf16*)(F.ws + WS_IN) + (size_t)unit0 * 4096 + (16 * ct + l15) * 64 + 8 * lq;
    const bf16* Kg = (const bf16*)(F.ws + WS_KDT) + (size_t)unit0 * 8192 + (16 * w + l15) * 64 + 8 * lq;
    const bf16* Ug = (const bf16*)(F.ws + WS_UT) + (size_t)unit0 * 8192 + (16 * 4 * dvh + l15) * 64 + 16 * ct + 4 * lq;
    bf16* OR = (bf16*)(F.ws + WS_OR);
    bx8 fW[4], fQ[4], fI[2], fK[2]; v2u fU[4];
#pragma unroll
    for (int ks = 0; ks < 4; ++ks) { fW[ks] = *(const bx8*)(Wg + 32 * ks); fQ[ks] = *(const bx8*)(Qg + 32 * ks); fU[ks] = *(const v2u*)(Ug + ks * 16 * 64); }
#pragma unroll
    for (int ks = 0; ks < 2; ++ks) { fI[ks] = *(const bx8*)(Ig + 32 * ks); fK[ks] = *(const bx8*)(Kg + 32 * ks); }
#pragma unroll
    for (int t = 0; t < 4; ++t) gn[t] = *(const f32x4*)(F.onorm_g + 16 * (4 * dvh + t) + 4 * lq);
    __syncthreads();
    for (int sI = 0; sI < 8; ++sI) {
        const float dec = sDEC[sI];
        const int nn = (sI < 7) ? 1 : 0;
        f32x4 pS[4], qS[4];
#pragma unroll
        for (int t = 0; t < 4; ++t) { bx8 fS[4];
#pragma unroll
            for (int ks = 0; ks < 4; ++ks) fS[ks] = *(const LAS bx8*)(sST + (16 * (4 * dvh + t) + l15) * 136 + 32 * ks + 8 * lq);
            f32x4 p = {0.f, 0.f, 0.f, 0.f}, q = {0.f, 0.f, 0.f, 0.f};
#pragma unroll
            for (int ks = 0; ks < 4; ++ks) { p = MFMA16(fW[ks], fS[ks], p); q = MFMA16(fS[ks], fQ[ks], q); }
            pS[t] = p; qS[t] = q; }
#pragma unroll
        for (int t = 0; t < 4; ++t) { const f32x4 u = {bflo(fU[t].x), bfhi(fU[t].x), bflo(fU[t].y), bfhi(fU[t].y)};
            *(LAS v2u*)(sVT + (16 * (4 * dvh + t) + l15) * 72 + 16 * ct + 4 * lq) = pack4(u - pS[t]); }
        Wg += nn * 8192; Qg += nn * 8192; Ug += nn * 8192;
#pragma unroll
        for (int ks = 0; ks < 4; ++ks) { fW[ks] = *(const bx8*)(Wg + 32 * ks); fQ[ks] = *(const bx8*)(Qg + 32 * ks); fU[ks] = *(const v2u*)(Ug + ks * 16 * 64); }
        __syncthreads();
        float ss = 0.f;
#pragma unroll
        for (int t = 0; t < 4; ++t) {
#pragma unroll
            for (int ks = 0; ks < 2; ++ks) { const bx8 fV = *(const LAS bx8*)(sVT + (16 * (4 * dvh + t) + l15) * 72 + 32 * ks + 8 * lq); qS[t] = MFMA16(fV, fI[ks], qS[t]); }
            ss += (qS[t][0] * qS[t][0] + qS[t][1] * qS[t][1]) + (qS[t][2] * qS[t][2] + qS[t][3] * qS[t][3]); }
        ss += __shfl_xor(ss, 16); ss += __shfl_xor(ss, 32);
        if (lq == 0) sSS[dvh * 64 + 16 * ct + l15] = ss;
        Ig += nn * 4096;
#pragma unroll
        for (int ks = 0; ks < 2; ++ks) fI[ks] = *(const bx8*)(Ig + 32 * ks);
#pragma unroll
        for (int t = 0; t < 8; ++t) { S[t] = S[t] * dec;
#pragma unroll
            for (int ks = 0; ks < 2; ++ks) { const bx8 fV = *(const LAS bx8*)(sVT + (16 * t + l15) * 72 + 32 * ks + 8 * lq); S[t] = MFMA16(fK[ks], fV, S[t]); }
            *(LAS v2u*)(sST + (16 * t + l15) * 136 + 16 * w + 4 * lq) = pack4(S[t]); }
        Kg += nn * 8192;
#pragma unroll
        for (int ks = 0; ks < 2; ++ks) fK[ks] = *(const bx8*)(Kg + 32 * ks);
        __syncthreads();
        const float rstd = __frsqrt_rn((sSS[16 * ct + l15] + sSS[64 + 16 * ct + l15]) * (1.0f / 128.0f) + EPS);
        bf16* orow = OR + (size_t)(b * T + (8 * g + sI) * CH + 16 * ct + l15) * D + h * 128 + 16 * 4 * dvh + 4 * lq;
#pragma unroll
        for (int t = 0; t < 4; ++t) *(v2u*)(orow + 16 * t) = pack4(qS[t] * rstd * gn[t]);
    }
    __syncthreads();
}

__device__ __forceinline__ void p8_router(Frame& F) {
    const int gw = blockIdx.x * NWAVES + F.wave, RPW = M / (F.G * NWAVES);
    bf16* H2 = (bf16*)(F.ws + WS_H2); int* TOKE = (int*)(F.ws + WS_TOKE); float* TOKW = (float*)(F.ws + WS_TOKW);
    LAS unsigned* hist = (LAS unsigned*)F.lds;
    if (F.tid < NE) hist[F.tid] = 0u;
    __syncthreads();
    f32x4 gsc[4], gsh[4];
    { const int b = (gw * RPW) / T;
#pragma unroll
      for (int j = 0; j < 4; ++j) { const int col = 256 * j + 4 * F.lane; const f32x4 g2 = *(const f32x4*)(F.norm2_g + col);
          gsc[j] = g2 * (1.0f + *(const f32x4*)((const float*)(F.ws + CTL_MODACC) + b * 6144 + 4 * D + col)); gsh[j] = *(const f32x4*)((const float*)(F.ws + CTL_MODACC) + b * 6144 + 3 * D + col); } }
    for (int m = gw * RPW; m < (gw + 1) * RPW; ++m) {
        const f32x4* xr = (const f32x4*)(F.out + (size_t)m * D) + F.lane;
        f32x4 v[4]; float s = 0.f;
#pragma unroll
        for (int j = 0; j < 4; ++j) { v[j] = xr[64 * j]; s += (v[j].x * v[j].x + v[j].y * v[j].y) + (v[j].z * v[j].z + v[j].w * v[j].w); }
        const float rstd = __frsqrt_rn(wave_sum(s) * (1.f / D) + EPS);
        float gl[4] = {0.f, 0.f, 0.f, 0.f};
#pragma unroll
        for (int j = 0; j < 4; ++j) { const int col = 256 * j + 4 * F.lane;
            v[j] = v[j] * rstd * gsc[j] + gsh[j];
#pragma unroll
            for (int e = 0; e < 4; ++e) {
                const f32x4 wg = *(const f32x4*)(F.w_group + (size_t)(col + e) * 4);
#pragma unroll
                for (int q = 0; q < 4; ++q) gl[q] += v[j][e] * wg[q]; }
            *(v2u*)(H2 + (size_t)m * D + col) = (v2u){pk2(v[j][0], v[j][1]), pk2(v[j][2], v[j][3])};
        }
#pragma unroll
        for (int q = 0; q < 4; ++q) gl[q] = wave_sum(gl[q]) + F.b_group[q];
        int gs = 0; float gm = gl[0];
#pragma unroll
        for (int q = 1; q < 4; ++q) if (gl[q] > gm) { gm = gl[q]; gs = q; }
        float den = 0.f;
#pragma unroll
        for (int q = 0; q < 4; ++q) den += __expf(gl[q] - gm);
        const float pg = 1.0f / den;
        float el[8] = {0.f, 0.f, 0.f, 0.f, 0.f, 0.f, 0.f, 0.f};
#pragma unroll
        for (int j = 0; j < 4; ++j) { const int col = 256 * j + 4 * F.lane;
#pragma unroll
            for (int e = 0; e < 4; ++e) { const float* wp = F.w_expert + (size_t)(col + e) * NE + gs * 8; const f32x4 w0 = *(const f32x4*)wp, w1 = *(const f32x4*)(wp + 4);
#pragma unroll
                for (int q = 0; q < 4; ++q) { el[q] += v[j][e] * w0[q]; el[4 + q] += v[j][e] * w1[q]; } } }
#pragma unroll
        for (int q = 0; q < 8; ++q) el[q] = wave_sum(el[q]) + F.b_expert[gs * 8 + q];
        int i0 = 0; float v0 = el[0];
#pragma unroll
        for (int q = 1; q < 8; ++q) if (el[q] > v0) { v0 = el[q]; i0 = q; }
        int i1 = -1; float v1 = -3.0e38f;
#pragma unroll
        for (int q = 0; q < 8; ++q) if (q != i0 && el[q] > v1) { v1 = el[q]; i1 = q; }
        const float e1 = __expf(v1 - v0), sw = 1.0f / (1.0f + e1);
        if (F.lane == 0) {
            const int ea = gs * 8 + i0, eb = gs * 8 + i1;
            TOKE[m * 2] = ea; TOKE[m * 2 + 1] = eb; TOKW[m * 2] = pg * sw; TOKW[m * 2 + 1] = pg * e1 * sw;
            __hip_atomic_fetch_add((unsigned*)(hist + ea), 1u, __ATOMIC_RELAXED, __HIP_MEMORY_SCOPE_WORKGROUP); __hip_atomic_fetch_add((unsigned*)(hist + eb), 1u, __ATOMIC_RELAXED, __HIP_MEMORY_SCOPE_WORKGROUP);
        }
    }
    __syncthreads();
    if (F.tid < NE) ((unsigned*)(F.ws + WS_WGHIST))[blockIdx.x * NE + F.tid] = hist[F.tid];
}

__device__ __forceinline__ int moe_tables(Frame& F) {
    volatile LAS int* ps = (volatile LAS int*)(F.lds + MISC_OFF + 64); volatile LAS int* te = (volatile LAS int*)(F.lds + MISC_OFF + 256);
    volatile LAS int* tot = (volatile LAS int*)(F.lds + MISC_OFF + 1024); volatile LAS int* base = (volatile LAS int*)(F.lds + MISC_OFF + 1152);
    LAS int* part = (LAS int*)(F.lds + MISC_OFF - 4096);
    const unsigned* WGH = (const unsigned*)(F.ws + WS_WGHIST);
    __syncthreads();
    { const int e = F.tid & 31, p = F.tid >> 5; int t = 0, bsum = 0;
      for (int j = p; j < F.G; j += 16) { const int v = (int)WGH[j * NE + e]; t += v; bsum += (j < (int)blockIdx.x) ? v : 0; }
      part[p * 32 + e] = t; part[512 + p * 32 + e] = bsum; }
    __syncthreads();
    if (F.tid < 32) { int t = 0, bsum = 0;
#pragma unroll
        for (int p = 0; p < 16; ++p) { t += part[p * 32 + F.tid]; bsum += part[512 + p * 32 + F.tid]; }
        tot[F.tid] = t; base[F.tid] = bsum; }
    __syncthreads();
    if (F.tid == 0) { int a = 0;
        for (int e = 0; e < NE; ++e) { const int cnt = tot[e]; ps[e] = a; const int nb = (cnt + 255) >> 8;
            for (int r = 0; r < nb; ++r) te[(a >> 8) + r] = e; a += nb << 8; }
        ps[32] = a; }
    __syncthreads();
    return ps[32] >> 8;
}
__device__ __forceinline__ void p9_gather(Frame& F) {
    moe_tables(F);
    volatile LAS int* ps = (volatile LAS int*)(F.lds + MISC_OFF + 64); volatile LAS int* tot = (volatile LAS int*)(F.lds + MISC_OFF + 1024); volatile LAS int* base = (volatile LAS int*)(F.lds + MISC_OFF + 1152);
    LAS unsigned* lcur = (LAS unsigned*)F.lds;
    if (F.tid < NE) lcur[F.tid] = 0u;
    __syncthreads();
    const int gw = blockIdx.x * NWAVES + F.wave, RPW = M / (F.G * NWAVES);
    int* ROWTOK = (int*)(F.ws + WS_ROWTOK); float* ROWW = (float*)(F.ws + WS_ROWW);
    const int* TOKE = (const int*)(F.ws + WS_TOKE); const float* TOKW = (const float*)(F.ws + WS_TOKW);
    const bf16* H2 = (const bf16*)(F.ws + WS_H2); bf16* XS = (bf16*)(F.ws + WS_XS);
    for (int e = blockIdx.x; e < NE; e += F.G) for (int r = ps[e] + tot[e] + F.tid; r < ps[e + 1]; r += 512) ROWTOK[r] = -1;
    for (int m = gw * RPW; m < (gw + 1) * RPW; ++m) {
        int pos = 0;
        if (F.lane < 2) { const int e = TOKE[m * 2 + F.lane]; pos = ps[e] + base[e] + (int)__hip_atomic_fetch_add((unsigned*)(lcur + e), 1u, __ATOMIC_RELAXED, __HIP_MEMORY_SCOPE_WORKGROUP); ROWTOK[pos] = m * 2 + F.lane; ROWW[pos] = TOKW[m * 2 + F.lane]; }
        const int p0 = __shfl(pos, 0), p1 = __shfl(pos, 1);
        const v4u a = *((const v4u*)(H2 + (size_t)m * D) + F.lane), bb = *((const v4u*)(H2 + (size_t)m * D) + 64 + F.lane);
        *((v4u*)(XS + (size_t)p0 * D) + F.lane) = a; *((v4u*)(XS + (size_t)p0 * D) + 64 + F.lane) = bb;
        *((v4u*)(XS + (size_t)p1 * D) + F.lane) = a; *((v4u*)(XS + (size_t)p1 * D) + 64 + F.lane) = bb;
    }
}
__device__ __forceinline__ void p12_final(Frame& F) {
    const int gw = blockIdx.x * NWAVES + F.wave, RPW = M / (F.G * NWAVES);
    const bf16* YBUF = (const bf16*)(F.ws + WS_YBUF);
    f32x4 gt[4], gf[4];
    { const int b = (gw * RPW) / T;
#pragma unroll
      for (int j = 0; j < 4; ++j) { gt[j] = *(const f32x4*)((const float*)(F.ws + CTL_MODACC) + b * 6144 + 5 * D + 256 * j + 4 * F.lane); gf[j] = *(const f32x4*)(F.normf_g + 256 * j + 4 * F.lane); } }
    for (int m = gw * RPW; m < (gw + 1) * RPW; ++m) {
        f32x4* xr = (f32x4*)(F.out + (size_t)m * D) + F.lane;
        f32x4 v[4]; float s = 0.f;
#pragma unroll
        for (int j = 0; j < 4; ++j) { const int col = 256 * j + 4 * F.lane; v[j] = xr[64 * j];
            const v2u y0 = *(const v2u*)(YBUF + (size_t)(2 * m) * D + col), y1 = *(const v2u*)(YBUF + (size_t)(2 * m + 1) * D + col);
            const f32x4 ys = {bflo(y0.x) + bflo(y1.x), bfhi(y0.x) + bfhi(y1.x), bflo(y0.y) + bflo(y1.y), bfhi(y0.y) + bfhi(y1.y)};
            v[j] += gt[j] * ys;
            s += (v[j].x * v[j].x + v[j].y * v[j].y) + (v[j].z * v[j].z + v[j].w * v[j].w); }
        const float rstd = __frsqrt_rn(wave_sum(s) * (1.f / D) + EPS);
#pragma unroll
        for (int j = 0; j < 4; ++j) xr[64 * j] = v[j] * rstd * gf[j];
    }
}

constexpr int NPH = 18;
struct Args { const float* in[23]; float* out; unsigned char* ws; int ph_lo, ph_hi; };
__global__ void __launch_bounds__(NWAVES * 64, 2) fwd(Args args) {
    extern __shared__ __attribute__((aligned(16))) unsigned char lds[];
    Frame F;
    F.lds = (LAS unsigned char*)lds; F.MISC = (volatile LAS unsigned*)(F.lds + MISC_OFF);
    F.tid = threadIdx.x; F.lane = F.tid & 63; F.wave = __builtin_amdgcn_readfirstlane(F.tid >> 6);
    F.G = gridDim.x; { const int bx = blockIdx.x; F.vcu = (F.G % 8 == 0) ? (bx % 8) * (F.G / 8) + bx / 8 : bx; }
    F.ws = args.ws; F.out = args.out; F.ctl = (unsigned*)(args.ws + WS_CTL);
    F.x = args.in[0]; F.c = args.in[1]; F.w_ada = args.in[2]; F.b_ada = args.in[3]; F.norm1_g = args.in[4]; F.w_in = args.in[5]; F.conv_qkv_w = args.in[6];
    F.a_log = args.in[7]; F.dt_bias = args.in[8]; F.onorm_g = args.in[9]; F.w_proj_a = args.in[10]; F.conv_sc_w = args.in[11]; F.w_proj_b = args.in[12]; F.w_out = args.in[13];
    F.norm2_g = args.in[14]; F.w_group = args.in[15]; F.b_group = args.in[16]; F.w_expert = args.in[17]; F.b_expert = args.in[18]; F.w1 = args.in[19]; F.w3 = args.in[20];
    F.w2 = args.in[21]; F.normf_g = args.in[22];
    if (F.tid < 4) F.MISC[F.tid] = 0u;
    __syncthreads();
    const int lo = args.ph_lo, hi = args.ph_hi;
    const bool fused = (hi - lo) > 1;
    XcdBarrier bar; bar.bar = F.ctl + CW_BAR; bar.x = 0; bar.st = F.MISC;
    if (fused) bar = xcd_barrier_post(F.ctl + CW_BAR, F.MISC);
#ifndef PH_MASK
#define PH_MASK 0xFFFFFFFFu
#endif
#define IN(k) (((PH_MASK >> (k)) & 1) && lo <= (k) && (k) < hi)
#define SEAM(k) do { if (IN(k) && IN((k) + 1)) xcd_barrier(bar); } while (0)
    bf16* H = (bf16*)F.out; bf16* YBP = (bf16*)F.out + (size_t)M * D;

    if (IN(0)) { p0_prologue(F); } SEAM(0);
    if (IN(1)) { p1_norm1(F); } SEAM(1);
    if (IN(2)) {
        pg8::Gemm g{H, (const bf16*)(F.ws + WS_WINA), M, 6144, D}; pg8::StaticOrder S; S.init(M, 6144, F.G, (int)blockIdx.x);
        EpiInA E{(bf16*)(F.ws + WS_QKV), (bf16*)(F.ws + WS_SB), (bf16*)(F.ws + WS_P)};
        pg8::gemm_phase<EpiInA, pg8::StaticOrder, true, true>(F.lds, g, S, E);
    } SEAM(2);
    if (IN(3)) { p3a_ybp(F); } SEAM(3);
    if (IN(4)) { for (int u = blockIdx.x; u < NUNIT; u += F.G) p3b_fast(F, u); } SEAM(4);
    if (IN(5)) {
        pg8::Gemm g{YBP, (const bf16*)(F.ws + WS_WB), M, D, D}; pg8::StaticOrder S; S.init(M, D, F.G, (int)blockIdx.x);
        EpiPlain E{(bf16*)(F.ws + WS_YB), D};
        pg8::gemm_phase<EpiPlain, pg8::StaticOrder, true, true>(F.lds, g, S, E);
    } SEAM(5);
    if (IN(6)) { for (int it = blockIdx.x; it < NB * NH * 16; it += F.G) p4a_seg(F, it); } SEAM(6);
    if (IN(7)) { for (int it = blockIdx.x; it < NB * NH * 4; it += F.G) p4b_fold(F, it); } SEAM(7);
    if (IN(8)) { for (int it = blockIdx.x; it < NB * NH * 16; it += F.G) p4c_seg(F, it); } SEAM(8);
    if (IN(9)) { p_moe_weights(F); } SEAM(9);
    if (IN(10)) {
        pg8::Gemm g{H, (const bf16*)(F.ws + WS_WINB), M, 3072, D}; pg8::StaticOrder S; S.init(M, 3072, F.G, (int)blockIdx.x);
        EpiInB E{(bf16*)(F.ws + WS_OR), (bf16*)(F.ws + WS_GA), (bf16*)(F.ws + WS_GB), (const float*)(F.ws + CTL_SSQ), F.onorm_g};
        pg8::gemm_phase<EpiInB, pg8::StaticOrder, true, true>(F.lds, g, S, E);
    } SEAM(10);
    if (IN(11)) {
        pg8::Gemm g{(const bf16*)(F.ws + WS_OR), (const bf16*)(F.ws + WS_WA), M, D, D}; pg8::StaticOrder S; S.init(M, D, F.G, (int)blockIdx.x);
        EpiMerge E{(const bf16*)(F.ws + WS_GA), (const bf16*)(F.ws + WS_GB), (const bf16*)(F.ws + WS_YB), (bf16*)(F.ws + WS_GA)};
        pg8::gemm_phase<EpiMerge, pg8::StaticOrder, true, true>(F.lds, g, S, E);
    } SEAM(11);
    if (IN(12)) {
        pg8::Gemm g{(const bf16*)(F.ws + WS_GA), (const bf16*)(F.ws + WS_WO), M, D, D}; pg8::StaticOrder S; S.init(M, D, F.G, (int)blockIdx.x);
        EpiX1 E{F.x, F.out, (const float*)(F.ws + CTL_MODACC), F.b_ada};
        pg8::gemm_phase<EpiX1, pg8::StaticOrder, true, true>(F.lds, g, S, E);
    } SEAM(12);
    if (IN(13)) { p8_router(F); } SEAM(13);
    if (IN(14)) { p9_gather(F); } SEAM(14);
    if (IN(15)) {
        const int nt = moe_tables(F);
        pg8::Gemm g{(const bf16*)(F.ws + WS_XS), (const bf16*)(F.ws + WS_W13), MOE_CAP, NE * D, D};
        MoeOrder S{nt * 4, F.G, (int)blockIdx.x, (const volatile LAS int*)(F.lds + MISC_OFF + 256)};
        EpiHid E{(bf16*)(F.ws + WS_HID)};
        pg8::gemm_phase<EpiHid, MoeOrder, true, true>(F.lds, g, S, E);
    } SEAM(15);
    if (IN(16)) {
        const int nt = moe_tables(F);
        pg8::Gemm g{(const bf16*)(F.ws + WS_HID), (const bf16*)(F.ws + WS_W2), MOE_CAP, NE * D, DE};
        MoeOrder S{nt * 4, F.G, (int)blockIdx.x, (const volatile LAS int*)(F.lds + MISC_OFF + 256)};
        EpiMoeOut E{(bf16*)(F.ws + WS_YBUF), (const int*)(F.ws + WS_ROWTOK), (const float*)(F.ws + WS_ROWW)};
        pg8::gemm_phase<EpiMoeOut, MoeOrder, true, true>(F.lds, g, S, E);
    } SEAM(16);
    if (IN(17)) { p12_final(F); }
#undef IN
#undef SEAM
}

extern "C" void kernel_launch(void* const* d_in, const int* in_sizes, int n_in, void* d_out, int out_size, void* d_ws, size_t ws_size, hipStream_t stream) {
    static int grid = 0;
    if (grid == 0) {
        if (n_in != 23 || out_size != M * D || ws_size < WS_END) { fprintf(stderr, "kernel_launch: unexpected problem (n_in %d, out %d, ws %zu)\n", n_in, out_size, ws_size); grid = -1; return; }
        int dev = 0, cus = 0, per_cu = 0;
        if (hipGetDevice(&dev) != hipSuccess || hipDeviceGetAttribute(&cus, hipDeviceAttributeMultiprocessorCount, dev) != hipSuccess) { grid = -1; return; }
        if (hipFuncSetAttribute((const void*)fwd, hipFuncAttributeMaxDynamicSharedMemorySize, LDS_BYTES) != hipSuccess) { fprintf(stderr, "kernel_launch: hipFuncSetAttribute failed\n"); grid = -1; return; }
        if (hipOccupancyMaxActiveBlocksPerMultiprocessor(&per_cu, (const void*)fwd, NWAVES * 64, LDS_BYTES) != hipSuccess || per_cu < 1) { fprintf(stderr, "kernel_launch: occupancy query says %d\n", per_cu); }
        (void)hipGetLastError();
        grid = cus;
        if (M % (grid * NWAVES) != 0 || grid < 64) { fprintf(stderr, "kernel_launch: unsupported CU count %d\n", cus); grid = -1; return; }
    }
    if (grid < 0) return;
    (void)hipMemsetAsync((char*)d_ws + WS_CTL, 0, CTL_ZERO_BYTES, stream);
    Args a{};
    for (int i = 0; i < 23; ++i) a.in[i] = (const float*)d_in[i];
    a.out = (float*)d_out; a.ws = (unsigned char*)d_ws;
#ifndef MK_FUSED
#define MK_FUSED 1
#endif
#ifdef PROBE_DUP
    { const int cuts[4] = {0, PROBE_DUP + 1, PROBE_DUP, NPH}; const int ends[3] = {PROBE_DUP + 1, PROBE_DUP + 1, NPH};
      for (int li = 0; li < 3; ++li) { a.ph_lo = (li == 0) ? 0 : (li == 1 ? PROBE_DUP : PROBE_DUP + 1); a.ph_hi = ends[li]; (void)cuts;
          hipMemsetAsync((char*)d_ws + WS_CTL + CW_BAR * 4, 0, XCD_BAR_WORDS * 4, stream);
          if (a.ph_lo < a.ph_hi) hipLaunchKernelGGL(fwd, dim3(grid), dim3(NWAVES * 64), LDS_BYTES, stream, a); } return; }
#endif
    if (MK_FUSED) { a.ph_lo = 0; a.ph_hi = NPH; hipLaunchKernelGGL(fwd, dim3(grid), dim3(NWAVES * 64), LDS_BYTES, stream, a); }
    else for (int p = 0; p < NPH; ++p) { a.ph_lo = p; a.ph_hi = p + 1; hipLaunchKernelGGL(fwd, dim3(grid), dim3(NWAVES * 64), LDS_BYTES, stream, a); }
}
```

```cpp
#include <hip/hip_runtime.h>
#include <cstdio>
#include <cstdint>
namespace pg8 {
#define PG8_LAS __attribute__((address_space(3)))
typedef unsigned short bf16_t;
typedef short bf16x8 __attribute__((ext_vector_type(8)));
typedef float f32x4 __attribute__((ext_vector_type(4)));
typedef unsigned u32x4 __attribute__((ext_vector_type(4)));
constexpr int BM = 256, BK = 64, HALF = 128, HTB = HALF * BK * 2  , STAGE_BYTES = 8 * HTB, NXCD = 8, WGM = 8;

__host__ __device__ __forceinline__ int lds_byte(int r, int c) { const int st = (r >> 4) * 2 + (c >> 5), rr = r & 15, cc = c & 31, ob = rr * 64 + cc * 2; return st * 1024 + (ob ^ (((ob >> 9) & 1) << 5)); }
__host__ __device__ __forceinline__ void stage_rc(int b, int& R, int& C) { const int st = b / 1024, sb = b % 1024, swz = sb ^ (((sb >> 9) & 1) << 5); R = (st >> 1) * 16 + swz / 64; C = (st & 1) * 32 + (swz % 64) / 2; }
__host__ __device__ __forceinline__ int perm32(int rho) { const int n = rho >> 4, i = rho & 15; return 8 * (i >> 2) + 4 * n + (i & 3); }

struct Unit { int pm, pn; };
struct Gemm { const bf16_t* A; const bf16_t* Bt; int M, N, K; };

struct StaticOrder {
    int nM, nN, nwg, G, c;
    __host__ __device__ void init(int M, int N, int G_, int c_) { nM = M / BM; nN = N / BM; nwg = nM * nN; G = G_; c = c_; }
    __host__ __device__ bool next(int i, Unit& u) const {
        const long L = (long)i * G + c; if (L >= nwg) return false;
        int wgid = (int)L; { const int q = nwg / NXCD, r = nwg % NXCD, xcd = wgid % NXCD, off = wgid / NXCD; wgid = (xcd < r ? xcd * (q + 1) : r * (q + 1) + (xcd - r) * q) + off; }
        const int nig = WGM * nN, gid = wgid / nig, fm = gid * WGM, gsz = (nM - fm) < WGM ? (nM - fm) : WGM;
        u.pm = fm + ((wgid % nig) % gsz); u.pn = (wgid % nig) / gsz; return true;
    }
    __device__ __forceinline__ void a_ready(const Unit&) const {}
    __device__ __forceinline__ void done(const Unit&) const {}
};

typedef float f32x2_cv __attribute__((ext_vector_type(2)));
typedef __bf16 bf16x2_cv __attribute__((ext_vector_type(2)));
__device__ __forceinline__ unsigned cvt_pk_bf16(float lo, float hi) { const f32x2_cv v = {lo, hi}; return __builtin_bit_cast(unsigned, __builtin_convertvector(v, bf16x2_cv)); }
template <class Epi, class Sched, bool ALIGN_EPI = false, bool SP2 = false>
__device__ __forceinline__ void gemm_phase(PG8_LAS unsigned char* lds, const Gemm g, const Sched& S, const Epi& E) {
    const int tid = threadIdx.x, wid = __builtin_amdgcn_readfirstlane(tid >> 6), lane = tid & 63, wr = wid >> 2, wc = wid & 3, fr = lane & 15, fq = lane >> 4;
    const int K = g.K, nt = K / BK;
    unsigned voffA[2], voffB[2];
#pragma unroll
    for (int i = 0; i < 2; ++i) { int R, C; stage_rc(tid * 16 + i * 8192, R, C); const int Rb = Epi::PERM ? ((R & ~31) + perm32(R & 31)) : R;
        voffA[i] = (unsigned)(R * K + C) * 2u; voffB[i] = (unsigned)(Rb * K + C) * 2u; }
    const size_t kstep = (size_t)(BK * 2);
    const size_t hstep = (size_t)HALF * K * 2;
    const size_t tstep = 2 * hstep;
    const unsigned ldsw = (unsigned)wid * 1024u;
    const int aoff = lds_byte(wr * 64 + fr, fq * 8), boff = lds_byte(wc * 32 + fr, fq * 8);
#define PG8_SA(b, h) (((b) * 2 + (h)) * HTB)
#define PG8_SB(b, h) ((4 + (b) * 2 + (h)) * HTB)
#define PG8_STAGE(bufoff, gbase, voff) do { _Pragma("unroll") for (int _i = 0; _i < 2; ++_i) \
        __builtin_amdgcn_global_load_lds((const unsigned*)((const char*)(gbase) + (voff)[_i]), (PG8_LAS unsigned*)(lds + (bufoff) + ldsw + _i * 8192), 16, 0, 0); } while (0)
#define PG8_LDA(dst, b, h) do { _Pragma("unroll") for (int m = 0; m < 4; ++m) _Pragma("unroll") for (int k = 0; k < 2; ++k) dst[m][k] = *(const PG8_LAS bf16x8*)(lds + PG8_SA(b, h) + aoff + m * 2048 + k * 1024); } while (0)
#define PG8_LDB(dst, b, h) do { _Pragma("unroll") for (int n = 0; n < 2; ++n) _Pragma("unroll") for (int k = 0; k < 2; ++k) dst[n][k] = *(const PG8_LAS bf16x8*)(lds + PG8_SB(b, h) + boff + n * 2048 + k * 1024); } while (0)
#define PG8_MMA(ai, bj, At, Bt) do { __builtin_amdgcn_s_setprio(1); _Pragma("unroll") for (int m = 0; m < 4; ++m) _Pragma("unroll") for (int n = 0; n < 2; ++n) _Pragma("unroll") for (int k = 0; k < 2; ++k) \
        acc[ai][bj][m][n] = __builtin_amdgcn_mfma_f32_16x16x32_bf16(Bt[n][k], At[m][k], acc[ai][bj][m][n], 0, 0, 0); __builtin_amdgcn_s_setprio(0); } while (0)
#define PG8_WAIT_V(n) asm volatile("s_waitcnt vmcnt(" #n ")" ::: "memory")
#define PG8_WAIT_L(n) asm volatile("s_waitcnt lgkmcnt(" #n ")" ::: "memory")
#define PG8_BAR __builtin_amdgcn_s_barrier()
#define PG8_SCHED __builtin_amdgcn_sched_barrier(0)
    Unit cur, nxt; int ui = 0;
    if (!S.next(0, cur)) return;
    f32x4 acc[2][2][4][2];
#pragma unroll
    for (int a = 0; a < 2; ++a)
#pragma unroll
        for (int b = 0; b < 2; ++b)
#pragma unroll
            for (int m = 0; m < 4; ++m)
#pragma unroll
                for (int n = 0; n < 2; ++n) acc[a][b][m][n] = (f32x4){0.f, 0.f, 0.f, 0.f};
    bf16x8 At[4][2], B0[2][2], B1[2][2];
    const char* cA = (const char*)g.A + (size_t)cur.pm * tstep; const char* cB = (const char*)g.Bt + (size_t)cur.pn * tstep;
    S.a_ready(cur);
    if constexpr (SP2) {
        PG8_STAGE(PG8_SB(0, 0), cB, voffB); PG8_STAGE(PG8_SB(0, 1), cB + hstep, voffB); PG8_STAGE(PG8_SA(0, 0), cA, voffA); PG8_STAGE(PG8_SA(0, 1), cA + hstep, voffA);
        if (wr == 1) PG8_BAR;
        PG8_WAIT_V(2); PG8_BAR;
        PG8_STAGE(PG8_SB(1, 0), cB + kstep, voffB); PG8_STAGE(PG8_SA(1, 0), cA + kstep, voffA); PG8_STAGE(PG8_SB(1, 1), cB + hstep + kstep, voffB);
        PG8_WAIT_V(6); PG8_BAR;
    } else {
        PG8_STAGE(PG8_SB(0, 0), cB, voffB); PG8_STAGE(PG8_SA(0, 0), cA, voffA); PG8_STAGE(PG8_SB(0, 1), cB + hstep, voffB); PG8_STAGE(PG8_SA(0, 1), cA + hstep, voffA);
        if (wr == 1) PG8_BAR;
        PG8_WAIT_V(4); PG8_BAR;
        PG8_STAGE(PG8_SB(1, 0), cB + kstep, voffB); PG8_STAGE(PG8_SA(1, 0), cA + kstep, voffA); PG8_STAGE(PG8_SB(1, 1), cB + hstep + kstep, voffB);
        PG8_WAIT_V(6); PG8_BAR;
    }
    for (;;) {
        const bool has_next = S.next(ui + 1, nxt);
        const char* nA = has_next ? (const char*)g.A + (size_t)nxt.pm * tstep : cA; const char* nB = has_next ? (const char*)g.Bt + (size_t)nxt.pn * tstep : cB;
        for (int t = 0; t < nt; t += 2) {
            const bool last = (t == nt - 2);
            const char* a1 = cA + (size_t)(t + 1) * kstep;
            const char* a2 = last ? nA : cA + (size_t)(t + 2) * kstep; const char* b2 = last ? nB : cB + (size_t)(t + 2) * kstep;
            const char* a3 = a2 + kstep; const char* b3 = b2 + kstep;
            if (last && has_next) S.a_ready(nxt);
            if constexpr (SP2) {
            PG8_LDB(B0, 0, 0); PG8_LDB(B1, 0, 1); PG8_SCHED; PG8_LDA(At, 0, 0); PG8_STAGE(PG8_SA(1, 1), a1 + hstep, voffA);
            PG8_WAIT_V(8); PG8_WAIT_L(0); PG8_BAR; PG8_MMA(0, 0, At, B0); PG8_MMA(0, 1, At, B1); PG8_BAR; PG8_SCHED;
            PG8_LDA(At, 0, 1); PG8_STAGE(PG8_SB(0, 0), b2, voffB); PG8_STAGE(PG8_SB(0, 1), b2 + hstep, voffB); PG8_STAGE(PG8_SA(0, 0), a2, voffA);
            PG8_WAIT_V(8); PG8_WAIT_L(0); PG8_BAR; PG8_MMA(1, 0, At, B0); PG8_MMA(1, 1, At, B1); PG8_BAR; PG8_SCHED;
            PG8_LDB(B0, 1, 0); PG8_LDB(B1, 1, 1); PG8_SCHED; PG8_LDA(At, 1, 0); PG8_STAGE(PG8_SA(0, 1), a2 + hstep, voffA);
            PG8_WAIT_V(8); PG8_WAIT_L(0); PG8_BAR; PG8_MMA(0, 0, At, B0); PG8_MMA(0, 1, At, B1); PG8_BAR; PG8_SCHED;
            PG8_LDA(At, 1, 1); PG8_STAGE(PG8_SB(1, 0), b3, voffB); PG8_STAGE(PG8_SB(1, 1), b3 + hstep, voffB); PG8_STAGE(PG8_SA(1, 0), a3, voffA);
            PG8_WAIT_V(8); PG8_WAIT_L(0); PG8_BAR; PG8_MMA(1, 0, At, B0); PG8_MMA(1, 1, At, B1); PG8_BAR; PG8_SCHED;
            } else {
            PG8_LDB(B0, 0, 0); PG8_SCHED; PG8_LDA(At, 0, 0); PG8_STAGE(PG8_SA(1, 1), a1 + hstep, voffA);
            PG8_WAIT_L(8); PG8_BAR; PG8_WAIT_L(0); PG8_MMA(0, 0, At, B0); PG8_BAR; PG8_SCHED;
            PG8_LDB(B1, 0, 1); PG8_STAGE(PG8_SB(0, 0), b2, voffB);
            PG8_BAR; PG8_WAIT_L(0); PG8_MMA(0, 1, At, B1); PG8_BAR;
            PG8_LDA(At, 0, 1); PG8_STAGE(PG8_SA(0, 0), a2, voffA);
            PG8_BAR; PG8_WAIT_L(0); PG8_MMA(1, 0, At, B0); PG8_BAR; PG8_SCHED;
            PG8_STAGE(PG8_SB(0, 1), b2 + hstep, voffB);
            PG8_WAIT_V(6); PG8_BAR; PG8_MMA(1, 1, At, B1); PG8_BAR;
            PG8_LDB(B0, 1, 0); PG8_SCHED; PG8_LDA(At, 1, 0); PG8_STAGE(PG8_SA(0, 1), a2 + hstep, voffA);
            PG8_WAIT_L(8); PG8_BAR; PG8_WAIT_L(0); PG8_MMA(0, 0, At, B0); PG8_BAR; PG8_SCHED;
            PG8_LDB(B1, 1, 1); PG8_STAGE(PG8_SB(1, 0), b3, voffB);
            PG8_BAR; PG8_WAIT_L(0); PG8_MMA(0, 1, At, B1); PG8_BAR;
            PG8_LDA(At, 1, 1); PG8_STAGE(PG8_SA(1, 0), a3, voffA);
            PG8_BAR; PG8_WAIT_L(0); PG8_MMA(1, 0, At, B0); PG8_BAR; PG8_SCHED;
            PG8_STAGE(PG8_SB(1, 1), b3 + hstep, voffB);
            PG8_WAIT_V(6); PG8_BAR; PG8_MMA(1, 1, At, B1); PG8_BAR;
            }
        }
        if constexpr (ALIGN_EPI) { if (wr == 0) PG8_BAR; }
        if constexpr (!Epi::AFTER_DRAIN) { E(acc, cur, wr, wc, fr, fq); S.done(cur); }
        if (!has_next) break;
#pragma unroll
        for (int a = 0; a < 2; ++a)
#pragma unroll
            for (int b = 0; b < 2; ++b)
#pragma unroll
                for (int m = 0; m < 4; ++m)
#pragma unroll
                    for (int n = 0; n < 2; ++n) acc[a][b][m][n] = (f32x4){0.f, 0.f, 0.f, 0.f};
        cur = nxt; cA = nA; cB = nB; ++ui;
        if constexpr (ALIGN_EPI) { if (wr == 1) PG8_BAR; }
    }
    PG8_WAIT_V(0);
    if constexpr (!ALIGN_EPI) { if (wr == 0) PG8_BAR; }
    PG8_BAR;
    if constexpr (Epi::AFTER_DRAIN) { E.fused(acc, cur, wr, wc, fr, fq, lds, wid, lane); S.done(cur); }
#undef PG8_SA
#undef PG8_SB
#undef PG8_STAGE
#undef PG8_LDA
#undef PG8_LDB
#undef PG8_MMA
#undef PG8_WAIT_V
#undef PG8_WAIT_L
#undef PG8_BAR
#undef PG8_SCHED
}
}

constexpr int NB = 2, T = 8192, D = 1024, M = NB * T;
constexpr int NH = 8, DK = 128, DV = 128, CH = 64, NCH = T / CH;
constexpr int NQKV = 3072, IN_TOTAL = 9232;
constexpr int NE = 32, EPG = 8, NGRP = 4, DE = 512;
constexpr int NUNIT = NB * NH * NCH;
constexpr float EPS = 1e-6f;
constexpr int MOE_CAP = 40960;
constexpr int NWAVES = 8;

constexpr size_t MiB = 1u << 20;
constexpr size_t WS_CTL = 0, CTL_ZERO_BYTES = 1 * MiB;
constexpr size_t WS_BG = 1 * MiB;
constexpr size_t WS_TOKE = 2 * MiB;
constexpr size_t WS_TOKW = WS_TOKE + 128 * 1024;
constexpr size_t WS_ROWTOK = WS_TOKE + 256 * 1024;
constexpr size_t WS_ROWW = WS_TOKE + 512 * 1024;
constexpr size_t WS_DEC = 3 * MiB;
constexpr size_t WS_WGHIST = 3 * MiB + 64 * 1024;
constexpr size_t WS_WINA = 4 * MiB;
constexpr size_t WS_IN = 4 * MiB;
constexpr size_t WS_WINB = 20 * MiB;
constexpr size_t WS_WA = 27 * MiB, WS_WB = 29 * MiB, WS_WO = 31 * MiB;
constexpr size_t WS_QKV = 33 * MiB;
constexpr size_t WS_W13 = 33 * MiB;
constexpr size_t WS_W2 = 97 * MiB;
constexpr size_t WS_SB = 129 * MiB, WS_YB = 129 * MiB;
constexpr size_t WS_P = 161 * MiB, WS_OR = 161 * MiB;
constexpr size_t WS_UT = 193 * MiB, WS_W = 225 * MiB, WS_QD = 257 * MiB, WS_KDT = 289 * MiB;
constexpr size_t WS_GA = 193 * MiB, WS_GB = 225 * MiB;
constexpr size_t WS_H2 = 257 * MiB;
constexpr size_t WS_XS = 129 * MiB;
constexpr size_t WS_HID = 209 * MiB;
constexpr size_t WS_YBUF = 129 * MiB;
constexpr size_t OUT_PHI = 32 * MiB, OUT_LSEG = 40 * MiB;
constexpr size_t WS_END = 321 * MiB;
constexpr int CW_TMO = 0, CW_BAR = 4096, CW_Q = 8192;
constexpr size_t CTL_MODACC = 64 * 1024;
constexpr size_t CTL_SSQ = 128 * 1024;
constexpr int LDS_BYTES = 163840, MISC_OFF = LDS_BYTES - 2048;

#define GAS __attribute__((address_space(1)))
#define LAS __attribute__((address_space(3)))
typedef unsigned short bf16;
typedef unsigned v4u __attribute__((ext_vector_type(4)));
typedef unsigned v2u __attribute__((ext_vector_type(2)));
typedef float f32x4 __attribute__((ext_vector_type(4)));
#define LDS_WAIT() asm volatile("s_waitcnt lgkmcnt(0)" ::: "memory")
__device__ __forceinline__ unsigned f2bf(float f) { unsigned u = __builtin_bit_cast(unsigned, f); return (u + 0x7fffu + ((u >> 16) & 1u)) >> 16; }
__device__ __forceinline__ unsigned pk2(float lo, float hi) { return f2bf(lo) | (f2bf(hi) << 16); }
__device__ __forceinline__ float bf2f(unsigned short b) { return __builtin_bit_cast(float, ((unsigned)b) << 16); }
__device__ __forceinline__ float bflo(unsigned w) { return __builtin_bit_cast(float, w << 16); }
__device__ __forceinline__ float bfhi(unsigned w) { return __builtin_bit_cast(float, w & 0xffff0000u); }
__device__ __forceinline__ float sigmoidf_(float x) { return 1.0f / (1.0f + __expf(-x)); }
__device__ __forceinline__ float siluf_(float x) { return x / (1.0f + __expf(-x)); }
__device__ __forceinline__ float readlane_f(float v, int l) { return __builtin_bit_cast(float, __builtin_amdgcn_readlane(__builtin_bit_cast(int, v), l)); }
__device__ __forceinline__ float wave_sum(float v) {
#pragma unroll
    for (int o = 1; o < 64; o <<= 1) v += __shfl_xor(v, o);
    return v;
}


template <int N, int CAP> __device__ __forceinline__ void fold_step(float (&v)[CAP], int xr, bool bit) {
#pragma unroll
    for (int i = 0; i < N / 2; ++i) { const float send = bit ? v[i] : v[i + N / 2]; const float keep = bit ? v[i + N / 2] : v[i]; v[i] = keep + __shfl_xor(send, xr); }
}

#define XB_TMO      128
#define XB_XCNT(j)  (256  + 64 * (j))
#define XB_XSUB(j)  (1280 + 64 * (j))
#define XB_XGEN(j)  (2304 + 64 * (j))
#define XB_TOP      3328
#define XB_TOPGEN   3392
#define XCD_BAR_WORDS 3456
#define XB_SPIN_CAP (1u << 18)
__device__ __forceinline__ unsigned xb_ld(unsigned* p)              { return __hip_atomic_load(p, __ATOMIC_RELAXED, __HIP_MEMORY_SCOPE_AGENT); }
__device__ __forceinline__ unsigned xb_add(unsigned* p, unsigned v) { return __hip_atomic_fetch_add(p, v, __ATOMIC_RELAXED, __HIP_MEMORY_SCOPE_AGENT); }
__device__ __forceinline__ unsigned xb_xcc_id() { return (unsigned)__builtin_amdgcn_s_getreg((3 << 11) | 20) & 0xFu; }
#define XB_SPIN(cond, bar) do { unsigned _sp = 0; while (cond) { __builtin_amdgcn_s_sleep(1); \
    if ((++_sp & 255u) == 0u) { if (xb_ld(&(bar)[XB_TMO])) break; if (_sp > XB_SPIN_CAP) { atomicAdd(&(bar)[XB_TMO], 1u); break; } } } } while (0)
struct XcdBarrier { unsigned* bar; unsigned x; volatile LAS unsigned* st; };
__device__ __forceinline__ XcdBarrier xcd_barrier_post(unsigned* bar, volatile LAS unsigned* st) {
    XcdBarrier b; b.bar = bar; b.x = xb_xcc_id(); b.st = st;
    if (threadIdx.x == 0) (void)xb_add(&bar[XB_XCNT(b.x)], 1u);
    return b;
}
__device__ __forceinline__ void xcd_barrier_complete(unsigned* bar, unsigned x, unsigned& nloc, unsigned& nx) {
    const unsigned G = gridDim.x * gridDim.y * gridDim.z;
    unsigned sum, cnt, mine, sp = 0u;
    for (;;) {
        sum = 0u; cnt = 0u; mine = 0u;
#pragma unroll
        for (unsigned j = 0; j < 16; ++j) { const unsigned c = xb_ld(&bar[XB_XCNT(j)]); sum += c; cnt += (c > 0u) ? 1u : 0u; mine = (j == x) ? c : mine; }
        if (sum == G) break;
        __builtin_amdgcn_s_sleep(1);
        if ((++sp & 255u) == 0u) { if (xb_ld(&bar[XB_TMO])) break; if (sp > XB_SPIN_CAP) { atomicAdd(&bar[XB_TMO], 1u); break; } }
    }
    nloc = mine > 0u ? mine : 1u; nx = cnt > 0u ? cnt : 1u;
}
__device__ __forceinline__ void xcd_barrier(const XcdBarrier& b) {
    asm volatile("s_waitcnt vmcnt(0)" ::: "memory");
    __syncthreads();
    if (threadIdx.x == 0) {
        unsigned* bar = b.bar;
        __builtin_amdgcn_s_waitcnt(0);
        unsigned nloc = b.st[0], nx = b.st[1];
        if (nloc == 0u) { xcd_barrier_complete(bar, b.x, nloc, nx); b.st[0] = nloc; b.st[1] = nx; }
        const unsigned old = xb_add(&bar[XB_XSUB(b.x)], 1u);
        const unsigned gen = old / nloc;
        if (old + 1u == (gen + 1u) * nloc) {
            __builtin_amdgcn_fence(__ATOMIC_RELEASE, "agent");
            asm volatile("s_waitcnt vmcnt(0)" ::: "memory");
            const unsigned og = xb_add(&bar[XB_TOP], 1u);
            const unsigned tg = og / nx;
            if (og + 1u == (tg + 1u) * nx) xb_add(&bar[XB_TOPGEN], 1u);
            else XB_SPIN(xb_ld(&bar[XB_TOPGEN]) == tg, bar);
            __builtin_amdgcn_fence(__ATOMIC_ACQUIRE, "agent");
            xb_add(&bar[XB_XGEN(b.x)], 1u);
            asm volatile("s_waitcnt vmcnt(0)" ::: "memory");
        } else {
            XB_SPIN(xb_ld(&bar[XB_XGEN(b.x)]) == gen, bar);
            __builtin_amdgcn_fence(__ATOMIC_ACQUIRE, "agent");
            asm volatile("s_waitcnt vmcnt(0)" ::: "memory");
        }
    }
    __syncthreads();
}

struct Frame {
    LAS unsigned char* lds;
    volatile LAS unsigned* MISC;
    unsigned* ctl;
    int tid, lane, wave, vcu, G;
    const float *x, *c, *w_ada, *b_ada, *norm1_g, *w_in, *conv_qkv_w, *a_log, *dt_bias, *onorm_g, *w_proj_a, *conv_sc_w, *w_proj_b, *w_out,
                *norm2_g, *w_group, *b_group, *w_expert, *b_expert, *w1, *w3, *w2, *normf_g;
    float* out; unsigned char* ws;
};
__device__ __forceinline__ float mod_at(const Frame& F, int b, int idx) {
    return ((const float*)(F.ws + CTL_MODACC))[b * 6144 + idx];
}

using pg8::Unit; using pg8::cvt_pk_bf16;
__device__ __forceinline__ v4u pack8(const f32x4 a, const f32x4 b) { v4u w; w.x = cvt_pk_bf16(a[0], a[1]); w.y = cvt_pk_bf16(a[2], a[3]); w.z = cvt_pk_bf16(b[0], b[1]); w.w = cvt_pk_bf16(b[2], b[3]); return w; }
__device__ __forceinline__ void unpack8(const v4u w, f32x4& a, f32x4& b) { a = (f32x4){bflo(w.x), bfhi(w.x), bflo(w.y), bfhi(w.y)}; b = (f32x4){bflo(w.z), bfhi(w.z), bflo(w.w), bfhi(w.w)}; }

struct EpiInA {
    static constexpr bool PERM = true, AFTER_DRAIN = false;
    bf16 *QKV, *SB, *P;
    __device__ __forceinline__ void operator()(const f32x4 (&acc)[2][2][4][2], const Unit& u, int wr, int wc, int fr, int fq) const {
        const int row0 = u.pm * 256 + wr * 64 + fr;
        if (u.pn < 16) {
            bf16* base; int ldc, colt;
            if (u.pn < 12) { base = QKV; ldc = NQKV; colt = u.pn * 256; } else { base = SB; ldc = D; colt = (u.pn - 12) * 256; }
            const int col0 = colt + wc * 32 + 8 * fq;
#pragma unroll
            for (int ai = 0; ai < 2; ++ai)
#pragma unroll
                for (int m = 0; m < 4; ++m) { bf16* rowp = base + (size_t)(row0 + ai * 128 + m * 16) * ldc + col0;
#pragma unroll
                    for (int bj = 0; bj < 2; ++bj) *(v4u*)(rowp + bj * 128) = pack8(acc[ai][bj][m][0], acc[ai][bj][m][1]); }
        } else {
            const int col0 = (u.pn - 16) * 128 + wc * 32 + 8 * fq;
#pragma unroll
            for (int ai = 0; ai < 2; ++ai)
#pragma unroll
                for (int m = 0; m < 4; ++m) { bf16* rowp = P + (size_t)(row0 + ai * 128 + m * 16) * D + col0;
                    *(v4u*)rowp = pack8(acc[ai][0][m][0] * acc[ai][1][m][0], acc[ai][0][m][1] * acc[ai][1][m][1]); }
        }
    }
};
struct EpiInB {
    static constexpr bool PERM = true, AFTER_DRAIN = false;
    bf16 *OG, *GA, *GB; const float* SSQ; const float* onorm_g;
    __device__ __forceinline__ void operator()(const f32x4 (&acc)[2][2][4][2], const Unit& u, int wr, int wc, int fr, int fq) const {
        const int row0 = u.pm * 256 + wr * 64 + fr;
        if (u.pn < 4) {
            const int col0 = u.pn * 256 + wc * 32 + 8 * fq;
#pragma unroll
            for (int ai = 0; ai < 2; ++ai)
#pragma unroll
                for (int m = 0; m < 4; ++m) { const int row = row0 + ai * 128 + m * 16;
#pragma unroll
                    for (int bj = 0; bj < 2; ++bj) { const int col = col0 + bj * 128; bf16* p = OG + (size_t)row * D + col;
                        f32x4 o0, o1; unpack8(*(const v4u*)p, o0, o1);
                        f32x4 z0 = acc[ai][bj][m][0], z1 = acc[ai][bj][m][1];
#pragma unroll
                        for (int j = 0; j < 4; ++j) { z0[j] = siluf_(z0[j]) * o0[j]; z1[j] = siluf_(z1[j]) * o1[j]; }
                        *(v4u*)p = pack8(z0, z1); } }
        } else {
            bf16* base = (u.pn < 8) ? GA : GB; const int col0 = (u.pn & 3) * 256 + wc * 32 + 8 * fq;
#pragma unroll
            for (int ai = 0; ai < 2; ++ai)
#pragma unroll
                for (int m = 0; m < 4; ++m) { bf16* rowp = base + (size_t)(row0 + ai * 128 + m * 16) * D + col0;
#pragma unroll
                    for (int bj = 0; bj < 2; ++bj) { f32x4 a = acc[ai][bj][m][0], b = acc[ai][bj][m][1];
#pragma unroll
                        for (int j = 0; j < 4; ++j) { a[j] = sigmoidf_(a[j]); b[j] = sigmoidf_(b[j]); }
                        *(v4u*)(rowp + bj * 128) = pack8(a, b); } }
        }
    }
};
struct EpiPlain {
    static constexpr bool PERM = true, AFTER_DRAIN = false;
    bf16* O; int ldc;
    __device__ __forceinline__ void operator()(const f32x4 (&acc)[2][2][4][2], const Unit& u, int wr, int wc, int fr, int fq) const {
        const int row0 = u.pm * 256 + wr * 64 + fr, col0 = u.pn * 256 + wc * 32 + 8 * fq;
#pragma unroll
        for (int ai = 0; ai < 2; ++ai)
#pragma unroll
            for (int m = 0; m < 4; ++m) { bf16* rowp = O + (size_t)(row0 + ai * 128 + m * 16) * ldc + col0;
#pragma unroll
                for (int bj = 0; bj < 2; ++bj) *(v4u*)(rowp + bj * 128) = pack8(acc[ai][bj][m][0], acc[ai][bj][m][1]); }
    }
};
struct EpiMerge {
    static constexpr bool PERM = true, AFTER_DRAIN = false;
    const bf16 *GA, *GB, *YB; bf16* MG;
    __device__ __forceinline__ void operator()(const f32x4 (&acc)[2][2][4][2], const Unit& u, int wr, int wc, int fr, int fq) const {
        const int row0 = u.pm * 256 + wr * 64 + fr, col0 = u.pn * 256 + wc * 32 + 8 * fq;
#pragma unroll
        for (int ai = 0; ai < 2; ++ai)
#pragma unroll
            for (int m = 0; m < 4; ++m) { const size_t off = (size_t)(row0 + ai * 128 + m * 16) * D + col0;
#pragma unroll
                for (int bj = 0; bj < 2; ++bj) { f32x4 a0, a1, b0, b1, y0, y1;
                    unpack8(*(const v4u*)(GA + off + bj * 128), a0, a1); unpack8(*(const v4u*)(GB + off + bj * 128), b0, b1); unpack8(*(const v4u*)(YB + off + bj * 128), y0, y1);
                    *(v4u*)(MG + off + bj * 128) = pack8(a0 * acc[ai][bj][m][0] + b0 * y0, a1 * acc[ai][bj][m][1] + b1 * y1); } }
    }
};
struct EpiX1 {
    static constexpr bool PERM = true, AFTER_DRAIN = false;
    const float* X; float* X1; const float* modacc; const float* b_ada;
    __device__ __forceinline__ void operator()(const f32x4 (&acc)[2][2][4][2], const Unit& u, int wr, int wc, int fr, int fq) const {
        const int row0 = u.pm * 256 + wr * 64 + fr, col0 = u.pn * 256 + wc * 32 + 8 * fq, b = u.pm >> 5;
        f32x4 gt[2][2];
#pragma unroll
        for (int bj = 0; bj < 2; ++bj)
#pragma unroll
            for (int n = 0; n < 2; ++n) gt[bj][n] = *(const f32x4*)(modacc + b * 6144 + 2048 + col0 + bj * 128 + 4 * n);
#pragma unroll
        for (int ai = 0; ai < 2; ++ai)
#pragma unroll
            for (int m = 0; m < 4; ++m) { const size_t off = (size_t)(row0 + ai * 128 + m * 16) * D + col0;
#pragma unroll
                for (int bj = 0; bj < 2; ++bj)
#pragma unroll
                    for (int n = 0; n < 2; ++n) { const f32x4 xv = *(const f32x4*)(X + off + bj * 128 + 4 * n);
                        *(f32x4*)(X1 + off + bj * 128 + 4 * n) = xv + gt[bj][n] * acc[ai][bj][m][n]; } }
    }
};
struct EpiHid {
    static constexpr bool PERM = true, AFTER_DRAIN = false;
    bf16* HID;
    __device__ __forceinline__ void operator()(const f32x4 (&acc)[2][2][4][2], const Unit& u, int wr, int wc, int fr, int fq) const {
        const int row0 = u.pm * 256 + wr * 64 + fr, col0 = (u.pn & 3) * 128 + wc * 32 + 8 * fq;
#pragma unroll
        for (int ai = 0; ai < 2; ++ai)
#pragma unroll
            for (int m = 0; m < 4; ++m) { f32x4 a = acc[ai][0][m][0], b = acc[ai][0][m][1];
#pragma unroll
                for (int j = 0; j < 4; ++j) { a[j] = siluf_(a[j]) * acc[ai][1][m][0][j]; b[j] = siluf_(b[j]) * acc[ai][1][m][1][j]; }
                *(v4u*)(HID + (size_t)(row0 + ai * 128 + m * 16) * DE + col0) = pack8(a, b); }
    }
};
struct EpiMoeOut {
    static constexpr bool PERM = true, AFTER_DRAIN = false;
    bf16* YBUF; const int* ROWTOK; const float* ROWW;
    __device__ __forceinline__ void operator()(const f32x4 (&acc)[2][2][4][2], const Unit& u, int wr, int wc, int fr, int fq) const {
        const int row0 = u.pm * 256 + wr * 64 + fr, col0 = (u.pn & 3) * 256 + wc * 32 + 8 * fq;
#pragma unroll
        for (int ai = 0; ai < 2; ++ai)
#pragma unroll
            for (int m = 0; m < 4; ++m) { const int r = row0 + ai * 128 + m * 16; const int tk = ROWTOK[r];
                if (tk >= 0) { const float w = ROWW[r]; bf16* rowp = YBUF + (size_t)tk * D + col0;
#pragma unroll
                    for (int bj = 0; bj < 2; ++bj) *(v4u*)(rowp + bj * 128) = pack8(acc[ai][bj][m][0] * w, acc[ai][bj][m][1] * w); } }
    }
};
struct MoeOrder {
    int n4, G, c; const volatile LAS int* tile_e;
    __device__ __forceinline__ bool next(int i, Unit& u) const { const int L = i * G + c; if (L >= n4) return false; const int rb = L >> 2; u.pm = rb; u.pn = tile_e[rb] * 4 + (L & 3); return true; }
    __device__ __forceinline__ void a_ready(const Unit&) const {}
    __device__ __forceinline__ void done(const Unit&) const {}
};

__device__ __forceinline__ void transpose_item(const float* W, int ldw, int src_col0, int k0, bf16* WT, int dst_row0, int K, LAS float* scr, int lane) {
#pragma unroll 8
    for (int i = 0; i < 32; ++i) { const int kk = 2 * i + (lane >> 5); scr[kk * 33 + (lane & 31)] = W[(size_t)(k0 + kk) * ldw + src_col0 + (lane & 31)]; }
    LDS_WAIT(); asm volatile("" ::: "memory");
    const int c = lane & 7;
#pragma unroll
    for (int j = 0; j < 4; ++j) { const int n = (lane >> 3) + 8 * j; const LAS float* s = scr + (8 * c) * 33 + n;
        v4u o; o.x = pk2(s[0 * 33], s[1 * 33]); o.y = pk2(s[2 * 33], s[3 * 33]); o.z = pk2(s[4 * 33], s[5 * 33]); o.w = pk2(s[6 * 33], s[7 * 33]);
        *(v4u*)(WT + (size_t)(dst_row0 + n) * K + k0 + 8 * c) = o; }
    LDS_WAIT(); asm volatile("" ::: "memory");
}
__device__ __forceinline__ int win_src_col(int d0) {
    if (d0 < 3072) return d0;
    if (d0 < 4096) return 4112 + (d0 - 3072);
    if (d0 < 6144) { const int j = (d0 - 4096) >> 8, r = (d0 - 4096) & 255; return (r < 128 ? 5136 + r : 6160 + (r - 128)) + 128 * j; }
    if (d0 < 7168) return 3072 + (d0 - 6144);
    if (d0 < 8192) return 7184 + (d0 - 7168);
    return 8208 + (d0 - 8192);
}

__device__ __forceinline__ void p0_prologue(Frame& F) {
    LAS float* sC = (LAS float*)(F.lds + 8 * 8448);
    for (int i = F.tid; i < 2 * D; i += 512) sC[i] = siluf_(F.c[i]);
    __syncthreads();
    const int gw = F.vcu * NWAVES + F.wave, NGW = F.G * NWAVES;
    float* modv = (float*)(F.ws + CTL_MODACC);
    LAS float* sPart = sC + 2 * D;
    for (int cg = blockIdx.x; cg < 96; cg += F.G) {
        const int col = cg * 64 + F.lane, k0 = F.wave * 128;
        float a0 = 0.f, a1 = 0.f;
#pragma unroll 16
        for (int k = 0; k < 128; ++k) { const float wv = F.w_ada[(size_t)(k0 + k) * 6144 + col]; a0 += sC[k0 + k] * wv; a1 += sC[D + k0 + k] * wv; }
        sPart[F.wave * 128 + F.lane] = a0; sPart[F.wave * 128 + 64 + F.lane] = a1;
        __syncthreads();
        if (F.wave < 2) { float t = 0.f;
#pragma unroll
            for (int q = 0; q < 8; ++q) t += sPart[q * 128 + F.wave * 64 + F.lane];
            modv[F.wave * 6144 + col] = t + F.b_ada[col]; }
        __syncthreads();
    }
    LAS float* scr = (LAS float*)(F.lds + F.wave * 8448);
    constexpr int I_IN = 288 * 16, I_SQ = 32 * 16;
    for (int it = gw; it < I_IN + 3 * I_SQ; it += NGW) {
        int r = it;
        if (r < I_IN) { const int dg = r % 288, kb = r / 288, d0 = dg * 32; bf16* dst = (d0 < 6144) ? (bf16*)(F.ws + WS_WINA) : (bf16*)(F.ws + WS_WINB);
            transpose_item(F.w_in, IN_TOTAL, win_src_col(d0), kb * 64, dst, d0 < 6144 ? d0 : d0 - 6144, D, scr, F.lane); continue; }
        r -= I_IN;
        if (r < I_SQ) { transpose_item(F.w_proj_a, D, (r % 32) * 32, (r / 32) * 64, (bf16*)(F.ws + WS_WA), (r % 32) * 32, D, scr, F.lane); continue; } r -= I_SQ;
        if (r < I_SQ) { transpose_item(F.w_proj_b, D, (r % 32) * 32, (r / 32) * 64, (bf16*)(F.ws + WS_WB), (r % 32) * 32, D, scr, F.lane); continue; } r -= I_SQ;
        transpose_item(F.w_out, D, (r % 32) * 32, (r / 32) * 64, (bf16*)(F.ws + WS_WO), (r % 32) * 32, D, scr, F.lane);
    }
}
__device__ __forceinline__ void moe_weight_item(Frame& F, int it, LAS float* scr) {
    constexpr int I13 = NE * 32 * 16;
    if (it < I13) { const int e = it / 512, r = it % 512, dg = r % 32, kb = r / 32, d0 = dg * 32, j = d0 >> 8, rr = d0 & 255;
        if (rr < 128) transpose_item(F.w1 + (size_t)e * D * DE, DE, 128 * j + (rr & 127), kb * 64, (bf16*)(F.ws + WS_W13) + (size_t)e * D * D, d0, D, scr, F.lane);
        else          transpose_item(F.w3 + (size_t)e * D * DE, DE, 128 * j + (rr & 127), kb * 64, (bf16*)(F.ws + WS_W13) + (size_t)e * D * D, d0, D, scr, F.lane);
    } else { const int r2 = it - I13, e = r2 / 256, r = r2 % 256, dg = r % 32, kb = r / 32;
        transpose_item(F.w2 + (size_t)e * DE * D, D, dg * 32, kb * 64, (bf16*)(F.ws + WS_W2) + (size_t)e * D * DE, dg * 32, DE, scr, F.lane); }
}
__device__ __forceinline__ void p_moe_weights(Frame& F) {
    LAS float* scr = (LAS float*)(F.lds + F.wave * 8448);
    constexpr int NBATCH = (NE * 32 * 16 + NE * 32 * 8) / 64;
    __syncthreads();
    for (;;) {
        if (F.tid == 0) F.MISC[3] = atomicAdd(F.ctl + CW_Q, 1u);
        __syncthreads();
        const int bt = (int)F.MISC[3];
        __syncthreads();
        if (bt >= NBATCH) break;
        for (int i = 0; i < 8; ++i) moe_weight_item(F, bt * 64 + F.wave * 8 + i, scr);
    }
}

__device__ __forceinline__ void p1_norm1(Frame& F) {
    LAS float* sBA = (LAS float*)F.lds;
    for (int i = F.tid; i < 16 * D; i += 512) { const int k = i >> 4, o = i & 15; sBA[o * D + k] = F.w_in[(size_t)k * IN_TOTAL + 4096 + o]; }
    __syncthreads();
    const int gw = blockIdx.x * NWAVES + F.wave, RPW = M / (F.G * NWAVES);
    bf16* H = (bf16*)F.out; float* BG = (float*)(F.ws + WS_BG);
    f32x4 gsc[4], gsh[4];
    { const int b = (gw * RPW) / T;
#pragma unroll
      for (int j = 0; j < 4; ++j) { const int col = 256 * j + 4 * F.lane; const f32x4 g1 = *(const f32x4*)(F.norm1_g + col);
          gsc[j] = g1 * (1.0f + *(const f32x4*)((const float*)(F.ws + CTL_MODACC) + b * 6144 + D + col)); gsh[j] = *(const f32x4*)((const float*)(F.ws + CTL_MODACC) + b * 6144 + col); } }
    for (int m = gw * RPW; m < (gw + 1) * RPW; ++m) {
        const f32x4* xr = (const f32x4*)(F.x + (size_t)m * D) + F.lane;
        f32x4 v[4]; float s = 0.f;
#pragma unroll
        for (int j = 0; j < 4; ++j) { v[j] = xr[64 * j]; s += (v[j].x * v[j].x + v[j].y * v[j].y) + (v[j].z * v[j].z + v[j].w * v[j].w); }
        const float rstd = __frsqrt_rn(wave_sum(s) * (1.f / D) + EPS);
        f32x4 hv[4];
#pragma unroll
        for (int j = 0; j < 4; ++j) { const int col = 256 * j + 4 * F.lane;
            hv[j] = v[j] * rstd * gsc[j] + gsh[j];
            *(v2u*)(H + (size_t)m * D + col) = (v2u){pk2(hv[j][0], hv[j][1]), pk2(hv[j][2], hv[j][3])};
        }
        float lg[16];
#pragma unroll
        for (int o = 0; o < 16; ++o) { float p = 0.f;
#pragma unroll
            for (int j = 0; j < 4; ++j) { const f32x4 w = *(const LAS f32x4*)(sBA + o * D + 256 * j + 4 * F.lane); p += (hv[j][0] * w[0] + hv[j][1] * w[1]) + (hv[j][2] * w[2] + hv[j][3] * w[3]); }
            lg[o] = p; if ((o & 3) == 3) __builtin_amdgcn_sched_barrier(0); }
        fold_step<16, 16>(lg, 32, (F.lane & 32) != 0); fold_step<8, 16>(lg, 16, (F.lane & 16) != 0); fold_step<4, 16>(lg, 8, (F.lane & 8) != 0); fold_step<2, 16>(lg, 4, (F.lane & 4) != 0);
        float val = lg[0]; val += __shfl_xor(val, 2); val += __shfl_xor(val, 1);
        const int oidx = ((F.lane >> 5) & 1) * 8 + ((F.lane >> 4) & 1) * 4 + ((F.lane >> 3) & 1) * 2 + ((F.lane >> 2) & 1);
        if ((F.lane & 3) == 0) {
            float r;
            if (oidx < 8) r = sigmoidf_(val);
            else { const int hh = oidx - 8; const float xx = val + F.dt_bias[hh]; const float sp = xx > 20.f ? xx : log1pf(__expf(xx)); r = -__expf(F.a_log[hh]) * sp; }
            BG[(size_t)m * 16 + oidx] = r;
        }
    }
}

__device__ __forceinline__ void p3a_ybp(Frame& F) {
    const bf16* SB = (const bf16*)(F.ws + WS_SB); const bf16* P = (const bf16*)(F.ws + WS_P); bf16* YBP = (bf16*)F.out + (size_t)M * D;
    const size_t total = (size_t)M * (D / 8);
    for (size_t i = (size_t)blockIdx.x * 512 + F.tid; i < total; i += (size_t)F.G * 512) {
        const int m = (int)(i >> 7), c8 = (int)(i & 127) * 8, t = m % T;
        f32x4 a0 = {0.f, 0.f, 0.f, 0.f}, a1 = a0;
#pragma unroll
        for (int j = 0; j < 3; ++j) { const int tt = t - 2 + j;
            if (tt >= 0) { f32x4 p0, p1; unpack8(*(const v4u*)(P + (size_t)(m - 2 + j) * D + c8), p0, p1);
                a0 += *(const f32x4*)(F.conv_sc_w + j * D + c8) * p0; a1 += *(const f32x4*)(F.conv_sc_w + j * D + c8 + 4) * p1; } }
        f32x4 s0, s1; unpack8(*(const v4u*)(SB + (size_t)m * D + c8), s0, s1);
        *(v4u*)(YBP + (size_t)m * D + c8) = pack8(s0 * a0, s1 * a1);
    }
}

__device__ __forceinline__ void p3b_chunk(Frame& F, int unit) {
    const int n = unit % NCH, bh = unit / NCH, h = bh % NH, b = bh / NH, t0 = n * CH, row0 = b * T + t0;
    LAS float* sq = (LAS float*)F.lds; LAS float* sk = sq + 64 * 129; LAS float* sv = sk + 64 * 129; LAS float* sA = sv + 64 * 129; LAS float* sT = sA + 64 * 65;
    LAS float* sgc = sT + 64 * 65; LAS float* sbeta = sgc + 64;
    const bf16* QKV = (const bf16*)(F.ws + WS_QKV); const float* BG = (const float*)(F.ws + WS_BG);
    for (int idx = F.tid; idx < 3 * 64 * 128; idx += 512) {
        const int sec = idx >> 13, r = (idx >> 7) & 63, c = idx & 127, gcol = sec * 1024 + h * 128 + c;
        float a = 0.f;
#pragma unroll
        for (int j = 0; j < 4; ++j) { const int tt = t0 + r - 3 + j; if (tt >= 0) a += F.conv_qkv_w[j * NQKV + gcol] * bf2f(QKV[(size_t)(b * T + tt) * NQKV + gcol]); }
        sq[sec * (64 * 129) + r * 129 + c] = siluf_(a);
    }
    if (F.tid < 64) { sgc[F.tid] = BG[(size_t)(row0 + F.tid) * 16 + 8 + h]; sbeta[F.tid] = BG[(size_t)(row0 + F.tid) * 16 + h]; }
    __syncthreads();
    for (int r = F.wave * 8; r < F.wave * 8 + 8; ++r) {
        const float q0 = sq[r * 129 + F.lane], q1 = sq[r * 129 + 64 + F.lane], k0 = sk[r * 129 + F.lane], k1 = sk[r * 129 + 64 + F.lane];
        const float qs = __frsqrt_rn(wave_sum(q0 * q0 + q1 * q1) + EPS) * 0.08838834764831845f, ks = __frsqrt_rn(wave_sum(k0 * k0 + k1 * k1) + EPS);
        sq[r * 129 + F.lane] = q0 * qs; sq[r * 129 + 64 + F.lane] = q1 * qs; sk[r * 129 + F.lane] = k0 * ks; sk[r * 129 + 64 + F.lane] = k1 * ks;
    }
    if (F.tid == 0) { float a = 0.f; for (int i = 0; i < 64; ++i) { a += sgc[i]; sgc[i] = a; } }
    __syncthreads();
    bf16* INo = (bf16*)(F.ws + WS_IN) + (size_t)unit * 4096;
    for (int idx = F.tid; idx < 4096; idx += 512) {
        const int i = idx >> 6, j = idx & 63; float av = 0.f, iv = 0.f;
        if (j <= i) { float dkk = 0.f, dqk = 0.f;
            for (int d = 0; d < 128; ++d) { const float kj = sk[j * 129 + d]; dkk += sk[i * 129 + d] * kj; dqk += sq[i * 129 + d] * kj; }
            const float dec = __expf(sgc[i] - sgc[j]); iv = dqk * dec; av = (j < i) ? sbeta[i] * dkk * dec : 0.f; }
        sA[i * 65 + j] = av; INo[idx] = (bf16)f2bf(iv);
    }
    __syncthreads();
    if (F.tid < 64) { const int c = F.tid;
        for (int i = 0; i < 64; ++i) { float t = 0.f;
            for (int j = 0; j < i; ++j) t -= sA[i * 65 + j] * sT[j * 65 + c];
            sT[i * 65 + c] = (i == c) ? 1.0f : ((i < c) ? 0.f : t); } }
    __syncthreads();
    bf16* UTo = (bf16*)(F.ws + WS_UT) + (size_t)unit * 8192; bf16* Wo = (bf16*)(F.ws + WS_W) + (size_t)unit * 8192;
    bf16* QDo = (bf16*)(F.ws + WS_QD) + (size_t)unit * 8192; bf16* KDTo = (bf16*)(F.ws + WS_KDT) + (size_t)unit * 8192;
    const float glast = sgc[63];
    for (int idx = F.tid; idx < 8192; idx += 512) {
        { const int dv = idx >> 6, i = idx & 63; float u = 0.f;
          for (int j = 0; j <= i; ++j) u += sT[i * 65 + j] * sbeta[j] * sv[j * 129 + dv];
          UTo[idx] = (bf16)f2bf(u);
          KDTo[idx] = (bf16)f2bf(sk[i * 129 + dv] * __expf(glast - sgc[i])); }
        { const int i = idx >> 7, dk = idx & 127; float w = 0.f;
          for (int j = 0; j <= i; ++j) w += sT[i * 65 + j] * sbeta[j] * __expf(sgc[j]) * sk[j * 129 + dk];
          Wo[idx] = (bf16)f2bf(w);
          QDo[idx] = (bf16)f2bf(sq[i * 129 + dk] * __expf(sgc[i])); }
    }
    if (F.tid == 0) ((float*)(F.ws + WS_DEC))[unit] = __expf(glast);
    __syncthreads();
}

__device__ __forceinline__ void p4_scan(Frame& F, int item) {
    const int bh = item >> 2, sl = item & 3, h = bh % NH, b = bh / NH;
    LAS float* sS = (LAS float*)F.lds;
    LAS float* sV = sS + 128 * 33;
    LAS bf16* sW = (LAS bf16*)(sV + 64 * 33);
    LAS bf16* sQ = sW + 64 * 136;
    LAS bf16* sK = sQ + 64 * 136;
    LAS bf16* sI = sK + 128 * 72;
    for (int i = F.tid; i < 128 * 33; i += 512) sS[i] = 0.f;
    bf16* OR = (bf16*)(F.ws + WS_OR); float* SSQ = (float*)(F.ws + CTL_SSQ);
    const int c = F.tid >> 3, d4 = (F.tid & 7) * 4, dk2 = F.tid >> 2, d8 = (F.tid & 3) * 8;
    for (int n = 0; n < NCH; ++n) {
        const int unit = bh * NCH + n;
        const bf16* Wg = (const bf16*)(F.ws + WS_W) + (size_t)unit * 8192; const bf16* Qg = (const bf16*)(F.ws + WS_QD) + (size_t)unit * 8192;
        const bf16* Kg = (const bf16*)(F.ws + WS_KDT) + (size_t)unit * 8192; const bf16* Ig = (const bf16*)(F.ws + WS_IN) + (size_t)unit * 4096;
        const bf16* Ug = (const bf16*)(F.ws + WS_UT) + (size_t)unit * 8192;
        __syncthreads();
        for (int i = F.tid; i < 1024; i += 512) { const int r = i >> 4, c8 = (i & 15) * 8;
            *(LAS v4u*)(sW + r * 136 + c8) = *(const v4u*)(Wg + r * 128 + c8); *(LAS v4u*)(sQ + r * 136 + c8) = *(const v4u*)(Qg + r * 128 + c8); }
        for (int i = F.tid; i < 1024; i += 512) { const int r = i >> 3, c8 = (i & 7) * 8; *(LAS v4u*)(sK + r * 72 + c8) = *(const v4u*)(Kg + r * 64 + c8); }
        { const int r = F.tid >> 3, c8 = (F.tid & 7) * 8; *(LAS v4u*)(sI + r * 72 + c8) = *(const v4u*)(Ig + r * 64 + c8); }
        const float dec = ((const float*)(F.ws + WS_DEC))[unit];
        __syncthreads();
        float pS[4] = {0.f, 0.f, 0.f, 0.f}, qS[4] = {0.f, 0.f, 0.f, 0.f};
        for (int dk = 0; dk < 128; ++dk) { const float wv = bf2f(sW[c * 136 + dk]), qv = bf2f(sQ[c * 136 + dk]);
#pragma unroll
            for (int e = 0; e < 4; ++e) { const float s = sS[dk * 33 + d4 + e]; pS[e] += wv * s; qS[e] += qv * s; } }
        float vn[4];
#pragma unroll
        for (int e = 0; e < 4; ++e) { vn[e] = bf2f(Ug[(sl * 32 + d4 + e) * 64 + c]) - pS[e]; sV[c * 33 + d4 + e] = vn[e]; }
        __syncthreads();
        float o[4] = {qS[0], qS[1], qS[2], qS[3]};
        for (int j = 0; j < 64; ++j) { const float iv = bf2f(sI[c * 72 + j]);
#pragma unroll
            for (int e = 0; e < 4; ++e) o[e] += iv * sV[j * 33 + d4 + e]; }
        const int row = b * T + n * CH + c;
        *(v2u*)(OR + (size_t)row * D + h * 128 + sl * 32 + d4) = (v2u){pk2(o[0], o[1]), pk2(o[2], o[3])};
        float ss = (o[0] * o[0] + o[1] * o[1]) + (o[2] * o[2] + o[3] * o[3]);
        ss += __shfl_xor(ss, 1); ss += __shfl_xor(ss, 2); ss += __shfl_xor(ss, 4);
        if ((F.tid & 7) == 0) atomicAdd(SSQ + (size_t)row * 8 + h, ss);
        float sn[8];
#pragma unroll
        for (int e = 0; e < 8; ++e) sn[e] = dec * sS[dk2 * 33 + d8 + e];
        for (int cc = 0; cc < 64; ++cc) { const float kv = bf2f(sK[dk2 * 72 + cc]);
#pragma unroll
            for (int e = 0; e < 8; ++e) sn[e] += kv * sV[cc * 33 + d8 + e]; }
        __syncthreads();
#pragma unroll
        for (int e = 0; e < 8; ++e) sS[dk2 * 33 + d8 + e] = sn[e];
    }
    __syncthreads();
}


typedef pg8::bf16x8 bx8;
#define MFMA16(a, b, c) __builtin_amdgcn_mfma_f32_16x16x32_bf16(a, b, c, 0, 0, 0)
__device__ __forceinline__ v2u pack4(const f32x4 a) { v2u r; r.x = cvt_pk_bf16(a[0], a[1]); r.y = cvt_pk_bf16(a[2], a[3]); return r; }
__device__ __forceinline__ void p4_scan_fast(Frame& F, int bh) {
    const int h = bh % NH, b = bh / NH, w = F.wave, l15 = F.lane & 15, lq = F.lane >> 4, ct = w >> 1, dvh = w & 1;
    LAS bf16* sST = (LAS bf16*)F.lds;
    LAS bf16* sVT = sST + 128 * 136;
    LAS float* sSS = (LAS float*)(sVT + 128 * 72);
    LAS float* sDEC = sSS + 128;
    if (F.tid < NCH) sDEC[F.tid] = ((const float*)(F.ws + WS_DEC))[bh * NCH + F.tid];
    for (int i = F.tid; i < 128 * 136 / 2; i += 512) ((LAS unsigned*)sST)[i] = 0u;
    const bf16* Wg = (const bf16*)(F.ws + WS_W) + (size_t)bh * NCH * 8192 + (16 * ct + l15) * 128 + 8 * lq;
    const bf16* Qg = (const bf16*)(F.ws + WS_QD) + (size_t)bh * NCH * 8192 + (16 * ct + l15) * 128 + 8 * lq;
    const bf16* Ig = (const bf16*)(F.ws + WS_IN) + (size_t)bh * NCH * 4096 + (16 * ct + l15) * 64 + 8 * lq;
    const bf16* Kg = (const bf16*)(F.ws + WS_KDT) + (size_t)bh * NCH * 8192 + (16 * w + l15) * 64 + 8 * lq;
    const bf16* Ug = (const bf16*)(F.ws + WS_UT) + (size_t)bh * NCH * 8192 + (16 * 4 * dvh + l15) * 64 + 16 * ct + 4 * lq;
    bf16* OR = (bf16*)(F.ws + WS_OR);
    bx8 fW[4], fQ[4], fI[2], fK[2]; v2u fU[4];
#pragma unroll
    for (int ks = 0; ks < 4; ++ks) { fW[ks] = *(const bx8*)(Wg + 32 * ks); fQ[ks] = *(const bx8*)(Qg + 32 * ks); fU[ks] = *(const v2u*)(Ug + ks * 16 * 64); }
#pragma unroll
    for (int ks = 0; ks < 2; ++ks) { fI[ks] = *(const bx8*)(Ig + 32 * ks); fK[ks] = *(const bx8*)(Kg + 32 * ks); }
    f32x4 S[8], gn[4];
#pragma unroll
    for (int t = 0; t < 8; ++t) S[t] = (f32x4){0.f, 0.f, 0.f, 0.f};
#pragma unroll
    for (int t = 0; t < 4; ++t) gn[t] = *(const f32x4*)(F.onorm_g + 16 * (4 * dvh + t) + 4 * lq);
    __syncthreads();
    for (int n = 0; n < NCH; ++n) {
        const float dec = sDEC[n];
        const int nn = (n + 1 < NCH) ? 1 : 0;
        f32x4 pS[4], qS[4];
#pragma unroll
        for (int t = 0; t < 4; ++t) { bx8 fS[4];
#pragma unroll
            for (int ks = 0; ks < 4; ++ks) fS[ks] = *(const LAS bx8*)(sST + (16 * (4 * dvh + t) + l15) * 136 + 32 * ks + 8 * lq);
            f32x4 p = {0.f, 0.f, 0.f, 0.f}, q = {0.f, 0.f, 0.f, 0.f};
#pragma unroll
            for (int ks = 0; ks < 4; ++ks) { p = MFMA16(fW[ks], fS[ks], p); q = MFMA16(fS[ks], fQ[ks], q); }
            pS[t] = p; qS[t] = q; }
#pragma unroll
        for (int t = 0; t < 4; ++t) { const f32x4 u = {bflo(fU[t].x), bfhi(fU[t].x), bflo(fU[t].y), bfhi(fU[t].y)};
            *(LAS v2u*)(sVT + (16 * (4 * dvh + t) + l15) * 72 + 16 * ct + 4 * lq) = pack4(u - pS[t]); }
        Wg += nn * 8192; Qg += nn * 8192; Ug += nn * 8192;
#pragma unroll
        for (int ks = 0; ks < 4; ++ks) { fW[ks] = *(const bx8*)(Wg + 32 * ks); fQ[ks] = *(const bx8*)(Qg + 32 * ks); fU[ks] = *(const v2u*)(Ug + ks * 16 * 64); }
        __syncthreads();
        float ss = 0.f;
#pragma unroll
        for (int t = 0; t < 4; ++t) {
#pragma unroll
            for (int ks = 0; ks < 2; ++ks) { const bx8 fV = *(const LAS bx8*)(sVT + (16 * (4 * dvh + t) + l15) * 72 + 32 * ks + 8 * lq); qS[t] = MFMA16(fV, fI[ks], qS[t]); }
            ss += (qS[t][0] * qS[t][0] + qS[t][1] * qS[t][1]) + (qS[t][2] * qS[t][2] + qS[t][3] * qS[t][3]); }
        ss += __shfl_xor(ss, 16); ss += __shfl_xor(ss, 32);
        if (lq == 0) sSS[dvh * 64 + 16 * ct + l15] = ss;
        Ig += nn * 4096;
#pragma unroll
        for (int ks = 0; ks < 2; ++ks) fI[ks] = *(const bx8*)(Ig + 32 * ks);
#pragma unroll
        for (int t = 0; t < 8; ++t) { S[t] = S[t] * dec;
#pragma unroll
            for (int ks = 0; ks < 2; ++ks) { const bx8 fV = *(const LAS bx8*)(sVT + (16 * t + l15) * 72 + 32 * ks + 8 * lq); S[t] = MFMA16(fK[ks], fV, S[t]); }
            *(LAS v2u*)(sST + (16 * t + l15) * 136 + 16 * w + 4 * lq) = pack4(S[t]); }
        Kg += nn * 8192;
#pragma unroll
        for (int ks = 0; ks < 2; ++ks) fK[ks] = *(const bx8*)(Kg + 32 * ks);
        __syncthreads();
        const float rstd = __frsqrt_rn((sSS[16 * ct + l15] + sSS[64 + 16 * ct + l15]) * (1.0f / 128.0f) + EPS);
        bf16* orow = OR + (size_t)(b * T + n * CH + 16 * ct + l15) * D + h * 128 + 16 * 4 * dvh + 4 * lq;
#pragma unroll
        for (int t = 0; t < 4; ++t) *(v2u*)(orow + 16 * t) = pack4(qS[t] * rstd * gn[t]);
    }
    __syncthreads();
}


#define MFMA_F32(a, b, c) __builtin_amdgcn_mfma_f32_16x16x4f32(a, b, c, 0, 0, 0)
__device__ __forceinline__ void solve_block(LAS float* sA, LAS float* sT, int bi, int bj, int l15, int lq) {
    f32x4 y = {0.f, 0.f, 0.f, 0.f};
    for (int km = bj; km < bi; ++km)
#pragma unroll
        for (int kb = 0; kb < 4; ++kb) y = MFMA_F32(sA[(16 * bi + l15) * 68 + 16 * km + 4 * kb + lq], sT[(16 * km + 4 * kb + lq) * 68 + 16 * bj + l15], y);
    f32x4 z = {0.f, 0.f, 0.f, 0.f};
#pragma unroll
    for (int e = 0; e < 4; ++e) z = MFMA_F32(sT[(16 * bi + l15) * 68 + 16 * bi + 4 * lq + e], y[e], z);
#pragma unroll
    for (int e = 0; e < 4; ++e) sT[(16 * bi + 4 * lq + e) * 68 + 16 * bj + l15] = -z[e];
}
__device__ __forceinline__ void p3b_fast(Frame& F, int unit) {
    const int n = unit % NCH, bh = unit / NCH, h = bh % NH, b = bh / NH, t0 = n * CH, row0 = b * T + t0;
    const int tid = F.tid, w = F.wave, lane = F.lane, l15 = lane & 15, lq = lane >> 4;
    LAS bf16* sQ = (LAS bf16*)F.lds; LAS bf16* sK = sQ + 64 * 136; LAS bf16* sKG = sK + 64 * 136; LAS bf16* sVB = sKG + 128 * 72;
    LAS float* sA = (LAS float*)(sVB + 128 * 72); LAS float* sT = sA + 64 * 68; LAS bf16* sTb = (LAS bf16*)(sT + 64 * 68); LAS float* sgc = (LAS float*)(sTb + 64 * 72);
    const bf16* QKV = (const bf16*)(F.ws + WS_QKV); const float* BG = (const float*)(F.ws + WS_BG);
    bf16* INo = (bf16*)(F.ws + WS_IN) + (size_t)unit * 4096; bf16* UTo = (bf16*)(F.ws + WS_UT) + (size_t)unit * 8192; bf16* Wo = (bf16*)(F.ws + WS_W) + (size_t)unit * 8192;
    bf16* QDo = (bf16*)(F.ws + WS_QD) + (size_t)unit * 8192; bf16* KDTo = (bf16*)(F.ws + WS_KDT) + (size_t)unit * 8192;
    if (w == 0) {
        const float g = BG[(size_t)(row0 + lane) * 16 + 8 + h], bt = BG[(size_t)(row0 + lane) * 16 + h];
        float s = g;
#pragma unroll
        for (int o = 1; o < 64; o <<= 1) { const float t = __shfl_up(s, o); if (lane >= o) s += t; }
        const float gl = __shfl(s, 63);
        sgc[lane] = s; sgc[64 + lane] = bt; sgc[128 + lane] = __expf(s); sgc[192 + lane] = __expf(gl - s);
        if (lane == 0) ((float*)(F.ws + WS_DEC))[unit] = __expf(gl);
    }
    for (int i = tid; i < 64 * 68; i += 512) sT[i] = 0.f;
    __syncthreads();
    if (tid < 384) {
        const int rs = tid / 48, cg = tid % 48, sec = cg >> 4, c8 = (cg & 15) * 8, r0 = 8 * rs, gcol = sec * 1024 + h * 128 + c8;
        f32x4 wt[4][2];
#pragma unroll
        for (int j = 0; j < 4; ++j) { wt[j][0] = *(const f32x4*)(F.conv_qkv_w + j * NQKV + gcol); wt[j][1] = *(const f32x4*)(F.conv_qkv_w + j * NQKV + gcol + 4); }
        v4u raw[11];
#pragma unroll
        for (int i = 0; i < 11; ++i) { const int tt = t0 + r0 - 3 + i; raw[i] = (tt >= 0) ? *(const v4u*)(QKV + (size_t)(b * T + tt) * NQKV + gcol) : (v4u){0u, 0u, 0u, 0u}; }
        f32x4 o0[8], o1[8];
#pragma unroll
        for (int r = 0; r < 8; ++r) { f32x4 a0 = {0.f, 0.f, 0.f, 0.f}, a1 = a0;
#pragma unroll
            for (int j = 0; j < 4; ++j) { f32x4 x0, x1; unpack8(raw[r + j], x0, x1); a0 += wt[j][0] * x0; a1 += wt[j][1] * x1; }
#pragma unroll
            for (int e = 0; e < 4; ++e) { a0[e] = siluf_(a0[e]); a1[e] = siluf_(a1[e]); }
            float ss = (a0[0] * a0[0] + a0[1] * a0[1]) + (a0[2] * a0[2] + a0[3] * a0[3]) + (a1[0] * a1[0] + a1[1] * a1[1]) + (a1[2] * a1[2] + a1[3] * a1[3]);
            ss += __shfl_xor(ss, 1); ss += __shfl_xor(ss, 2); ss += __shfl_xor(ss, 4); ss += __shfl_xor(ss, 8);
            const float sc = (sec == 2) ? 1.0f : __frsqrt_rn(ss + EPS) * (sec == 0 ? 0.08838834764831845f : 1.0f);
            o0[r] = a0 * sc; o1[r] = a1 * sc; }
        if (sec == 0) {
#pragma unroll
            for (int r = 0; r < 8; ++r) { *(LAS v4u*)(sQ + (r0 + r) * 136 + c8) = pack8(o0[r], o1[r]); const float eg = sgc[128 + r0 + r];
                *(v4u*)(QDo + (r0 + r) * 128 + c8) = pack8(o0[r] * eg, o1[r] * eg); }
        } else if (sec == 1) {
            float fk[8], fd[8];
#pragma unroll
            for (int r = 0; r < 8; ++r) { *(LAS v4u*)(sK + (r0 + r) * 136 + c8) = pack8(o0[r], o1[r]); fk[r] = sgc[64 + r0 + r] * sgc[128 + r0 + r]; fd[r] = sgc[192 + r0 + r]; }
#pragma unroll
            for (int e = 0; e < 4; ++e) {
                { const f32x4 a = {o0[0][e] * fk[0], o0[1][e] * fk[1], o0[2][e] * fk[2], o0[3][e] * fk[3]}, bq = {o0[4][e] * fk[4], o0[5][e] * fk[5], o0[6][e] * fk[6], o0[7][e] * fk[7]};
                  *(LAS v4u*)(sKG + (c8 + e) * 72 + r0) = pack8(a, bq);
                  const f32x4 c = {o0[0][e] * fd[0], o0[1][e] * fd[1], o0[2][e] * fd[2], o0[3][e] * fd[3]}, d = {o0[4][e] * fd[4], o0[5][e] * fd[5], o0[6][e] * fd[6], o0[7][e] * fd[7]};
                  *(v4u*)(KDTo + (c8 + e) * 64 + r0) = pack8(c, d); }
                { const f32x4 a = {o1[0][e] * fk[0], o1[1][e] * fk[1], o1[2][e] * fk[2], o1[3][e] * fk[3]}, bq = {o1[4][e] * fk[4], o1[5][e] * fk[5], o1[6][e] * fk[6], o1[7][e] * fk[7]};
                  *(LAS v4u*)(sKG + (c8 + 4 + e) * 72 + r0) = pack8(a, bq);
                  const f32x4 c = {o1[0][e] * fd[0], o1[1][e] * fd[1], o1[2][e] * fd[2], o1[3][e] * fd[3]}, d = {o1[4][e] * fd[4], o1[5][e] * fd[5], o1[6][e] * fd[6], o1[7][e] * fd[7]};
                  *(v4u*)(KDTo + (c8 + 4 + e) * 64 + r0) = pack8(c, d); }
            }
        } else {
            float fb[8];
#pragma unroll
            for (int r = 0; r < 8; ++r) fb[r] = sgc[64 + r0 + r];
#pragma unroll
            for (int e = 0; e < 4; ++e) {
                { const f32x4 a = {o0[0][e] * fb[0], o0[1][e] * fb[1], o0[2][e] * fb[2], o0[3][e] * fb[3]}, bq = {o0[4][e] * fb[4], o0[5][e] * fb[5], o0[6][e] * fb[6], o0[7][e] * fb[7]};
                  *(LAS v4u*)(sVB + (c8 + e) * 72 + r0) = pack8(a, bq); }
                { const f32x4 a = {o1[0][e] * fb[0], o1[1][e] * fb[1], o1[2][e] * fb[2], o1[3][e] * fb[3]}, bq = {o1[4][e] * fb[4], o1[5][e] * fb[5], o1[6][e] * fb[6], o1[7][e] * fb[7]};
                  *(LAS v4u*)(sVB + (c8 + 4 + e) * 72 + r0) = pack8(a, bq); }
            }
        }
    }
    __syncthreads();
    {
        const int jt = w & 3, itp = w >> 2;
        bx8 ak[4];
#pragma unroll
        for (int ks = 0; ks < 4; ++ks) ak[ks] = *(const LAS bx8*)(sK + (16 * jt + l15) * 136 + 32 * ks + 8 * lq);
#pragma unroll
        for (int ii = 0; ii < 2; ++ii) { const int it = 2 * itp + ii, ci = 16 * it + l15;
            f32x4 xk = {0.f, 0.f, 0.f, 0.f}, xq = xk;
#pragma unroll
            for (int ks = 0; ks < 4; ++ks) { const bx8 bk = *(const LAS bx8*)(sK + ci * 136 + 32 * ks + 8 * lq), bq = *(const LAS bx8*)(sQ + ci * 136 + 32 * ks + 8 * lq);
                xk = MFMA16(ak[ks], bk, xk); xq = MFMA16(ak[ks], bq, xq); }
            const float gi = sgc[ci], bi = sgc[64 + ci];
            f32x4 av, iv;
#pragma unroll
            for (int e = 0; e < 4; ++e) { const int cj = 16 * jt + 4 * lq + e; const float dec = __expf(gi - sgc[cj]);
                av[e] = (cj < ci) ? bi * xk[e] * dec : 0.f; iv[e] = (cj <= ci) ? xq[e] * dec : 0.f; }
            *(LAS f32x4*)(sA + ci * 68 + 16 * jt + 4 * lq) = av;
            *(v2u*)(INo + ci * 64 + 16 * jt + 4 * lq) = pack4(iv); }
    }
    __syncthreads();
    if (w == 0) {
        const int blk = lq, c = l15; float t[16];
#pragma unroll
        for (int i = 0; i < 16; ++i) { float s = 0.f;
#pragma unroll
            for (int jb = 0; jb < (i + 3) / 4; ++jb) { const f32x4 a4 = *(const LAS f32x4*)(sA + (16 * blk + i) * 68 + 16 * blk + 4 * jb);
#pragma unroll
                for (int e = 0; e < 4; ++e) if (4 * jb + e < i) s -= a4[e] * t[4 * jb + e]; }
            t[i] = (i == c) ? 1.0f : s;
            sT[(16 * blk + i) * 68 + 16 * blk + c] = t[i]; }
    }
    __syncthreads();
    if (w < 3) solve_block(sA, sT, w + 1, w, l15, lq);
    __syncthreads();
    if (w < 2) solve_block(sA, sT, w + 2, w, l15, lq);
    __syncthreads();
    if (w < 1) solve_block(sA, sT, 3, 0, l15, lq);
    __syncthreads();
    { const int i = tid >> 3, j8 = (tid & 7) * 8; *(LAS v4u*)(sTb + i * 72 + j8) = pack8(*(const LAS f32x4*)(sT + i * 68 + j8), *(const LAS f32x4*)(sT + i * 68 + j8 + 4)); }
    __syncthreads();
    {
        bx8 bv[2], ag[2];
#pragma unroll
        for (int ks = 0; ks < 2; ++ks) { bv[ks] = *(const LAS bx8*)(sVB + (16 * w + l15) * 72 + 32 * ks + 8 * lq); ag[ks] = *(const LAS bx8*)(sKG + (16 * w + l15) * 72 + 32 * ks + 8 * lq); }
#pragma unroll
        for (int it = 0; it < 4; ++it) { f32x4 u = {0.f, 0.f, 0.f, 0.f}, ww = u;
#pragma unroll
            for (int ks = 0; ks < 2; ++ks) { const bx8 ft = *(const LAS bx8*)(sTb + (16 * it + l15) * 72 + 32 * ks + 8 * lq); u = MFMA16(ft, bv[ks], u); ww = MFMA16(ag[ks], ft, ww); }
            *(v2u*)(UTo + (16 * w + l15) * 64 + 16 * it + 4 * lq) = pack4(u);
            *(v2u*)(Wo + (16 * it + l15) * 128 + 16 * w + 4 * lq) = pack4(ww); }
    }
    __syncthreads();
}


__device__ __forceinline__ void p4a_seg(Frame& F, int seg) {
    const int w = F.wave, l15 = F.lane & 15, lq = F.lane >> 4, ct = w >> 1, ch = w & 1;
    const int bh = seg >> 4, g = seg & 15, unit0 = bh * NCH + 8 * g;
    LAS bf16* sST = (LAS bf16*)F.lds;
    LAS bf16* sVT = sST + 256 * 136;
    LAS float* sDEC = (LAS float*)(sVT + 256 * 72);
    if (F.tid < 8) sDEC[F.tid] = ((const float*)(F.ws + WS_DEC))[unit0 + F.tid];
    for (int i = F.tid; i < 256 * 136 / 2; i += 512) ((LAS unsigned*)sST)[i] = 0u;
    __syncthreads();
    if (F.tid < 128) sST[F.tid * 136 + F.tid] = (bf16)0x3F80;
    f32x4 ST[16];
#pragma unroll
    for (int t = 0; t < 16; ++t)
#pragma unroll
        for (int e = 0; e < 4; ++e) ST[t][e] = (t == w && l15 == 4 * lq + e) ? 1.0f : 0.0f;
    const bf16* Wg = (const bf16*)(F.ws + WS_W) + (size_t)unit0 * 8192 + (16 * ct + l15) * 128 + 8 * lq;
    const bf16* Kg = (const bf16*)(F.ws + WS_KDT) + (size_t)unit0 * 8192 + (16 * w + l15) * 64 + 8 * lq;
    const bf16* Ug = (const bf16*)(F.ws + WS_UT) + (size_t)unit0 * 8192 + l15 * 64 + 16 * ct + 4 * lq;
    bx8 fW[4], fK[2]; v2u fU[8];
#pragma unroll
    for (int ks = 0; ks < 4; ++ks) fW[ks] = *(const bx8*)(Wg + 32 * ks);
#pragma unroll
    for (int ks = 0; ks < 2; ++ks) fK[ks] = *(const bx8*)(Kg + 32 * ks);
#pragma unroll
    for (int t = 0; t < 8; ++t) fU[t] = ch ? *(const v2u*)(Ug + t * 16 * 64) : (v2u){0u, 0u};
    __syncthreads();
    for (int sI = 0; sI < 8; ++sI) {
        const float dec = sDEC[sI];
        const int nn = (sI < 7) ? 1 : 0;
#pragma unroll
        for (int t = 0; t < 8; ++t) { const int Tc = 8 * ch + t; f32x4 p = {0.f, 0.f, 0.f, 0.f};
#pragma unroll
            for (int ks = 0; ks < 4; ++ks) { const bx8 fS = *(const LAS bx8*)(sST + (16 * Tc + l15) * 136 + 32 * ks + 8 * lq); p = MFMA16(fW[ks], fS, p); }
            const f32x4 u = {bflo(fU[t].x), bfhi(fU[t].x), bflo(fU[t].y), bfhi(fU[t].y)};
            *(LAS v2u*)(sVT + (16 * Tc + l15) * 72 + 16 * ct + 4 * lq) = pack4(u - p); }
        Wg += nn * 8192; Ug += nn * 8192;
#pragma unroll
        for (int ks = 0; ks < 4; ++ks) fW[ks] = *(const bx8*)(Wg + 32 * ks);
#pragma unroll
        for (int t = 0; t < 8; ++t) fU[t] = ch ? *(const v2u*)(Ug + t * 16 * 64) : (v2u){0u, 0u};
        __syncthreads();
#pragma unroll
        for (int t = 0; t < 16; ++t) { ST[t] = ST[t] * dec;
#pragma unroll
            for (int ks = 0; ks < 2; ++ks) { const bx8 fV = *(const LAS bx8*)(sVT + (16 * t + l15) * 72 + 32 * ks + 8 * lq); ST[t] = MFMA16(fK[ks], fV, ST[t]); }
            *(LAS v2u*)(sST + (16 * t + l15) * 136 + 16 * w + 4 * lq) = pack4(ST[t]); }
        Kg += nn * 8192;
#pragma unroll
        for (int ks = 0; ks < 2; ++ks) fK[ks] = *(const bx8*)(Kg + 32 * ks);
        __syncthreads();
    }
    bf16* PHI = (bf16*)((unsigned char*)F.out + OUT_PHI) + (size_t)seg * 16384;
#pragma unroll
    for (int t = 0; t < 8; ++t)
#pragma unroll
        for (int e = 0; e < 4; ++e) PHI[(16 * w + 4 * lq + e) * 128 + 16 * t + l15] = (bf16)f2bf(ST[t][e]);
    f32x4* LS = (f32x4*)((unsigned char*)F.out + OUT_LSEG) + ((size_t)(seg * 8 + w) * 8) * 64 + F.lane;
#pragma unroll
    for (int t = 0; t < 8; ++t) LS[t * 64] = ST[8 + t];
}
__device__ __forceinline__ void p4b_fold(Frame& F, int item) {
    const int w = F.wave, l15 = F.lane & 15, lq = F.lane >> 4, bh = item >> 2, dvs = item & 3;
    LAS bf16* sS = (LAS bf16*)F.lds;
    for (int i = F.tid; i < 32 * 136 / 2; i += 512) ((LAS unsigned*)sS)[i] = 0u;
    const bf16* Pg = (const bf16*)((const unsigned char*)F.out + OUT_PHI) + (size_t)(bh * 16) * 16384 + (16 * w + l15) * 128 + 8 * lq;
    const f32x4* Lg = (const f32x4*)((const unsigned char*)F.out + OUT_LSEG) + ((size_t)(bh * 16 * 8 + w) * 8 + 2 * dvs) * 64 + F.lane;
    f32x4* So = (f32x4*)((unsigned char*)F.out + OUT_LSEG) + ((size_t)(bh * 16 * 8 + w) * 8 + 2 * dvs) * 64 + F.lane;
    bx8 fP[4]; f32x4 L[2];
#pragma unroll
    for (int ks = 0; ks < 4; ++ks) fP[ks] = *(const bx8*)(Pg + 32 * ks);
    L[0] = Lg[0]; L[1] = Lg[64];
    __syncthreads();
    for (int g = 0; g < 15; ++g) {
        f32x4 Sn[2];
#pragma unroll
        for (int t = 0; t < 2; ++t) { f32x4 acc = L[t];
#pragma unroll
            for (int ks = 0; ks < 4; ++ks) { const bx8 fS = *(const LAS bx8*)(sS + (16 * t + l15) * 136 + 32 * ks + 8 * lq); acc = MFMA16(fP[ks], fS, acc); }
            Sn[t] = acc; }
        const int nn = (g < 14) ? 1 : 0;
        Pg += nn * 16384; Lg += nn * 8 * 8 * 64;
#pragma unroll
        for (int ks = 0; ks < 4; ++ks) fP[ks] = *(const bx8*)(Pg + 32 * ks);
        L[0] = Lg[0]; L[1] = Lg[64];
        __syncthreads();
#pragma unroll
        for (int t = 0; t < 2; ++t) { *(LAS v2u*)(sS + (16 * t + l15) * 136 + 16 * w + 4 * lq) = pack4(Sn[t]); So[t * 64] = Sn[t]; }
        So += 8 * 8 * 64;
        __syncthreads();
    }
}
__device__ __forceinline__ void p4c_seg(Frame& F, int seg) {
    const int bh = seg >> 4, g = seg & 15, unit0 = bh * NCH + 8 * g;
    const int h = bh % NH, b = bh / NH, w = F.wave, l15 = F.lane & 15, lq = F.lane >> 4, ct = w >> 1, dvh = w & 1;
    LAS bf16* sST = (LAS bf16*)F.lds;
    LAS bf16* sVT = sST + 128 * 136;
    LAS float* sSS = (LAS float*)(sVT + 128 * 72);
    LAS float* sDEC = sSS + 128;
    if (F.tid < 8) sDEC[F.tid] = ((const float*)(F.ws + WS_DEC))[unit0 + F.tid];
    f32x4 S[8], gn[4];
    { const f32x4* Sg = (const f32x4*)((const unsigned char*)F.out + OUT_LSEG) + ((size_t)((seg - 1) * 8 + w) * 8) * 64 + F.lane;
#pragma unroll
      for (int t = 0; t < 8; ++t) { S[t] = (f32x4){0.f, 0.f, 0.f, 0.f}; if (g != 0) S[t] = Sg[t * 64];
          *(LAS v2u*)(sST + (16 * t + l15) * 136 + 16 * w + 4 * lq) = pack4(S[t]); } }
    const bf16* Wg = (const bf16*)(F.ws + WS_W) + (size_t)unit0 * 8192 + (16 * ct + l15) * 128 + 8 * lq;
    const bf16* Qg = (const bf16*)(F.ws + WS_QD) + (size_t)unit0 * 8192 + (16 * ct + l15) * 128 + 8 * lq;
    const bf16* Ig = (const bf16*)(F.ws + WS_IN) + (size_t)unit0 * 4096 + (16 * ct + l15) * 64 + 8 * lq;
    const bf16* Kg = (const bf16*)(F.ws + WS_KDT) + (size_t)unit0 * 8192 + (16 * w + l15) * 64 + 8 * lq;
    const bf16* Ug = (const bf16*)(F.ws + WS_UT) + (size_t)unit0 * 8192 + (16 * 4 * dvh + l15) * 64 + 16 * ct + 4 * lq;
    bf16* OR = (bf16*)(F.ws + WS_OR);
    bx8 fW[4], fQ[4], fI[2], fK[2]; v2u fU[4];
#pragma unroll
    for (int ks = 0; ks < 4; ++ks) { fW[ks] = *(const bx8*)(Wg + 32 * ks); fQ[ks] = *(const bx8*)(Qg + 32 * ks); fU[ks] = *(const v2u*)(Ug + ks * 16 * 64); }
#pragma unroll
    for (int ks = 0; ks < 2; ++ks) { fI[ks] = *(const bx8*)(Ig + 32 * ks); fK[ks] = *(const bx8*)(Kg + 32 * ks); }
#pragma unroll
    for (int t = 0; t < 4; ++t) gn[t] = *(const f32x4*)(F.onorm_g + 16 * (4 * dvh + t) + 4 * lq);
    __syncthreads();
    for (int sI = 0; sI < 8; ++sI) {
        const float dec = sDEC[sI];
        const int nn = (sI < 7) ? 1 : 0;
        f32x4 pS[4], qS[4];
#pragma unroll
        for (int t = 0; t < 4; ++t) { bx8 fS[4];
#pragma unroll
            for (int ks = 0; ks < 4; ++ks) fS[ks] = *(const LAS bx8*)(sST + (16 * (4 * dvh + t) + l15) * 136 + 32 * ks + 8 * lq);
            f32x4 p = {0.f, 0.f, 0.f, 0.f}, q = {0.f, 0.f, 0.f, 0.f};
#pragma unroll
            for (int ks = 0; ks < 4; ++ks) { p = MFMA16(fW[ks], fS[ks], p); q = MFMA16(fS[ks], fQ[ks], q); }
            pS[t] = p; qS[t] = q; }
#pragma unroll
        for (int t = 0; t < 4; ++t) { const f32x4 u = {bflo(fU[t].x), bfhi(fU[t].x), bflo(fU[t].y), bfhi(fU[t].y)};
            *(LAS v2u*)(sVT + (16 * (4 * dvh + t) + l15) * 72 + 16 * ct + 4 * lq) = pack4(u - pS[t]); }
        Wg += nn * 8192; Qg += nn * 8192; Ug += nn * 8192;
#pragma unroll
        for (int ks = 0; ks < 4; ++ks) { fW[ks] = *(const bx8*)(Wg + 32 * ks); fQ[ks] = *(const bx8*)(Qg + 32 * ks); fU[ks] = *(const v2u*)(Ug + ks * 16 * 64); }
        __syncthreads();
        float ss = 0.f;
#pragma unroll
        for (int t = 0; t < 4; ++t) {
#pragma unroll
            for (int ks = 0; ks < 2; ++ks) { const bx8 fV = *(const LAS bx8*)(sVT + (16 * (4 * dvh + t) + l15) * 72 + 32 * ks + 8 * lq); qS[t] = MFMA16(fV, fI[ks], qS[t]); }
            ss += (qS[t][0] * qS[t][0] + qS[t][1] * qS[t][1]) + (qS[t][2] * qS[t][2] + qS[t][3] * qS[t][3]); }
        ss += __shfl_xor(ss, 16); ss += __shfl_xor(ss, 32);
        if (lq == 0) sSS[dvh * 64 + 16 * ct + l15] = ss;
        Ig += nn * 4096;
#pragma unroll
        for (int ks = 0; ks < 2; ++ks) fI[ks] = *(const bx8*)(Ig + 32 * ks);
#pragma unroll
        for (int t = 0; t < 8; ++t) { S[t] = S[t] * dec;
#pragma unroll
            for (int ks = 0; ks < 2; ++ks) { const bx8 fV = *(const LAS bx8*)(sVT + (16 * t + l15) * 72 + 32 * ks + 8 * lq); S[t] = MFMA16(fK[ks], fV, S[t]); }
            *(LAS v2u*)(sST + (16 * t + l15) * 136 + 16 * w + 4 * lq) = pack4(S[t]); }
        Kg += nn * 8192;
#pragma unroll
        for (int ks = 0; ks < 2; ++ks) fK[ks] = *(const bx8*)(Kg + 32 * ks);
        __syncthreads();
        const float rstd = __frsqrt_rn((sSS[16 * ct + l15] + sSS[64 + 16 * ct + l15]) * (1.0f / 128.0f) + EPS);
        bf16* orow = OR + (size_t)(b * T + (8 * g + sI) * CH + 16 * ct + l15) * D + h * 128 + 16 * 4 * dvh + 4 * lq;
#pragma unroll
        for (int t = 0; t < 4; ++t) *(v2u*)(orow + 16 * t) = pack4(qS[t] * rstd * gn[t]);
    }
    __syncthreads();
}

__device__ __forceinline__ void p8_router(Frame& F) {
    const int gw = blockIdx.x * NWAVES + F.wave, RPW = M / (F.G * NWAVES);
    bf16* H2 = (bf16*)(F.ws + WS_H2); int* TOKE = (int*)(F.ws + WS_TOKE); float* TOKW = (float*)(F.ws + WS_TOKW);
    LAS float* wT = (LAS float*)F.lds;
    LAS unsigned* hist = (LAS unsigned*)(wT + 36 * 1028);
    for (int i = F.tid; i < D * NGRP; i += 512) wT[(i & 3) * 1028 + (i >> 2)] = F.w_group[i];
    for (int i = F.tid; i < D * NE; i += 512) wT[(4 + (i & 31)) * 1028 + (i >> 5)] = F.w_expert[i];
    if (F.tid < NE) hist[F.tid] = 0u;
    __syncthreads();
    f32x4 gsc[4], gsh[4];
    { const int b = (gw * RPW) / T;
#pragma unroll
      for (int j = 0; j < 4; ++j) { const int col = 256 * j + 4 * F.lane; const f32x4 g2 = *(const f32x4*)(F.norm2_g + col);
          gsc[j] = g2 * (1.0f + *(const f32x4*)((const float*)(F.ws + CTL_MODACC) + b * 6144 + 4 * D + col)); gsh[j] = *(const f32x4*)((const float*)(F.ws + CTL_MODACC) + b * 6144 + 3 * D + col); } }
    for (int m = gw * RPW; m < (gw + 1) * RPW; ++m) {
        const f32x4* xr = (const f32x4*)(F.out + (size_t)m * D) + F.lane;
        f32x4 v[4]; float s = 0.f;
#pragma unroll
        for (int j = 0; j < 4; ++j) { v[j] = xr[64 * j]; s += (v[j].x * v[j].x + v[j].y * v[j].y) + (v[j].z * v[j].z + v[j].w * v[j].w); }
        const float rstd = __frsqrt_rn(wave_sum(s) * (1.f / D) + EPS);
#pragma unroll
        for (int j = 0; j < 4; ++j) { v[j] = v[j] * rstd * gsc[j] + gsh[j];
            *(v2u*)(H2 + (size_t)m * D + 256 * j + 4 * F.lane) = (v2u){pk2(v[j][0], v[j][1]), pk2(v[j][2], v[j][3])}; }
        float gp[4];
#pragma unroll
        for (int q = 0; q < 4; ++q) { float p = 0.f;
#pragma unroll
            for (int j = 0; j < 4; ++j) { const f32x4 w = *(const LAS f32x4*)(wT + q * 1028 + 256 * j + 4 * F.lane); p += (v[j][0] * w[0] + v[j][1] * w[1]) + (v[j][2] * w[2] + v[j][3] * w[3]); }
            gp[q] = p; }
        fold_step<4, 4>(gp, 32, (F.lane & 32) != 0); fold_step<2, 4>(gp, 16, (F.lane & 16) != 0);
        float gv = gp[0]; gv += __shfl_xor(gv, 8); gv += __shfl_xor(gv, 4); gv += __shfl_xor(gv, 2); gv += __shfl_xor(gv, 1);
        float gl[4];
#pragma unroll
        for (int q = 0; q < 4; ++q) gl[q] = readlane_f(gv, 32 * (q >> 1) + 16 * (q & 1)) + F.b_group[q];
        int gs = 0; float gm = gl[0];
#pragma unroll
        for (int q = 1; q < 4; ++q) if (gl[q] > gm) { gm = gl[q]; gs = q; }
        float den = 0.f;
#pragma unroll
        for (int q = 0; q < 4; ++q) den += __expf(gl[q] - gm);
        const float pg = 1.0f / den;
        float ep[8];
#pragma unroll
        for (int q = 0; q < 8; ++q) { float p = 0.f;
#pragma unroll
            for (int j = 0; j < 4; ++j) { const f32x4 w = *(const LAS f32x4*)(wT + (4 + gs * 8 + q) * 1028 + 256 * j + 4 * F.lane); p += (v[j][0] * w[0] + v[j][1] * w[1]) + (v[j][2] * w[2] + v[j][3] * w[3]); }
            ep[q] = p; }
        fold_step<8, 8>(ep, 32, (F.lane & 32) != 0); fold_step<4, 8>(ep, 16, (F.lane & 16) != 0); fold_step<2, 8>(ep, 8, (F.lane & 8) != 0);
        float ev = ep[0]; ev += __shfl_xor(ev, 4); ev += __shfl_xor(ev, 2); ev += __shfl_xor(ev, 1);
        float el[8];
#pragma unroll
        for (int q = 0; q < 8; ++q) el[q] = readlane_f(ev, 32 * (q >> 2) + 16 * ((q >> 1) & 1) + 8 * (q & 1)) + F.b_expert[gs * 8 + q];
        int i0 = 0; float v0 = el[0];
#pragma unroll
        for (int q = 1; q < 8; ++q) if (el[q] > v0) { v0 = el[q]; i0 = q; }
        int i1 = -1; float v1 = -3.0e38f;
#pragma unroll
        for (int q = 0; q < 8; ++q) if (q != i0 && el[q] > v1) { v1 = el[q]; i1 = q; }
        const float e1 = __expf(v1 - v0), sw = 1.0f / (1.0f + e1);
        if (F.lane == 0) {
            const int ea = gs * 8 + i0, eb = gs * 8 + i1;
            TOKE[m * 2] = ea; TOKE[m * 2 + 1] = eb; TOKW[m * 2] = pg * sw; TOKW[m * 2 + 1] = pg * e1 * sw;
            __hip_atomic_fetch_add((unsigned*)(hist + ea), 1u, __ATOMIC_RELAXED, __HIP_MEMORY_SCOPE_WORKGROUP); __hip_atomic_fetch_add((unsigned*)(hist + eb), 1u, __ATOMIC_RELAXED, __HIP_MEMORY_SCOPE_WORKGROUP);
        }
    }
    __syncthreads();
    if (F.tid < NE) ((unsigned*)(F.ws + WS_WGHIST))[blockIdx.x * NE + F.tid] = hist[F.tid];
}
__device__ __forceinline__ int moe_tables(Frame& F) {
    volatile LAS int* ps = (volatile LAS int*)(F.lds + MISC_OFF + 64); volatile LAS int* te = (volatile LAS int*)(F.lds + MISC_OFF + 256);
    volatile LAS int* tot = (volatile LAS int*)(F.lds + MISC_OFF + 1024); volatile LAS int* base = (volatile LAS int*)(F.lds + MISC_OFF + 1152);
    LAS int* part = (LAS int*)(F.lds + MISC_OFF - 4096);
    const unsigned* WGH = (const unsigned*)(F.ws + WS_WGHIST);
    __syncthreads();
    { const int e = F.tid & 31, p = F.tid >> 5; int t = 0, bsum = 0;
      for (int j = p; j < F.G; j += 16) { const int v = (int)WGH[j * NE + e]; t += v; bsum += (j < (int)blockIdx.x) ? v : 0; }
      part[p * 32 + e] = t; part[512 + p * 32 + e] = bsum; }
    __syncthreads();
    if (F.tid < 32) { int t = 0, bsum = 0;
#pragma unroll
        for (int p = 0; p < 16; ++p) { t += part[p * 32 + F.tid]; bsum += part[512 + p * 32 + F.tid]; }
        tot[F.tid] = t; base[F.tid] = bsum; }
    __syncthreads();
    if (F.tid == 0) { int a = 0;
        for (int e = 0; e < NE; ++e) { const int cnt = tot[e]; ps[e] = a; const int nb = (cnt + 255) >> 8;
            for (int r = 0; r < nb; ++r) te[(a >> 8) + r] = e; a += nb << 8; }
        ps[32] = a; }
    __syncthreads();
    return ps[32] >> 8;
}
__device__ __forceinline__ void p9_gather(Frame& F) {
    moe_tables(F);
    volatile LAS int* ps = (volatile LAS int*)(F.lds + MISC_OFF + 64); volatile LAS int* tot = (volatile LAS int*)(F.lds + MISC_OFF + 1024); volatile LAS int* base = (volatile LAS int*)(F.lds + MISC_OFF + 1152);
    LAS unsigned* lcur = (LAS unsigned*)F.lds;
    if (F.tid < NE) lcur[F.tid] = 0u;
    __syncthreads();
    const int gw = blockIdx.x * NWAVES + F.wave, RPW = M / (F.G * NWAVES);
    int* ROWTOK = (int*)(F.ws + WS_ROWTOK); float* ROWW = (float*)(F.ws + WS_ROWW);
    const int* TOKE = (const int*)(F.ws + WS_TOKE); const float* TOKW = (const float*)(F.ws + WS_TOKW);
    const bf16* H2 = (const bf16*)(F.ws + WS_H2); bf16* XS = (bf16*)(F.ws + WS_XS);
    for (int e = blockIdx.x; e < NE; e += F.G) for (int r = ps[e] + tot[e] + F.tid; r < ps[e + 1]; r += 512) ROWTOK[r] = -1;
    for (int m = gw * RPW; m < (gw + 1) * RPW; ++m) {
        int pos = 0;
        if (F.lane < 2) { const int e = TOKE[m * 2 + F.lane]; pos = ps[e] + base[e] + (int)__hip_atomic_fetch_add((unsigned*)(lcur + e), 1u, __ATOMIC_RELAXED, __HIP_MEMORY_SCOPE_WORKGROUP); ROWTOK[pos] = m * 2 + F.lane; ROWW[pos] = TOKW[m * 2 + F.lane]; }
        const int p0 = __shfl(pos, 0), p1 = __shfl(pos, 1);
        const v4u a = *((const v4u*)(H2 + (size_t)m * D) + F.lane), bb = *((const v4u*)(H2 + (size_t)m * D) + 64 + F.lane);
        *((v4u*)(XS + (size_t)p0 * D) + F.lane) = a; *((v4u*)(XS + (size_t)p0 * D) + 64 + F.lane) = bb;
        *((v4u*)(XS + (size_t)p1 * D) + F.lane) = a; *((v4u*)(XS + (size_t)p1 * D) + 64 + F.lane) = bb;
    }
}
__device__ __forceinline__ void p12_final(Frame& F) {
    const int gw = blockIdx.x * NWAVES + F.wave, RPW = M / (F.G * NWAVES);
    const bf16* YBUF = (const bf16*)(F.ws + WS_YBUF);
    f32x4 gt[4], gf[4];
    { const int b = (gw * RPW) / T;
#pragma unroll
      for (int j = 0; j < 4; ++j) { gt[j] = *(const f32x4*)((const float*)(F.ws + CTL_MODACC) + b * 6144 + 5 * D + 256 * j + 4 * F.lane); gf[j] = *(const f32x4*)(F.normf_g + 256 * j + 4 * F.lane); } }
    for (int m = gw * RPW; m < (gw + 1) * RPW; ++m) {
        f32x4* xr = (f32x4*)(F.out + (size_t)m * D) + F.lane;
        f32x4 v[4]; float s = 0.f;
#pragma unroll
        for (int j = 0; j < 4; ++j) { const int col = 256 * j + 4 * F.lane; v[j] = xr[64 * j];
            const v2u y0 = *(const v2u*)(YBUF + (size_t)(2 * m) * D + col), y1 = *(const v2u*)(YBUF + (size_t)(2 * m + 1) * D + col);
            const f32x4 ys = {bflo(y0.x) + bflo(y1.x), bfhi(y0.x) + bfhi(y1.x), bflo(y0.y) + bflo(y1.y), bfhi(y0.y) + bfhi(y1.y)};
            v[j] += gt[j] * ys;
            s += (v[j].x * v[j].x + v[j].y * v[j].y) + (v[j].z * v[j].z + v[j].w * v[j].w); }
        const float rstd = __frsqrt_rn(wave_sum(s) * (1.f / D) + EPS);
#pragma unroll
        for (int j = 0; j < 4; ++j) xr[64 * j] = v[j] * rstd * gf[j];
    }
}

constexpr int NPH = 16;
struct Args { const float* in[23]; float* out; unsigned char* ws; int ph_lo, ph_hi; };
__global__ void __launch_bounds__(NWAVES * 64, 2) fwd(Args args) {
    extern __shared__ __attribute__((aligned(16))) unsigned char lds[];
    Frame F;
    F.lds = (LAS unsigned char*)lds; F.MISC = (volatile LAS unsigned*)(F.lds + MISC_OFF);
    F.tid = threadIdx.x; F.lane = F.tid & 63; F.wave = __builtin_amdgcn_readfirstlane(F.tid >> 6);
    F.G = gridDim.x; { const int bx = blockIdx.x; F.vcu = (F.G % 8 == 0) ? (bx % 8) * (F.G / 8) + bx / 8 : bx; }
    F.ws = args.ws; F.out = args.out; F.ctl = (unsigned*)(args.ws + WS_CTL);
    F.x = args.in[0]; F.c = args.in[1]; F.w_ada = args.in[2]; F.b_ada = args.in[3]; F.norm1_g = args.in[4]; F.w_in = args.in[5]; F.conv_qkv_w = args.in[6];
    F.a_log = args.in[7]; F.dt_bias = args.in[8]; F.onorm_g = args.in[9]; F.w_proj_a = args.in[10]; F.conv_sc_w = args.in[11]; F.w_proj_b = args.in[12]; F.w_out = args.in[13];
    F.norm2_g = args.in[14]; F.w_group = args.in[15]; F.b_group = args.in[16]; F.w_expert = args.in[17]; F.b_expert = args.in[18]; F.w1 = args.in[19]; F.w3 = args.in[20];
    F.w2 = args.in[21]; F.normf_g = args.in[22];
    if (F.tid < 4) F.MISC[F.tid] = 0u;
    __syncthreads();
    const int lo = args.ph_lo, hi = args.ph_hi;
    const bool fused = (hi - lo) > 1;
    XcdBarrier bar; bar.bar = F.ctl + CW_BAR; bar.x = 0; bar.st = F.MISC;
    if (fused) bar = xcd_barrier_post(F.ctl + CW_BAR, F.MISC);
#ifndef PH_MASK
#define PH_MASK 0xFFFFFFFFu
#endif
#define IN(k) (((PH_MASK >> (k)) & 1) && lo <= (k) && (k) < hi)
#define SEAM(k) do { if (IN(k) && IN((k) + 1)) xcd_barrier(bar); } while (0)
    bf16* H = (bf16*)F.out; bf16* YBP = (bf16*)F.out + (size_t)M * D;

    if (IN(0)) { p0_prologue(F); } SEAM(0);
    if (IN(1)) { p1_norm1(F); } SEAM(1);
    if (IN(2)) {
        pg8::Gemm g{H, (const bf16*)(F.ws + WS_WINA), M, 6144, D}; pg8::StaticOrder S; S.init(M, 6144, F.G, (int)blockIdx.x);
        EpiInA E{(bf16*)(F.ws + WS_QKV), (bf16*)(F.ws + WS_SB), (bf16*)(F.ws + WS_P)};
        pg8::gemm_phase<EpiInA, pg8::StaticOrder, true, true>(F.lds, g, S, E);
    } SEAM(2);
    if (IN(3)) { p3a_ybp(F); for (int u = blockIdx.x; u < NUNIT; u += F.G) p3b_fast(F, u); } SEAM(3);
    if (IN(4)) {
        pg8::Gemm g{YBP, (const bf16*)(F.ws + WS_WB), M, D, D}; pg8::StaticOrder S; S.init(M, D, F.G, (int)blockIdx.x);
        EpiPlain E{(bf16*)(F.ws + WS_YB), D};
        pg8::gemm_phase<EpiPlain, pg8::StaticOrder, true, true>(F.lds, g, S, E);
    } SEAM(4);
    if (IN(5)) { for (int it = blockIdx.x; it < NB * NH * 16; it += F.G) p4a_seg(F, it); } SEAM(5);
    if (IN(6)) { for (int it = blockIdx.x; it < NB * NH * 4; it += F.G) p4b_fold(F, it); p_moe_weights(F); } SEAM(6);
    if (IN(7)) { for (int it = blockIdx.x; it < NB * NH * 16; it += F.G) p4c_seg(F, it); } SEAM(7);
    if (IN(8)) {
        pg8::Gemm g{H, (const bf16*)(F.ws + WS_WINB), M, 3072, D}; pg8::StaticOrder S; S.init(M, 3072, F.G, (int)blockIdx.x);
        EpiInB E{(bf16*)(F.ws + WS_OR), (bf16*)(F.ws + WS_GA), (bf16*)(F.ws + WS_GB), (const float*)(F.ws + CTL_SSQ), F.onorm_g};
        pg8::gemm_phase<EpiInB, pg8::StaticOrder, true, true>(F.lds, g, S, E);
    } SEAM(8);
    if (IN(9)) {
        pg8::Gemm g{(const bf16*)(F.ws + WS_OR), (const bf16*)(F.ws + WS_WA), M, D, D}; pg8::StaticOrder S; S.init(M, D, F.G, (int)blockIdx.x);
        EpiMerge E{(const bf16*)(F.ws + WS_GA), (const bf16*)(F.ws + WS_GB), (const bf16*)(F.ws + WS_YB), (bf16*)(F.ws + WS_GA)};
        pg8::gemm_phase<EpiMerge, pg8::StaticOrder, true, true>(F.lds, g, S, E);
    } SEAM(9);
    if (IN(10)) {
        pg8::Gemm g{(const bf16*)(F.ws + WS_GA), (const bf16*)(F.ws + WS_WO), M, D, D}; pg8::StaticOrder S; S.init(M, D, F.G, (int)blockIdx.x);
        EpiX1 E{F.x, F.out, (const float*)(F.ws + CTL_MODACC), F.b_ada};
        pg8::gemm_phase<EpiX1, pg8::StaticOrder, true, true>(F.lds, g, S, E);
    } SEAM(10);
    if (IN(11)) { p8_router(F); } SEAM(11);
    if (IN(12)) { p9_gather(F); } SEAM(12);
    if (IN(13)) {
        const int nt = moe_tables(F);
        pg8::Gemm g{(const bf16*)(F.ws + WS_XS), (const bf16*)(F.ws + WS_W13), MOE_CAP, NE * D, D};
        MoeOrder S{nt * 4, F.G, (int)blockIdx.x, (const volatile LAS int*)(F.lds + MISC_OFF + 256)};
        EpiHid E{(bf16*)(F.ws + WS_HID)};
        pg8::gemm_phase<EpiHid, MoeOrder, true, true>(F.lds, g, S, E);
    } SEAM(13);
    if (IN(14)) {
        const int nt = moe_tables(F);
        pg8::Gemm g{(const bf16*)(F.ws + WS_HID), (const bf16*)(F.ws + WS_W2), MOE_CAP, NE * D, DE};
        MoeOrder S{nt * 4, F.G, (int)blockIdx.x, (const volatile LAS int*)(F.lds + MISC_OFF + 256)};
        EpiMoeOut E{(bf16*)(F.ws + WS_YBUF), (const int*)(F.ws + WS_ROWTOK), (const float*)(F.ws + WS_ROWW)};
        pg8::gemm_phase<EpiMoeOut, MoeOrder, true, true>(F.lds, g, S, E);
    } SEAM(14);
    if (IN(15)) { p12_final(F); }
#undef IN
#undef SEAM
}

extern "C" void kernel_launch(void* const* d_in, const int* in_sizes, int n_in, void* d_out, int out_size, void* d_ws, size_t ws_size, hipStream_t stream) {
    static int grid = 0;
    if (grid == 0) {
        if (n_in != 23 || out_size != M * D || ws_size < WS_END) { fprintf(stderr, "kernel_launch: unexpected problem (n_in %d, out %d, ws %zu)\n", n_in, out_size, ws_size); grid = -1; return; }
        int dev = 0, cus = 0, per_cu = 0;
        if (hipGetDevice(&dev) != hipSuccess || hipDeviceGetAttribute(&cus, hipDeviceAttributeMultiprocessorCount, dev) != hipSuccess) { grid = -1; return; }
        if (hipFuncSetAttribute((const void*)fwd, hipFuncAttributeMaxDynamicSharedMemorySize, LDS_BYTES) != hipSuccess) { fprintf(stderr, "kernel_launch: hipFuncSetAttribute failed\n"); grid = -1; return; }
        if (hipOccupancyMaxActiveBlocksPerMultiprocessor(&per_cu, (const void*)fwd, NWAVES * 64, LDS_BYTES) != hipSuccess || per_cu < 1) { fprintf(stderr, "kernel_launch: occupancy query says %d\n", per_cu); }
        (void)hipGetLastError();
        grid = cus;
        if (M % (grid * NWAVES) != 0 || grid < 64) { fprintf(stderr, "kernel_launch: unsupported CU count %d\n", cus); grid = -1; return; }
    }
    if (grid < 0) return;
    (void)hipMemsetAsync((char*)d_ws + WS_CTL, 0, CTL_ZERO_BYTES, stream);
    Args a{};
    for (int i = 0; i < 23; ++i) a.in[i] = (const float*)d_in[i];
    a.out = (float*)d_out; a.ws = (unsigned char*)d_ws;
#ifndef MK_FUSED
#define MK_FUSED 1
#endif
#ifdef PROBE_DUP
    { const int cuts[4] = {0, PROBE_DUP + 1, PROBE_DUP, NPH}; const int ends[3] = {PROBE_DUP + 1, PROBE_DUP + 1, NPH};
      for (int li = 0; li < 3; ++li) { a.ph_lo = (li == 0) ? 0 : (li == 1 ? PROBE_DUP : PROBE_DUP + 1); a.ph_hi = ends[li]; (void)cuts;
          hipMemsetAsync((char*)d_ws + WS_CTL + CW_BAR * 4, 0, XCD_BAR_WORDS * 4, stream);
          if (a.ph_lo < a.ph_hi) hipLaunchKernelGGL(fwd, dim3(grid), dim3(NWAVES * 64), LDS_BYTES, stream, a); } return; }
#endif
    if (MK_FUSED) { a.ph_lo = 0; a.ph_hi = NPH; hipLaunchKernelGGL(fwd, dim3(grid), dim3(NWAVES * 64), LDS_BYTES, stream, a); }
    else for (int p = 0; p < NPH; ++p) { a.ph_lo = p; a.ph_hi = p + 1; hipLaunchKernelGGL(fwd, dim3(grid), dim3(NWAVES * 64), LDS_BYTES, stream, a); }
}
```

```cpp
#include <hip/hip_runtime.h>
#include <cstdio>
#include <cstdint>
namespace pg8 {
#define PG8_LAS __attribute__((address_space(3)))
typedef unsigned short bf16_t;
typedef short bf16x8 __attribute__((ext_vector_type(8)));
typedef float f32x4 __attribute__((ext_vector_type(4)));
typedef unsigned u32x4 __attribute__((ext_vector_type(4)));
constexpr int BM = 256, BK = 64, HALF = 128, HTB = HALF * BK * 2  , STAGE_BYTES = 8 * HTB, NXCD = 8, WGM = 8;

__host__ __device__ __forceinline__ int lds_byte(int r, int c) { const int st = (r >> 4) * 2 + (c >> 5), rr = r & 15, cc = c & 31, ob = rr * 64 + cc * 2; return st * 1024 + (ob ^ (((ob >> 9) & 1) << 5)); }
__host__ __device__ __forceinline__ void stage_rc(int b, int& R, int& C) { const int st = b / 1024, sb = b % 1024, swz = sb ^ (((sb >> 9) & 1) << 5); R = (st >> 1) * 16 + swz / 64; C = (st & 1) * 32 + (swz % 64) / 2; }
__host__ __device__ __forceinline__ int perm32(int rho) { const int n = rho >> 4, i = rho & 15; return 8 * (i >> 2) + 4 * n + (i & 3); }

struct Unit { int pm, pn; };
struct Gemm { const bf16_t* A; const bf16_t* Bt; int M, N, K; };

struct StaticOrder {
    int nM, nN, nwg, G, c;
    __host__ __device__ void init(int M, int N, int G_, int c_) { nM = M / BM; nN = N / BM; nwg = nM * nN; G = G_; c = c_; }
    __host__ __device__ bool next(int i, Unit& u) const {
        const long L = (long)i * G + c; if (L >= nwg) return false;
        int wgid = (int)L; { const int q = nwg / NXCD, r = nwg % NXCD, xcd = wgid % NXCD, off = wgid / NXCD; wgid = (xcd < r ? xcd * (q + 1) : r * (q + 1) + (xcd - r) * q) + off; }
        const int nig = WGM * nN, gid = wgid / nig, fm = gid * WGM, gsz = (nM - fm) < WGM ? (nM - fm) : WGM;
        u.pm = fm + ((wgid % nig) % gsz); u.pn = (wgid % nig) / gsz; return true;
    }
    __device__ __forceinline__ void a_ready(const Unit&) const {}
    __device__ __forceinline__ void done(const Unit&) const {}
};

typedef float f32x2_cv __attribute__((ext_vector_type(2)));
typedef __bf16 bf16x2_cv __attribute__((ext_vector_type(2)));
__device__ __forceinline__ unsigned cvt_pk_bf16(float lo, float hi) { const f32x2_cv v = {lo, hi}; return __builtin_bit_cast(unsigned, __builtin_convertvector(v, bf16x2_cv)); }
template <class Epi, class Sched, bool ALIGN_EPI = false, bool SP2 = false>
__device__ __forceinline__ void gemm_phase(PG8_LAS unsigned char* lds, const Gemm g, const Sched& S, const Epi& E) {
    const int tid = threadIdx.x, wid = __builtin_amdgcn_readfirstlane(tid >> 6), lane = tid & 63, wr = wid >> 2, wc = wid & 3, fr = lane & 15, fq = lane >> 4;
    const int K = g.K, nt = K / BK;
    unsigned voffA[2], voffB[2];
#pragma unroll
    for (int i = 0; i < 2; ++i) { int R, C; stage_rc(tid * 16 + i * 8192, R, C); const int Rb = Epi::PERM ? ((R & ~31) + perm32(R & 31)) : R;
        voffA[i] = (unsigned)(R * K + C) * 2u; voffB[i] = (unsigned)(Rb * K + C) * 2u; }
    const size_t kstep = (size_t)(BK * 2);
    const size_t hstep = (size_t)HALF * K * 2;
    const size_t tstep = 2 * hstep;
    const unsigned ldsw = (unsigned)wid * 1024u;
    const int aoff = lds_byte(wr * 64 + fr, fq * 8), boff = lds_byte(wc * 32 + fr, fq * 8);
#define PG8_SA(b, h) (((b) * 2 + (h)) * HTB)
#define PG8_SB(b, h) ((4 + (b) * 2 + (h)) * HTB)
#define PG8_STAGE(bufoff, gbase, voff) do { _Pragma("unroll") for (int _i = 0; _i < 2; ++_i) \
        __builtin_amdgcn_global_load_lds((const unsigned*)((const char*)(gbase) + (voff)[_i]), (PG8_LAS unsigned*)(lds + (bufoff) + ldsw + _i * 8192), 16, 0, 0); } while (0)
#define PG8_LDA(dst, b, h) do { _Pragma("unroll") for (int m = 0; m < 4; ++m) _Pragma("unroll") for (int k = 0; k < 2; ++k) dst[m][k] = *(const PG8_LAS bf16x8*)(lds + PG8_SA(b, h) + aoff + m * 2048 + k * 1024); } while (0)
#define PG8_LDB(dst, b, h) do { _Pragma("unroll") for (int n = 0; n < 2; ++n) _Pragma("unroll") for (int k = 0; k < 2; ++k) dst[n][k] = *(const PG8_LAS bf16x8*)(lds + PG8_SB(b, h) + boff + n * 2048 + k * 1024); } while (0)
#define PG8_MMA(ai, bj, At, Bt) do { __builtin_amdgcn_s_setprio(1); _Pragma("unroll") for (int m = 0; m < 4; ++m) _Pragma("unroll") for (int n = 0; n < 2; ++n) _Pragma("unroll") for (int k = 0; k < 2; ++k) \
        acc[ai][bj][m][n] = __builtin_amdgcn_mfma_f32_16x16x32_bf16(Bt[n][k], At[m][k], acc[ai][bj][m][n], 0, 0, 0); __builtin_amdgcn_s_setprio(0); } while (0)
#define PG8_WAIT_V(n) asm volatile("s_waitcnt vmcnt(" #n ")" ::: "memory")
#define PG8_WAIT_L(n) asm volatile("s_waitcnt lgkmcnt(" #n ")" ::: "memory")
#define PG8_BAR __builtin_amdgcn_s_barrier()
#define PG8_SCHED __builtin_amdgcn_sched_barrier(0)
    Unit cur, nxt; int ui = 0;
    if (!S.next(0, cur)) return;
    f32x4 acc[2][2][4][2];
#pragma unroll
    for (int a = 0; a < 2; ++a)
#pragma unroll
        for (int b = 0; b < 2; ++b)
#pragma unroll
            for (int m = 0; m < 4; ++m)
#pragma unroll
                for (int n = 0; n < 2; ++n) acc[a][b][m][n] = (f32x4){0.f, 0.f, 0.f, 0.f};
    bf16x8 At[4][2], B0[2][2], B1[2][2];
    const char* cA = (const char*)g.A + (size_t)cur.pm * tstep; const char* cB = (const char*)g.Bt + (size_t)cur.pn * tstep;
    S.a_ready(cur);
    if constexpr (SP2) {
        PG8_STAGE(PG8_SB(0, 0), cB, voffB); PG8_STAGE(PG8_SB(0, 1), cB + hstep, voffB); PG8_STAGE(PG8_SA(0, 0), cA, voffA); PG8_STAGE(PG8_SA(0, 1), cA + hstep, voffA);
        if (wr == 1) PG8_BAR;
        PG8_WAIT_V(2); PG8_BAR;
        PG8_STAGE(PG8_SB(1, 0), cB + kstep, voffB); PG8_STAGE(PG8_SA(1, 0), cA + kstep, voffA); PG8_STAGE(PG8_SB(1, 1), cB + hstep + kstep, voffB);
        PG8_WAIT_V(6); PG8_BAR;
    } else {
        PG8_STAGE(PG8_SB(0, 0), cB, voffB); PG8_STAGE(PG8_SA(0, 0), cA, voffA); PG8_STAGE(PG8_SB(0, 1), cB + hstep, voffB); PG8_STAGE(PG8_SA(0, 1), cA + hstep, voffA);
        if (wr == 1) PG8_BAR;
        PG8_WAIT_V(4); PG8_BAR;
        PG8_STAGE(PG8_SB(1, 0), cB + kstep, voffB); PG8_STAGE(PG8_SA(1, 0), cA + kstep, voffA); PG8_STAGE(PG8_SB(1, 1), cB + hstep + kstep, voffB);
        PG8_WAIT_V(6); PG8_BAR;
    }
    for (;;) {
        const bool has_next = S.next(ui + 1, nxt);
        const char* nA = has_next ? (const char*)g.A + (size_t)nxt.pm * tstep : cA; const char* nB = has_next ? (const char*)g.Bt + (size_t)nxt.pn * tstep : cB;
        for (int t = 0; t < nt; t += 2) {
            const bool last = (t == nt - 2);
            const char* a1 = cA + (size_t)(t + 1) * kstep;
            const char* a2 = last ? nA : cA + (size_t)(t + 2) * kstep; const char* b2 = last ? nB : cB + (size_t)(t + 2) * kstep;
            const char* a3 = a2 + kstep; const char* b3 = b2 + kstep;
            if (last && has_next) S.a_ready(nxt);
            if constexpr (SP2) {
            PG8_LDB(B0, 0, 0); PG8_LDB(B1, 0, 1); PG8_SCHED; PG8_LDA(At, 0, 0); PG8_STAGE(PG8_SA(1, 1), a1 + hstep, voffA);
            PG8_WAIT_V(8); PG8_WAIT_L(0); PG8_BAR; PG8_MMA(0, 0, At, B0); PG8_MMA(0, 1, At, B1); PG8_BAR; PG8_SCHED;
            PG8_LDA(At, 0, 1); PG8_STAGE(PG8_SB(0, 0), b2, voffB); PG8_STAGE(PG8_SB(0, 1), b2 + hstep, voffB); PG8_STAGE(PG8_SA(0, 0), a2, voffA);
            PG8_WAIT_V(8); PG8_WAIT_L(0); PG8_BAR; PG8_MMA(1, 0, At, B0); PG8_MMA(1, 1, At, B1); PG8_BAR; PG8_SCHED;
            PG8_LDB(B0, 1, 0); PG8_LDB(B1, 1, 1); PG8_SCHED; PG8_LDA(At, 1, 0); PG8_STAGE(PG8_SA(0, 1), a2 + hstep, voffA);
            PG8_WAIT_V(8); PG8_WAIT_L(0); PG8_BAR; PG8_MMA(0, 0, At, B0); PG8_MMA(0, 1, At, B1); PG8_BAR; PG8_SCHED;
            PG8_LDA(At, 1, 1); PG8_STAGE(PG8_SB(1, 0), b3, voffB); PG8_STAGE(PG8_SB(1, 1), b3 + hstep, voffB); PG8_STAGE(PG8_SA(1, 0), a3, voffA);
            PG8_WAIT_V(8); PG8_WAIT_L(0); PG8_BAR; PG8_MMA(1, 0, At, B0); PG8_MMA(1, 1, At, B1); PG8_BAR; PG8_SCHED;
            } else {
            PG8_LDB(B0, 0, 0); PG8_SCHED; PG8_LDA(At, 0, 0); PG8_STAGE(PG8_SA(1, 1), a1 + hstep, voffA);
            PG8_WAIT_L(8); PG8_BAR; PG8_WAIT_L(0); PG8_MMA(0, 0, At, B0); PG8_BAR; PG8_SCHED;
            PG8_LDB(B1, 0, 1); PG8_STAGE(PG8_SB(0, 0), b2, voffB);
            PG8_BAR; PG8_WAIT_L(0); PG8_MMA(0, 1, At, B1); PG8_BAR;
            PG8_LDA(At, 0, 1); PG8_STAGE(PG8_SA(0, 0), a2, voffA);
            PG8_BAR; PG8_WAIT_L(0); PG8_MMA(1, 0, At, B0); PG8_BAR; PG8_SCHED;
            PG8_STAGE(PG8_SB(0, 1), b2 + hstep, voffB);
            PG8_WAIT_V(6); PG8_BAR; PG8_MMA(1, 1, At, B1); PG8_BAR;
            PG8_LDB(B0, 1, 0); PG8_SCHED; PG8_LDA(At, 1, 0); PG8_STAGE(PG8_SA(0, 1), a2 + hstep, voffA);
            PG8_WAIT_L(8); PG8_BAR; PG8_WAIT_L(0); PG8_MMA(0, 0, At, B0); PG8_BAR; PG8_SCHED;
            PG8_LDB(B1, 1, 1); PG8_STAGE(PG8_SB(1, 0), b3, voffB);
            PG8_BAR; PG8_WAIT_L(0); PG8_MMA(0, 1, At, B1); PG8_BAR;
            PG8_LDA(At, 1, 1); PG8_STAGE(PG8_SA(1, 0), a3, voffA);
            PG8_BAR; PG8_WAIT_L(0); PG8_MMA(1, 0, At, B0); PG8_BAR; PG8_SCHED;
            PG8_STAGE(PG8_SB(1, 1), b3 + hstep, voffB);
            PG8_WAIT_V(6); PG8_BAR; PG8_MMA(1, 1, At, B1); PG8_BAR;
            }
        }
        if constexpr (ALIGN_EPI) { if (wr == 0) PG8_BAR; }
        if constexpr (!Epi::AFTER_DRAIN) { E(acc, cur, wr, wc, fr, fq); S.done(cur); }
        if (!has_next) break;
#pragma unroll
        for (int a = 0; a < 2; ++a)
#pragma unroll
            for (int b = 0; b < 2; ++b)
#pragma unroll
                for (int m = 0; m < 4; ++m)
#pragma unroll
                    for (int n = 0; n < 2; ++n) acc[a][b][m][n] = (f32x4){0.f, 0.f, 0.f, 0.f};
        cur = nxt; cA = nA; cB = nB; ++ui;
        if constexpr (ALIGN_EPI) { if (wr == 1) PG8_BAR; }
    }
    PG8_WAIT_V(0);
    if constexpr (!ALIGN_EPI) { if (wr == 0) PG8_BAR; }
    PG8_BAR;
    if constexpr (Epi::AFTER_DRAIN) { E.fused(acc, cur, wr, wc, fr, fq, lds, wid, lane); S.done(cur); }
#undef PG8_SA
#undef PG8_SB
#undef PG8_STAGE
#undef PG8_LDA
#undef PG8_LDB
#undef PG8_MMA
#undef PG8_WAIT_V
#undef PG8_WAIT_L
#undef PG8_BAR
#undef PG8_SCHED
}
}

constexpr int NB = 2, T = 8192, D = 1024, M = NB * T;
constexpr int NH = 8, DK = 128, DV = 128, CH = 64, NCH = T / CH;
constexpr int NQKV = 3072, IN_TOTAL = 9232;
constexpr int NE = 32, EPG = 8, NGRP = 4, DE = 512;
constexpr int NUNIT = NB * NH * NCH;
constexpr float EPS = 1e-6f;
constexpr int MOE_CAP = 40960;
constexpr int NWAVES = 8;

constexpr size_t MiB = 1u << 20;
constexpr size_t WS_CTL = 0, CTL_ZERO_BYTES = 1 * MiB;
constexpr size_t WS_BG = 1 * MiB;
constexpr size_t WS_TOKE = 2 * MiB;
constexpr size_t WS_TOKW = WS_TOKE + 128 * 1024;
constexpr size_t WS_ROWTOK = WS_TOKE + 256 * 1024;
constexpr size_t WS_ROWW = WS_TOKE + 512 * 1024;
constexpr size_t WS_DEC = 3 * MiB;
constexpr size_t WS_WGHIST = 3 * MiB + 64 * 1024;
constexpr size_t WS_WINA = 4 * MiB;
constexpr size_t WS_IN = 4 * MiB;
constexpr size_t WS_WINB = 20 * MiB;
constexpr size_t WS_WA = 27 * MiB, WS_WB = 29 * MiB, WS_WO = 31 * MiB;
constexpr size_t WS_QKV = 33 * MiB;
constexpr size_t WS_W13 = 33 * MiB;
constexpr size_t WS_W2 = 97 * MiB;
constexpr size_t WS_SB = 129 * MiB, WS_YB = 129 * MiB;
constexpr size_t WS_P = 161 * MiB, WS_OR = 161 * MiB;
constexpr size_t WS_UT = 193 * MiB, WS_W = 225 * MiB, WS_QD = 257 * MiB, WS_KDT = 289 * MiB;
constexpr size_t WS_GA = 193 * MiB, WS_GB = 225 * MiB;
constexpr size_t WS_H2 = 257 * MiB;
constexpr size_t WS_XS = 129 * MiB;
constexpr size_t WS_HID = 209 * MiB;
constexpr size_t WS_YBUF = 129 * MiB;
constexpr size_t OUT_PHI = 32 * MiB, OUT_LSEG = 40 * MiB;
constexpr size_t WS_END = 321 * MiB;
constexpr int CW_TMO = 0, CW_BAR = 4096, CW_Q = 8192;
constexpr size_t CTL_MODACC = 64 * 1024;
constexpr size_t CTL_SSQ = 128 * 1024;
constexpr int LDS_BYTES = 163840, MISC_OFF = LDS_BYTES - 2048;

#define GAS __attribute__((address_space(1)))
#define LAS __attribute__((address_space(3)))
typedef unsigned short bf16;
typedef unsigned v4u __attribute__((ext_vector_type(4)));
typedef unsigned v2u __attribute__((ext_vector_type(2)));
typedef float f32x4 __attribute__((ext_vector_type(4)));
#define LDS_WAIT() asm volatile("s_waitcnt lgkmcnt(0)" ::: "memory")
__device__ __forceinline__ unsigned f2bf(float f) { unsigned u = __builtin_bit_cast(unsigned, f); return (u + 0x7fffu + ((u >> 16) & 1u)) >> 16; }
__device__ __forceinline__ unsigned pk2(float lo, float hi) { return f2bf(lo) | (f2bf(hi) << 16); }
__device__ __forceinline__ float bf2f(unsigned short b) { return __builtin_bit_cast(float, ((unsigned)b) << 16); }
__device__ __forceinline__ float bflo(unsigned w) { return __builtin_bit_cast(float, w << 16); }
__device__ __forceinline__ float bfhi(unsigned w) { return __builtin_bit_cast(float, w & 0xffff0000u); }
__device__ __forceinline__ float sigmoidf_(float x) { return __builtin_amdgcn_rcpf(1.0f + __expf(-x)); }
__device__ __forceinline__ float siluf_(float x) { return x * __builtin_amdgcn_rcpf(1.0f + __expf(-x)); }
__device__ __forceinline__ float readlane_f(float v, int l) { return __builtin_bit_cast(float, __builtin_amdgcn_readlane(__builtin_bit_cast(int, v), l)); }
__device__ __forceinline__ float wave_sum(float v) {
#pragma unroll
    for (int o = 1; o < 64; o <<= 1) v += __shfl_xor(v, o);
    return v;
}


template <int N, int CAP> __device__ __forceinline__ void fold_step(float (&v)[CAP], int xr, bool bit) {
#pragma unroll
    for (int i = 0; i < N / 2; ++i) { const float send = bit ? v[i] : v[i + N / 2]; const float keep = bit ? v[i + N / 2] : v[i]; v[i] = keep + __shfl_xor(send, xr); }
}

#define XB_TMO      128
#define XB_XCNT(j)  (256  + 64 * (j))
#define XB_XSUB(j)  (1280 + 64 * (j))
#define XB_XGEN(j)  (2304 + 64 * (j))
#define XB_TOP      3328
#define XB_TOPGEN   3392
#define XCD_BAR_WORDS 3456
#define XB_SPIN_CAP (1u << 18)
__device__ __forceinline__ unsigned xb_ld(unsigned* p)              { return __hip_atomic_load(p, __ATOMIC_RELAXED, __HIP_MEMORY_SCOPE_AGENT); }
__device__ __forceinline__ unsigned xb_add(unsigned* p, unsigned v) { return __hip_atomic_fetch_add(p, v, __ATOMIC_RELAXED, __HIP_MEMORY_SCOPE_AGENT); }
__device__ __forceinline__ unsigned xb_xcc_id() { return (unsigned)__builtin_amdgcn_s_getreg((3 << 11) | 20) & 0xFu; }
#define XB_SPIN(cond, bar) do { unsigned _sp = 0; while (cond) { __builtin_amdgcn_s_sleep(1); \
    if ((++_sp & 255u) == 0u) { if (xb_ld(&(bar)[XB_TMO])) break; if (_sp > XB_SPIN_CAP) { atomicAdd(&(bar)[XB_TMO], 1u); break; } } } } while (0)
struct XcdBarrier { unsigned* bar; unsigned x; volatile LAS unsigned* st; };
__device__ __forceinline__ XcdBarrier xcd_barrier_post(unsigned* bar, volatile LAS unsigned* st) {
    XcdBarrier b; b.bar = bar; b.x = xb_xcc_id(); b.st = st;
    if (threadIdx.x == 0) (void)xb_add(&bar[XB_XCNT(b.x)], 1u);
    return b;
}
__device__ __forceinline__ void xcd_barrier_complete(unsigned* bar, unsigned x, unsigned& nloc, unsigned& nx) {
    const unsigned G = gridDim.x * gridDim.y * gridDim.z;
    unsigned sum, cnt, mine, sp = 0u;
    for (;;) {
        sum = 0u; cnt = 0u; mine = 0u;
#pragma unroll
        for (unsigned j = 0; j < 16; ++j) { const unsigned c = xb_ld(&bar[XB_XCNT(j)]); sum += c; cnt += (c > 0u) ? 1u : 0u; mine = (j == x) ? c : mine; }
        if (sum == G) break;
        __builtin_amdgcn_s_sleep(1);
        if ((++sp & 255u) == 0u) { if (xb_ld(&bar[XB_TMO])) break; if (sp > XB_SPIN_CAP) { atomicAdd(&bar[XB_TMO], 1u); break; } }
    }
    nloc = mine > 0u ? mine : 1u; nx = cnt > 0u ? cnt : 1u;
}
__device__ __forceinline__ void xcd_barrier(const XcdBarrier& b) {
    asm volatile("s_waitcnt vmcnt(0)" ::: "memory");
    __syncthreads();
    if (threadIdx.x == 0) {
        unsigned* bar = b.bar;
        __builtin_amdgcn_s_waitcnt(0);
        unsigned nloc = b.st[0], nx = b.st[1];
        if (nloc == 0u) { xcd_barrier_complete(bar, b.x, nloc, nx); b.st[0] = nloc; b.st[1] = nx; }
        const unsigned old = xb_add(&bar[XB_XSUB(b.x)], 1u);
        const unsigned gen = old / nloc;
        if (old + 1u == (gen + 1u) * nloc) {
            __builtin_amdgcn_fence(__ATOMIC_RELEASE, "agent");
            asm volatile("s_waitcnt vmcnt(0)" ::: "memory");
            const unsigned og = xb_add(&bar[XB_TOP], 1u);
            const unsigned tg = og / nx;
            if (og + 1u == (tg + 1u) * nx) xb_add(&bar[XB_TOPGEN], 1u);
            else XB_SPIN(xb_ld(&bar[XB_TOPGEN]) == tg, bar);
            __builtin_amdgcn_fence(__ATOMIC_ACQUIRE, "agent");
            xb_add(&bar[XB_XGEN(b.x)], 1u);
            asm volatile("s_waitcnt vmcnt(0)" ::: "memory");
        } else {
            XB_SPIN(xb_ld(&bar[XB_XGEN(b.x)]) == gen, bar);
            __builtin_amdgcn_fence(__ATOMIC_ACQUIRE, "agent");
            asm volatile("s_waitcnt vmcnt(0)" ::: "memory");
        }
    }
    __syncthreads();
}

struct Frame {
    LAS unsigned char* lds;
    volatile LAS unsigned* MISC;
    unsigned* ctl;
    int tid, lane, wave, vcu, G;
    const float *x, *c, *w_ada, *b_ada, *norm1_g, *w_in, *conv_qkv_w, *a_log, *dt_bias, *onorm_g, *w_proj_a, *conv_sc_w, *w_proj_b, *w_out,
                *norm2_g, *w_group, *b_group, *w_expert, *b_expert, *w1, *w3, *w2, *normf_g;
    float* out; unsigned char* ws;
};
__device__ __forceinline__ float mod_at(const Frame& F, int b, int idx) {
    return ((const float*)(F.ws + CTL_MODACC))[b * 6144 + idx];
}

using pg8::Unit; using pg8::cvt_pk_bf16;
__device__ __forceinline__ v4u pack8(const f32x4 a, const f32x4 b) { v4u w; w.x = cvt_pk_bf16(a[0], a[1]); w.y = cvt_pk_bf16(a[2], a[3]); w.z = cvt_pk_bf16(b[0], b[1]); w.w = cvt_pk_bf16(b[2], b[3]); return w; }
__device__ __forceinline__ void unpack8(const v4u w, f32x4& a, f32x4& b) { a = (f32x4){bflo(w.x), bfhi(w.x), bflo(w.y), bfhi(w.y)}; b = (f32x4){bflo(w.z), bfhi(w.z), bflo(w.w), bfhi(w.w)}; }

struct EpiInA {
    static constexpr bool PERM = true, AFTER_DRAIN = false;
    bf16 *QKV, *SB, *P;
    __device__ __forceinline__ void operator()(const f32x4 (&acc)[2][2][4][2], const Unit& u, int wr, int wc, int fr, int fq) const {
        const int row0 = u.pm * 256 + wr * 64 + fr;
        if (u.pn < 16) {
            bf16* base; int ldc, colt;
            if (u.pn < 12) { base = QKV; ldc = NQKV; colt = u.pn * 256; } else { base = SB; ldc = D; colt = (u.pn - 12) * 256; }
            const int col0 = colt + wc * 32 + 8 * fq;
#pragma unroll
            for (int ai = 0; ai < 2; ++ai)
#pragma unroll
                for (int m = 0; m < 4; ++m) { bf16* rowp = base + (size_t)(row0 + ai * 128 + m * 16) * ldc + col0;
#pragma unroll
                    for (int bj = 0; bj < 2; ++bj) *(v4u*)(rowp + bj * 128) = pack8(acc[ai][bj][m][0], acc[ai][bj][m][1]); }
        } else {
            const int col0 = (u.pn - 16) * 128 + wc * 32 + 8 * fq;
#pragma unroll
            for (int ai = 0; ai < 2; ++ai)
#pragma unroll
                for (int m = 0; m < 4; ++m) { bf16* rowp = P + (size_t)(row0 + ai * 128 + m * 16) * D + col0;
                    *(v4u*)rowp = pack8(acc[ai][0][m][0] * acc[ai][1][m][0], acc[ai][0][m][1] * acc[ai][1][m][1]); }
        }
    }
};
struct EpiInB {
    static constexpr bool PERM = true, AFTER_DRAIN = false;
    unsigned char* ws;
    __device__ __forceinline__ void operator()(const f32x4 (&acc)[2][2][4][2], const Unit& u, int wr, int wc, int fr, int fq) const {
        const int row0 = u.pm * 256 + wr * 64 + fr, col0 = (u.pn & 3) * 256 + wc * 32 + 8 * fq;
        const bool zt = u.pn < 4;
        bf16* base = (bf16*)(ws + (zt ? WS_OR : ((u.pn < 8) ? WS_GA : WS_GB)));
#pragma unroll
        for (int ai = 0; ai < 2; ++ai)
#pragma unroll
            for (int m = 0; m < 4; ++m) { bf16* rowp = base + (size_t)(row0 + ai * 128 + m * 16) * D + col0;
#pragma unroll
                for (int bj = 0; bj < 2; ++bj) { f32x4 a = acc[ai][bj][m][0], b = acc[ai][bj][m][1];
                    f32x4 sa, sb;
#pragma unroll
                    for (int j = 0; j < 4; ++j) { sa[j] = sigmoidf_(a[j]); sb[j] = sigmoidf_(b[j]); }
                    if (zt) { f32x4 o0, o1; unpack8(*(const v4u*)(rowp + bj * 128), o0, o1); sa = sa * a * o0; sb = sb * b * o1; }
                    *(v4u*)(rowp + bj * 128) = pack8(sa, sb); }
                __builtin_amdgcn_sched_barrier(0); }
    }
};
struct EpiPlain {
    static constexpr bool PERM = true, AFTER_DRAIN = false;
    bf16* O; int ldc;
    __device__ __forceinline__ void operator()(const f32x4 (&acc)[2][2][4][2], const Unit& u, int wr, int wc, int fr, int fq) const {
        const int row0 = u.pm * 256 + wr * 64 + fr, col0 = u.pn * 256 + wc * 32 + 8 * fq;
#pragma unroll
        for (int ai = 0; ai < 2; ++ai)
#pragma unroll
            for (int m = 0; m < 4; ++m) { bf16* rowp = O + (size_t)(row0 + ai * 128 + m * 16) * ldc + col0;
#pragma unroll
                for (int bj = 0; bj < 2; ++bj) *(v4u*)(rowp + bj * 128) = pack8(acc[ai][bj][m][0], acc[ai][bj][m][1]); }
    }
};
struct EpiMerge {
    static constexpr bool PERM = true, AFTER_DRAIN = false;
    const bf16 *GA, *GB, *YB; bf16* MG;
    __device__ __forceinline__ void operator()(const f32x4 (&acc)[2][2][4][2], const Unit& u, int wr, int wc, int fr, int fq) const {
        const int row0 = u.pm * 256 + wr * 64 + fr, col0 = u.pn * 256 + wc * 32 + 8 * fq;
#pragma unroll
        for (int ai = 0; ai < 2; ++ai)
#pragma unroll
            for (int m = 0; m < 4; ++m) { const size_t off = (size_t)(row0 + ai * 128 + m * 16) * D + col0;
#pragma unroll
                for (int bj = 0; bj < 2; ++bj) { f32x4 a0, a1, b0, b1, y0, y1;
                    unpack8(*(const v4u*)(GA + off + bj * 128), a0, a1); unpack8(*(const v4u*)(GB + off + bj * 128), b0, b1); unpack8(*(const v4u*)(YB + off + bj * 128), y0, y1);
                    *(v4u*)(MG + off + bj * 128) = pack8(a0 * acc[ai][bj][m][0] + b0 * y0, a1 * acc[ai][bj][m][1] + b1 * y1); }
                asm volatile("" ::: "memory"); }
    }
};
struct EpiX1 {
    static constexpr bool PERM = true, AFTER_DRAIN = false;
    const float* X; float* X1; const float* modacc; const float* b_ada;
    __device__ __forceinline__ void operator()(const f32x4 (&acc)[2][2][4][2], const Unit& u, int wr, int wc, int fr, int fq) const {
        const int row0 = u.pm * 256 + wr * 64 + fr, col0 = u.pn * 256 + wc * 32 + 8 * fq, b = u.pm >> 5;
        f32x4 gt[2][2];
#pragma unroll
        for (int bj = 0; bj < 2; ++bj)
#pragma unroll
            for (int n = 0; n < 2; ++n) gt[bj][n] = *(const f32x4*)(modacc + b * 6144 + 2048 + col0 + bj * 128 + 4 * n);
#pragma unroll
        for (int ai = 0; ai < 2; ++ai)
#pragma unroll
            for (int m = 0; m < 4; ++m) { const size_t off = (size_t)(row0 + ai * 128 + m * 16) * D + col0;
#pragma unroll
                for (int bj = 0; bj < 2; ++bj)
#pragma unroll
                    for (int n = 0; n < 2; ++n) { const f32x4 xv = *(const f32x4*)(X + off + bj * 128 + 4 * n);
                        *(f32x4*)(X1 + off + bj * 128 + 4 * n) = xv + gt[bj][n] * acc[ai][bj][m][n]; } }
    }
};
struct EpiHid {
    static constexpr bool PERM = true, AFTER_DRAIN = false;
    bf16* HID;
    __device__ __forceinline__ void operator()(const f32x4 (&acc)[2][2][4][2], const Unit& u, int wr, int wc, int fr, int fq) const {
        const int row0 = u.pm * 256 + wr * 64 + fr, col0 = (u.pn & 3) * 128 + wc * 32 + 8 * fq;
#pragma unroll
        for (int ai = 0; ai < 2; ++ai)
#pragma unroll
            for (int m = 0; m < 4; ++m) { f32x4 a = acc[ai][0][m][0], b = acc[ai][0][m][1];
#pragma unroll
                for (int j = 0; j < 4; ++j) { a[j] = siluf_(a[j]) * acc[ai][1][m][0][j]; b[j] = siluf_(b[j]) * acc[ai][1][m][1][j]; }
                *(v4u*)(HID + (size_t)(row0 + ai * 128 + m * 16) * DE + col0) = pack8(a, b); }
    }
};
struct EpiMoeOut {
    static constexpr bool PERM = true, AFTER_DRAIN = false;
    bf16* YBUF; const int* ROWTOK; const float* ROWW;
    __device__ __forceinline__ void operator()(const f32x4 (&acc)[2][2][4][2], const Unit& u, int wr, int wc, int fr, int fq) const {
        const int row0 = u.pm * 256 + wr * 64 + fr, col0 = (u.pn & 3) * 256 + wc * 32 + 8 * fq;
#pragma unroll
        for (int ai = 0; ai < 2; ++ai)
#pragma unroll
            for (int m = 0; m < 4; ++m) { const int r = row0 + ai * 128 + m * 16; const int tk = ROWTOK[r];
                if (tk >= 0) { const float w = ROWW[r]; bf16* rowp = YBUF + (size_t)tk * D + col0;
#pragma unroll
                    for (int bj = 0; bj < 2; ++bj) *(v4u*)(rowp + bj * 128) = pack8(acc[ai][bj][m][0] * w, acc[ai][bj][m][1] * w); } }
    }
};
struct MoeOrder {
    int n4, G, c; const volatile LAS int* tile_e;
    __device__ __forceinline__ bool next(int i, Unit& u) const { const int L = i * G + c; if (L >= n4) return false; const int rb = L >> 2; u.pm = rb; u.pn = tile_e[rb] * 4 + (L & 3); return true; }
    __device__ __forceinline__ void a_ready(const Unit&) const {}
    __device__ __forceinline__ void done(const Unit&) const {}
};

__device__ __forceinline__ void transpose_item(const float* W, int ldw, int src_col0, int k0, bf16* WT, int dst_row0, int K, LAS float* scr, int lane) {
#pragma unroll 8
    for (int i = 0; i < 32; ++i) { const int kk = 2 * i + (lane >> 5); scr[kk * 33 + (lane & 31)] = W[(size_t)(k0 + kk) * ldw + src_col0 + (lane & 31)]; }
    LDS_WAIT(); asm volatile("" ::: "memory");
    const int c = lane & 7;
#pragma unroll
    for (int j = 0; j < 4; ++j) { const int n = (lane >> 3) + 8 * j; const LAS float* s = scr + (8 * c) * 33 + n;
        v4u o; o.x = pk2(s[0 * 33], s[1 * 33]); o.y = pk2(s[2 * 33], s[3 * 33]); o.z = pk2(s[4 * 33], s[5 * 33]); o.w = pk2(s[6 * 33], s[7 * 33]);
        *(v4u*)(WT + (size_t)(dst_row0 + n) * K + k0 + 8 * c) = o; }
    LDS_WAIT(); asm volatile("" ::: "memory");
}
__device__ __forceinline__ int win_src_col(int d0) {
    if (d0 < 3072) return d0;
    if (d0 < 4096) return 4112 + (d0 - 3072);
    if (d0 < 6144) { const int j = (d0 - 4096) >> 8, r = (d0 - 4096) & 255; return (r < 128 ? 5136 + r : 6160 + (r - 128)) + 128 * j; }
    if (d0 < 7168) return 3072 + (d0 - 6144);
    if (d0 < 8192) return 7184 + (d0 - 7168);
    return 8208 + (d0 - 8192);
}

__device__ __forceinline__ void p0_prologue(Frame& F) {
    LAS float* sC = (LAS float*)(F.lds + 8 * 8448);
    for (int i = F.tid; i < 2 * D; i += 512) sC[i] = siluf_(F.c[i]);
    __syncthreads();
    const int gw = F.vcu * NWAVES + F.wave, NGW = F.G * NWAVES;
    float* modv = (float*)(F.ws + CTL_MODACC);
    LAS float* sPart = sC + 2 * D;
    for (int cg = blockIdx.x; cg < 96; cg += F.G) {
        const int col = cg * 64 + F.lane, k0 = F.wave * 128;
        float a0 = 0.f, a1 = 0.f;
#pragma unroll 16
        for (int k = 0; k < 128; ++k) { const float wv = F.w_ada[(size_t)(k0 + k) * 6144 + col]; a0 += sC[k0 + k] * wv; a1 += sC[D + k0 + k] * wv; }
        sPart[F.wave * 128 + F.lane] = a0; sPart[F.wave * 128 + 64 + F.lane] = a1;
        __syncthreads();
        if (F.wave < 2) { float t = 0.f;
#pragma unroll
            for (int q = 0; q < 8; ++q) t += sPart[q * 128 + F.wave * 64 + F.lane];
            modv[F.wave * 6144 + col] = t + F.b_ada[col]; }
        __syncthreads();
    }
    LAS float* scr = (LAS float*)(F.lds + F.wave * 8448);
    constexpr int I_IN = 288 * 16, I_SQ = 32 * 16;
    for (int it = gw; it < I_IN + 3 * I_SQ; it += NGW) {
        int r = it;
        if (r < I_IN) { const int dg = r % 288, kb = r / 288, d0 = dg * 32; bf16* dst = (d0 < 6144) ? (bf16*)(F.ws + WS_WINA) : (bf16*)(F.ws + WS_WINB);
            transpose_item(F.w_in, IN_TOTAL, win_src_col(d0), kb * 64, dst, d0 < 6144 ? d0 : d0 - 6144, D, scr, F.lane); continue; }
        r -= I_IN;
        if (r < I_SQ) { transpose_item(F.w_proj_a, D, (r % 32) * 32, (r / 32) * 64, (bf16*)(F.ws + WS_WA), (r % 32) * 32, D, scr, F.lane); continue; } r -= I_SQ;
        if (r < I_SQ) { transpose_item(F.w_proj_b, D, (r % 32) * 32, (r / 32) * 64, (bf16*)(F.ws + WS_WB), (r % 32) * 32, D, scr, F.lane); continue; } r -= I_SQ;
        transpose_item(F.w_out, D, (r % 32) * 32, (r / 32) * 64, (bf16*)(F.ws + WS_WO), (r % 32) * 32, D, scr, F.lane);
    }
}
__device__ __forceinline__ void moe_weight_item(Frame& F, int it, LAS float* scr) {
    constexpr int I13 = NE * 32 * 16;
    if (it < I13) { const int e = it / 512, r = it % 512, dg = r % 32, kb = r / 32, d0 = dg * 32, j = d0 >> 8, rr = d0 & 255;
        if (rr < 128) transpose_item(F.w1 + (size_t)e * D * DE, DE, 128 * j + (rr & 127), kb * 64, (bf16*)(F.ws + WS_W13) + (size_t)e * D * D, d0, D, scr, F.lane);
        else          transpose_item(F.w3 + (size_t)e * D * DE, DE, 128 * j + (rr & 127), kb * 64, (bf16*)(F.ws + WS_W13) + (size_t)e * D * D, d0, D, scr, F.lane);
    } else { const int r2 = it - I13, e = r2 / 256, r = r2 % 256, dg = r % 32, kb = r / 32;
        transpose_item(F.w2 + (size_t)e * DE * D, D, dg * 32, kb * 64, (bf16*)(F.ws + WS_W2) + (size_t)e * D * DE, dg * 32, DE, scr, F.lane); }
}
__device__ __forceinline__ void p_moe_weights(Frame& F) {
    LAS float* scr = (LAS float*)(F.lds + F.wave * 8448);
    constexpr int NBATCH = (NE * 32 * 16 + NE * 32 * 8) / 64;
    __syncthreads();
    for (;;) {
        if (F.tid == 0) F.MISC[3] = atomicAdd(F.ctl + CW_Q, 1u);
        __syncthreads();
        const int bt = (int)F.MISC[3];
        __syncthreads();
        if (bt >= NBATCH) break;
        for (int i = 0; i < 8; ++i) moe_weight_item(F, bt * 64 + F.wave * 8 + i, scr);
    }
}

__device__ __forceinline__ void p1_norm1(Frame& F) {
    LAS float* sBA = (LAS float*)F.lds;
    for (int i = F.tid; i < 16 * D; i += 512) { const int k = i >> 4, o = i & 15; sBA[o * D + k] = F.w_in[(size_t)k * IN_TOTAL + 4096 + o]; }
    __syncthreads();
    const int gw = blockIdx.x * NWAVES + F.wave, RPW = M / (F.G * NWAVES);
    bf16* H = (bf16*)F.out; float* BG = (float*)(F.ws + WS_BG);
    f32x4 gsc[4], gsh[4];
    { const int b = (gw * RPW) / T;
#pragma unroll
      for (int j = 0; j < 4; ++j) { const int col = 256 * j + 4 * F.lane; const f32x4 g1 = *(const f32x4*)(F.norm1_g + col);
          gsc[j] = g1 * (1.0f + *(const f32x4*)((const float*)(F.ws + CTL_MODACC) + b * 6144 + D + col)); gsh[j] = *(const f32x4*)((const float*)(F.ws + CTL_MODACC) + b * 6144 + col); } }
    for (int m = gw * RPW; m < (gw + 1) * RPW; ++m) {
        const f32x4* xr = (const f32x4*)(F.x + (size_t)m * D) + F.lane;
        f32x4 v[4]; float s = 0.f;
#pragma unroll
        for (int j = 0; j < 4; ++j) { v[j] = xr[64 * j]; s += (v[j].x * v[j].x + v[j].y * v[j].y) + (v[j].z * v[j].z + v[j].w * v[j].w); }
        const float rstd = __frsqrt_rn(wave_sum(s) * (1.f / D) + EPS);
        f32x4 hv[4];
#pragma unroll
        for (int j = 0; j < 4; ++j) { const int col = 256 * j + 4 * F.lane;
            hv[j] = v[j] * rstd * gsc[j] + gsh[j];
            *(v2u*)(H + (size_t)m * D + col) = (v2u){pk2(hv[j][0], hv[j][1]), pk2(hv[j][2], hv[j][3])};
        }
        float lg[16];
#pragma unroll
        for (int o = 0; o < 16; ++o) { float p = 0.f;
#pragma unroll
            for (int j = 0; j < 4; ++j) { const f32x4 w = *(const LAS f32x4*)(sBA + o * D + 256 * j + 4 * F.lane); p += (hv[j][0] * w[0] + hv[j][1] * w[1]) + (hv[j][2] * w[2] + hv[j][3] * w[3]); }
            lg[o] = p; if ((o & 3) == 3) __builtin_amdgcn_sched_barrier(0); }
        fold_step<16, 16>(lg, 32, (F.lane & 32) != 0); fold_step<8, 16>(lg, 16, (F.lane & 16) != 0); fold_step<4, 16>(lg, 8, (F.lane & 8) != 0); fold_step<2, 16>(lg, 4, (F.lane & 4) != 0);
        float val = lg[0]; val += __shfl_xor(val, 2); val += __shfl_xor(val, 1);
        const int oidx = ((F.lane >> 5) & 1) * 8 + ((F.lane >> 4) & 1) * 4 + ((F.lane >> 3) & 1) * 2 + ((F.lane >> 2) & 1);
        if ((F.lane & 3) == 0) {
            float r;
            if (oidx < 8) r = sigmoidf_(val);
            else { const int hh = oidx - 8; const float xx = val + F.dt_bias[hh]; const float sp = xx > 20.f ? xx : log1pf(__expf(xx)); r = -__expf(F.a_log[hh]) * sp; }
            BG[(size_t)m * 16 + oidx] = r;
        }
    }
}

__device__ __forceinline__ void p3a_ybp(Frame& F) {
    const bf16* SB = (const bf16*)(F.ws + WS_SB); const bf16* P = (const bf16*)(F.ws + WS_P); bf16* YBP = (bf16*)F.out + (size_t)M * D;
    const size_t total = (size_t)M * (D / 8);
    for (size_t i = (size_t)blockIdx.x * 512 + F.tid; i < total; i += (size_t)F.G * 512) {
        const int m = (int)(i >> 7), c8 = (int)(i & 127) * 8, t = m % T;
        f32x4 a0 = {0.f, 0.f, 0.f, 0.f}, a1 = a0;
#pragma unroll
        for (int j = 0; j < 3; ++j) { const int tt = t - 2 + j;
            if (tt >= 0) { f32x4 p0, p1; unpack8(*(const v4u*)(P + (size_t)(m - 2 + j) * D + c8), p0, p1);
                a0 += *(const f32x4*)(F.conv_sc_w + j * D + c8) * p0; a1 += *(const f32x4*)(F.conv_sc_w + j * D + c8 + 4) * p1; } }
        f32x4 s0, s1; unpack8(*(const v4u*)(SB + (size_t)m * D + c8), s0, s1);
        *(v4u*)(YBP + (size_t)m * D + c8) = pack8(s0 * a0, s1 * a1);
    }
}

__device__ __forceinline__ void p3b_chunk(Frame& F, int unit) {
    const int n = unit % NCH, bh = unit / NCH, h = bh % NH, b = bh / NH, t0 = n * CH, row0 = b * T + t0;
    LAS float* sq = (LAS float*)F.lds; LAS float* sk = sq + 64 * 129; LAS float* sv = sk + 64 * 129; LAS float* sA = sv + 64 * 129; LAS float* sT = sA + 64 * 65;
    LAS float* sgc = sT + 64 * 65; LAS float* sbeta = sgc + 64;
    const bf16* QKV = (const bf16*)(F.ws + WS_QKV); const float* BG = (const float*)(F.ws + WS_BG);
    for (int idx = F.tid; idx < 3 * 64 * 128; idx += 512) {
        const int sec = idx >> 13, r = (idx >> 7) & 63, c = idx & 127, gcol = sec * 1024 + h * 128 + c;
        float a = 0.f;
#pragma unroll
        for (int j = 0; j < 4; ++j) { const int tt = t0 + r - 3 + j; if (tt >= 0) a += F.conv_qkv_w[j * NQKV + gcol] * bf2f(QKV[(size_t)(b * T + tt) * NQKV + gcol]); }
        sq[sec * (64 * 129) + r * 129 + c] = siluf_(a);
    }
    if (F.tid < 64) { sgc[F.tid] = BG[(size_t)(row0 + F.tid) * 16 + 8 + h]; sbeta[F.tid] = BG[(size_t)(row0 + F.tid) * 16 + h]; }
    __syncthreads();
    for (int r = F.wave * 8; r < F.wave * 8 + 8; ++r) {
        const float q0 = sq[r * 129 + F.lane], q1 = sq[r * 129 + 64 + F.lane], k0 = sk[r * 129 + F.lane], k1 = sk[r * 129 + 64 + F.lane];
        const float qs = __frsqrt_rn(wave_sum(q0 * q0 + q1 * q1) + EPS) * 0.08838834764831845f, ks = __frsqrt_rn(wave_sum(k0 * k0 + k1 * k1) + EPS);
        sq[r * 129 + F.lane] = q0 * qs; sq[r * 129 + 64 + F.lane] = q1 * qs; sk[r * 129 + F.lane] = k0 * ks; sk[r * 129 + 64 + F.lane] = k1 * ks;
    }
    if (F.tid == 0) { float a = 0.f; for (int i = 0; i < 64; ++i) { a += sgc[i]; sgc[i] = a; } }
    __syncthreads();
    bf16* INo = (bf16*)(F.ws + WS_IN) + (size_t)unit * 4096;
    for (int idx = F.tid; idx < 4096; idx += 512) {
        const int i = idx >> 6, j = idx & 63; float av = 0.f, iv = 0.f;
        if (j <= i) { float dkk = 0.f, dqk = 0.f;
            for (int d = 0; d < 128; ++d) { const float kj = sk[j * 129 + d]; dkk += sk[i * 129 + d] * kj; dqk += sq[i * 129 + d] * kj; }
            const float dec = __expf(sgc[i] - sgc[j]); iv = dqk * dec; av = (j < i) ? sbeta[i] * dkk * dec : 0.f; }
        sA[i * 65 + j] = av; INo[idx] = (bf16)f2bf(iv);
    }
    __syncthreads();
    if (F.tid < 64) { const int c = F.tid;
        for (int i = 0; i < 64; ++i) { float t = 0.f;
            for (int j = 0; j < i; ++j) t -= sA[i * 65 + j] * sT[j * 65 + c];
            sT[i * 65 + c] = (i == c) ? 1.0f : ((i < c) ? 0.f : t); } }
    __syncthreads();
    bf16* UTo = (bf16*)(F.ws + WS_UT) + (size_t)unit * 8192; bf16* Wo = (bf16*)(F.ws + WS_W) + (size_t)unit * 8192;
    bf16* QDo = (bf16*)(F.ws + WS_QD) + (size_t)unit * 8192; bf16* KDTo = (bf16*)(F.ws + WS_KDT) + (size_t)unit * 8192;
    const float glast = sgc[63];
    for (int idx = F.tid; idx < 8192; idx += 512) {
        { const int dv = idx >> 6, i = idx & 63; float u = 0.f;
          for (int j = 0; j <= i; ++j) u += sT[i * 65 + j] * sbeta[j] * sv[j * 129 + dv];
          UTo[idx] = (bf16)f2bf(u);
          KDTo[idx] = (bf16)f2bf(sk[i * 129 + dv] * __expf(glast - sgc[i])); }
        { const int i = idx >> 7, dk = idx & 127; float w = 0.f;
          for (int j = 0; j <= i; ++j) w += sT[i * 65 + j] * sbeta[j] * __expf(sgc[j]) * sk[j * 129 + dk];
          Wo[idx] = (bf16)f2bf(w);
          QDo[idx] = (bf16)f2bf(sq[i * 129 + dk] * __expf(sgc[i])); }
    }
    if (F.tid == 0) ((float*)(F.ws + WS_DEC))[unit] = __expf(glast);
    __syncthreads();
}

__device__ __forceinline__ void p4_scan(Frame& F, int item) {
    const int bh = item >> 2, sl = item & 3, h = bh % NH, b = bh / NH;
    LAS float* sS = (LAS float*)F.lds;
    LAS float* sV = sS + 128 * 33;
    LAS bf16* sW = (LAS bf16*)(sV + 64 * 33);
    LAS bf16* sQ = sW + 64 * 136;
    LAS bf16* sK = sQ + 64 * 136;
    LAS bf16* sI = sK + 128 * 72;
    for (int i = F.tid; i < 128 * 33; i += 512) sS[i] = 0.f;
    bf16* OR = (bf16*)(F.ws + WS_OR); float* SSQ = (float*)(F.ws + CTL_SSQ);
    const int c = F.tid >> 3, d4 = (F.tid & 7) * 4, dk2 = F.tid >> 2, d8 = (F.tid & 3) * 8;
    for (int n = 0; n < NCH; ++n) {
        const int unit = bh * NCH + n;
        const bf16* Wg = (const bf16*)(F.ws + WS_W) + (size_t)unit * 8192; const bf16* Qg = (const bf16*)(F.ws + WS_QD) + (size_t)unit * 8192;
        const bf16* Kg = (const bf16*)(F.ws + WS_KDT) + (size_t)unit * 8192; const bf16* Ig = (const bf16*)(F.ws + WS_IN) + (size_t)unit * 4096;
        const bf16* Ug = (const bf16*)(F.ws + WS_UT) + (size_t)unit * 8192;
        __syncthreads();
        for (int i = F.tid; i < 1024; i += 512) { const int r = i >> 4, c8 = (i & 15) * 8;
            *(LAS v4u*)(sW + r * 136 + c8) = *(const v4u*)(Wg + r * 128 + c8); *(LAS v4u*)(sQ + r * 136 + c8) = *(const v4u*)(Qg + r * 128 + c8); }
        for (int i = F.tid; i < 1024; i += 512) { const int r = i >> 3, c8 = (i & 7) * 8; *(LAS v4u*)(sK + r * 72 + c8) = *(const v4u*)(Kg + r * 64 + c8); }
        { const int r = F.tid >> 3, c8 = (F.tid & 7) * 8; *(LAS v4u*)(sI + r * 72 + c8) = *(const v4u*)(Ig + r * 64 + c8); }
        const float dec = ((const float*)(F.ws + WS_DEC))[unit];
        __syncthreads();
        float pS[4] = {0.f, 0.f, 0.f, 0.f}, qS[4] = {0.f, 0.f, 0.f, 0.f};
        for (int dk = 0; dk < 128; ++dk) { const float wv = bf2f(sW[c * 136 + dk]), qv = bf2f(sQ[c * 136 + dk]);
#pragma unroll
            for (int e = 0; e < 4; ++e) { const float s = sS[dk * 33 + d4 + e]; pS[e] += wv * s; qS[e] += qv * s; } }
        float vn[4];
#pragma unroll
        for (int e = 0; e < 4; ++e) { vn[e] = bf2f(Ug[(sl * 32 + d4 + e) * 64 + c]) - pS[e]; sV[c * 33 + d4 + e] = vn[e]; }
        __syncthreads();
        float o[4] = {qS[0], qS[1], qS[2], qS[3]};
        for (int j = 0; j < 64; ++j) { const float iv = bf2f(sI[c * 72 + j]);
#pragma unroll
            for (int e = 0; e < 4; ++e) o[e] += iv * sV[j * 33 + d4 + e]; }
        const int row = b * T + n * CH + c;
        *(v2u*)(OR + (size_t)row * D + h * 128 + sl * 32 + d4) = (v2u){pk2(o[0], o[1]), pk2(o[2], o[3])};
        float ss = (o[0] * o[0] + o[1] * o[1]) + (o[2] * o[2] + o[3] * o[3]);
        ss += __shfl_xor(ss, 1); ss += __shfl_xor(ss, 2); ss += __shfl_xor(ss, 4);
        if ((F.tid & 7) == 0) atomicAdd(SSQ + (size_t)row * 8 + h, ss);
        float sn[8];
#pragma unroll
        for (int e = 0; e < 8; ++e) sn[e] = dec * sS[dk2 * 33 + d8 + e];
        for (int cc = 0; cc < 64; ++cc) { const float kv = bf2f(sK[dk2 * 72 + cc]);
#pragma unroll
            for (int e = 0; e < 8; ++e) sn[e] += kv * sV[cc * 33 + d8 + e]; }
        __syncthreads();
#pragma unroll
        for (int e = 0; e < 8; ++e) sS[dk2 * 33 + d8 + e] = sn[e];
    }
    __syncthreads();
}


typedef pg8::bf16x8 bx8;
#define MFMA16(a, b, c) __builtin_amdgcn_mfma_f32_16x16x32_bf16(a, b, c, 0, 0, 0)
__device__ __forceinline__ v2u pack4(const f32x4 a) { v2u r; r.x = cvt_pk_bf16(a[0], a[1]); r.y = cvt_pk_bf16(a[2], a[3]); return r; }
__device__ __forceinline__ void p4_scan_fast(Frame& F, int bh) {
    const int h = bh % NH, b = bh / NH, w = F.wave, l15 = F.lane & 15, lq = F.lane >> 4, ct = w >> 1, dvh = w & 1;
    LAS bf16* sST = (LAS bf16*)F.lds;
    LAS bf16* sVT = sST + 128 * 136;
    LAS float* sSS = (LAS float*)(sVT + 128 * 72);
    LAS float* sDEC = sSS + 128;
    if (F.tid < NCH) sDEC[F.tid] = ((const float*)(F.ws + WS_DEC))[bh * NCH + F.tid];
    for (int i = F.tid; i < 128 * 136 / 2; i += 512) ((LAS unsigned*)sST)[i] = 0u;
    const bf16* Wg = (const bf16*)(F.ws + WS_W) + (size_t)bh * NCH * 8192 + (16 * ct + l15) * 128 + 8 * lq;
    const bf16* Qg = (const bf16*)(F.ws + WS_QD) + (size_t)bh * NCH * 8192 + (16 * ct + l15) * 128 + 8 * lq;
    const bf16* Ig = (const bf16*)(F.ws + WS_IN) + (size_t)bh * NCH * 4096 + (16 * ct + l15) * 64 + 8 * lq;
    const bf16* Kg = (const bf16*)(F.ws + WS_KDT) + (size_t)bh * NCH * 8192 + (16 * w + l15) * 64 + 8 * lq;
    const bf16* Ug = (const bf16*)(F.ws + WS_UT) + (size_t)bh * NCH * 8192 + (16 * 4 * dvh + l15) * 64 + 16 * ct + 4 * lq;
    bf16* OR = (bf16*)(F.ws + WS_OR);
    bx8 fW[4], fQ[4], fI[2], fK[2]; v2u fU[4];
#pragma unroll
    for (int ks = 0; ks < 4; ++ks) { fW[ks] = *(const bx8*)(Wg + 32 * ks); fQ[ks] = *(const bx8*)(Qg + 32 * ks); fU[ks] = *(const v2u*)(Ug + ks * 16 * 64); }
#pragma unroll
    for (int ks = 0; ks < 2; ++ks) { fI[ks] = *(const bx8*)(Ig + 32 * ks); fK[ks] = *(const bx8*)(Kg + 32 * ks); }
    f32x4 S[8], gn[4];
#pragma unroll
    for (int t = 0; t < 8; ++t) S[t] = (f32x4){0.f, 0.f, 0.f, 0.f};
#pragma unroll
    for (int t = 0; t < 4; ++t) gn[t] = *(const f32x4*)(F.onorm_g + 16 * (4 * dvh + t) + 4 * lq);
    __syncthreads();
    for (int n = 0; n < NCH; ++n) {
        const float dec = sDEC[n];
        const int nn = (n + 1 < NCH) ? 1 : 0;
        f32x4 pS[4], qS[4];
#pragma unroll
        for (int t = 0; t < 4; ++t) { bx8 fS[4];
#pragma unroll
            for (int ks = 0; ks < 4; ++ks) fS[ks] = *(const LAS bx8*)(sST + (16 * (4 * dvh + t) + l15) * 136 + 32 * ks + 8 * lq);
            f32x4 p = {0.f, 0.f, 0.f, 0.f}, q = {0.f, 0.f, 0.f, 0.f};
#pragma unroll
            for (int ks = 0; ks < 4; ++ks) { p = MFMA16(fW[ks], fS[ks], p); q = MFMA16(fS[ks], fQ[ks], q); }
            pS[t] = p; qS[t] = q; }
#pragma unroll
        for (int t = 0; t < 4; ++t) { const f32x4 u = {bflo(fU[t].x), bfhi(fU[t].x), bflo(fU[t].y), bfhi(fU[t].y)};
            *(LAS v2u*)(sVT + (16 * (4 * dvh + t) + l15) * 72 + 16 * ct + 4 * lq) = pack4(u - pS[t]); }
        Wg += nn * 8192; Qg += nn * 8192; Ug += nn * 8192;
#pragma unroll
        for (int ks = 0; ks < 4; ++ks) { fW[ks] = *(const bx8*)(Wg + 32 * ks); fQ[ks] = *(const bx8*)(Qg + 32 * ks); fU[ks] = *(const v2u*)(Ug + ks * 16 * 64); }
        __syncthreads();
        float ss = 0.f;
#pragma unroll
        for (int t = 0; t < 4; ++t) {
#pragma unroll
            for (int ks = 0; ks < 2; ++ks) { const bx8 fV = *(const LAS bx8*)(sVT + (16 * (4 * dvh + t) + l15) * 72 + 32 * ks + 8 * lq); qS[t] = MFMA16(fV, fI[ks], qS[t]); }
            ss += (qS[t][0] * qS[t][0] + qS[t][1] * qS[t][1]) + (qS[t][2] * qS[t][2] + qS[t][3] * qS[t][3]); }
        ss += __shfl_xor(ss, 16); ss += __shfl_xor(ss, 32);
        if (lq == 0) sSS[dvh * 64 + 16 * ct + l15] = ss;
        Ig += nn * 4096;
#pragma unroll
        for (int ks = 0; ks < 2; ++ks) fI[ks] = *(const bx8*)(Ig + 32 * ks);
#pragma unroll
        for (int t = 0; t < 8; ++t) { S[t] = S[t] * dec;
#pragma unroll
            for (int ks = 0; ks < 2; ++ks) { const bx8 fV = *(const LAS bx8*)(sVT + (16 * t + l15) * 72 + 32 * ks + 8 * lq); S[t] = MFMA16(fK[ks], fV, S[t]); }
            *(LAS v2u*)(sST + (16 * t + l15) * 136 + 16 * w + 4 * lq) = pack4(S[t]); }
        Kg += nn * 8192;
#pragma unroll
        for (int ks = 0; ks < 2; ++ks) fK[ks] = *(const bx8*)(Kg + 32 * ks);
        __syncthreads();
        const float rstd = __frsqrt_rn((sSS[16 * ct + l15] + sSS[64 + 16 * ct + l15]) * (1.0f / 128.0f) + EPS);
        bf16* orow = OR + (size_t)(b * T + n * CH + 16 * ct + l15) * D + h * 128 + 16 * 4 * dvh + 4 * lq;
#pragma unroll
        for (int t = 0; t < 4; ++t) *(v2u*)(orow + 16 * t) = pack4(qS[t] * rstd * gn[t]);
    }
    __syncthreads();
}


#define MFMA_F32(a, b, c) __builtin_amdgcn_mfma_f32_16x16x4f32(a, b, c, 0, 0, 0)
__device__ __forceinline__ void solve_block(LAS float* sA, LAS float* sT, int bi, int bj, int l15, int lq) {
    f32x4 y = {0.f, 0.f, 0.f, 0.f};
    for (int km = bj; km < bi; ++km)
#pragma unroll
        for (int kb = 0; kb < 4; ++kb) y = MFMA_F32(sA[(16 * bi + l15) * 68 + 16 * km + 4 * kb + lq], sT[(16 * km + 4 * kb + lq) * 68 + 16 * bj + l15], y);
    f32x4 z = {0.f, 0.f, 0.f, 0.f};
#pragma unroll
    for (int e = 0; e < 4; ++e) z = MFMA_F32(sT[(16 * bi + l15) * 68 + 16 * bi + 4 * lq + e], y[e], z);
#pragma unroll
    for (int e = 0; e < 4; ++e) sT[(16 * bi + 4 * lq + e) * 68 + 16 * bj + l15] = -z[e];
}
__device__ __forceinline__ void p3b_loop(Frame& F) {
    const int tid = F.tid, w = F.wave, lane = F.lane, l15 = lane & 15, lq = lane >> 4;
    LAS bf16* sQ = (LAS bf16*)F.lds; LAS bf16* sK = sQ + 64 * 136; LAS bf16* sKG = sK + 64 * 136; LAS bf16* sVB = sKG + 128 * 72;
    LAS float* sA = (LAS float*)(sVB + 128 * 72); LAS float* sT = sA + 64 * 68; LAS bf16* sTb = (LAS bf16*)(sT + 64 * 68); LAS float* sgc = (LAS float*)(sTb + 64 * 72);
    const bf16* QKV = (const bf16*)(F.ws + WS_QKV); const float* BG = (const float*)(F.ws + WS_BG);
    const int rs = tid / 48, cg = tid % 48, sec = cg >> 4, c8 = (cg & 15) * 8, r0 = 8 * rs;
    const int wswz = (cg & 7);
    const int rswz = (2 * w + (l15 >> 3)) & 7;
    v4u raw[11]; f32x4 wt[4][2]; float pg = 0.f, pb = 0.f;
    int unit = blockIdx.x;
#define P3B_PREFETCH(U) do { const int n_ = (U) % NCH, bh_ = (U) / NCH, h_ = bh_ % NH, b_ = bh_ / NH, t0_ = n_ * CH; \
        pg = BG[(size_t)(b_ * T + t0_ + lane) * 16 + 8 + h_]; pb = BG[(size_t)(b_ * T + t0_ + lane) * 16 + h_]; \
        if (tid < 384) { const int gcol_ = sec * 1024 + h_ * 128 + c8; \
            _Pragma("unroll") for (int i = 0; i < 11; ++i) { const int tt = t0_ + r0 - 3 + i; raw[i] = (tt >= 0) ? *(const v4u*)(QKV + (size_t)(b_ * T + tt) * NQKV + gcol_) : (v4u){0u, 0u, 0u, 0u}; } } } while (0)
    if (unit < NUNIT) P3B_PREFETCH(unit);
    for (; unit < NUNIT; unit += F.G) {
        int zr = 0; asm volatile("" : "+v"(zr));
        const int c8z = c8 + zr, r0z = r0 + zr, l15z = l15 + zr;
        bf16* INo = (bf16*)(F.ws + WS_IN) + (size_t)unit * 4096; bf16* UTo = (bf16*)(F.ws + WS_UT) + (size_t)unit * 8192; bf16* Wo = (bf16*)(F.ws + WS_W) + (size_t)unit * 8192;
        bf16* QDo = (bf16*)(F.ws + WS_QD) + (size_t)unit * 8192; bf16* KDTo = (bf16*)(F.ws + WS_KDT) + (size_t)unit * 8192;
        float gcs = pg;
#pragma unroll
        for (int o = 1; o < 64; o <<= 1) { const float t = __shfl_up(gcs, o); if (lane >= o) gcs += t; }
        const float gl = __shfl(gcs, 63), bts = pb;
        if (w == 7) { sgc[lane] = gcs; sgc[64 + lane] = bts; if (lane == 0) ((float*)(F.ws + WS_DEC))[unit] = __expf(gl); }
        for (int i = tid; i < 64 * 68; i += 512) sT[i] = 0.f;
        if (tid < 384) {
            { const int gcol = sec * 1024 + ((unit / NCH) % NH) * 128 + c8;
#pragma unroll
              for (int j = 0; j < 4; ++j) { wt[j][0] = *(const f32x4*)(F.conv_qkv_w + j * NQKV + gcol); wt[j][1] = *(const f32x4*)(F.conv_qkv_w + j * NQKV + gcol + 4); } }
            const int wb = 8 * (rs ^ wswz) + zr;
#pragma unroll
            for (int g = 0; g < 2; ++g) {
                float gcr[4], btr[4];
#pragma unroll
                for (int r = 0; r < 4; ++r) { gcr[r] = __shfl(gcs, r0 + 4 * g + r); btr[r] = __shfl(bts, r0 + 4 * g + r); }
                f32x4 o0[4], o1[4];
#pragma unroll
                for (int r = 0; r < 4; ++r) { f32x4 a0 = {0.f, 0.f, 0.f, 0.f}, a1 = a0;
#pragma unroll
                    for (int j = 0; j < 4; ++j) { f32x4 x0, x1; unpack8(raw[4 * g + r + j], x0, x1); a0 += wt[j][0] * x0; a1 += wt[j][1] * x1; }
#pragma unroll
                    for (int e = 0; e < 4; ++e) { a0[e] = siluf_(a0[e]); a1[e] = siluf_(a1[e]); }
                    float ss = (a0[0] * a0[0] + a0[1] * a0[1]) + (a0[2] * a0[2] + a0[3] * a0[3]) + (a1[0] * a1[0] + a1[1] * a1[1]) + (a1[2] * a1[2] + a1[3] * a1[3]);
                    ss += __shfl_xor(ss, 1); ss += __shfl_xor(ss, 2); ss += __shfl_xor(ss, 4); ss += __shfl_xor(ss, 8);
                    const float sc = (sec == 2) ? 1.0f : __frsqrt_rn(ss + EPS) * (sec == 0 ? 0.08838834764831845f : 1.0f);
                    o0[r] = a0 * sc; o1[r] = a1 * sc; }
                const int rb = r0z + 4 * g;
                if (sec == 0) {
#pragma unroll
                    for (int r = 0; r < 4; ++r) { *(LAS v4u*)(sQ + (rb + r) * 136 + c8z) = pack8(o0[r], o1[r]); const float eg = __expf(gcr[r]);
                        *(v4u*)(QDo + (rb + r) * 128 + c8z) = pack8(o0[r] * eg, o1[r] * eg); }
                } else if (sec == 1) {
                    float fk[4], fd[4];
#pragma unroll
                    for (int r = 0; r < 4; ++r) { *(LAS v4u*)(sK + (rb + r) * 136 + c8z) = pack8(o0[r], o1[r]); fk[r] = btr[r] * __expf(gcr[r]); fd[r] = __expf(gl - gcr[r]); }
#pragma unroll
                    for (int e = 0; e < 4; ++e) {
                        *(LAS v2u*)(sKG + (c8z + e) * 72 + wb + 4 * g) = pack4((f32x4){o0[0][e] * fk[0], o0[1][e] * fk[1], o0[2][e] * fk[2], o0[3][e] * fk[3]});
                        *(v2u*)(KDTo + (c8z + e) * 64 + rb) = pack4((f32x4){o0[0][e] * fd[0], o0[1][e] * fd[1], o0[2][e] * fd[2], o0[3][e] * fd[3]});
                        *(LAS v2u*)(sKG + (c8z + 4 + e) * 72 + wb + 4 * g) = pack4((f32x4){o1[0][e] * fk[0], o1[1][e] * fk[1], o1[2][e] * fk[2], o1[3][e] * fk[3]});
                        *(v2u*)(KDTo + (c8z + 4 + e) * 64 + rb) = pack4((f32x4){o1[0][e] * fd[0], o1[1][e] * fd[1], o1[2][e] * fd[2], o1[3][e] * fd[3]}); }
                } else {
#pragma unroll
                    for (int e = 0; e < 4; ++e) {
                        *(LAS v2u*)(sVB + (c8z + e) * 72 + wb + 4 * g) = pack4((f32x4){o0[0][e] * btr[0], o0[1][e] * btr[1], o0[2][e] * btr[2], o0[3][e] * btr[3]});
                        *(LAS v2u*)(sVB + (c8z + 4 + e) * 72 + wb + 4 * g) = pack4((f32x4){o1[0][e] * btr[0], o1[1][e] * btr[1], o1[2][e] * btr[2], o1[3][e] * btr[3]}); }
                }
            }
        }
        __builtin_amdgcn_sched_barrier(0);
        if (unit + F.G < NUNIT) P3B_PREFETCH(unit + F.G);
        __builtin_amdgcn_sched_barrier(0);
        __syncthreads();
        {
            const int jt = w & 3, itp = w >> 2;
            bx8 ak[4];
#pragma unroll
            for (int ks = 0; ks < 4; ++ks) ak[ks] = *(const LAS bx8*)(sK + (16 * jt + l15) * 136 + 32 * ks + 8 * lq);
#pragma unroll
            for (int ii = 0; ii < 2; ++ii) { const int it = 2 * itp + ii, ci = 16 * it + l15z;
                f32x4 xk = {0.f, 0.f, 0.f, 0.f}, xq = xk;
#pragma unroll
                for (int ks = 0; ks < 4; ++ks) { const bx8 bk = *(const LAS bx8*)(sK + ci * 136 + 32 * ks + 8 * lq), bq = *(const LAS bx8*)(sQ + ci * 136 + 32 * ks + 8 * lq);
                    xk = MFMA16(ak[ks], bk, xk); xq = MFMA16(ak[ks], bq, xq); }
                const float gi = sgc[ci], bi = sgc[64 + ci];
                f32x4 av, iv;
#pragma unroll
                for (int e = 0; e < 4; ++e) { const int cj = 16 * jt + 4 * lq + e; const float dec = __expf(gi - sgc[cj]);
                    av[e] = (cj < ci) ? bi * xk[e] * dec : 0.f; iv[e] = (cj <= ci) ? xq[e] * dec : 0.f; }
                *(LAS f32x4*)(sA + ci * 68 + 16 * jt + 4 * lq) = av;
                *(v2u*)(INo + ci * 64 + 16 * jt + 4 * lq) = pack4(iv); }
        }
        __syncthreads();
        if (w == 0) {
            const int blk = lq, c = l15; float t[16];
#pragma unroll
            for (int i = 0; i < 16; ++i) { float s2 = 0.f;
#pragma unroll
                for (int jb = 0; jb < (i + 3) / 4; ++jb) { const f32x4 a4 = *(const LAS f32x4*)(sA + (16 * blk + i) * 68 + 16 * blk + 4 * jb);
#pragma unroll
                    for (int e = 0; e < 4; ++e) if (4 * jb + e < i) s2 -= a4[e] * t[4 * jb + e]; }
                t[i] = (i == c) ? 1.0f : s2;
                sT[(16 * blk + i) * 68 + 16 * blk + c] = t[i];
                if ((i & 3) == 3) __builtin_amdgcn_sched_barrier(0); }
        }
        __syncthreads();
        if (w < 3) solve_block(sA, sT, w + 1, w, l15, lq);
        __syncthreads();
        if (w < 2) solve_block(sA, sT, w + 2, w, l15, lq);
        __syncthreads();
        if (w < 1) solve_block(sA, sT, 3, 0, l15, lq);
        __syncthreads();
        { const int i = tid >> 3, j8 = (tid & 7) * 8; *(LAS v4u*)(sTb + i * 72 + j8) = pack8(*(const LAS f32x4*)(sT + i * 68 + j8), *(const LAS f32x4*)(sT + i * 68 + j8 + 4)); }
        __syncthreads();
        {
            bx8 bv[2], ag[2];
#pragma unroll
            for (int ks = 0; ks < 2; ++ks) { const int cb = 8 * ((4 * ks + lq) ^ rswz);
                bv[ks] = *(const LAS bx8*)(sVB + (16 * w + l15) * 72 + cb); ag[ks] = *(const LAS bx8*)(sKG + (16 * w + l15) * 72 + cb); }
#pragma unroll
            for (int it = 0; it < 4; ++it) { f32x4 u = {0.f, 0.f, 0.f, 0.f}, ww = u;
#pragma unroll
                for (int ks = 0; ks < 2; ++ks) { const bx8 ft = *(const LAS bx8*)(sTb + (16 * it + l15) * 72 + 32 * ks + 8 * lq); u = MFMA16(ft, bv[ks], u); ww = MFMA16(ag[ks], ft, ww); }
                *(v2u*)(UTo + (16 * w + l15z) * 64 + 16 * it + 4 * lq) = pack4(u);
                *(v2u*)(Wo + (16 * it + l15z) * 128 + 16 * w + 4 * lq) = pack4(ww); }
        }
        __syncthreads();
    }
#undef P3B_PREFETCH
}

__device__ __forceinline__ void p4a_seg(Frame& F, int seg) {
    const int w = F.wave, l15 = F.lane & 15, lq = F.lane >> 4, ct = w >> 1, ch = w & 1;
    const int bh = seg >> 4, g = seg & 15, unit0 = bh * NCH + 8 * g;
    LAS bf16* sST = (LAS bf16*)F.lds;
    LAS bf16* sVT = sST + 256 * 136;
    LAS float* sDEC = (LAS float*)(sVT + 256 * 72);
    if (F.tid < 8) sDEC[F.tid] = ((const float*)(F.ws + WS_DEC))[unit0 + F.tid];
    for (int i = F.tid; i < 256 * 136 / 2; i += 512) ((LAS unsigned*)sST)[i] = 0u;
    __syncthreads();
    if (F.tid < 128) sST[F.tid * 136 + F.tid] = (bf16)0x3F80;
    f32x4 ST[16];
#pragma unroll
    for (int t = 0; t < 16; ++t)
#pragma unroll
        for (int e = 0; e < 4; ++e) ST[t][e] = (t == w && l15 == 4 * lq + e) ? 1.0f : 0.0f;
    const bf16* Wg = (const bf16*)(F.ws + WS_W) + (size_t)unit0 * 8192 + (16 * ct + l15) * 128 + 8 * lq;
    const bf16* Kg = (const bf16*)(F.ws + WS_KDT) + (size_t)unit0 * 8192 + (16 * w + l15) * 64 + 8 * lq;
    const bf16* Ug = (const bf16*)(F.ws + WS_UT) + (size_t)unit0 * 8192 + l15 * 64 + 16 * ct + 4 * lq;
    bx8 fW[4], fK[2]; v2u fU[8];
#pragma unroll
    for (int ks = 0; ks < 4; ++ks) fW[ks] = *(const bx8*)(Wg + 32 * ks);
#pragma unroll
    for (int ks = 0; ks < 2; ++ks) fK[ks] = *(const bx8*)(Kg + 32 * ks);
#pragma unroll
    for (int t = 0; t < 8; ++t) fU[t] = ch ? *(const v2u*)(Ug + t * 16 * 64) : (v2u){0u, 0u};
    __syncthreads();
    for (int sI = 0; sI < 8; ++sI) {
        const float dec = sDEC[sI];
        const int nn = (sI < 7) ? 1 : 0;
#pragma unroll
        for (int t = 0; t < 8; ++t) { const int Tc = 8 * ch + t; f32x4 p = {0.f, 0.f, 0.f, 0.f};
#pragma unroll
            for (int ks = 0; ks < 4; ++ks) { const bx8 fS = *(const LAS bx8*)(sST + (16 * Tc + l15) * 136 + 32 * ks + 8 * lq); p = MFMA16(fW[ks], fS, p); }
            const f32x4 u = {bflo(fU[t].x), bfhi(fU[t].x), bflo(fU[t].y), bfhi(fU[t].y)};
            *(LAS v2u*)(sVT + (16 * Tc + l15) * 72 + 16 * ct + 4 * lq) = pack4(u - p); }
        Wg += nn * 8192; Ug += nn * 8192;
#pragma unroll
        for (int ks = 0; ks < 4; ++ks) fW[ks] = *(const bx8*)(Wg + 32 * ks);
#pragma unroll
        for (int t = 0; t < 8; ++t) fU[t] = ch ? *(const v2u*)(Ug + t * 16 * 64) : (v2u){0u, 0u};
        __syncthreads();
#pragma unroll
        for (int t = 0; t < 16; ++t) { ST[t] = ST[t] * dec;
#pragma unroll
            for (int ks = 0; ks < 2; ++ks) { const bx8 fV = *(const LAS bx8*)(sVT + (16 * t + l15) * 72 + 32 * ks + 8 * lq); ST[t] = MFMA16(fK[ks], fV, ST[t]); }
            *(LAS v2u*)(sST + (16 * t + l15) * 136 + 16 * w + 4 * lq) = pack4(ST[t]); }
        Kg += nn * 8192;
#pragma unroll
        for (int ks = 0; ks < 2; ++ks) fK[ks] = *(const bx8*)(Kg + 32 * ks);
        __syncthreads();
    }
    bf16* PHI = (bf16*)((unsigned char*)F.out + OUT_PHI) + (size_t)seg * 16384;
#pragma unroll
    for (int t = 0; t < 8; ++t)
#pragma unroll
        for (int e = 0; e < 4; ++e) PHI[(16 * w + 4 * lq + e) * 128 + 16 * t + l15] = (bf16)f2bf(ST[t][e]);
    f32x4* LS = (f32x4*)((unsigned char*)F.out + OUT_LSEG) + ((size_t)(seg * 8 + w) * 8) * 64 + F.lane;
#pragma unroll
    for (int t = 0; t < 8; ++t) LS[t * 64] = ST[8 + t];
}
__device__ __forceinline__ void p4b_fold(Frame& F, int item) {
    const int w = F.wave, l15 = F.lane & 15, lq = F.lane >> 4, bh = item >> 2, dvs = item & 3;
    LAS bf16* sS = (LAS bf16*)F.lds;
    for (int i = F.tid; i < 32 * 136 / 2; i += 512) ((LAS unsigned*)sS)[i] = 0u;
    const bf16* Pg = (const bf16*)((const unsigned char*)F.out + OUT_PHI) + (size_t)(bh * 16) * 16384 + (16 * w + l15) * 128 + 8 * lq;
    const f32x4* Lg = (const f32x4*)((const unsigned char*)F.out + OUT_LSEG) + ((size_t)(bh * 16 * 8 + w) * 8 + 2 * dvs) * 64 + F.lane;
    f32x4* So = (f32x4*)((unsigned char*)F.out + OUT_LSEG) + ((size_t)(bh * 16 * 8 + w) * 8 + 2 * dvs) * 64 + F.lane;
    bx8 fP[4]; f32x4 L[2];
#pragma unroll
    for (int ks = 0; ks < 4; ++ks) fP[ks] = *(const bx8*)(Pg + 32 * ks);
    L[0] = Lg[0]; L[1] = Lg[64];
    __syncthreads();
    for (int g = 0; g < 15; ++g) {
        f32x4 Sn[2];
#pragma unroll
        for (int t = 0; t < 2; ++t) { f32x4 acc = L[t];
#pragma unroll
            for (int ks = 0; ks < 4; ++ks) { const bx8 fS = *(const LAS bx8*)(sS + (16 * t + l15) * 136 + 32 * ks + 8 * lq); acc = MFMA16(fP[ks], fS, acc); }
            Sn[t] = acc; }
        const int nn = (g < 14) ? 1 : 0;
        Pg += nn * 16384; Lg += nn * 8 * 8 * 64;
#pragma unroll
        for (int ks = 0; ks < 4; ++ks) fP[ks] = *(const bx8*)(Pg + 32 * ks);
        L[0] = Lg[0]; L[1] = Lg[64];
        __syncthreads();
#pragma unroll
        for (int t = 0; t < 2; ++t) { *(LAS v2u*)(sS + (16 * t + l15) * 136 + 16 * w + 4 * lq) = pack4(Sn[t]); So[t * 64] = Sn[t]; }
        So += 8 * 8 * 64;
        __syncthreads();
    }
}
__device__ __forceinline__ void p4c_seg(Frame& F, int seg) {
    const int bh = seg >> 4, g = seg & 15, unit0 = bh * NCH + 8 * g;
    const int h = bh % NH, b = bh / NH, w = F.wave, l15 = F.lane & 15, lq = F.lane >> 4, ct = w >> 1, dvh = w & 1;
    LAS bf16* sST = (LAS bf16*)F.lds;
    LAS bf16* sVT = sST + 128 * 136;
    LAS float* sSS = (LAS float*)(sVT + 128 * 72);
    LAS float* sDEC = sSS + 128;
    if (F.tid < 8) sDEC[F.tid] = ((const float*)(F.ws + WS_DEC))[unit0 + F.tid];
    f32x4 S[8], gn[4];
    { const f32x4* Sg = (const f32x4*)((const unsigned char*)F.out + OUT_LSEG) + ((size_t)((seg - 1) * 8 + w) * 8) * 64 + F.lane;
#pragma unroll
      for (int t = 0; t < 8; ++t) { S[t] = (f32x4){0.f, 0.f, 0.f, 0.f}; if (g != 0) S[t] = Sg[t * 64];
          *(LAS v2u*)(sST + (16 * t + l15) * 136 + 16 * w + 4 * lq) = pack4(S[t]); } }
    const bf16* Wg = (const bf16*)(F.ws + WS_W) + (size_t)unit0 * 8192 + (16 * ct + l15) * 128 + 8 * lq;
    const bf16* Qg = (const bf16*)(F.ws + WS_QD) + (size_t)unit0 * 8192 + (16 * ct + l15) * 128 + 8 * lq;
    const bf16* Ig = (const bf16*)(F.ws + WS_IN) + (size_t)unit0 * 4096 + (16 * ct + l15) * 64 + 8 * lq;
    const bf16* Kg = (const bf16*)(F.ws + WS_KDT) + (size_t)unit0 * 8192 + (16 * w + l15) * 64 + 8 * lq;
    const bf16* Ug = (const bf16*)(F.ws + WS_UT) + (size_t)unit0 * 8192 + (16 * 4 * dvh + l15) * 64 + 16 * ct + 4 * lq;
    bf16* OR = (bf16*)(F.ws + WS_OR);
    bx8 fW[4], fQ[4], fI[2], fK[2]; v2u fU[4];
#pragma unroll
    for (int ks = 0; ks < 4; ++ks) { fW[ks] = *(const bx8*)(Wg + 32 * ks); fQ[ks] = *(const bx8*)(Qg + 32 * ks); fU[ks] = *(const v2u*)(Ug + ks * 16 * 64); }
#pragma unroll
    for (int ks = 0; ks < 2; ++ks) { fI[ks] = *(const bx8*)(Ig + 32 * ks); fK[ks] = *(const bx8*)(Kg + 32 * ks); }
#pragma unroll
    for (int t = 0; t < 4; ++t) gn[t] = *(const f32x4*)(F.onorm_g + 16 * (4 * dvh + t) + 4 * lq);
    __syncthreads();
    for (int sI = 0; sI < 8; ++sI) {
        const float dec = sDEC[sI];
        const int nn = (sI < 7) ? 1 : 0;
        f32x4 pS[4], qS[4];
#pragma unroll
        for (int t = 0; t < 4; ++t) { bx8 fS[4];
#pragma unroll
            for (int ks = 0; ks < 4; ++ks) fS[ks] = *(const LAS bx8*)(sST + (16 * (4 * dvh + t) + l15) * 136 + 32 * ks + 8 * lq);
            f32x4 p = {0.f, 0.f, 0.f, 0.f}, q = {0.f, 0.f, 0.f, 0.f};
#pragma unroll
            for (int ks = 0; ks < 4; ++ks) { p = MFMA16(fW[ks], fS[ks], p); q = MFMA16(fS[ks], fQ[ks], q); }
            pS[t] = p; qS[t] = q; }
#pragma unroll
        for (int t = 0; t < 4; ++t) { const f32x4 u = {bflo(fU[t].x), bfhi(fU[t].x), bflo(fU[t].y), bfhi(fU[t].y)};
            *(LAS v2u*)(sVT + (16 * (4 * dvh + t) + l15) * 72 + 16 * ct + 4 * lq) = pack4(u - pS[t]); }
        Wg += nn * 8192; Qg += nn * 8192; Ug += nn * 8192;
#pragma unroll
        for (int ks = 0; ks < 4; ++ks) { fW[ks] = *(const bx8*)(Wg + 32 * ks); fQ[ks] = *(const bx8*)(Qg + 32 * ks); fU[ks] = *(const v2u*)(Ug + ks * 16 * 64); }
        __syncthreads();
        float ss = 0.f;
#pragma unroll
        for (int t = 0; t < 4; ++t) {
#pragma unroll
            for (int ks = 0; ks < 2; ++ks) { const bx8 fV = *(const LAS bx8*)(sVT + (16 * (4 * dvh + t) + l15) * 72 + 32 * ks + 8 * lq); qS[t] = MFMA16(fV, fI[ks], qS[t]); }
            ss += (qS[t][0] * qS[t][0] + qS[t][1] * qS[t][1]) + (qS[t][2] * qS[t][2] + qS[t][3] * qS[t][3]); }
        ss += __shfl_xor(ss, 16); ss += __shfl_xor(ss, 32);
        if (lq == 0) sSS[dvh * 64 + 16 * ct + l15] = ss;
        Ig += nn * 4096;
#pragma unroll
        for (int ks = 0; ks < 2; ++ks) fI[ks] = *(const bx8*)(Ig + 32 * ks);
#pragma unroll
        for (int t = 0; t < 8; ++t) { S[t] = S[t] * dec;
#pragma unroll
            for (int ks = 0; ks < 2; ++ks) { const bx8 fV = *(const LAS bx8*)(sVT + (16 * t + l15) * 72 + 32 * ks + 8 * lq); S[t] = MFMA16(fK[ks], fV, S[t]); }
            *(LAS v2u*)(sST + (16 * t + l15) * 136 + 16 * w + 4 * lq) = pack4(S[t]); }
        Kg += nn * 8192;
#pragma unroll
        for (int ks = 0; ks < 2; ++ks) fK[ks] = *(const bx8*)(Kg + 32 * ks);
        __syncthreads();
        const float rstd = __frsqrt_rn((sSS[16 * ct + l15] + sSS[64 + 16 * ct + l15]) * (1.0f / 128.0f) + EPS);
        bf16* orow = OR + (size_t)(b * T + (8 * g + sI) * CH + 16 * ct + l15) * D + h * 128 + 16 * 4 * dvh + 4 * lq;
#pragma unroll
        for (int t = 0; t < 4; ++t) *(v2u*)(orow + 16 * t) = pack4(qS[t] * rstd * gn[t]);
    }
    __syncthreads();
}

__device__ __forceinline__ void p8_router(Frame& F) {
    const int gw = blockIdx.x * NWAVES + F.wave, RPW = M / (F.G * NWAVES);
    bf16* H2 = (bf16*)(F.ws + WS_H2); int* TOKE = (int*)(F.ws + WS_TOKE); float* TOKW = (float*)(F.ws + WS_TOKW);
    LAS float* wT = (LAS float*)F.lds;
    LAS unsigned* hist = (LAS unsigned*)(wT + 36 * 1028);
    for (int i = F.tid; i < D * NGRP; i += 512) wT[(i & 3) * 1028 + (i >> 2)] = F.w_group[i];
    for (int i = F.tid; i < D * NE; i += 512) wT[(4 + (i & 31)) * 1028 + (i >> 5)] = F.w_expert[i];
    if (F.tid < NE) hist[F.tid] = 0u;
    __syncthreads();
    f32x4 gsc[4], gsh[4];
    { const int b = (gw * RPW) / T;
#pragma unroll
      for (int j = 0; j < 4; ++j) { const int col = 256 * j + 4 * F.lane; const f32x4 g2 = *(const f32x4*)(F.norm2_g + col);
          gsc[j] = g2 * (1.0f + *(const f32x4*)((const float*)(F.ws + CTL_MODACC) + b * 6144 + 4 * D + col)); gsh[j] = *(const f32x4*)((const float*)(F.ws + CTL_MODACC) + b * 6144 + 3 * D + col); } }
    for (int m = gw * RPW; m < (gw + 1) * RPW; ++m) {
        const f32x4* xr = (const f32x4*)(F.out + (size_t)m * D) + F.lane;
        f32x4 v[4]; float s = 0.f;
#pragma unroll
        for (int j = 0; j < 4; ++j) { v[j] = xr[64 * j]; s += (v[j].x * v[j].x + v[j].y * v[j].y) + (v[j].z * v[j].z + v[j].w * v[j].w); }
        const float rstd = __frsqrt_rn(wave_sum(s) * (1.f / D) + EPS);
#pragma unroll
        for (int j = 0; j < 4; ++j) { v[j] = v[j] * rstd * gsc[j] + gsh[j];
            *(v2u*)(H2 + (size_t)m * D + 256 * j + 4 * F.lane) = (v2u){pk2(v[j][0], v[j][1]), pk2(v[j][2], v[j][3])}; }
        float gp[4];
#pragma unroll
        for (int q = 0; q < 4; ++q) { float p = 0.f;
#pragma unroll
            for (int j = 0; j < 4; ++j) { const f32x4 w = *(const LAS f32x4*)(wT + q * 1028 + 256 * j + 4 * F.lane); p += (v[j][0] * w[0] + v[j][1] * w[1]) + (v[j][2] * w[2] + v[j][3] * w[3]); }
            gp[q] = p; }
        fold_step<4, 4>(gp, 32, (F.lane & 32) != 0); fold_step<2, 4>(gp, 16, (F.lane & 16) != 0);
        float gv = gp[0]; gv += __shfl_xor(gv, 8); gv += __shfl_xor(gv, 4); gv += __shfl_xor(gv, 2); gv += __shfl_xor(gv, 1);
        float gl[4];
#pragma unroll
        for (int q = 0; q < 4; ++q) gl[q] = readlane_f(gv, 32 * (q >> 1) + 16 * (q & 1)) + F.b_group[q];
        int gs = 0; float gm = gl[0];
#pragma unroll
        for (int q = 1; q < 4; ++q) if (gl[q] > gm) { gm = gl[q]; gs = q; }
        float den = 0.f;
#pragma unroll
        for (int q = 0; q < 4; ++q) den += __expf(gl[q] - gm);
        const float pg = 1.0f / den;
        float ep[8];
#pragma unroll
        for (int q = 0; q < 8; ++q) { float p = 0.f;
#pragma unroll
            for (int j = 0; j < 4; ++j) { const f32x4 w = *(const LAS f32x4*)(wT + (4 + gs * 8 + q) * 1028 + 256 * j + 4 * F.lane); p += (v[j][0] * w[0] + v[j][1] * w[1]) + (v[j][2] * w[2] + v[j][3] * w[3]); }
            ep[q] = p; }
        fold_step<8, 8>(ep, 32, (F.lane & 32) != 0); fold_step<4, 8>(ep, 16, (F.lane & 16) != 0); fold_step<2, 8>(ep, 8, (F.lane & 8) != 0);
        float ev = ep[0]; ev += __shfl_xor(ev, 4); ev += __shfl_xor(ev, 2); ev += __shfl_xor(ev, 1);
        float el[8];
#pragma unroll
        for (int q = 0; q < 8; ++q) el[q] = readlane_f(ev, 32 * (q >> 2) + 16 * ((q >> 1) & 1) + 8 * (q & 1)) + F.b_expert[gs * 8 + q];
        int i0 = 0; float v0 = el[0];
#pragma unroll
        for (int q = 1; q < 8; ++q) if (el[q] > v0) { v0 = el[q]; i0 = q; }
        int i1 = -1; float v1 = -3.0e38f;
#pragma unroll
        for (int q = 0; q < 8; ++q) if (q != i0 && el[q] > v1) { v1 = el[q]; i1 = q; }
        const float e1 = __expf(v1 - v0), sw = 1.0f / (1.0f + e1);
        if (F.lane == 0) {
            const int ea = gs * 8 + i0, eb = gs * 8 + i1;
            TOKE[m * 2] = ea; TOKE[m * 2 + 1] = eb; TOKW[m * 2] = pg * sw; TOKW[m * 2 + 1] = pg * e1 * sw;
            __hip_atomic_fetch_add((unsigned*)(hist + ea), 1u, __ATOMIC_RELAXED, __HIP_MEMORY_SCOPE_WORKGROUP); __hip_atomic_fetch_add((unsigned*)(hist + eb), 1u, __ATOMIC_RELAXED, __HIP_MEMORY_SCOPE_WORKGROUP);
        }
    }
    __syncthreads();
    if (F.tid < NE) ((unsigned*)(F.ws + WS_WGHIST))[blockIdx.x * NE + F.tid] = hist[F.tid];
}
__device__ __forceinline__ int moe_tables(Frame& F) {
    volatile LAS int* ps = (volatile LAS int*)(F.lds + MISC_OFF + 64); volatile LAS int* te = (volatile LAS int*)(F.lds + MISC_OFF + 256);
    volatile LAS int* tot = (volatile LAS int*)(F.lds + MISC_OFF + 1024); volatile LAS int* base = (volatile LAS int*)(F.lds + MISC_OFF + 1152);
    LAS int* part = (LAS int*)(F.lds + MISC_OFF - 4096);
    const unsigned* WGH = (const unsigned*)(F.ws + WS_WGHIST);
    __syncthreads();
    { const int e = F.tid & 31, p = F.tid >> 5; int t = 0, bsum = 0;
      for (int j = p; j < F.G; j += 16) { const int v = (int)WGH[j * NE + e]; t += v; bsum += (j < (int)blockIdx.x) ? v : 0; }
      part[p * 32 + e] = t; part[512 + p * 32 + e] = bsum; }
    __syncthreads();
    if (F.tid < 32) { int t = 0, bsum = 0;
#pragma unroll
        for (int p = 0; p < 16; ++p) { t += part[p * 32 + F.tid]; bsum += part[512 + p * 32 + F.tid]; }
        tot[F.tid] = t; base[F.tid] = bsum; }
    __syncthreads();
    if (F.tid == 0) { int a = 0;
        for (int e = 0; e < NE; ++e) { const int cnt = tot[e]; ps[e] = a; const int nb = (cnt + 255) >> 8;
            for (int r = 0; r < nb; ++r) te[(a >> 8) + r] = e; a += nb << 8; }
        ps[32] = a; }
    __syncthreads();
    return ps[32] >> 8;
}
__device__ __forceinline__ void p9_gather(Frame& F) {
    moe_tables(F);
    volatile LAS int* ps = (volatile LAS int*)(F.lds + MISC_OFF + 64); volatile LAS int* tot = (volatile LAS int*)(F.lds + MISC_OFF + 1024); volatile LAS int* base = (volatile LAS int*)(F.lds + MISC_OFF + 1152);
    LAS unsigned* lcur = (LAS unsigned*)F.lds;
    if (F.tid < NE) lcur[F.tid] = 0u;
    __syncthreads();
    const int gw = blockIdx.x * NWAVES + F.wave, RPW = M / (F.G * NWAVES);
    int* ROWTOK = (int*)(F.ws + WS_ROWTOK); float* ROWW = (float*)(F.ws + WS_ROWW);
    const int* TOKE = (const int*)(F.ws + WS_TOKE); const float* TOKW = (const float*)(F.ws + WS_TOKW);
    const bf16* H2 = (const bf16*)(F.ws + WS_H2); bf16* XS = (bf16*)(F.ws + WS_XS);
    for (int e = blockIdx.x; e < NE; e += F.G) for (int r = ps[e] + tot[e] + F.tid; r < ps[e + 1]; r += 512) ROWTOK[r] = -1;
    for (int m = gw * RPW; m < (gw + 1) * RPW; ++m) {
        int pos = 0;
        if (F.lane < 2) { const int e = TOKE[m * 2 + F.lane]; pos = ps[e] + base[e] + (int)__hip_atomic_fetch_add((unsigned*)(lcur + e), 1u, __ATOMIC_RELAXED, __HIP_MEMORY_SCOPE_WORKGROUP); ROWTOK[pos] = m * 2 + F.lane; ROWW[pos] = TOKW[m * 2 + F.lane]; }
        const int p0 = __shfl(pos, 0), p1 = __shfl(pos, 1);
        const v4u a = *((const v4u*)(H2 + (size_t)m * D) + F.lane), bb = *((const v4u*)(H2 + (size_t)m * D) + 64 + F.lane);
        *((v4u*)(XS + (size_t)p0 * D) + F.lane) = a; *((v4u*)(XS + (size_t)p0 * D) + 64 + F.lane) = bb;
        *((v4u*)(XS + (size_t)p1 * D) + F.lane) = a; *((v4u*)(XS + (size_t)p1 * D) + 64 + F.lane) = bb;
    }
}
__device__ __forceinline__ void p12_final(Frame& F) {
    const int gw = blockIdx.x * NWAVES + F.wave, RPW = M / (F.G * NWAVES);
    const bf16* YBUF = (const bf16*)(F.ws + WS_YBUF);
    f32x4 gt[4], gf[4];
    { const int b = (gw * RPW) / T;
#pragma unroll
      for (int j = 0; j < 4; ++j) { gt[j] = *(const f32x4*)((const float*)(F.ws + CTL_MODACC) + b * 6144 + 5 * D + 256 * j + 4 * F.lane); gf[j] = *(const f32x4*)(F.normf_g + 256 * j + 4 * F.lane); } }
    for (int m = gw * RPW; m < (gw + 1) * RPW; ++m) {
        f32x4* xr = (f32x4*)(F.out + (size_t)m * D) + F.lane;
        f32x4 v[4]; float s = 0.f;
#pragma unroll
        for (int j = 0; j < 4; ++j) { const int col = 256 * j + 4 * F.lane; v[j] = xr[64 * j];
            const v2u y0 = *(const v2u*)(YBUF + (size_t)(2 * m) * D + col), y1 = *(const v2u*)(YBUF + (size_t)(2 * m + 1) * D + col);
            const f32x4 ys = {bflo(y0.x) + bflo(y1.x), bfhi(y0.x) + bfhi(y1.x), bflo(y0.y) + bflo(y1.y), bfhi(y0.y) + bfhi(y1.y)};
            v[j] += gt[j] * ys;
            s += (v[j].x * v[j].x + v[j].y * v[j].y) + (v[j].z * v[j].z + v[j].w * v[j].w); }
        const float rstd = __frsqrt_rn(wave_sum(s) * (1.f / D) + EPS);
#pragma unroll
        for (int j = 0; j < 4; ++j) xr[64 * j] = v[j] * rstd * gf[j];
    }
}

constexpr int NPH = 16;
struct Args { const float* in[23]; float* out; unsigned char* ws; int ph_lo, ph_hi; };
__global__ void __launch_bounds__(NWAVES * 64, 2) fwd(Args args) {
    extern __shared__ __attribute__((aligned(16))) unsigned char lds[];
    Frame F;
    F.lds = (LAS unsigned char*)lds; F.MISC = (volatile LAS unsigned*)(F.lds + MISC_OFF);
    F.tid = threadIdx.x; F.lane = F.tid & 63; F.wave = __builtin_amdgcn_readfirstlane(F.tid >> 6);
    F.G = gridDim.x; { const int bx = blockIdx.x; F.vcu = (F.G % 8 == 0) ? (bx % 8) * (F.G / 8) + bx / 8 : bx; }
    F.ws = args.ws; F.out = args.out; F.ctl = (unsigned*)(args.ws + WS_CTL);
    F.x = args.in[0]; F.c = args.in[1]; F.w_ada = args.in[2]; F.b_ada = args.in[3]; F.norm1_g = args.in[4]; F.w_in = args.in[5]; F.conv_qkv_w = args.in[6];
    F.a_log = args.in[7]; F.dt_bias = args.in[8]; F.onorm_g = args.in[9]; F.w_proj_a = args.in[10]; F.conv_sc_w = args.in[11]; F.w_proj_b = args.in[12]; F.w_out = args.in[13];
    F.norm2_g = args.in[14]; F.w_group = args.in[15]; F.b_group = args.in[16]; F.w_expert = args.in[17]; F.b_expert = args.in[18]; F.w1 = args.in[19]; F.w3 = args.in[20];
    F.w2 = args.in[21]; F.normf_g = args.in[22];
    if (F.tid < 4) F.MISC[F.tid] = 0u;
    __syncthreads();
    const int lo = args.ph_lo, hi = args.ph_hi;
    const bool fused = (hi - lo) > 1;
    XcdBarrier bar; bar.bar = F.ctl + CW_BAR; bar.x = 0; bar.st = F.MISC;
    if (fused) bar = xcd_barrier_post(F.ctl + CW_BAR, F.MISC);
#ifndef PH_MASK
#define PH_MASK 0xFFFFFFFFu
#endif
#define IN(k) (((PH_MASK >> (k)) & 1) && lo <= (k) && (k) < hi)
#define SEAM(k) do { if (IN(k) && IN((k) + 1)) xcd_barrier(bar); } while (0)
    bf16* H = (bf16*)F.out; bf16* YBP = (bf16*)F.out + (size_t)M * D;

    if (IN(0)) { p0_prologue(F); } SEAM(0);
    if (IN(1)) { p1_norm1(F); } SEAM(1);
    if (IN(2)) {
        pg8::Gemm g{H, (const bf16*)(F.ws + WS_WINA), M, 6144, D}; pg8::StaticOrder S; S.init(M, 6144, F.G, (int)blockIdx.x);
        EpiInA E{(bf16*)(F.ws + WS_QKV), (bf16*)(F.ws + WS_SB), (bf16*)(F.ws + WS_P)};
        pg8::gemm_phase<EpiInA, pg8::StaticOrder, true, true>(F.lds, g, S, E);
    } SEAM(2);
    if (IN(3)) { p3a_ybp(F); p3b_loop(F); } SEAM(3);
    if (IN(4)) {
        pg8::Gemm g{YBP, (const bf16*)(F.ws + WS_WB), M, D, D}; pg8::StaticOrder S; S.init(M, D, F.G, (int)blockIdx.x);
        EpiPlain E{(bf16*)(F.ws + WS_YB), D};
        pg8::gemm_phase<EpiPlain, pg8::StaticOrder, true, true>(F.lds, g, S, E);
    } SEAM(4);
    if (IN(5)) { for (int it = blockIdx.x; it < NB * NH * 16; it += F.G) p4a_seg(F, it); } SEAM(5);
    if (IN(6)) { for (int it = blockIdx.x; it < NB * NH * 4; it += F.G) p4b_fold(F, it); p_moe_weights(F); } SEAM(6);
    if (IN(7)) { for (int it = blockIdx.x; it < NB * NH * 16; it += F.G) p4c_seg(F, it); } SEAM(7);
    if (IN(8)) {
        pg8::Gemm g{H, (const bf16*)(F.ws + WS_WINB), M, 3072, D}; pg8::StaticOrder S; S.init(M, 3072, F.G, (int)blockIdx.x);
        EpiInB E{F.ws};
        pg8::gemm_phase<EpiInB, pg8::StaticOrder, true, true>(F.lds, g, S, E);
    } SEAM(8);
    if (IN(9)) {
        pg8::Gemm g{(const bf16*)(F.ws + WS_OR), (const bf16*)(F.ws + WS_WA), M, D, D}; pg8::StaticOrder S; S.init(M, D, F.G, (int)blockIdx.x);
        EpiMerge E{(const bf16*)(F.ws + WS_GA), (const bf16*)(F.ws + WS_GB), (const bf16*)(F.ws + WS_YB), (bf16*)(F.ws + WS_GA)};
        pg8::gemm_phase<EpiMerge, pg8::StaticOrder, true, true>(F.lds, g, S, E);
    } SEAM(9);
    if (IN(10)) {
        pg8::Gemm g{(const bf16*)(F.ws + WS_GA), (const bf16*)(F.ws + WS_WO), M, D, D}; pg8::StaticOrder S; S.init(M, D, F.G, (int)blockIdx.x);
        EpiX1 E{F.x, F.out, (const float*)(F.ws + CTL_MODACC), F.b_ada};
        pg8::gemm_phase<EpiX1, pg8::StaticOrder, true, true>(F.lds, g, S, E);
    } SEAM(10);
    if (IN(11)) { p8_router(F); } SEAM(11);
    if (IN(12)) { p9_gather(F); } SEAM(12);
    if (IN(13)) {
        const int nt = moe_tables(F);
        pg8::Gemm g{(const bf16*)(F.ws + WS_XS), (const bf16*)(F.ws + WS_W13), MOE_CAP, NE * D, D};
        MoeOrder S{nt * 4, F.G, (int)blockIdx.x, (const volatile LAS int*)(F.lds + MISC_OFF + 256)};
        EpiHid E{(bf16*)(F.ws + WS_HID)};
        pg8::gemm_phase<EpiHid, MoeOrder, true, true>(F.lds, g, S, E);
    } SEAM(13);
    if (IN(14)) {
        const int nt = moe_tables(F);
        pg8::Gemm g{(const bf16*)(F.ws + WS_HID), (const bf16*)(F.ws + WS_W2), MOE_CAP, NE * D, DE};
        MoeOrder S{nt * 4, F.G, (int)blockIdx.x, (const volatile LAS int*)(F.lds + MISC_OFF + 256)};
        EpiMoeOut E{(bf16*)(F.ws + WS_YBUF), (const int*)(F.ws + WS_ROWTOK), (const float*)(F.ws + WS_ROWW)};
        pg8::gemm_phase<EpiMoeOut, MoeOrder, true, true>(F.lds, g, S, E);
    } SEAM(14);
    if (IN(15)) { p12_final(F); }
#undef IN
#undef SEAM
}

extern "C" void kernel_launch(void* const* d_in, const int* in_sizes, int n_in, void* d_out, int out_size, void* d_ws, size_t ws_size, hipStream_t stream) {
    static int grid = 0;
    if (grid == 0) {
        if (n_in != 23 || out_size != M * D || ws_size < WS_END) { fprintf(stderr, "kernel_launch: unexpected problem (n_in %d, out %d, ws %zu)\n", n_in, out_size, ws_size); grid = -1; return; }
        int dev = 0, cus = 0, per_cu = 0;
        if (hipGetDevice(&dev) != hipSuccess || hipDeviceGetAttribute(&cus, hipDeviceAttributeMultiprocessorCount, dev) != hipSuccess) { grid = -1; return; }
        if (hipFuncSetAttribute((const void*)fwd, hipFuncAttributeMaxDynamicSharedMemorySize, LDS_BYTES) != hipSuccess) { fprintf(stderr, "kernel_launch: hipFuncSetAttribute failed\n"); grid = -1; return; }
        if (hipOccupancyMaxActiveBlocksPerMultiprocessor(&per_cu, (const void*)fwd, NWAVES * 64, LDS_BYTES) != hipSuccess || per_cu < 1) { fprintf(stderr, "kernel_launch: occupancy query says %d\n", per_cu); }
        (void)hipGetLastError();
        grid = cus;
        if (M % (grid * NWAVES) != 0 || grid < 64) { fprintf(stderr, "kernel_launch: unsupported CU count %d\n", cus); grid = -1; return; }
    }
    if (grid < 0) return;
    (void)hipMemsetAsync((char*)d_ws + WS_CTL, 0, CTL_ZERO_BYTES, stream);
    Args a{};
    for (int i = 0; i < 23; ++i) a.in[i] = (const float*)d_in[i];
    a.out = (float*)d_out; a.ws = (unsigned char*)d_ws;
#ifndef MK_FUSED
#define MK_FUSED 1
#endif
#ifdef PROBE_DUP
    { const int cuts[4] = {0, PROBE_DUP + 1, PROBE_DUP, NPH}; const int ends[3] = {PROBE_DUP + 1, PROBE_DUP + 1, NPH};
      for (int li = 0; li < 3; ++li) { a.ph_lo = (li == 0) ? 0 : (li == 1 ? PROBE_DUP : PROBE_DUP + 1); a.ph_hi = ends[li]; (void)cuts;
          hipMemsetAsync((char*)d_ws + WS_CTL + CW_BAR * 4, 0, XCD_BAR_WORDS * 4, stream);
          if (a.ph_lo < a.ph_hi) hipLaunchKernelGGL(fwd, dim3(grid), dim3(NWAVES * 64), LDS_BYTES, stream, a); } return; }
#endif
    if (MK_FUSED) { a.ph_lo = 0; a.ph_hi = NPH; hipLaunchKernelGGL(fwd, dim3(grid), dim3(NWAVES * 64), LDS_BYTES, stream, a); }
    else for (int p = 0; p < NPH; ++p) { a.ph_lo = p; a.ph_hi = p + 1; hipLaunchKernelGGL(fwd, dim3(grid), dim3(NWAVES * 64), LDS_BYTES, stream, a); }
}
```

```cpp
#include <hip/hip_runtime.h>
#include <cstdio>
#include <cstdint>
namespace pg8 {
#define PG8_LAS __attribute__((address_space(3)))
typedef unsigned short bf16_t;
typedef short bf16x8 __attribute__((ext_vector_type(8)));
typedef float f32x4 __attribute__((ext_vector_type(4)));
typedef unsigned u32x4 __attribute__((ext_vector_type(4)));
constexpr int BM = 256, BK = 64, HALF = 128, HTB = HALF * BK * 2  , STAGE_BYTES = 8 * HTB, NXCD = 8, WGM = 8;

__host__ __device__ __forceinline__ int lds_byte(int r, int c) { const int st = (r >> 4) * 2 + (c >> 5), rr = r & 15, cc = c & 31, ob = rr * 64 + cc * 2; return st * 1024 + (ob ^ (((ob >> 9) & 1) << 5)); }
__host__ __device__ __forceinline__ void stage_rc(int b, int& R, int& C) { const int st = b / 1024, sb = b % 1024, swz = sb ^ (((sb >> 9) & 1) << 5); R = (st >> 1) * 16 + swz / 64; C = (st & 1) * 32 + (swz % 64) / 2; }
__host__ __device__ __forceinline__ int perm32(int rho) { const int n = rho >> 4, i = rho & 15; return 8 * (i >> 2) + 4 * n + (i & 3); }

struct Unit { int pm, pn; };
struct Gemm { const bf16_t* A; const bf16_t* Bt; int M, N, K; };

struct StaticOrder {
    int nM, nN, nwg, G, c;
    __host__ __device__ void init(int M, int N, int G_, int c_) { nM = M / BM; nN = N / BM; nwg = nM * nN; G = G_; c = c_; }
    __host__ __device__ bool next(int i, Unit& u) const {
        const long L = (long)i * G + c; if (L >= nwg) return false;
        int wgid = (int)L; { const int q = nwg / NXCD, r = nwg % NXCD, xcd = wgid % NXCD, off = wgid / NXCD; wgid = (xcd < r ? xcd * (q + 1) : r * (q + 1) + (xcd - r) * q) + off; }
        const int nig = WGM * nN, gid = wgid / nig, fm = gid * WGM, gsz = (nM - fm) < WGM ? (nM - fm) : WGM;
        u.pm = fm + ((wgid % nig) % gsz); u.pn = (wgid % nig) / gsz; return true;
    }
    __device__ __forceinline__ void a_ready(const Unit&) const {}
    __device__ __forceinline__ void done(const Unit&) const {}
};

typedef float f32x2_cv __attribute__((ext_vector_type(2)));
typedef __bf16 bf16x2_cv __attribute__((ext_vector_type(2)));
__device__ __forceinline__ unsigned cvt_pk_bf16(float lo, float hi) { const f32x2_cv v = {lo, hi}; return __builtin_bit_cast(unsigned, __builtin_convertvector(v, bf16x2_cv)); }
template <class Epi, class Sched, bool ALIGN_EPI = false, bool SP2 = false>
__device__ __forceinline__ void gemm_phase(PG8_LAS unsigned char* lds, const Gemm g, const Sched& S, const Epi& E) {
    const int tid = threadIdx.x, wid = __builtin_amdgcn_readfirstlane(tid >> 6), lane = tid & 63, wr = wid >> 2, wc = wid & 3, fr = lane & 15, fq = lane >> 4;
    const int K = g.K, nt = K / BK;
    unsigned voffA[2], voffB[2];
#pragma unroll
    for (int i = 0; i < 2; ++i) { int R, C; stage_rc(tid * 16 + i * 8192, R, C); const int Rb = Epi::PERM ? ((R & ~31) + perm32(R & 31)) : R;
        voffA[i] = (unsigned)(R * K + C) * 2u; voffB[i] = (unsigned)(Rb * K + C) * 2u; }
    const size_t kstep = (size_t)(BK * 2);
    const size_t hstep = (size_t)HALF * K * 2;
    const size_t tstep = 2 * hstep;
    const unsigned ldsw = (unsigned)wid * 1024u;
    const int aoff = lds_byte(wr * 64 + fr, fq * 8), boff = lds_byte(wc * 32 + fr, fq * 8);
#define PG8_SA(b, h) (((b) * 2 + (h)) * HTB)
#define PG8_SB(b, h) ((4 + (b) * 2 + (h)) * HTB)
#define PG8_STAGE(bufoff, gbase, voff) do { _Pragma("unroll") for (int _i = 0; _i < 2; ++_i) \
        __builtin_amdgcn_global_load_lds((const unsigned*)((const char*)(gbase) + (voff)[_i]), (PG8_LAS unsigned*)(lds + (bufoff) + ldsw + _i * 8192), 16, 0, 0); } while (0)
#define PG8_LDA(dst, b, h) do { _Pragma("unroll") for (int m = 0; m < 4; ++m) _Pragma("unroll") for (int k = 0; k < 2; ++k) dst[m][k] = *(const PG8_LAS bf16x8*)(lds + PG8_SA(b, h) + aoff + m * 2048 + k * 1024); } while (0)
#define PG8_LDB(dst, b, h) do { _Pragma("unroll") for (int n = 0; n < 2; ++n) _Pragma("unroll") for (int k = 0; k < 2; ++k) dst[n][k] = *(const PG8_LAS bf16x8*)(lds + PG8_SB(b, h) + boff + n * 2048 + k * 1024); } while (0)
#define PG8_MMA(ai, bj, At, Bt) do { __builtin_amdgcn_s_setprio(1); _Pragma("unroll") for (int m = 0; m < 4; ++m) _Pragma("unroll") for (int n = 0; n < 2; ++n) _Pragma("unroll") for (int k = 0; k < 2; ++k) \
        acc[ai][bj][m][n] = __builtin_amdgcn_mfma_f32_16x16x32_bf16(Bt[n][k], At[m][k], acc[ai][bj][m][n], 0, 0, 0); __builtin_amdgcn_s_setprio(0); } while (0)
#define PG8_WAIT_V(n) asm volatile("s_waitcnt vmcnt(" #n ")" ::: "memory")
#define PG8_WAIT_L(n) asm volatile("s_waitcnt lgkmcnt(" #n ")" ::: "memory")
#define PG8_BAR __builtin_amdgcn_s_barrier()
#define PG8_SCHED __builtin_amdgcn_sched_barrier(0)
    Unit cur, nxt; int ui = 0;
    if (!S.next(0, cur)) return;
    f32x4 acc[2][2][4][2];
#pragma unroll
    for (int a = 0; a < 2; ++a)
#pragma unroll
        for (int b = 0; b < 2; ++b)
#pragma unroll
            for (int m = 0; m < 4; ++m)
#pragma unroll
                for (int n = 0; n < 2; ++n) acc[a][b][m][n] = (f32x4){0.f, 0.f, 0.f, 0.f};
    bf16x8 At[4][2], B0[2][2], B1[2][2];
    const char* cA = (const char*)g.A + (size_t)cur.pm * tstep; const char* cB = (const char*)g.Bt + (size_t)cur.pn * tstep;
    S.a_ready(cur);
    if constexpr (SP2) {
        PG8_STAGE(PG8_SB(0, 0), cB, voffB); PG8_STAGE(PG8_SB(0, 1), cB + hstep, voffB); PG8_STAGE(PG8_SA(0, 0), cA, voffA); PG8_STAGE(PG8_SA(0, 1), cA + hstep, voffA);
        if (wr == 1) PG8_BAR;
        PG8_WAIT_V(2); PG8_BAR;
        PG8_STAGE(PG8_SB(1, 0), cB + kstep, voffB); PG8_STAGE(PG8_SA(1, 0), cA + kstep, voffA); PG8_STAGE(PG8_SB(1, 1), cB + hstep + kstep, voffB);
        PG8_WAIT_V(6); PG8_BAR;
    } else {
        PG8_STAGE(PG8_SB(0, 0), cB, voffB); PG8_STAGE(PG8_SA(0, 0), cA, voffA); PG8_STAGE(PG8_SB(0, 1), cB + hstep, voffB); PG8_STAGE(PG8_SA(0, 1), cA + hstep, voffA);
        if (wr == 1) PG8_BAR;
        PG8_WAIT_V(4); PG8_BAR;
        PG8_STAGE(PG8_SB(1, 0), cB + kstep, voffB); PG8_STAGE(PG8_SA(1, 0), cA + kstep, voffA); PG8_STAGE(PG8_SB(1, 1), cB + hstep + kstep, voffB);
        PG8_WAIT_V(6); PG8_BAR;
    }
    for (;;) {
        const bool has_next = S.next(ui + 1, nxt);
        const char* nA = has_next ? (const char*)g.A + (size_t)nxt.pm * tstep : cA; const char* nB = has_next ? (const char*)g.Bt + (size_t)nxt.pn * tstep : cB;
        for (int t = 0; t < nt; t += 2) {
            const bool last = (t == nt - 2);
            const char* a1 = cA + (size_t)(t + 1) * kstep;
            const char* a2 = last ? nA : cA + (size_t)(t + 2) * kstep; const char* b2 = last ? nB : cB + (size_t)(t + 2) * kstep;
            const char* a3 = a2 + kstep; const char* b3 = b2 + kstep;
            if (last && has_next) S.a_ready(nxt);
            if constexpr (SP2) {
            PG8_LDB(B0, 0, 0); PG8_LDB(B1, 0, 1); PG8_SCHED; PG8_LDA(At, 0, 0); PG8_STAGE(PG8_SA(1, 1), a1 + hstep, voffA);
            PG8_WAIT_V(8); PG8_WAIT_L(0); PG8_BAR; PG8_MMA(0, 0, At, B0); PG8_MMA(0, 1, At, B1); PG8_BAR; PG8_SCHED;
            PG8_LDA(At, 0, 1); PG8_STAGE(PG8_SB(0, 0), b2, voffB); PG8_STAGE(PG8_SB(0, 1), b2 + hstep, voffB); PG8_STAGE(PG8_SA(0, 0), a2, voffA);
            PG8_WAIT_V(8); PG8_WAIT_L(0); PG8_BAR; PG8_MMA(1, 0, At, B0); PG8_MMA(1, 1, At, B1); PG8_BAR; PG8_SCHED;
            PG8_LDB(B0, 1, 0); PG8_LDB(B1, 1, 1); PG8_SCHED; PG8_LDA(At, 1, 0); PG8_STAGE(PG8_SA(0, 1), a2 + hstep, voffA);
            PG8_WAIT_V(8); PG8_WAIT_L(0); PG8_BAR; PG8_MMA(0, 0, At, B0); PG8_MMA(0, 1, At, B1); PG8_BAR; PG8_SCHED;
            PG8_LDA(At, 1, 1); PG8_STAGE(PG8_SB(1, 0), b3, voffB); PG8_STAGE(PG8_SB(1, 1), b3 + hstep, voffB); PG8_STAGE(PG8_SA(1, 0), a3, voffA);
            PG8_WAIT_V(8); PG8_WAIT_L(0); PG8_BAR; PG8_MMA(1, 0, At, B0); PG8_MMA(1, 1, At, B1); PG8_BAR; PG8_SCHED;
            } else {
            PG8_LDB(B0, 0, 0); PG8_SCHED; PG8_LDA(At, 0, 0); PG8_STAGE(PG8_SA(1, 1), a1 + hstep, voffA);
            PG8_WAIT_L(8); PG8_BAR; PG8_WAIT_L(0); PG8_MMA(0, 0, At, B0); PG8_BAR; PG8_SCHED;
            PG8_LDB(B1, 0, 1); PG8_STAGE(PG8_SB(0, 0), b2, voffB);
            PG8_BAR; PG8_WAIT_L(0); PG8_MMA(0, 1, At, B1); PG8_BAR;
            PG8_LDA(At, 0, 1); PG8_STAGE(PG8_SA(0, 0), a2, voffA);
            PG8_BAR; PG8_WAIT_L(0); PG8_MMA(1, 0, At, B0); PG8_BAR; PG8_SCHED;
            PG8_STAGE(PG8_SB(0, 1), b2 + hstep, voffB);
            PG8_WAIT_V(6); PG8_BAR; PG8_MMA(1, 1, At, B1); PG8_BAR;
            PG8_LDB(B0, 1, 0); PG8_SCHED; PG8_LDA(At, 1, 0); PG8_STAGE(PG8_SA(0, 1), a2 + hstep, voffA);
            PG8_WAIT_L(8); PG8_BAR; PG8_WAIT_L(0); PG8_MMA(0, 0, At, B0); PG8_BAR; PG8_SCHED;
            PG8_LDB(B1, 1, 1); PG8_STAGE(PG8_SB(1, 0), b3, voffB);
            PG8_BAR; PG8_WAIT_L(0); PG8_MMA(0, 1, At, B1); PG8_BAR;
            PG8_LDA(At, 1, 1); PG8_STAGE(PG8_SA(1, 0), a3, voffA);
            PG8_BAR; PG8_WAIT_L(0); PG8_MMA(1, 0, At, B0); PG8_BAR; PG8_SCHED;
            PG8_STAGE(PG8_SB(1, 1), b3 + hstep, voffB);
            PG8_WAIT_V(6); PG8_BAR; PG8_MMA(1, 1, At, B1); PG8_BAR;
            }
        }
        if constexpr (ALIGN_EPI) { if (wr == 0) PG8_BAR; }
        if constexpr (!Epi::AFTER_DRAIN) { E(acc, cur, wr, wc, fr, fq); S.done(cur); }
        if (!has_next) break;
#pragma unroll
        for (int a = 0; a < 2; ++a)
#pragma unroll
            for (int b = 0; b < 2; ++b)
#pragma unroll
                for (int m = 0; m < 4; ++m)
#pragma unroll
                    for (int n = 0; n < 2; ++n) acc[a][b][m][n] = (f32x4){0.f, 0.f, 0.f, 0.f};
        cur = nxt; cA = nA; cB = nB; ++ui;
        if constexpr (ALIGN_EPI) { if (wr == 1) PG8_BAR; }
    }
    PG8_WAIT_V(0);
    if constexpr (!ALIGN_EPI) { if (wr == 0) PG8_BAR; }
    PG8_BAR;
    if constexpr (Epi::AFTER_DRAIN) { E.fused(acc, cur, wr, wc, fr, fq, lds, wid, lane); S.done(cur); }
#undef PG8_SA
#undef PG8_SB
#undef PG8_STAGE
#undef PG8_LDA
#undef PG8_LDB
#undef PG8_MMA
#undef PG8_WAIT_V
#undef PG8_WAIT_L
#undef PG8_BAR
#undef PG8_SCHED
}
}

constexpr int NB = 2, T = 8192, D = 1024, M = NB * T;
constexpr int NH = 8, DK = 128, DV = 128, CH = 64, NCH = T / CH;
constexpr int NQKV = 3072, IN_TOTAL = 9232;
constexpr int NE = 32, EPG = 8, NGRP = 4, DE = 512;
constexpr int NUNIT = NB * NH * NCH;
constexpr float EPS = 1e-6f;
constexpr int MOE_CAP = 40960;
constexpr int NWAVES = 8;

constexpr size_t MiB = 1u << 20;
constexpr size_t WS_CTL = 0, CTL_ZERO_BYTES = 1 * MiB;
constexpr size_t WS_BG = 1 * MiB;
constexpr size_t WS_TOKE = 2 * MiB;
constexpr size_t WS_TOKW = WS_TOKE + 128 * 1024;
constexpr size_t WS_ROWTOK = WS_TOKE + 256 * 1024;
constexpr size_t WS_ROWW = WS_TOKE + 512 * 1024;
constexpr size_t WS_DEC = 3 * MiB;
constexpr size_t WS_WGHIST = 3 * MiB + 64 * 1024;
constexpr size_t WS_WINA = 4 * MiB;
constexpr size_t WS_IN = 4 * MiB;
constexpr size_t WS_WINB = 20 * MiB;
constexpr size_t WS_WA = 27 * MiB, WS_WB = 29 * MiB, WS_WO = 31 * MiB;
constexpr size_t WS_QKV = 33 * MiB;
constexpr size_t WS_W13 = 33 * MiB;
constexpr size_t WS_W2 = 97 * MiB;
constexpr size_t WS_SB = 129 * MiB, WS_YB = 129 * MiB;
constexpr size_t WS_P = 161 * MiB, WS_OR = 161 * MiB;
constexpr size_t WS_UT = 193 * MiB, WS_W = 225 * MiB, WS_QD = 257 * MiB, WS_KDT = 289 * MiB;
constexpr size_t WS_GA = 193 * MiB, WS_GB = 225 * MiB;
constexpr size_t WS_H2 = 257 * MiB;
constexpr size_t WS_XS = 129 * MiB;
constexpr size_t WS_HID = 209 * MiB;
constexpr size_t WS_YBUF = 129 * MiB;
constexpr size_t OUT_PHI = 32 * MiB, OUT_LSEG = 40 * MiB;
constexpr size_t WS_END = 321 * MiB;
constexpr int CW_TMO = 0, CW_BAR = 4096, CW_Q = 8192;
constexpr size_t CTL_MODACC = 64 * 1024;
constexpr size_t CTL_SSQ = 128 * 1024;
constexpr int LDS_BYTES = 163840, MISC_OFF = LDS_BYTES - 2048;

#define GAS __attribute__((address_space(1)))
#define LAS __attribute__((address_space(3)))
typedef unsigned short bf16;
typedef unsigned v4u __attribute__((ext_vector_type(4)));
typedef unsigned v2u __attribute__((ext_vector_type(2)));
typedef float f32x4 __attribute__((ext_vector_type(4)));
#define LDS_WAIT() asm volatile("s_waitcnt lgkmcnt(0)" ::: "memory")
__device__ __forceinline__ unsigned f2bf(float f) { unsigned u = __builtin_bit_cast(unsigned, f); return (u + 0x7fffu + ((u >> 16) & 1u)) >> 16; }
__device__ __forceinline__ unsigned pk2(float lo, float hi) { return f2bf(lo) | (f2bf(hi) << 16); }
__device__ __forceinline__ float bf2f(unsigned short b) { return __builtin_bit_cast(float, ((unsigned)b) << 16); }
__device__ __forceinline__ float bflo(unsigned w) { return __builtin_bit_cast(float, w << 16); }
__device__ __forceinline__ float bfhi(unsigned w) { return __builtin_bit_cast(float, w & 0xffff0000u); }
__device__ __forceinline__ float sigmoidf_(float x) { return __builtin_amdgcn_rcpf(1.0f + __expf(-x)); }
__device__ __forceinline__ float siluf_(float x) { return x * __builtin_amdgcn_rcpf(1.0f + __expf(-x)); }
__device__ __forceinline__ float readlane_f(float v, int l) { return __builtin_bit_cast(float, __builtin_amdgcn_readlane(__builtin_bit_cast(int, v), l)); }
__device__ __forceinline__ float wave_sum(float v) {
#pragma unroll
    for (int o = 1; o < 64; o <<= 1) v += __shfl_xor(v, o);
    return v;
}


template <int N, int CAP> __device__ __forceinline__ void fold_step(float (&v)[CAP], int xr, bool bit) {
#pragma unroll
    for (int i = 0; i < N / 2; ++i) { const float send = bit ? v[i] : v[i + N / 2]; const float keep = bit ? v[i + N / 2] : v[i]; v[i] = keep + __shfl_xor(send, xr); }
}

#define XB_TMO      128
#define XB_XCNT(j)  (256  + 64 * (j))
#define XB_XSUB(j)  (1280 + 64 * (j))
#define XB_XGEN(j)  (2304 + 64 * (j))
#define XB_TOP      3328
#define XB_TOPGEN   3392
#define XCD_BAR_WORDS 3456
#define XB_SPIN_CAP (1u << 18)
__device__ __forceinline__ unsigned xb_ld(unsigned* p)              { return __hip_atomic_load(p, __ATOMIC_RELAXED, __HIP_MEMORY_SCOPE_AGENT); }
__device__ __forceinline__ unsigned xb_add(unsigned* p, unsigned v) { return __hip_atomic_fetch_add(p, v, __ATOMIC_RELAXED, __HIP_MEMORY_SCOPE_AGENT); }
__device__ __forceinline__ unsigned xb_xcc_id() { return (unsigned)__builtin_amdgcn_s_getreg((3 << 11) | 20) & 0xFu; }
#define XB_SPIN(cond, bar) do { unsigned _sp = 0; while (cond) { __builtin_amdgcn_s_sleep(1); \
    if ((++_sp & 255u) == 0u) { if (xb_ld(&(bar)[XB_TMO])) break; if (_sp > XB_SPIN_CAP) { atomicAdd(&(bar)[XB_TMO], 1u); break; } } } } while (0)
struct XcdBarrier { unsigned* bar; unsigned x; volatile LAS unsigned* st; };
__device__ __forceinline__ XcdBarrier xcd_barrier_post(unsigned* bar, volatile LAS unsigned* st) {
    XcdBarrier b; b.bar = bar; b.x = xb_xcc_id(); b.st = st;
    if (threadIdx.x == 0) (void)xb_add(&bar[XB_XCNT(b.x)], 1u);
    return b;
}
__device__ __forceinline__ void xcd_barrier_complete(unsigned* bar, unsigned x, unsigned& nloc, unsigned& nx) {
    const unsigned G = gridDim.x * gridDim.y * gridDim.z;
    unsigned sum, cnt, mine, sp = 0u;
    for (;;) {
        sum = 0u; cnt = 0u; mine = 0u;
#pragma unroll
        for (unsigned j = 0; j < 16; ++j) { const unsigned c = xb_ld(&bar[XB_XCNT(j)]); sum += c; cnt += (c > 0u) ? 1u : 0u; mine = (j == x) ? c : mine; }
        if (sum == G) break;
        __builtin_amdgcn_s_sleep(1);
        if ((++sp & 255u) == 0u) { if (xb_ld(&bar[XB_TMO])) break; if (sp > XB_SPIN_CAP) { atomicAdd(&bar[XB_TMO], 1u); break; } }
    }
    nloc = mine > 0u ? mine : 1u; nx = cnt > 0u ? cnt : 1u;
}
__device__ __forceinline__ void xcd_barrier(const XcdBarrier& b) {
    asm volatile("s_waitcnt vmcnt(0)" ::: "memory");
    __syncthreads();
    if (threadIdx.x == 0) {
        unsigned* bar = b.bar;
        __builtin_amdgcn_s_waitcnt(0);
        unsigned nloc = b.st[0], nx = b.st[1];
        if (nloc == 0u) { xcd_barrier_complete(bar, b.x, nloc, nx); b.st[0] = nloc; b.st[1] = nx; }
        const unsigned old = xb_add(&bar[XB_XSUB(b.x)], 1u);
        const unsigned gen = old / nloc;
        if (old + 1u == (gen + 1u) * nloc) {
            __builtin_amdgcn_fence(__ATOMIC_RELEASE, "agent");
            asm volatile("s_waitcnt vmcnt(0)" ::: "memory");
            const unsigned og = xb_add(&bar[XB_TOP], 1u);
            const unsigned tg = og / nx;
            if (og + 1u == (tg + 1u) * nx) xb_add(&bar[XB_TOPGEN], 1u);
            else XB_SPIN(xb_ld(&bar[XB_TOPGEN]) == tg, bar);
            __builtin_amdgcn_fence(__ATOMIC_ACQUIRE, "agent");
            xb_add(&bar[XB_XGEN(b.x)], 1u);
            asm volatile("s_waitcnt vmcnt(0)" ::: "memory");
        } else {
            XB_SPIN(xb_ld(&bar[XB_XGEN(b.x)]) == gen, bar);
            __builtin_amdgcn_fence(__ATOMIC_ACQUIRE, "agent");
            asm volatile("s_waitcnt vmcnt(0)" ::: "memory");
        }
    }
    __syncthreads();
}

struct Frame {
    LAS unsigned char* lds;
    volatile LAS unsigned* MISC;
    unsigned* ctl;
    int tid, lane, wave, vcu, G;
    const float *x, *c, *w_ada, *b_ada, *norm1_g, *w_in, *conv_qkv_w, *a_log, *dt_bias, *onorm_g, *w_proj_a, *conv_sc_w, *w_proj_b, *w_out,
                *norm2_g, *w_group, *b_group, *w_expert, *b_expert, *w1, *w3, *w2, *normf_g;
    float* out; unsigned char* ws;
};
__device__ __forceinline__ float mod_at(const Frame& F, int b, int idx) {
    return ((const float*)(F.ws + CTL_MODACC))[b * 6144 + idx];
}

using pg8::Unit; using pg8::cvt_pk_bf16;
__device__ __forceinline__ v4u pack8(const f32x4 a, const f32x4 b) { v4u w; w.x = cvt_pk_bf16(a[0], a[1]); w.y = cvt_pk_bf16(a[2], a[3]); w.z = cvt_pk_bf16(b[0], b[1]); w.w = cvt_pk_bf16(b[2], b[3]); return w; }
__device__ __forceinline__ void unpack8(const v4u w, f32x4& a, f32x4& b) { a = (f32x4){bflo(w.x), bfhi(w.x), bflo(w.y), bfhi(w.y)}; b = (f32x4){bflo(w.z), bfhi(w.z), bflo(w.w), bfhi(w.w)}; }

struct EpiInA {
    static constexpr bool PERM = true, AFTER_DRAIN = false;
    bf16 *QKV, *SB, *P;
    __device__ __forceinline__ void operator()(const f32x4 (&acc)[2][2][4][2], const Unit& u, int wr, int wc, int fr, int fq) const {
        const int row0 = u.pm * 256 + wr * 64 + fr;
        if (u.pn < 16) {
            bf16* base; int ldc, colt;
            if (u.pn < 12) { base = QKV; ldc = NQKV; colt = u.pn * 256; } else { base = SB; ldc = D; colt = (u.pn - 12) * 256; }
            const int col0 = colt + wc * 32 + 8 * fq;
#pragma unroll
            for (int ai = 0; ai < 2; ++ai)
#pragma unroll
                for (int m = 0; m < 4; ++m) { bf16* rowp = base + (size_t)(row0 + ai * 128 + m * 16) * ldc + col0;
#pragma unroll
                    for (int bj = 0; bj < 2; ++bj) *(v4u*)(rowp + bj * 128) = pack8(acc[ai][bj][m][0], acc[ai][bj][m][1]); }
        } else {
            const int col0 = (u.pn - 16) * 128 + wc * 32 + 8 * fq;
#pragma unroll
            for (int ai = 0; ai < 2; ++ai)
#pragma unroll
                for (int m = 0; m < 4; ++m) { bf16* rowp = P + (size_t)(row0 + ai * 128 + m * 16) * D + col0;
                    *(v4u*)rowp = pack8(acc[ai][0][m][0] * acc[ai][1][m][0], acc[ai][0][m][1] * acc[ai][1][m][1]); }
        }
    }
};
struct EpiInB {
    static constexpr bool PERM = true, AFTER_DRAIN = false;
    unsigned char* ws;
    __device__ __forceinline__ void operator()(const f32x4 (&acc)[2][2][4][2], const Unit& u, int wr, int wc, int fr, int fq) const {
        const int row0 = u.pm * 256 + wr * 64 + fr, col0 = (u.pn & 3) * 256 + wc * 32 + 8 * fq;
        const bool zt = u.pn < 4;
        bf16* base = (bf16*)(ws + (zt ? WS_OR : ((u.pn < 8) ? WS_GA : WS_GB)));
        v4u cur[2] = {{0u, 0u, 0u, 0u}, {0u, 0u, 0u, 0u}}, nxt[2] = {{0u, 0u, 0u, 0u}, {0u, 0u, 0u, 0u}};
        if (zt) { const bf16* rp = base + (size_t)row0 * D + col0; cur[0] = *(const v4u*)rp; cur[1] = *(const v4u*)(rp + 128); }
#pragma unroll
        for (int g = 0; g < 8; ++g) { const int ai = g >> 2, m = g & 3; bf16* rowp = base + (size_t)(row0 + ai * 128 + m * 16) * D + col0;
            if (zt && g < 7) { const bf16* rn = base + (size_t)(row0 + ((g + 1) >> 2) * 128 + ((g + 1) & 3) * 16) * D + col0; nxt[0] = *(const v4u*)rn; nxt[1] = *(const v4u*)(rn + 128); }
            __builtin_amdgcn_sched_barrier(0);
#pragma unroll
            for (int bj = 0; bj < 2; ++bj) { f32x4 a = acc[ai][bj][m][0], b = acc[ai][bj][m][1];
                f32x4 sa, sb;
#pragma unroll
                for (int j = 0; j < 4; ++j) { sa[j] = sigmoidf_(a[j]); sb[j] = sigmoidf_(b[j]); }
                if (zt) { f32x4 o0, o1; unpack8(cur[bj], o0, o1); sa = sa * a * o0; sb = sb * b * o1; }
                *(v4u*)(rowp + bj * 128) = pack8(sa, sb); }
            cur[0] = nxt[0]; cur[1] = nxt[1];
            __builtin_amdgcn_sched_barrier(0); }
    }
};
struct EpiPlain {
    static constexpr bool PERM = true, AFTER_DRAIN = false;
    bf16* O; int ldc;
    __device__ __forceinline__ void operator()(const f32x4 (&acc)[2][2][4][2], const Unit& u, int wr, int wc, int fr, int fq) const {
        const int row0 = u.pm * 256 + wr * 64 + fr, col0 = u.pn * 256 + wc * 32 + 8 * fq;
#pragma unroll
        for (int ai = 0; ai < 2; ++ai)
#pragma unroll
            for (int m = 0; m < 4; ++m) { bf16* rowp = O + (size_t)(row0 + ai * 128 + m * 16) * ldc + col0;
#pragma unroll
                for (int bj = 0; bj < 2; ++bj) *(v4u*)(rowp + bj * 128) = pack8(acc[ai][bj][m][0], acc[ai][bj][m][1]); }
    }
};
struct EpiMerge {
    static constexpr bool PERM = true, AFTER_DRAIN = false;
    const bf16 *GA, *GB, *YB; bf16* MG;
    __device__ __forceinline__ void operator()(const f32x4 (&acc)[2][2][4][2], const Unit& u, int wr, int wc, int fr, int fq) const {
        const int row0 = u.pm * 256 + wr * 64 + fr, col0 = u.pn * 256 + wc * 32 + 8 * fq;
        v4u cur[6], nxt[6];
#define EPM_LOAD(dst, g_) do { const size_t o_ = (size_t)(row0 + ((g_) >> 2) * 128 + ((g_) & 3) * 16) * D + col0; \
        dst[0] = *(const v4u*)(GA + o_); dst[1] = *(const v4u*)(GA + o_ + 128); dst[2] = *(const v4u*)(GB + o_); dst[3] = *(const v4u*)(GB + o_ + 128); dst[4] = *(const v4u*)(YB + o_); dst[5] = *(const v4u*)(YB + o_ + 128); } while (0)
        EPM_LOAD(cur, 0);
#pragma unroll
        for (int g = 0; g < 8; ++g) { const int ai = g >> 2, m = g & 3; const size_t off = (size_t)(row0 + ai * 128 + m * 16) * D + col0;
            if (g < 7) EPM_LOAD(nxt, g + 1);
            __builtin_amdgcn_sched_barrier(0);
#pragma unroll
            for (int bj = 0; bj < 2; ++bj) { f32x4 a0, a1, b0, b1, y0, y1; unpack8(cur[bj], a0, a1); unpack8(cur[2 + bj], b0, b1); unpack8(cur[4 + bj], y0, y1);
                *(v4u*)(MG + off + bj * 128) = pack8(a0 * acc[ai][bj][m][0] + b0 * y0, a1 * acc[ai][bj][m][1] + b1 * y1); }
#pragma unroll
            for (int q = 0; q < 6; ++q) cur[q] = nxt[q];
            __builtin_amdgcn_sched_barrier(0); }
#undef EPM_LOAD
    }
};
struct EpiX1 {
    static constexpr bool PERM = true, AFTER_DRAIN = false;
    const float* X; float* X1; const float* modacc; const float* b_ada;
    __device__ __forceinline__ void operator()(const f32x4 (&acc)[2][2][4][2], const Unit& u, int wr, int wc, int fr, int fq) const {
        const int row0 = u.pm * 256 + wr * 64 + fr, col0 = u.pn * 256 + wc * 32 + 8 * fq, b = u.pm >> 5;
        f32x4 gt[2][2];
#pragma unroll
        for (int bj = 0; bj < 2; ++bj)
#pragma unroll
            for (int n = 0; n < 2; ++n) gt[bj][n] = *(const f32x4*)(modacc + b * 6144 + 2048 + col0 + bj * 128 + 4 * n);
        f32x4 cur[4], nxt[4];
#define EPX_LOAD(dst, g_) do { const size_t o_ = (size_t)(row0 + ((g_) >> 2) * 128 + ((g_) & 3) * 16) * D + col0; \
        dst[0] = *(const f32x4*)(X + o_); dst[1] = *(const f32x4*)(X + o_ + 4); dst[2] = *(const f32x4*)(X + o_ + 128); dst[3] = *(const f32x4*)(X + o_ + 132); } while (0)
        EPX_LOAD(cur, 0);
#pragma unroll
        for (int g = 0; g < 8; ++g) { const int ai = g >> 2, m = g & 3; const size_t off = (size_t)(row0 + ai * 128 + m * 16) * D + col0;
            if (g < 7) EPX_LOAD(nxt, g + 1);
            __builtin_amdgcn_sched_barrier(0);
#pragma unroll
            for (int bj = 0; bj < 2; ++bj)
#pragma unroll
                for (int n = 0; n < 2; ++n) *(f32x4*)(X1 + off + bj * 128 + 4 * n) = cur[bj * 2 + n] + gt[bj][n] * acc[ai][bj][m][n];
#pragma unroll
            for (int q = 0; q < 4; ++q) cur[q] = nxt[q];
            __builtin_amdgcn_sched_barrier(0); }
#undef EPX_LOAD
    }
};
struct EpiHid {
    static constexpr bool PERM = true, AFTER_DRAIN = false;
    bf16* HID;
    __device__ __forceinline__ void operator()(const f32x4 (&acc)[2][2][4][2], const Unit& u, int wr, int wc, int fr, int fq) const {
        const int row0 = u.pm * 256 + wr * 64 + fr, col0 = (u.pn & 3) * 128 + wc * 32 + 8 * fq;
#pragma unroll
        for (int ai = 0; ai < 2; ++ai)
#pragma unroll
            for (int m = 0; m < 4; ++m) { f32x4 a = acc[ai][0][m][0], b = acc[ai][0][m][1];
#pragma unroll
                for (int j = 0; j < 4; ++j) { a[j] = siluf_(a[j]) * acc[ai][1][m][0][j]; b[j] = siluf_(b[j]) * acc[ai][1][m][1][j]; }
                *(v4u*)(HID + (size_t)(row0 + ai * 128 + m * 16) * DE + col0) = pack8(a, b); }
    }
};
struct EpiMoeOut {
    static constexpr bool PERM = true, AFTER_DRAIN = false;
    bf16* YBUF; const int* ROWTOK; const float* ROWW;
    __device__ __forceinline__ void operator()(const f32x4 (&acc)[2][2][4][2], const Unit& u, int wr, int wc, int fr, int fq) const {
        const int row0 = u.pm * 256 + wr * 64 + fr, col0 = (u.pn & 3) * 256 + wc * 32 + 8 * fq;
        int tk[8]; float wgt[8];
#pragma unroll
        for (int g = 0; g < 8; ++g) { const int r = row0 + (g >> 2) * 128 + (g & 3) * 16; tk[g] = ROWTOK[r]; wgt[g] = ROWW[r]; }
        __builtin_amdgcn_sched_barrier(0);
#pragma unroll
        for (int g = 0; g < 8; ++g) { const int ai = g >> 2, m = g & 3;
            if (tk[g] >= 0) { const float w = wgt[g]; bf16* rowp = YBUF + (size_t)tk[g] * D + col0;
#pragma unroll
                for (int bj = 0; bj < 2; ++bj) *(v4u*)(rowp + bj * 128) = pack8(acc[ai][bj][m][0] * w, acc[ai][bj][m][1] * w); } }
    }
};
struct MoeOrder {
    int nt, G, c; const volatile LAS int* tile_e;
    __device__ __forceinline__ bool next(int i, Unit& u) const {
        const int x = c & 7, vi = c >> 3, per = G >> 3, lo = (nt * x) >> 3, hi = (nt * (x + 1)) >> 3, q = i * per + vi;
        if (q >= 4 * (hi - lo)) return false;
        const int rb = lo + (q >> 2); u.pm = rb; u.pn = tile_e[rb] * 4 + (q & 3); return true; }
    __device__ __forceinline__ void a_ready(const Unit&) const {}
    __device__ __forceinline__ void done(const Unit&) const {}
};

__device__ __forceinline__ void transpose_item(const float* W, int ldw, int src_col0, int k0, bf16* WT, int dst_row0, int K, LAS float* scr, int lane) {
#pragma unroll 8
    for (int i = 0; i < 32; ++i) { const int kk = 2 * i + (lane >> 5); scr[kk * 33 + (lane & 31)] = W[(size_t)(k0 + kk) * ldw + src_col0 + (lane & 31)]; }
    LDS_WAIT(); asm volatile("" ::: "memory");
    const int c = lane & 7;
#pragma unroll
    for (int j = 0; j < 4; ++j) { const int n = (lane >> 3) + 8 * j; const LAS float* s = scr + (8 * c) * 33 + n;
        v4u o; o.x = pk2(s[0 * 33], s[1 * 33]); o.y = pk2(s[2 * 33], s[3 * 33]); o.z = pk2(s[4 * 33], s[5 * 33]); o.w = pk2(s[6 * 33], s[7 * 33]);
        *(v4u*)(WT + (size_t)(dst_row0 + n) * K + k0 + 8 * c) = o; }
    LDS_WAIT(); asm volatile("" ::: "memory");
}
__device__ __forceinline__ int win_src_col(int d0) {
    if (d0 < 3072) return d0;
    if (d0 < 4096) return 4112 + (d0 - 3072);
    if (d0 < 6144) { const int j = (d0 - 4096) >> 8, r = (d0 - 4096) & 255; return (r < 128 ? 5136 + r : 6160 + (r - 128)) + 128 * j; }
    if (d0 < 7168) return 3072 + (d0 - 6144);
    if (d0 < 8192) return 7184 + (d0 - 7168);
    return 8208 + (d0 - 8192);
}

__device__ __forceinline__ void p0_prologue(Frame& F) {
    LAS float* sC = (LAS float*)(F.lds + 8 * 8448);
    for (int i = F.tid; i < 2 * D; i += 512) sC[i] = siluf_(F.c[i]);
    __syncthreads();
    const int gw = F.vcu * NWAVES + F.wave, NGW = F.G * NWAVES;
    float* modv = (float*)(F.ws + CTL_MODACC);
    LAS float* sPart = sC + 2 * D;
    for (int cg = blockIdx.x; cg < 96; cg += F.G) {
        const int col = cg * 64 + F.lane, k0 = F.wave * 128;
        float a0 = 0.f, a1 = 0.f;
#pragma unroll 16
        for (int k = 0; k < 128; ++k) { const float wv = F.w_ada[(size_t)(k0 + k) * 6144 + col]; a0 += sC[k0 + k] * wv; a1 += sC[D + k0 + k] * wv; }
        sPart[F.wave * 128 + F.lane] = a0; sPart[F.wave * 128 + 64 + F.lane] = a1;
        __syncthreads();
        if (F.wave < 2) { float t = 0.f;
#pragma unroll
            for (int q = 0; q < 8; ++q) t += sPart[q * 128 + F.wave * 64 + F.lane];
            modv[F.wave * 6144 + col] = t + F.b_ada[col]; }
        __syncthreads();
    }
    LAS float* scr = (LAS float*)(F.lds + F.wave * 8448);
    constexpr int I_IN = 288 * 16, I_SQ = 32 * 16;
    for (int it = gw; it < I_IN + 3 * I_SQ; it += NGW) {
        int r = it;
        if (r < I_IN) { const int dg = r % 288, kb = r / 288, d0 = dg * 32; bf16* dst = (d0 < 6144) ? (bf16*)(F.ws + WS_WINA) : (bf16*)(F.ws + WS_WINB);
            transpose_item(F.w_in, IN_TOTAL, win_src_col(d0), kb * 64, dst, d0 < 6144 ? d0 : d0 - 6144, D, scr, F.lane); continue; }
        r -= I_IN;
        if (r < I_SQ) { transpose_item(F.w_proj_a, D, (r % 32) * 32, (r / 32) * 64, (bf16*)(F.ws + WS_WA), (r % 32) * 32, D, scr, F.lane); continue; } r -= I_SQ;
        if (r < I_SQ) { transpose_item(F.w_proj_b, D, (r % 32) * 32, (r / 32) * 64, (bf16*)(F.ws + WS_WB), (r % 32) * 32, D, scr, F.lane); continue; } r -= I_SQ;
        transpose_item(F.w_out, D, (r % 32) * 32, (r / 32) * 64, (bf16*)(F.ws + WS_WO), (r % 32) * 32, D, scr, F.lane);
    }
}
__device__ __forceinline__ void moe_weight_item(Frame& F, int it, LAS float* scr) {
    constexpr int I13 = NE * 32 * 16;
    if (it < I13) { const int e = it / 512, r = it % 512, dg = r % 32, kb = r / 32, d0 = dg * 32, j = d0 >> 8, rr = d0 & 255;
        if (rr < 128) transpose_item(F.w1 + (size_t)e * D * DE, DE, 128 * j + (rr & 127), kb * 64, (bf16*)(F.ws + WS_W13) + (size_t)e * D * D, d0, D, scr, F.lane);
        else          transpose_item(F.w3 + (size_t)e * D * DE, DE, 128 * j + (rr & 127), kb * 64, (bf16*)(F.ws + WS_W13) + (size_t)e * D * D, d0, D, scr, F.lane);
    } else { const int r2 = it - I13, e = r2 / 256, r = r2 % 256, dg = r % 32, kb = r / 32;
        transpose_item(F.w2 + (size_t)e * DE * D, D, dg * 32, kb * 64, (bf16*)(F.ws + WS_W2) + (size_t)e * D * DE, dg * 32, DE, scr, F.lane); }
}
__device__ __forceinline__ void p_moe_weights(Frame& F) {
    LAS float* scr = (LAS float*)(F.lds + F.wave * 8448);
    constexpr int NBATCH = (NE * 32 * 16 + NE * 32 * 8) / 64;
    __syncthreads();
    for (;;) {
        if (F.tid == 0) F.MISC[3] = atomicAdd(F.ctl + CW_Q, 1u);
        __syncthreads();
        const int bt = (int)F.MISC[3];
        __syncthreads();
        if (bt >= NBATCH) break;
        for (int i = 0; i < 8; ++i) moe_weight_item(F, bt * 64 + F.wave * 8 + i, scr);
    }
}

__device__ __forceinline__ void p1_norm1(Frame& F) {
    LAS float* sBA = (LAS float*)F.lds;
    for (int i = F.tid; i < 16 * D; i += 512) { const int k = i >> 4, o = i & 15; sBA[o * D + k] = F.w_in[(size_t)k * IN_TOTAL + 4096 + o]; }
    __syncthreads();
    const int gw = blockIdx.x * NWAVES + F.wave, RPW = M / (F.G * NWAVES);
    bf16* H = (bf16*)F.out; float* BG = (float*)(F.ws + WS_BG);
    f32x4 gsc[4], gsh[4];
    { const int b = (gw * RPW) / T;
#pragma unroll
      for (int j = 0; j < 4; ++j) { const int col = 256 * j + 4 * F.lane; const f32x4 g1 = *(const f32x4*)(F.norm1_g + col);
          gsc[j] = g1 * (1.0f + *(const f32x4*)((const float*)(F.ws + CTL_MODACC) + b * 6144 + D + col)); gsh[j] = *(const f32x4*)((const float*)(F.ws + CTL_MODACC) + b * 6144 + col); } }
    for (int m = gw * RPW; m < (gw + 1) * RPW; ++m) {
        const f32x4* xr = (const f32x4*)(F.x + (size_t)m * D) + F.lane;
        f32x4 v[4]; float s = 0.f;
#pragma unroll
        for (int j = 0; j < 4; ++j) { v[j] = xr[64 * j]; s += (v[j].x * v[j].x + v[j].y * v[j].y) + (v[j].z * v[j].z + v[j].w * v[j].w); }
        const float rstd = __frsqrt_rn(wave_sum(s) * (1.f / D) + EPS);
        f32x4 hv[4];
#pragma unroll
        for (int j = 0; j < 4; ++j) { const int col = 256 * j + 4 * F.lane;
            hv[j] = v[j] * rstd * gsc[j] + gsh[j];
            *(v2u*)(H + (size_t)m * D + col) = (v2u){pk2(hv[j][0], hv[j][1]), pk2(hv[j][2], hv[j][3])};
        }
        float lg[16];
#pragma unroll
        for (int o = 0; o < 16; ++o) { float p = 0.f;
#pragma unroll
            for (int j = 0; j < 4; ++j) { const f32x4 w = *(const LAS f32x4*)(sBA + o * D + 256 * j + 4 * F.lane); p += (hv[j][0] * w[0] + hv[j][1] * w[1]) + (hv[j][2] * w[2] + hv[j][3] * w[3]); }
            lg[o] = p; if ((o & 3) == 3) __builtin_amdgcn_sched_barrier(0); }
        fold_step<16, 16>(lg, 32, (F.lane & 32) != 0); fold_step<8, 16>(lg, 16, (F.lane & 16) != 0); fold_step<4, 16>(lg, 8, (F.lane & 8) != 0); fold_step<2, 16>(lg, 4, (F.lane & 4) != 0);
        float val = lg[0]; val += __shfl_xor(val, 2); val += __shfl_xor(val, 1);
        const int oidx = ((F.lane >> 5) & 1) * 8 + ((F.lane >> 4) & 1) * 4 + ((F.lane >> 3) & 1) * 2 + ((F.lane >> 2) & 1);
        if ((F.lane & 3) == 0) {
            float r;
            if (oidx < 8) r = sigmoidf_(val);
            else { const int hh = oidx - 8; const float xx = val + F.dt_bias[hh]; const float sp = xx > 20.f ? xx : log1pf(__expf(xx)); r = -__expf(F.a_log[hh]) * sp; }
            BG[(size_t)m * 16 + oidx] = r;
        }
    }
}

__device__ __forceinline__ void p3a_ybp(Frame& F) {
    const bf16* SB = (const bf16*)(F.ws + WS_SB); const bf16* P = (const bf16*)(F.ws + WS_P); bf16* YBP = (bf16*)F.out + (size_t)M * D;
    const size_t total = (size_t)M * (D / 8);
    for (size_t i = (size_t)blockIdx.x * 512 + F.tid; i < total; i += (size_t)F.G * 512) {
        const int m = (int)(i >> 7), c8 = (int)(i & 127) * 8, t = m % T;
        f32x4 a0 = {0.f, 0.f, 0.f, 0.f}, a1 = a0;
#pragma unroll
        for (int j = 0; j < 3; ++j) { const int tt = t - 2 + j;
            if (tt >= 0) { f32x4 p0, p1; unpack8(*(const v4u*)(P + (size_t)(m - 2 + j) * D + c8), p0, p1);
                a0 += *(const f32x4*)(F.conv_sc_w + j * D + c8) * p0; a1 += *(const f32x4*)(F.conv_sc_w + j * D + c8 + 4) * p1; } }
        f32x4 s0, s1; unpack8(*(const v4u*)(SB + (size_t)m * D + c8), s0, s1);
        *(v4u*)(YBP + (size_t)m * D + c8) = pack8(s0 * a0, s1 * a1);
    }
}

__device__ __forceinline__ void p3b_chunk(Frame& F, int unit) {
    const int n = unit % NCH, bh = unit / NCH, h = bh % NH, b = bh / NH, t0 = n * CH, row0 = b * T + t0;
    LAS float* sq = (LAS float*)F.lds; LAS float* sk = sq + 64 * 129; LAS float* sv = sk + 64 * 129; LAS float* sA = sv + 64 * 129; LAS float* sT = sA + 64 * 65;
    LAS float* sgc = sT + 64 * 65; LAS float* sbeta = sgc + 64;
    const bf16* QKV = (const bf16*)(F.ws + WS_QKV); const float* BG = (const float*)(F.ws + WS_BG);
    for (int idx = F.tid; idx < 3 * 64 * 128; idx += 512) {
        const int sec = idx >> 13, r = (idx >> 7) & 63, c = idx & 127, gcol = sec * 1024 + h * 128 + c;
        float a = 0.f;
#pragma unroll
        for (int j = 0; j < 4; ++j) { const int tt = t0 + r - 3 + j; if (tt >= 0) a += F.conv_qkv_w[j * NQKV + gcol] * bf2f(QKV[(size_t)(b * T + tt) * NQKV + gcol]); }
        sq[sec * (64 * 129) + r * 129 + c] = siluf_(a);
    }
    if (F.tid < 64) { sgc[F.tid] = BG[(size_t)(row0 + F.tid) * 16 + 8 + h]; sbeta[F.tid] = BG[(size_t)(row0 + F.tid) * 16 + h]; }
    __syncthreads();
    for (int r = F.wave * 8; r < F.wave * 8 + 8; ++r) {
        const float q0 = sq[r * 129 + F.lane], q1 = sq[r * 129 + 64 + F.lane], k0 = sk[r * 129 + F.lane], k1 = sk[r * 129 + 64 + F.lane];
        const float qs = __frsqrt_rn(wave_sum(q0 * q0 + q1 * q1) + EPS) * 0.08838834764831845f, ks = __frsqrt_rn(wave_sum(k0 * k0 + k1 * k1) + EPS);
        sq[r * 129 + F.lane] = q0 * qs; sq[r * 129 + 64 + F.lane] = q1 * qs; sk[r * 129 + F.lane] = k0 * ks; sk[r * 129 + 64 + F.lane] = k1 * ks;
    }
    if (F.tid == 0) { float a = 0.f; for (int i = 0; i < 64; ++i) { a += sgc[i]; sgc[i] = a; } }
    __syncthreads();
    bf16* INo = (bf16*)(F.ws + WS_IN) + (size_t)unit * 4096;
    for (int idx = F.tid; idx < 4096; idx += 512) {
        const int i = idx >> 6, j = idx & 63; float av = 0.f, iv = 0.f;
        if (j <= i) { float dkk = 0.f, dqk = 0.f;
            for (int d = 0; d < 128; ++d) { const float kj = sk[j * 129 + d]; dkk += sk[i * 129 + d] * kj; dqk += sq[i * 129 + d] * kj; }
            const float dec = __expf(sgc[i] - sgc[j]); iv = dqk * dec; av = (j < i) ? sbeta[i] * dkk * dec : 0.f; }
        sA[i * 65 + j] = av; INo[idx] = (bf16)f2bf(iv);
    }
    __syncthreads();
    if (F.tid < 64) { const int c = F.tid;
        for (int i = 0; i < 64; ++i) { float t = 0.f;
            for (int j = 0; j < i; ++j) t -= sA[i * 65 + j] * sT[j * 65 + c];
            sT[i * 65 + c] = (i == c) ? 1.0f : ((i < c) ? 0.f : t); } }
    __syncthreads();
    bf16* UTo = (bf16*)(F.ws + WS_UT) + (size_t)unit * 8192; bf16* Wo = (bf16*)(F.ws + WS_W) + (size_t)unit * 8192;
    bf16* QDo = (bf16*)(F.ws + WS_QD) + (size_t)unit * 8192; bf16* KDTo = (bf16*)(F.ws + WS_KDT) + (size_t)unit * 8192;
    const float glast = sgc[63];
    for (int idx = F.tid; idx < 8192; idx += 512) {
        { const int dv = idx >> 6, i = idx & 63; float u = 0.f;
          for (int j = 0; j <= i; ++j) u += sT[i * 65 + j] * sbeta[j] * sv[j * 129 + dv];
          UTo[idx] = (bf16)f2bf(u);
          KDTo[idx] = (bf16)f2bf(sk[i * 129 + dv] * __expf(glast - sgc[i])); }
        { const int i = idx >> 7, dk = idx & 127; float w = 0.f;
          for (int j = 0; j <= i; ++j) w += sT[i * 65 + j] * sbeta[j] * __expf(sgc[j]) * sk[j * 129 + dk];
          Wo[idx] = (bf16)f2bf(w);
          QDo[idx] = (bf16)f2bf(sq[i * 129 + dk] * __expf(sgc[i])); }
    }
    if (F.tid == 0) ((float*)(F.ws + WS_DEC))[unit] = __expf(glast);
    __syncthreads();
}

__device__ __forceinline__ void p4_scan(Frame& F, int item) {
    const int bh = item >> 2, sl = item & 3, h = bh % NH, b = bh / NH;
    LAS float* sS = (LAS float*)F.lds;
    LAS float* sV = sS + 128 * 33;
    LAS bf16* sW = (LAS bf16*)(sV + 64 * 33);
    LAS bf16* sQ = sW + 64 * 136;
    LAS bf16* sK = sQ + 64 * 136;
    LAS bf16* sI = sK + 128 * 72;
    for (int i = F.tid; i < 128 * 33; i += 512) sS[i] = 0.f;
    bf16* OR = (bf16*)(F.ws + WS_OR); float* SSQ = (float*)(F.ws + CTL_SSQ);
    const int c = F.tid >> 3, d4 = (F.tid & 7) * 4, dk2 = F.tid >> 2, d8 = (F.tid & 3) * 8;
    for (int n = 0; n < NCH; ++n) {
        const int unit = bh * NCH + n;
        const bf16* Wg = (const bf16*)(F.ws + WS_W) + (size_t)unit * 8192; const bf16* Qg = (const bf16*)(F.ws + WS_QD) + (size_t)unit * 8192;
        const bf16* Kg = (const bf16*)(F.ws + WS_KDT) + (size_t)unit * 8192; const bf16* Ig = (const bf16*)(F.ws + WS_IN) + (size_t)unit * 4096;
        const bf16* Ug = (const bf16*)(F.ws + WS_UT) + (size_t)unit * 8192;
        __syncthreads();
        for (int i = F.tid; i < 1024; i += 512) { const int r = i >> 4, c8 = (i & 15) * 8;
            *(LAS v4u*)(sW + r * 136 + c8) = *(const v4u*)(Wg + r * 128 + c8); *(LAS v4u*)(sQ + r * 136 + c8) = *(const v4u*)(Qg + r * 128 + c8); }
        for (int i = F.tid; i < 1024; i += 512) { const int r = i >> 3, c8 = (i & 7) * 8; *(LAS v4u*)(sK + r * 72 + c8) = *(const v4u*)(Kg + r * 64 + c8); }
        { const int r = F.tid >> 3, c8 = (F.tid & 7) * 8; *(LAS v4u*)(sI + r * 72 + c8) = *(const v4u*)(Ig + r * 64 + c8); }
        const float dec = ((const float*)(F.ws + WS_DEC))[unit];
        __syncthreads();
        float pS[4] = {0.f, 0.f, 0.f, 0.f}, qS[4] = {0.f, 0.f, 0.f, 0.f};
        for (int dk = 0; dk < 128; ++dk) { const float wv = bf2f(sW[c * 136 + dk]), qv = bf2f(sQ[c * 136 + dk]);
#pragma unroll
            for (int e = 0; e < 4; ++e) { const float s = sS[dk * 33 + d4 + e]; pS[e] += wv * s; qS[e] += qv * s; } }
        float vn[4];
#pragma unroll
        for (int e = 0; e < 4; ++e) { vn[e] = bf2f(Ug[(sl * 32 + d4 + e) * 64 + c]) - pS[e]; sV[c * 33 + d4 + e] = vn[e]; }
        __syncthreads();
        float o[4] = {qS[0], qS[1], qS[2], qS[3]};
        for (int j = 0; j < 64; ++j) { const float iv = bf2f(sI[c * 72 + j]);
#pragma unroll
            for (int e = 0; e < 4; ++e) o[e] += iv * sV[j * 33 + d4 + e]; }
        const int row = b * T + n * CH + c;
        *(v2u*)(OR + (size_t)row * D + h * 128 + sl * 32 + d4) = (v2u){pk2(o[0], o[1]), pk2(o[2], o[3])};
        float ss = (o[0] * o[0] + o[1] * o[1]) + (o[2] * o[2] + o[3] * o[3]);
        ss += __shfl_xor(ss, 1); ss += __shfl_xor(ss, 2); ss += __shfl_xor(ss, 4);
        if ((F.tid & 7) == 0) atomicAdd(SSQ + (size_t)row * 8 + h, ss);
        float sn[8];
#pragma unroll
        for (int e = 0; e < 8; ++e) sn[e] = dec * sS[dk2 * 33 + d8 + e];
        for (int cc = 0; cc < 64; ++cc) { const float kv = bf2f(sK[dk2 * 72 + cc]);
#pragma unroll
            for (int e = 0; e < 8; ++e) sn[e] += kv * sV[cc * 33 + d8 + e]; }
        __syncthreads();
#pragma unroll
        for (int e = 0; e < 8; ++e) sS[dk2 * 33 + d8 + e] = sn[e];
    }
    __syncthreads();
}


typedef pg8::bf16x8 bx8;
#define MFMA16(a, b, c) __builtin_amdgcn_mfma_f32_16x16x32_bf16(a, b, c, 0, 0, 0)
__device__ __forceinline__ v2u pack4(const f32x4 a) { v2u r; r.x = cvt_pk_bf16(a[0], a[1]); r.y = cvt_pk_bf16(a[2], a[3]); return r; }
__device__ __forceinline__ void p4_scan_fast(Frame& F, int bh) {
    const int h = bh % NH, b = bh / NH, w = F.wave, l15 = F.lane & 15, lq = F.lane >> 4, ct = w >> 1, dvh = w & 1;
    LAS bf16* sST = (LAS bf16*)F.lds;
    LAS bf16* sVT = sST + 128 * 136;
    LAS float* sSS = (LAS float*)(sVT + 128 * 72);
    LAS float* sDEC = sSS + 128;
    if (F.tid < NCH) sDEC[F.tid] = ((const float*)(F.ws + WS_DEC))[bh * NCH + F.tid];
    for (int i = F.tid; i < 128 * 136 / 2; i += 512) ((LAS unsigned*)sST)[i] = 0u;
    const bf16* Wg = (const bf16*)(F.ws + WS_W) + (size_t)bh * NCH * 8192 + (16 * ct + l15) * 128 + 8 * lq;
    const bf16* Qg = (const bf16*)(F.ws + WS_QD) + (size_t)bh * NCH * 8192 + (16 * ct + l15) * 128 + 8 * lq;
    const bf16* Ig = (const bf16*)(F.ws + WS_IN) + (size_t)bh * NCH * 4096 + (16 * ct + l15) * 64 + 8 * lq;
    const bf16* Kg = (const bf16*)(F.ws + WS_KDT) + (size_t)bh * NCH * 8192 + (16 * w + l15) * 64 + 8 * lq;
    const bf16* Ug = (const bf16*)(F.ws + WS_UT) + (size_t)bh * NCH * 8192 + (16 * 4 * dvh + l15) * 64 + 16 * ct + 4 * lq;
    bf16* OR = (bf16*)(F.ws + WS_OR);
    bx8 fW[4], fQ[4], fI[2], fK[2]; v2u fU[4];
#pragma unroll
    for (int ks = 0; ks < 4; ++ks) { fW[ks] = *(const bx8*)(Wg + 32 * ks); fQ[ks] = *(const bx8*)(Qg + 32 * ks); fU[ks] = *(const v2u*)(Ug + ks * 16 * 64); }
#pragma unroll
    for (int ks = 0; ks < 2; ++ks) { fI[ks] = *(const bx8*)(Ig + 32 * ks); fK[ks] = *(const bx8*)(Kg + 32 * ks); }
    f32x4 S[8], gn[4];
#pragma unroll
    for (int t = 0; t < 8; ++t) S[t] = (f32x4){0.f, 0.f, 0.f, 0.f};
#pragma unroll
    for (int t = 0; t < 4; ++t) gn[t] = *(const f32x4*)(F.onorm_g + 16 * (4 * dvh + t) + 4 * lq);
    __syncthreads();
    for (int n = 0; n < NCH; ++n) {
        const float dec = sDEC[n];
        const int nn = (n + 1 < NCH) ? 1 : 0;
        f32x4 pS[4], qS[4];
#pragma unroll
        for (int t = 0; t < 4; ++t) { bx8 fS[4];
#pragma unroll
            for (int ks = 0; ks < 4; ++ks) fS[ks] = *(const LAS bx8*)(sST + (16 * (4 * dvh + t) + l15) * 136 + 32 * ks + 8 * lq);
            f32x4 p = {0.f, 0.f, 0.f, 0.f}, q = {0.f, 0.f, 0.f, 0.f};
#pragma unroll
            for (int ks = 0; ks < 4; ++ks) { p = MFMA16(fW[ks], fS[ks], p); q = MFMA16(fS[ks], fQ[ks], q); }
            pS[t] = p; qS[t] = q; }
#pragma unroll
        for (int t = 0; t < 4; ++t) { const f32x4 u = {bflo(fU[t].x), bfhi(fU[t].x), bflo(fU[t].y), bfhi(fU[t].y)};
            *(LAS v2u*)(sVT + (16 * (4 * dvh + t) + l15) * 72 + 16 * ct + 4 * lq) = pack4(u - pS[t]); }
        Wg += nn * 8192; Qg += nn * 8192; Ug += nn * 8192;
#pragma unroll
        for (int ks = 0; ks < 4; ++ks) { fW[ks] = *(const bx8*)(Wg + 32 * ks); fQ[ks] = *(const bx8*)(Qg + 32 * ks); fU[ks] = *(const v2u*)(Ug + ks * 16 * 64); }
        __syncthreads();
        float ss = 0.f;
#pragma unroll
        for (int t = 0; t < 4; ++t) {
#pragma unroll
            for (int ks = 0; ks < 2; ++ks) { const bx8 fV = *(const LAS bx8*)(sVT + (16 * (4 * dvh + t) + l15) * 72 + 32 * ks + 8 * lq); qS[t] = MFMA16(fV, fI[ks], qS[t]); }
            ss += (qS[t][0] * qS[t][0] + qS[t][1] * qS[t][1]) + (qS[t][2] * qS[t][2] + qS[t][3] * qS[t][3]); }
        ss += __shfl_xor(ss, 16); ss += __shfl_xor(ss, 32);
        if (lq == 0) sSS[dvh * 64 + 16 * ct + l15] = ss;
        Ig += nn * 4096;
#pragma unroll
        for (int ks = 0; ks < 2; ++ks) fI[ks] = *(const bx8*)(Ig + 32 * ks);
#pragma unroll
        for (int t = 0; t < 8; ++t) { S[t] = S[t] * dec;
#pragma unroll
            for (int ks = 0; ks < 2; ++ks) { const bx8 fV = *(const LAS bx8*)(sVT + (16 * t + l15) * 72 + 32 * ks + 8 * lq); S[t] = MFMA16(fK[ks], fV, S[t]); }
            *(LAS v2u*)(sST + (16 * t + l15) * 136 + 16 * w + 4 * lq) = pack4(S[t]); }
        Kg += nn * 8192;
#pragma unroll
        for (int ks = 0; ks < 2; ++ks) fK[ks] = *(const bx8*)(Kg + 32 * ks);
        __syncthreads();
        const float rstd = __frsqrt_rn((sSS[16 * ct + l15] + sSS[64 + 16 * ct + l15]) * (1.0f / 128.0f) + EPS);
        bf16* orow = OR + (size_t)(b * T + n * CH + 16 * ct + l15) * D + h * 128 + 16 * 4 * dvh + 4 * lq;
#pragma unroll
        for (int t = 0; t < 4; ++t) *(v2u*)(orow + 16 * t) = pack4(qS[t] * rstd * gn[t]);
    }
    __syncthreads();
}


#define MFMA_F32(a, b, c) __builtin_amdgcn_mfma_f32_16x16x4f32(a, b, c, 0, 0, 0)
__device__ __forceinline__ void solve_block(LAS float* sA, LAS float* sT, int bi, int bj, int l15, int lq) {
    f32x4 y = {0.f, 0.f, 0.f, 0.f};
    for (int km = bj; km < bi; ++km)
#pragma unroll
        for (int kb = 0; kb < 4; ++kb) y = MFMA_F32(sA[(16 * bi + l15) * 68 + 16 * km + 4 * kb + lq], sT[(16 * km + 4 * kb + lq) * 68 + 16 * bj + l15], y);
    f32x4 z = {0.f, 0.f, 0.f, 0.f};
#pragma unroll
    for (int e = 0; e < 4; ++e) z = MFMA_F32(sT[(16 * bi + l15) * 68 + 16 * bi + 4 * lq + e], y[e], z);
#pragma unroll
    for (int e = 0; e < 4; ++e) sT[(16 * bi + 4 * lq + e) * 68 + 16 * bj + l15] = -z[e];
}
__device__ __forceinline__ void p3b_loop(Frame& F) {
    const int tid = F.tid, w = F.wave, lane = F.lane, l15 = lane & 15, lq = lane >> 4;
    LAS bf16* sQ = (LAS bf16*)F.lds; LAS bf16* sK = sQ + 64 * 136; LAS bf16* sKG = sK + 64 * 136; LAS bf16* sVB = sKG + 128 * 72;
    LAS float* sA = (LAS float*)(sVB + 128 * 72); LAS float* sT = sA + 64 * 68; LAS bf16* sTb = (LAS bf16*)(sT + 64 * 68); LAS float* sgc = (LAS float*)(sTb + 64 * 72);
    const bf16* QKV = (const bf16*)(F.ws + WS_QKV); const float* BG = (const float*)(F.ws + WS_BG);
    const int rs = tid / 48, cg = tid % 48, sec = cg >> 4, c8 = (cg & 15) * 8, r0 = 8 * rs;
    const int wswz = (cg & 7);
    const int rswz = (2 * w + (l15 >> 3)) & 7;
    v4u raw[11]; f32x4 wt[4][2]; float pg = 0.f, pb = 0.f;
    int unit = blockIdx.x;
#define P3B_PREFETCH(U) do { const int n_ = (U) % NCH, bh_ = (U) / NCH, h_ = bh_ % NH, b_ = bh_ / NH, t0_ = n_ * CH; \
        pg = BG[(size_t)(b_ * T + t0_ + lane) * 16 + 8 + h_]; pb = BG[(size_t)(b_ * T + t0_ + lane) * 16 + h_]; \
        if (tid < 384) { const int gcol_ = sec * 1024 + h_ * 128 + c8; \
            _Pragma("unroll") for (int i = 0; i < 11; ++i) { const int tt = t0_ + r0 - 3 + i; raw[i] = (tt >= 0) ? *(const v4u*)(QKV + (size_t)(b_ * T + tt) * NQKV + gcol_) : (v4u){0u, 0u, 0u, 0u}; } } } while (0)
    if (unit < NUNIT) P3B_PREFETCH(unit);
    for (; unit < NUNIT; unit += F.G) {
        int zr = 0; asm volatile("" : "+v"(zr));
        const int c8z = c8 + zr, r0z = r0 + zr, l15z = l15 + zr;
        bf16* INo = (bf16*)(F.ws + WS_IN) + (size_t)unit * 4096; bf16* UTo = (bf16*)(F.ws + WS_UT) + (size_t)unit * 8192; bf16* Wo = (bf16*)(F.ws + WS_W) + (size_t)unit * 8192;
        bf16* QDo = (bf16*)(F.ws + WS_QD) + (size_t)unit * 8192; bf16* KDTo = (bf16*)(F.ws + WS_KDT) + (size_t)unit * 8192;
        float gcs = pg;
#pragma unroll
        for (int o = 1; o < 64; o <<= 1) { const float t = __shfl_up(gcs, o); if (lane >= o) gcs += t; }
        const float gl = __shfl(gcs, 63), bts = pb;
        if (w == 7) { sgc[lane] = gcs; sgc[64 + lane] = bts; if (lane == 0) ((float*)(F.ws + WS_DEC))[unit] = __expf(gl); }
        for (int i = tid; i < 64 * 68; i += 512) sT[i] = 0.f;
        if (tid < 384) {
            { const int gcol = sec * 1024 + ((unit / NCH) % NH) * 128 + c8;
#pragma unroll
              for (int j = 0; j < 4; ++j) { wt[j][0] = *(const f32x4*)(F.conv_qkv_w + j * NQKV + gcol); wt[j][1] = *(const f32x4*)(F.conv_qkv_w + j * NQKV + gcol + 4); } }
            const int wb = 8 * (rs ^ wswz) + zr;
#pragma unroll
            for (int g = 0; g < 2; ++g) {
                float gcr[4], btr[4];
#pragma unroll
                for (int r = 0; r < 4; ++r) { gcr[r] = __shfl(gcs, r0 + 4 * g + r); btr[r] = __shfl(bts, r0 + 4 * g + r); }
                f32x4 o0[4], o1[4];
#pragma unroll
                for (int r = 0; r < 4; ++r) { f32x4 a0 = {0.f, 0.f, 0.f, 0.f}, a1 = a0;
#pragma unroll
                    for (int j = 0; j < 4; ++j) { f32x4 x0, x1; unpack8(raw[4 * g + r + j], x0, x1); a0 += wt[j][0] * x0; a1 += wt[j][1] * x1; }
#pragma unroll
                    for (int e = 0; e < 4; ++e) { a0[e] = siluf_(a0[e]); a1[e] = siluf_(a1[e]); }
                    float ss = (a0[0] * a0[0] + a0[1] * a0[1]) + (a0[2] * a0[2] + a0[3] * a0[3]) + (a1[0] * a1[0] + a1[1] * a1[1]) + (a1[2] * a1[2] + a1[3] * a1[3]);
                    ss += __shfl_xor(ss, 1); ss += __shfl_xor(ss, 2); ss += __shfl_xor(ss, 4); ss += __shfl_xor(ss, 8);
                    const float sc = (sec == 2) ? 1.0f : __frsqrt_rn(ss + EPS) * (sec == 0 ? 0.08838834764831845f : 1.0f);
                    o0[r] = a0 * sc; o1[r] = a1 * sc; }
                const int rb = r0z + 4 * g;
                if (sec == 0) {
#pragma unroll
                    for (int r = 0; r < 4; ++r) { *(LAS v4u*)(sQ + (rb + r) * 136 + c8z) = pack8(o0[r], o1[r]); const float eg = __expf(gcr[r]);
                        *(v4u*)(QDo + (rb + r) * 128 + c8z) = pack8(o0[r] * eg, o1[r] * eg); }
                } else if (sec == 1) {
                    float fk[4], fd[4];
#pragma unroll
                    for (int r = 0; r < 4; ++r) { *(LAS v4u*)(sK + (rb + r) * 136 + c8z) = pack8(o0[r], o1[r]); fk[r] = btr[r] * __expf(gcr[r]); fd[r] = __expf(gl - gcr[r]); }
#pragma unroll
                    for (int e = 0; e < 4; ++e) {
                        *(LAS v2u*)(sKG + (c8z + e) * 72 + wb + 4 * g) = pack4((f32x4){o0[0][e] * fk[0], o0[1][e] * fk[1], o0[2][e] * fk[2], o0[3][e] * fk[3]});
                        *(v2u*)(KDTo + (c8z + e) * 64 + rb) = pack4((f32x4){o0[0][e] * fd[0], o0[1][e] * fd[1], o0[2][e] * fd[2], o0[3][e] * fd[3]});
                        *(LAS v2u*)(sKG + (c8z + 4 + e) * 72 + wb + 4 * g) = pack4((f32x4){o1[0][e] * fk[0], o1[1][e] * fk[1], o1[2][e] * fk[2], o1[3][e] * fk[3]});
                        *(v2u*)(KDTo + (c8z + 4 + e) * 64 + rb) = pack4((f32x4){o1[0][e] * fd[0], o1[1][e] * fd[1], o1[2][e] * fd[2], o1[3][e] * fd[3]}); }
                } else {
#pragma unroll
                    for (int e = 0; e < 4; ++e) {
                        *(LAS v2u*)(sVB + (c8z + e) * 72 + wb + 4 * g) = pack4((f32x4){o0[0][e] * btr[0], o0[1][e] * btr[1], o0[2][e] * btr[2], o0[3][e] * btr[3]});
                        *(LAS v2u*)(sVB + (c8z + 4 + e) * 72 + wb + 4 * g) = pack4((f32x4){o1[0][e] * btr[0], o1[1][e] * btr[1], o1[2][e] * btr[2], o1[3][e] * btr[3]}); }
                }
            }
        }
        __builtin_amdgcn_sched_barrier(0);
        if (unit + F.G < NUNIT) P3B_PREFETCH(unit + F.G);
        __builtin_amdgcn_sched_barrier(0);
        __syncthreads();
        {
            const int jt = w & 3, itp = w >> 2;
            bx8 ak[4];
#pragma unroll
            for (int ks = 0; ks < 4; ++ks) ak[ks] = *(const LAS bx8*)(sK + (16 * jt + l15) * 136 + 32 * ks + 8 * lq);
#pragma unroll
            for (int ii = 0; ii < 2; ++ii) { const int it = 2 * itp + ii, ci = 16 * it + l15z;
                f32x4 xk = {0.f, 0.f, 0.f, 0.f}, xq = xk;
#pragma unroll
                for (int ks = 0; ks < 4; ++ks) { const bx8 bk = *(const LAS bx8*)(sK + ci * 136 + 32 * ks + 8 * lq), bq = *(const LAS bx8*)(sQ + ci * 136 + 32 * ks + 8 * lq);
                    xk = MFMA16(ak[ks], bk, xk); xq = MFMA16(ak[ks], bq, xq); }
                const float gi = sgc[ci], bi = sgc[64 + ci];
                f32x4 av, iv;
#pragma unroll
                for (int e = 0; e < 4; ++e) { const int cj = 16 * jt + 4 * lq + e; const float dec = __expf(gi - sgc[cj]);
                    av[e] = (cj < ci) ? bi * xk[e] * dec : 0.f; iv[e] = (cj <= ci) ? xq[e] * dec : 0.f; }
                *(LAS f32x4*)(sA + ci * 68 + 16 * jt + 4 * lq) = av;
                *(v2u*)(INo + ci * 64 + 16 * jt + 4 * lq) = pack4(iv); }
        }
        __syncthreads();
        if (w == 0) {
            const int blk = lq, c = l15; float t[16];
#pragma unroll
            for (int i = 0; i < 16; ++i) { float s2 = 0.f;
#pragma unroll
                for (int jb = 0; jb < (i + 3) / 4; ++jb) { const f32x4 a4 = *(const LAS f32x4*)(sA + (16 * blk + i) * 68 + 16 * blk + 4 * jb);
#pragma unroll
                    for (int e = 0; e < 4; ++e) if (4 * jb + e < i) s2 -= a4[e] * t[4 * jb + e]; }
                t[i] = (i == c) ? 1.0f : s2;
                sT[(16 * blk + i) * 68 + 16 * blk + c] = t[i];
                if ((i & 3) == 3) __builtin_amdgcn_sched_barrier(0); }
        }
        __syncthreads();
        if (w < 3) solve_block(sA, sT, w + 1, w, l15, lq);
        __syncthreads();
        if (w < 2) solve_block(sA, sT, w + 2, w, l15, lq);
        __syncthreads();
        if (w < 1) solve_block(sA, sT, 3, 0, l15, lq);
        __syncthreads();
        { const int i = tid >> 3, j8 = (tid & 7) * 8; *(LAS v4u*)(sTb + i * 72 + j8) = pack8(*(const LAS f32x4*)(sT + i * 68 + j8), *(const LAS f32x4*)(sT + i * 68 + j8 + 4)); }
        __syncthreads();
        {
            bx8 bv[2], ag[2];
#pragma unroll
            for (int ks = 0; ks < 2; ++ks) { const int cb = 8 * ((4 * ks + lq) ^ rswz);
                bv[ks] = *(const LAS bx8*)(sVB + (16 * w + l15) * 72 + cb); ag[ks] = *(const LAS bx8*)(sKG + (16 * w + l15) * 72 + cb); }
#pragma unroll
            for (int it = 0; it < 4; ++it) { f32x4 u = {0.f, 0.f, 0.f, 0.f}, ww = u;
#pragma unroll
                for (int ks = 0; ks < 2; ++ks) { const bx8 ft = *(const LAS bx8*)(sTb + (16 * it + l15) * 72 + 32 * ks + 8 * lq); u = MFMA16(ft, bv[ks], u); ww = MFMA16(ag[ks], ft, ww); }
                *(v2u*)(UTo + (16 * w + l15z) * 64 + 16 * it + 4 * lq) = pack4(u);
                *(v2u*)(Wo + (16 * it + l15z) * 128 + 16 * w + 4 * lq) = pack4(ww); }
        }
        __syncthreads();
    }
#undef P3B_PREFETCH
}

__device__ __forceinline__ void p4a_seg(Frame& F, int seg) {
    const int w = F.wave, l15 = F.lane & 15, lq = F.lane >> 4, ct = w >> 1, ch = w & 1;
    const int bh = seg >> 4, g = seg & 15, unit0 = bh * NCH + 8 * g;
    LAS bf16* sST = (LAS bf16*)F.lds;
    LAS bf16* sVT = sST + 256 * 136;
    LAS float* sDEC = (LAS float*)(sVT + 256 * 72);
    if (F.tid < 8) sDEC[F.tid] = ((const float*)(F.ws + WS_DEC))[unit0 + F.tid];
    for (int i = F.tid; i < 256 * 136 / 2; i += 512) ((LAS unsigned*)sST)[i] = 0u;
    __syncthreads();
    if (F.tid < 128) sST[F.tid * 136 + F.tid] = (bf16)0x3F80;
    f32x4 ST[16];
#pragma unroll
    for (int t = 0; t < 16; ++t)
#pragma unroll
        for (int e = 0; e < 4; ++e) ST[t][e] = (t == w && l15 == 4 * lq + e) ? 1.0f : 0.0f;
    const bf16* Wg = (const bf16*)(F.ws + WS_W) + (size_t)unit0 * 8192 + (16 * ct + l15) * 128 + 8 * lq;
    const bf16* Kg = (const bf16*)(F.ws + WS_KDT) + (size_t)unit0 * 8192 + (16 * w + l15) * 64 + 8 * lq;
    const bf16* Ug = (const bf16*)(F.ws + WS_UT) + (size_t)unit0 * 8192 + l15 * 64 + 16 * ct + 4 * lq;
    bx8 fW[4], fK[2]; v2u fU[8];
#pragma unroll
    for (int ks = 0; ks < 4; ++ks) fW[ks] = *(const bx8*)(Wg + 32 * ks);
#pragma unroll
    for (int ks = 0; ks < 2; ++ks) fK[ks] = *(const bx8*)(Kg + 32 * ks);
#pragma unroll
    for (int t = 0; t < 8; ++t) fU[t] = ch ? *(const v2u*)(Ug + t * 16 * 64) : (v2u){0u, 0u};
    __syncthreads();
    for (int sI = 0; sI < 8; ++sI) {
        const float dec = sDEC[sI];
        const int nn = (sI < 7) ? 1 : 0;
#pragma unroll
        for (int t = 0; t < 8; ++t) { const int Tc = 8 * ch + t; f32x4 p = {0.f, 0.f, 0.f, 0.f};
#pragma unroll
            for (int ks = 0; ks < 4; ++ks) { const bx8 fS = *(const LAS bx8*)(sST + (16 * Tc + l15) * 136 + 32 * ks + 8 * lq); p = MFMA16(fW[ks], fS, p); }
            const f32x4 u = {bflo(fU[t].x), bfhi(fU[t].x), bflo(fU[t].y), bfhi(fU[t].y)};
            *(LAS v2u*)(sVT + (16 * Tc + l15) * 72 + 16 * ct + 4 * lq) = pack4(u - p); }
        Wg += nn * 8192; Ug += nn * 8192;
#pragma unroll
        for (int ks = 0; ks < 4; ++ks) fW[ks] = *(const bx8*)(Wg + 32 * ks);
#pragma unroll
        for (int t = 0; t < 8; ++t) fU[t] = ch ? *(const v2u*)(Ug + t * 16 * 64) : (v2u){0u, 0u};
        __syncthreads();
#pragma unroll
        for (int t = 0; t < 16; ++t) { ST[t] = ST[t] * dec;
#pragma unroll
            for (int ks = 0; ks < 2; ++ks) { const bx8 fV = *(const LAS bx8*)(sVT + (16 * t + l15) * 72 + 32 * ks + 8 * lq); ST[t] = MFMA16(fK[ks], fV, ST[t]); }
            *(LAS v2u*)(sST + (16 * t + l15) * 136 + 16 * w + 4 * lq) = pack4(ST[t]); }
        Kg += nn * 8192;
#pragma unroll
        for (int ks = 0; ks < 2; ++ks) fK[ks] = *(const bx8*)(Kg + 32 * ks);
        __syncthreads();
    }
    bf16* PHI = (bf16*)((unsigned char*)F.out + OUT_PHI) + (size_t)seg * 16384;
#pragma unroll
    for (int t = 0; t < 8; ++t)
#pragma unroll
        for (int e = 0; e < 4; ++e) PHI[(16 * w + 4 * lq + e) * 128 + 16 * t + l15] = (bf16)f2bf(ST[t][e]);
    f32x4* LS = (f32x4*)((unsigned char*)F.out + OUT_LSEG) + ((size_t)(seg * 8 + w) * 8) * 64 + F.lane;
#pragma unroll
    for (int t = 0; t < 8; ++t) LS[t * 64] = ST[8 + t];
}
__device__ __forceinline__ void p4b_fold(Frame& F, int item) {
    const int w = F.wave, l15 = F.lane & 15, lq = F.lane >> 4, bh = item >> 2, dvs = item & 3;
    LAS bf16* sS = (LAS bf16*)F.lds;
    for (int i = F.tid; i < 32 * 136 / 2; i += 512) ((LAS unsigned*)sS)[i] = 0u;
    const bf16* Pg = (const bf16*)((const unsigned char*)F.out + OUT_PHI) + (size_t)(bh * 16) * 16384 + (16 * w + l15) * 128 + 8 * lq;
    const f32x4* Lg = (const f32x4*)((const unsigned char*)F.out + OUT_LSEG) + ((size_t)(bh * 16 * 8 + w) * 8 + 2 * dvs) * 64 + F.lane;
    f32x4* So = (f32x4*)((unsigned char*)F.out + OUT_LSEG) + ((size_t)(bh * 16 * 8 + w) * 8 + 2 * dvs) * 64 + F.lane;
    bx8 fP[4]; f32x4 L[2];
#pragma unroll
    for (int ks = 0; ks < 4; ++ks) fP[ks] = *(const bx8*)(Pg + 32 * ks);
    L[0] = Lg[0]; L[1] = Lg[64];
    __syncthreads();
    for (int g = 0; g < 15; ++g) {
        f32x4 Sn[2];
#pragma unroll
        for (int t = 0; t < 2; ++t) { f32x4 acc = L[t];
#pragma unroll
            for (int ks = 0; ks < 4; ++ks) { const bx8 fS = *(const LAS bx8*)(sS + (16 * t + l15) * 136 + 32 * ks + 8 * lq); acc = MFMA16(fP[ks], fS, acc); }
            Sn[t] = acc; }
        const int nn = (g < 14) ? 1 : 0;
        Pg += nn * 16384; Lg += nn * 8 * 8 * 64;
#pragma unroll
        for (int ks = 0; ks < 4; ++ks) fP[ks] = *(const bx8*)(Pg + 32 * ks);
        L[0] = Lg[0]; L[1] = Lg[64];
        __syncthreads();
#pragma unroll
        for (int t = 0; t < 2; ++t) { *(LAS v2u*)(sS + (16 * t + l15) * 136 + 16 * w + 4 * lq) = pack4(Sn[t]); So[t * 64] = Sn[t]; }
        So += 8 * 8 * 64;
        __syncthreads();
    }
}
__device__ __forceinline__ void p4c_seg(Frame& F, int seg) {
    const int bh = seg >> 4, g = seg & 15, unit0 = bh * NCH + 8 * g;
    const int h = bh % NH, b = bh / NH, w = F.wave, l15 = F.lane & 15, lq = F.lane >> 4, ct = w >> 1, dvh = w & 1;
    LAS bf16* sST = (LAS bf16*)F.lds;
    LAS bf16* sVT = sST + 128 * 136;
    LAS float* sSS = (LAS float*)(sVT + 128 * 72);
    LAS float* sDEC = sSS + 128;
    if (F.tid < 8) sDEC[F.tid] = ((const float*)(F.ws + WS_DEC))[unit0 + F.tid];
    f32x4 S[8], gn[4];
    { const f32x4* Sg = (const f32x4*)((const unsigned char*)F.out + OUT_LSEG) + ((size_t)((seg - 1) * 8 + w) * 8) * 64 + F.lane;
#pragma unroll
      for (int t = 0; t < 8; ++t) { S[t] = (f32x4){0.f, 0.f, 0.f, 0.f}; if (g != 0) S[t] = Sg[t * 64];
          *(LAS v2u*)(sST + (16 * t + l15) * 136 + 16 * w + 4 * lq) = pack4(S[t]); } }
    const bf16* Wg = (const bf16*)(F.ws + WS_W) + (size_t)unit0 * 8192 + (16 * ct + l15) * 128 + 8 * lq;
    const bf16* Qg = (const bf16*)(F.ws + WS_QD) + (size_t)unit0 * 8192 + (16 * ct + l15) * 128 + 8 * lq;
    const bf16* Ig = (const bf16*)(F.ws + WS_IN) + (size_t)unit0 * 4096 + (16 * ct + l15) * 64 + 8 * lq;
    const bf16* Kg = (const bf16*)(F.ws + WS_KDT) + (size_t)unit0 * 8192 + (16 * w + l15) * 64 + 8 * lq;
    const bf16* Ug = (const bf16*)(F.ws + WS_UT) + (size_t)unit0 * 8192 + (16 * 4 * dvh + l15) * 64 + 16 * ct + 4 * lq;
    bf16* OR = (bf16*)(F.ws + WS_OR);
    bx8 fW[4], fQ[4], fI[2], fK[2]; v2u fU[4];
#pragma unroll
    for (int ks = 0; ks < 4; ++ks) { fW[ks] = *(const bx8*)(Wg + 32 * ks); fQ[ks] = *(const bx8*)(Qg + 32 * ks); fU[ks] = *(const v2u*)(Ug + ks * 16 * 64); }
#pragma unroll
    for (int ks = 0; ks < 2; ++ks) { fI[ks] = *(const bx8*)(Ig + 32 * ks); fK[ks] = *(const bx8*)(Kg + 32 * ks); }
#pragma unroll
    for (int t = 0; t < 4; ++t) gn[t] = *(const f32x4*)(F.onorm_g + 16 * (4 * dvh + t) + 4 * lq);
    __syncthreads();
    for (int sI = 0; sI < 8; ++sI) {
        const float dec = sDEC[sI];
        const int nn = (sI < 7) ? 1 : 0;
        f32x4 pS[4], qS[4];
#pragma unroll
        for (int t = 0; t < 4; ++t) { bx8 fS[4];
#pragma unroll
            for (int ks = 0; ks < 4; ++ks) fS[ks] = *(const LAS bx8*)(sST + (16 * (4 * dvh + t) + l15) * 136 + 32 * ks + 8 * lq);
            f32x4 p = {0.f, 0.f, 0.f, 0.f}, q = {0.f, 0.f, 0.f, 0.f};
#pragma unroll
            for (int ks = 0; ks < 4; ++ks) { p = MFMA16(fW[ks], fS[ks], p); q = MFMA16(fS[ks], fQ[ks], q); }
            pS[t] = p; qS[t] = q; }
#pragma unroll
        for (int t = 0; t < 4; ++t) { const f32x4 u = {bflo(fU[t].x), bfhi(fU[t].x), bflo(fU[t].y), bfhi(fU[t].y)};
            *(LAS v2u*)(sVT + (16 * (4 * dvh + t) + l15) * 72 + 16 * ct + 4 * lq) = pack4(u - pS[t]); }
        Wg += nn * 8192; Qg += nn * 8192; Ug += nn * 8192;
#pragma unroll
        for (int ks = 0; ks < 4; ++ks) { fW[ks] = *(const bx8*)(Wg + 32 * ks); fQ[ks] = *(const bx8*)(Qg + 32 * ks); fU[ks] = *(const v2u*)(Ug + ks * 16 * 64); }
        __syncthreads();
        float ss = 0.f;
#pragma unroll
        for (int t = 0; t < 4; ++t) {
#pragma unroll
            for (int ks = 0; ks < 2; ++ks) { const bx8 fV = *(const LAS bx8*)(sVT + (16 * (4 * dvh + t) + l15) * 72 + 32 * ks + 8 * lq); qS[t] = MFMA16(fV, fI[ks], qS[t]); }
            ss += (qS[t][0] * qS[t][0] + qS[t][1] * qS[t][1]) + (qS[t][2] * qS[t][2] + qS[t][3] * qS[t][3]); }
        ss += __shfl_xor(ss, 16); ss += __shfl_xor(ss, 32);
        if (lq == 0) sSS[dvh * 64 + 16 * ct + l15] = ss;
        Ig += nn * 4096;
#pragma unroll
        for (int ks = 0; ks < 2; ++ks) fI[ks] = *(const bx8*)(Ig + 32 * ks);
#pragma unroll
        for (int t = 0; t < 8; ++t) { S[t] = S[t] * dec;
#pragma unroll
            for (int ks = 0; ks < 2; ++ks) { const bx8 fV = *(const LAS bx8*)(sVT + (16 * t + l15) * 72 + 32 * ks + 8 * lq); S[t] = MFMA16(fK[ks], fV, S[t]); }
            *(LAS v2u*)(sST + (16 * t + l15) * 136 + 16 * w + 4 * lq) = pack4(S[t]); }
        Kg += nn * 8192;
#pragma unroll
        for (int ks = 0; ks < 2; ++ks) fK[ks] = *(const bx8*)(Kg + 32 * ks);
        __syncthreads();
        const float rstd = __frsqrt_rn((sSS[16 * ct + l15] + sSS[64 + 16 * ct + l15]) * (1.0f / 128.0f) + EPS);
        bf16* orow = OR + (size_t)(b * T + (8 * g + sI) * CH + 16 * ct + l15) * D + h * 128 + 16 * 4 * dvh + 4 * lq;
#pragma unroll
        for (int t = 0; t < 4; ++t) *(v2u*)(orow + 16 * t) = pack4(qS[t] * rstd * gn[t]);
    }
    __syncthreads();
}

__device__ __forceinline__ void p8_router(Frame& F) {
    const int gw = blockIdx.x * NWAVES + F.wave, RPW = M / (F.G * NWAVES);
    bf16* H2 = (bf16*)(F.ws + WS_H2); int* TOKE = (int*)(F.ws + WS_TOKE); float* TOKW = (float*)(F.ws + WS_TOKW);
    LAS float* wT = (LAS float*)F.lds;
    LAS unsigned* hist = (LAS unsigned*)(wT + 36 * 1028);
    for (int i = F.tid; i < D * NGRP; i += 512) wT[(i & 3) * 1028 + (i >> 2)] = F.w_group[i];
    for (int i = F.tid; i < D * NE; i += 512) wT[(4 + (i & 31)) * 1028 + (i >> 5)] = F.w_expert[i];
    if (F.tid < NE) hist[F.tid] = 0u;
    __syncthreads();
    f32x4 gsc[4], gsh[4];
    { const int b = (gw * RPW) / T;
#pragma unroll
      for (int j = 0; j < 4; ++j) { const int col = 256 * j + 4 * F.lane; const f32x4 g2 = *(const f32x4*)(F.norm2_g + col);
          gsc[j] = g2 * (1.0f + *(const f32x4*)((const float*)(F.ws + CTL_MODACC) + b * 6144 + 4 * D + col)); gsh[j] = *(const f32x4*)((const float*)(F.ws + CTL_MODACC) + b * 6144 + 3 * D + col); } }
    for (int m = gw * RPW; m < (gw + 1) * RPW; ++m) {
        const f32x4* xr = (const f32x4*)(F.out + (size_t)m * D) + F.lane;
        f32x4 v[4]; float s = 0.f;
#pragma unroll
        for (int j = 0; j < 4; ++j) { v[j] = xr[64 * j]; s += (v[j].x * v[j].x + v[j].y * v[j].y) + (v[j].z * v[j].z + v[j].w * v[j].w); }
        const float rstd = __frsqrt_rn(wave_sum(s) * (1.f / D) + EPS);
#pragma unroll
        for (int j = 0; j < 4; ++j) { v[j] = v[j] * rstd * gsc[j] + gsh[j];
            *(v2u*)(H2 + (size_t)m * D + 256 * j + 4 * F.lane) = (v2u){pk2(v[j][0], v[j][1]), pk2(v[j][2], v[j][3])}; }
        float gp[4];
#pragma unroll
        for (int q = 0; q < 4; ++q) { float p = 0.f;
#pragma unroll
            for (int j = 0; j < 4; ++j) { const f32x4 w = *(const LAS f32x4*)(wT + q * 1028 + 256 * j + 4 * F.lane); p += (v[j][0] * w[0] + v[j][1] * w[1]) + (v[j][2] * w[2] + v[j][3] * w[3]); }
            gp[q] = p; }
        fold_step<4, 4>(gp, 32, (F.lane & 32) != 0); fold_step<2, 4>(gp, 16, (F.lane & 16) != 0);
        float gv = gp[0]; gv += __shfl_xor(gv, 8); gv += __shfl_xor(gv, 4); gv += __shfl_xor(gv, 2); gv += __shfl_xor(gv, 1);
        float gl[4];
#pragma unroll
        for (int q = 0; q < 4; ++q) gl[q] = readlane_f(gv, 32 * (q >> 1) + 16 * (q & 1)) + F.b_group[q];
        int gs = 0; float gm = gl[0];
#pragma unroll
        for (int q = 1; q < 4; ++q) if (gl[q] > gm) { gm = gl[q]; gs = q; }
        float den = 0.f;
#pragma unroll
        for (int q = 0; q < 4; ++q) den += __expf(gl[q] - gm);
        const float pg = 1.0f / den;
        float ep[8];
#pragma unroll
        for (int q = 0; q < 8; ++q) { float p = 0.f;
#pragma unroll
            for (int j = 0; j < 4; ++j) { const f32x4 w = *(const LAS f32x4*)(wT + (4 + gs * 8 + q) * 1028 + 256 * j + 4 * F.lane); p += (v[j][0] * w[0] + v[j][1] * w[1]) + (v[j][2] * w[2] + v[j][3] * w[3]); }
            ep[q] = p; }
        fold_step<8, 8>(ep, 32, (F.lane & 32) != 0); fold_step<4, 8>(ep, 16, (F.lane & 16) != 0); fold_step<2, 8>(ep, 8, (F.lane & 8) != 0);
        float ev = ep[0]; ev += __shfl_xor(ev, 4); ev += __shfl_xor(ev, 2); ev += __shfl_xor(ev, 1);
        float el[8];
#pragma unroll
        for (int q = 0; q < 8; ++q) el[q] = readlane_f(ev, 32 * (q >> 2) + 16 * ((q >> 1) & 1) + 8 * (q & 1)) + F.b_expert[gs * 8 + q];
        int i0 = 0; float v0 = el[0];
#pragma unroll
        for (int q = 1; q < 8; ++q) if (el[q] > v0) { v0 = el[q]; i0 = q; }
        int i1 = -1; float v1 = -3.0e38f;
#pragma unroll
        for (int q = 0; q < 8; ++q) if (q != i0 && el[q] > v1) { v1 = el[q]; i1 = q; }
        const float e1 = __expf(v1 - v0), sw = 1.0f / (1.0f + e1);
        if (F.lane == 0) {
            const int ea = gs * 8 + i0, eb = gs * 8 + i1;
            TOKE[m * 2] = ea; TOKE[m * 2 + 1] = eb; TOKW[m * 2] = pg * sw; TOKW[m * 2 + 1] = pg * e1 * sw;
            __hip_atomic_fetch_add((unsigned*)(hist + ea), 1u, __ATOMIC_RELAXED, __HIP_MEMORY_SCOPE_WORKGROUP); __hip_atomic_fetch_add((unsigned*)(hist + eb), 1u, __ATOMIC_RELAXED, __HIP_MEMORY_SCOPE_WORKGROUP);
        }
    }
    __syncthreads();
    if (F.tid < NE) ((unsigned*)(F.ws + WS_WGHIST))[blockIdx.x * NE + F.tid] = hist[F.tid];
}
__device__ __forceinline__ int moe_tables(Frame& F) {
    volatile LAS int* ps = (volatile LAS int*)(F.lds + MISC_OFF + 64); volatile LAS int* te = (volatile LAS int*)(F.lds + MISC_OFF + 256);
    volatile LAS int* tot = (volatile LAS int*)(F.lds + MISC_OFF + 1024); volatile LAS int* base = (volatile LAS int*)(F.lds + MISC_OFF + 1152);
    LAS int* part = (LAS int*)(F.lds + MISC_OFF - 4096);
    const unsigned* WGH = (const unsigned*)(F.ws + WS_WGHIST);
    __syncthreads();
    { const int e = F.tid & 31, p = F.tid >> 5; int t = 0, bsum = 0;
      for (int j = p; j < F.G; j += 16) { const int v = (int)WGH[j * NE + e]; t += v; bsum += (j < (int)blockIdx.x) ? v : 0; }
      part[p * 32 + e] = t; part[512 + p * 32 + e] = bsum; }
    __syncthreads();
    if (F.tid < 32) { int t = 0, bsum = 0;
#pragma unroll
        for (int p = 0; p < 16; ++p) { t += part[p * 32 + F.tid]; bsum += part[512 + p * 32 + F.tid]; }
        tot[F.tid] = t; base[F.tid] = bsum; }
    __syncthreads();
    if (F.tid == 0) { int a = 0;
        for (int e = 0; e < NE; ++e) { const int cnt = tot[e]; ps[e] = a; const int nb = (cnt + 255) >> 8;
            for (int r = 0; r < nb; ++r) te[(a >> 8) + r] = e; a += nb << 8; }
        ps[32] = a; }
    __syncthreads();
    return ps[32] >> 8;
}
__device__ __forceinline__ void p9_gather(Frame& F) {
    moe_tables(F);
    volatile LAS int* ps = (volatile LAS int*)(F.lds + MISC_OFF + 64); volatile LAS int* tot = (volatile LAS int*)(F.lds + MISC_OFF + 1024); volatile LAS int* base = (volatile LAS int*)(F.lds + MISC_OFF + 1152);
    LAS unsigned* lcur = (LAS unsigned*)F.lds;
    if (F.tid < NE) lcur[F.tid] = 0u;
    __syncthreads();
    const int gw = blockIdx.x * NWAVES + F.wave, RPW = M / (F.G * NWAVES);
    int* ROWTOK = (int*)(F.ws + WS_ROWTOK); float* ROWW = (float*)(F.ws + WS_ROWW);
    const int* TOKE = (const int*)(F.ws + WS_TOKE); const float* TOKW = (const float*)(F.ws + WS_TOKW);
    const bf16* H2 = (const bf16*)(F.ws + WS_H2); bf16* XS = (bf16*)(F.ws + WS_XS);
    for (int e = blockIdx.x; e < NE; e += F.G) for (int r = ps[e] + tot[e] + F.tid; r < ps[e + 1]; r += 512) ROWTOK[r] = -1;
    for (int m = gw * RPW; m < (gw + 1) * RPW; ++m) {
        int pos = 0;
        if (F.lane < 2) { const int e = TOKE[m * 2 + F.lane]; pos = ps[e] + base[e] + (int)__hip_atomic_fetch_add((unsigned*)(lcur + e), 1u, __ATOMIC_RELAXED, __HIP_MEMORY_SCOPE_WORKGROUP); ROWTOK[pos] = m * 2 + F.lane; ROWW[pos] = TOKW[m * 2 + F.lane]; }
        const int p0 = __shfl(pos, 0), p1 = __shfl(pos, 1);
        const v4u a = *((const v4u*)(H2 + (size_t)m * D) + F.lane), bb = *((const v4u*)(H2 + (size_t)m * D) + 64 + F.lane);
        *((v4u*)(XS + (size_t)p0 * D) + F.lane) = a; *((v4u*)(XS + (size_t)p0 * D) + 64 + F.lane) = bb;
        *((v4u*)(XS + (size_t)p1 * D) + F.lane) = a; *((v4u*)(XS + (size_t)p1 * D) + 64 + F.lane) = bb;
    }
}
__device__ __forceinline__ void p12_final(Frame& F) {
    const int gw = blockIdx.x * NWAVES + F.wave, RPW = M / (F.G * NWAVES);
    const bf16* YBUF = (const bf16*)(F.ws + WS_YBUF);
    f32x4 gt[4], gf[4];
    { const int b = (gw * RPW) / T;
#pragma unroll
      for (int j = 0; j < 4; ++j) { gt[j] = *(const f32x4*)((const float*)(F.ws + CTL_MODACC) + b * 6144 + 5 * D + 256 * j + 4 * F.lane); gf[j] = *(const f32x4*)(F.normf_g + 256 * j + 4 * F.lane); } }
    for (int m = gw * RPW; m < (gw + 1) * RPW; ++m) {
        f32x4* xr = (f32x4*)(F.out + (size_t)m * D) + F.lane;
        f32x4 v[4]; float s = 0.f;
#pragma unroll
        for (int j = 0; j < 4; ++j) { const int col = 256 * j + 4 * F.lane; v[j] = xr[64 * j];
            const v2u y0 = *(const v2u*)(YBUF + (size_t)(2 * m) * D + col), y1 = *(const v2u*)(YBUF + (size_t)(2 * m + 1) * D + col);
            const f32x4 ys = {bflo(y0.x) + bflo(y1.x), bfhi(y0.x) + bfhi(y1.x), bflo(y0.y) + bflo(y1.y), bfhi(y0.y) + bfhi(y1.y)};
            v[j] += gt[j] * ys;
            s += (v[j].x * v[j].x + v[j].y * v[j].y) + (v[j].z * v[j].z + v[j].w * v[j].w); }
        const float rstd = __frsqrt_rn(wave_sum(s) * (1.f / D) + EPS);
#pragma unroll
        for (int j = 0; j < 4; ++j) xr[64 * j] = v[j] * rstd * gf[j];
    }
}

constexpr int NPH = 16;
struct Args { const float* in[23]; float* out; unsigned char* ws; int ph_lo, ph_hi; };
__global__ void __launch_bounds__(NWAVES * 64, 2) fwd(Args args) {
    extern __shared__ __attribute__((aligned(16))) unsigned char lds[];
    Frame F;
    F.lds = (LAS unsigned char*)lds; F.MISC = (volatile LAS unsigned*)(F.lds + MISC_OFF);
    F.tid = threadIdx.x; F.lane = F.tid & 63; F.wave = __builtin_amdgcn_readfirstlane(F.tid >> 6);
    F.G = gridDim.x; { const int bx = blockIdx.x; F.vcu = (F.G % 8 == 0) ? (bx % 8) * (F.G / 8) + bx / 8 : bx; }
    F.ws = args.ws; F.out = args.out; F.ctl = (unsigned*)(args.ws + WS_CTL);
    F.x = args.in[0]; F.c = args.in[1]; F.w_ada = args.in[2]; F.b_ada = args.in[3]; F.norm1_g = args.in[4]; F.w_in = args.in[5]; F.conv_qkv_w = args.in[6];
    F.a_log = args.in[7]; F.dt_bias = args.in[8]; F.onorm_g = args.in[9]; F.w_proj_a = args.in[10]; F.conv_sc_w = args.in[11]; F.w_proj_b = args.in[12]; F.w_out = args.in[13];
    F.norm2_g = args.in[14]; F.w_group = args.in[15]; F.b_group = args.in[16]; F.w_expert = args.in[17]; F.b_expert = args.in[18]; F.w1 = args.in[19]; F.w3 = args.in[20];
    F.w2 = args.in[21]; F.normf_g = args.in[22];
    if (F.tid < 4) F.MISC[F.tid] = 0u;
    __syncthreads();
    const int lo = args.ph_lo, hi = args.ph_hi;
    const bool fused = (hi - lo) > 1;
    XcdBarrier bar; bar.bar = F.ctl + CW_BAR; bar.x = 0; bar.st = F.MISC;
    if (fused) bar = xcd_barrier_post(F.ctl + CW_BAR, F.MISC);
#ifndef PH_MASK
#define PH_MASK 0xFFFFFFFFu
#endif
#define IN(k) (((PH_MASK >> (k)) & 1) && lo <= (k) && (k) < hi)
#define SEAM(k) do { if (IN(k) && IN((k) + 1)) xcd_barrier(bar); } while (0)
    bf16* H = (bf16*)F.out; bf16* YBP = (bf16*)F.out + (size_t)M * D;

    if (IN(0)) { p0_prologue(F); } SEAM(0);
    if (IN(1)) { p1_norm1(F); } SEAM(1);
    if (IN(2)) {
        pg8::Gemm g{H, (const bf16*)(F.ws + WS_WINA), M, 6144, D}; pg8::StaticOrder S; S.init(M, 6144, F.G, (int)blockIdx.x);
        EpiInA E{(bf16*)(F.ws + WS_QKV), (bf16*)(F.ws + WS_SB), (bf16*)(F.ws + WS_P)};
        pg8::gemm_phase<EpiInA, pg8::StaticOrder, true, true>(F.lds, g, S, E);
    } SEAM(2);
    if (IN(3)) { p3a_ybp(F); p3b_loop(F); } SEAM(3);
    if (IN(4)) {
        pg8::Gemm g{YBP, (const bf16*)(F.ws + WS_WB), M, D, D}; pg8::StaticOrder S; S.init(M, D, F.G, (int)blockIdx.x);
        EpiPlain E{(bf16*)(F.ws + WS_YB), D};
        pg8::gemm_phase<EpiPlain, pg8::StaticOrder, true, true>(F.lds, g, S, E);
    } SEAM(4);
    if (IN(5)) { for (int it = blockIdx.x; it < NB * NH * 16; it += F.G) p4a_seg(F, it); } SEAM(5);
    if (IN(6)) { for (int it = blockIdx.x; it < NB * NH * 4; it += F.G) p4b_fold(F, it); p_moe_weights(F); } SEAM(6);
    if (IN(7)) { for (int it = blockIdx.x; it < NB * NH * 16; it += F.G) p4c_seg(F, it); } SEAM(7);
    if (IN(8)) {
        pg8::Gemm g{H, (const bf16*)(F.ws + WS_WINB), M, 3072, D}; pg8::StaticOrder S; S.init(M, 3072, F.G, (int)blockIdx.x);
        EpiInB E{F.ws};
        pg8::gemm_phase<EpiInB, pg8::StaticOrder, true, true>(F.lds, g, S, E);
    } SEAM(8);
    if (IN(9)) {
        pg8::Gemm g{(const bf16*)(F.ws + WS_OR), (const bf16*)(F.ws + WS_WA), M, D, D}; pg8::StaticOrder S; S.init(M, D, F.G, (int)blockIdx.x);
        EpiMerge E{(const bf16*)(F.ws + WS_GA), (const bf16*)(F.ws + WS_GB), (const bf16*)(F.ws + WS_YB), (bf16*)(F.ws + WS_GA)};
        pg8::gemm_phase<EpiMerge, pg8::StaticOrder, true, true>(F.lds, g, S, E);
    } SEAM(9);
    if (IN(10)) {
        pg8::Gemm g{(const bf16*)(F.ws + WS_GA), (const bf16*)(F.ws + WS_WO), M, D, D}; pg8::StaticOrder S; S.init(M, D, F.G, (int)blockIdx.x);
        EpiX1 E{F.x, F.out, (const float*)(F.ws + CTL_MODACC), F.b_ada};
        pg8::gemm_phase<EpiX1, pg8::StaticOrder, true, true>(F.lds, g, S, E);
    } SEAM(10);
    if (IN(11)) { p8_router(F); } SEAM(11);
    if (IN(12)) { p9_gather(F); } SEAM(12);
    if (IN(13)) {
        const int nt = moe_tables(F);
        pg8::Gemm g{(const bf16*)(F.ws + WS_XS), (const bf16*)(F.ws + WS_W13), MOE_CAP, NE * D, D};
        MoeOrder S{nt, F.G, (int)blockIdx.x, (const volatile LAS int*)(F.lds + MISC_OFF + 256)};
        EpiHid E{(bf16*)(F.ws + WS_HID)};
        pg8::gemm_phase<EpiHid, MoeOrder, true, true>(F.lds, g, S, E);
    } SEAM(13);
    if (IN(14)) {
        const int nt = moe_tables(F);
        pg8::Gemm g{(const bf16*)(F.ws + WS_HID), (const bf16*)(F.ws + WS_W2), MOE_CAP, NE * D, DE};
        MoeOrder S{nt, F.G, (int)blockIdx.x, (const volatile LAS int*)(F.lds + MISC_OFF + 256)};
        EpiMoeOut E{(bf16*)(F.ws + WS_YBUF), (const int*)(F.ws + WS_ROWTOK), (const float*)(F.ws + WS_ROWW)};
        pg8::gemm_phase<EpiMoeOut, MoeOrder, true, true>(F.lds, g, S, E);
    } SEAM(14);
    if (IN(15)) { p12_final(F); }
#undef IN
#undef SEAM
}

extern "C" void kernel_launch(void* const* d_in, const int* in_sizes, int n_in, void* d_out, int out_size, void* d_ws, size_t ws_size, hipStream_t stream) {
    static int grid = 0;
    if (grid == 0) {
        if (n_in != 23 || out_size != M * D || ws_size < WS_END) { fprintf(stderr, "kernel_launch: unexpected problem (n_in %d, out %d, ws %zu)\n", n_in, out_size, ws_size); grid = -1; return; }
        int dev = 0, cus = 0, per_cu = 0;
        if (hipGetDevice(&dev) != hipSuccess || hipDeviceGetAttribute(&cus, hipDeviceAttributeMultiprocessorCount, dev) != hipSuccess) { grid = -1; return; }
        if (hipFuncSetAttribute((const void*)fwd, hipFuncAttributeMaxDynamicSharedMemorySize, LDS_BYTES) != hipSuccess) { fprintf(stderr, "kernel_launch: hipFuncSetAttribute failed\n"); grid = -1; return; }
        if (hipOccupancyMaxActiveBlocksPerMultiprocessor(&per_cu, (const void*)fwd, NWAVES * 64, LDS_BYTES) != hipSuccess || per_cu < 1) { fprintf(stderr, "kernel_launch: occupancy query says %d\n", per_cu); }
        (void)hipGetLastError();
        grid = cus;
        if (M % (grid * NWAVES) != 0 || grid < 64) { fprintf(stderr, "kernel_launch: unsupported CU count %d\n", cus); grid = -1; return; }
    }
    if (grid < 0) return;
    (void)hipMemsetAsync((char*)d_ws + WS_CTL, 0, CTL_ZERO_BYTES, stream);
    Args a{};
    for (int i = 0; i < 23; ++i) a.in[i] = (const float*)d_in[i];
    a.out = (float*)d_out; a.ws = (unsigned char*)d_ws;
#ifndef MK_FUSED
#define MK_FUSED 1
#endif
#ifdef PROBE_DUP
    { const int cuts[4] = {0, PROBE_DUP + 1, PROBE_DUP, NPH}; const int ends[3] = {PROBE_DUP + 1, PROBE_DUP + 1, NPH};
      for (int li = 0; li < 3; ++li) { a.ph_lo = (li == 0) ? 0 : (li == 1 ? PROBE_DUP : PROBE_DUP + 1); a.ph_hi = ends[li]; (void)cuts;
          hipMemsetAsync((char*)d_ws + WS_CTL + CW_BAR * 4, 0, XCD_BAR_WORDS * 4, stream);
          if (a.ph_lo < a.ph_hi) hipLaunchKernelGGL(fwd, dim3(grid), dim3(NWAVES * 64), LDS_BYTES, stream, a); } return; }
#endif
    if (MK_FUSED) { a.ph_lo = 0; a.ph_hi = NPH; hipLaunchKernelGGL(fwd, dim3(grid), dim3(NWAVES * 64), LDS_BYTES, stream, a); }
    else for (int p = 0; p < NPH; ++p) { a.ph_lo = p; a.ph_hi = p + 1; hipLaunchKernelGGL(fwd, dim3(grid), dim3(NWAVES * 64), LDS_BYTES, stream, a); }
}
```

```cpp
#include <hip/hip_runtime.h>
#include <cstdio>
#include <cstdint>
namespace pg8 {
#define PG8_LAS __attribute__((address_space(3)))
typedef unsigned short bf16_t;
typedef short bf16x8 __attribute__((ext_vector_type(8)));
typedef float f32x4 __attribute__((ext_vector_type(4)));
typedef unsigned u32x4 __attribute__((ext_vector_type(4)));
constexpr int BM = 256, BK = 64, HALF = 128, HTB = HALF * BK * 2  , STAGE_BYTES = 8 * HTB, NXCD = 8, WGM = 8;

__host__ __device__ __forceinline__ int lds_byte(int r, int c) { const int st = (r >> 4) * 2 + (c >> 5), rr = r & 15, cc = c & 31, ob = rr * 64 + cc * 2; return st * 1024 + (ob ^ (((ob >> 9) & 1) << 5)); }
__host__ __device__ __forceinline__ void stage_rc(int b, int& R, int& C) { const int st = b / 1024, sb = b % 1024, swz = sb ^ (((sb >> 9) & 1) << 5); R = (st >> 1) * 16 + swz / 64; C = (st & 1) * 32 + (swz % 64) / 2; }
__host__ __device__ __forceinline__ int perm32(int rho) { const int n = rho >> 4, i = rho & 15; return 8 * (i >> 2) + 4 * n + (i & 3); }

struct Unit { int pm, pn; };
struct Gemm { const bf16_t* A; const bf16_t* Bt; int M, N, K; };

struct StaticOrder {
    int nM, nN, nwg, G, c;
    __host__ __device__ void init(int M, int N, int G_, int c_) { nM = M / BM; nN = N / BM; nwg = nM * nN; G = G_; c = c_; }
    __host__ __device__ bool next(int i, Unit& u) const {
        const long L = (long)i * G + c; if (L >= nwg) return false;
        int wgid = (int)L; { const int q = nwg / NXCD, r = nwg % NXCD, xcd = wgid % NXCD, off = wgid / NXCD; wgid = (xcd < r ? xcd * (q + 1) : r * (q + 1) + (xcd - r) * q) + off; }
        const int nig = WGM * nN, gid = wgid / nig, fm = gid * WGM, gsz = (nM - fm) < WGM ? (nM - fm) : WGM;
        u.pm = fm + ((wgid % nig) % gsz); u.pn = (wgid % nig) / gsz; return true;
    }
    __device__ __forceinline__ void a_ready(const Unit&) const {}
    __device__ __forceinline__ void done(const Unit&) const {}
};

typedef float f32x2_cv __attribute__((ext_vector_type(2)));
typedef __bf16 bf16x2_cv __attribute__((ext_vector_type(2)));
__device__ __forceinline__ unsigned cvt_pk_bf16(float lo, float hi) { const f32x2_cv v = {lo, hi}; return __builtin_bit_cast(unsigned, __builtin_convertvector(v, bf16x2_cv)); }
template <class Epi, class Sched, bool ALIGN_EPI = false, bool SP2 = false>
__device__ __forceinline__ void gemm_phase(PG8_LAS unsigned char* lds, const Gemm g, const Sched& S, const Epi& E) {
    const int tid = threadIdx.x, wid = __builtin_amdgcn_readfirstlane(tid >> 6), lane = tid & 63, wr = wid >> 2, wc = wid & 3, fr = lane & 15, fq = lane >> 4;
    const int K = g.K, nt = K / BK;
    unsigned voffA[2], voffB[2];
#pragma unroll
    for (int i = 0; i < 2; ++i) { int R, C; stage_rc(tid * 16 + i * 8192, R, C); const int Rb = Epi::PERM ? ((R & ~31) + perm32(R & 31)) : R;
        voffA[i] = (unsigned)(R * K + C) * 2u; voffB[i] = (unsigned)(Rb * K + C) * 2u; }
    const size_t kstep = (size_t)(BK * 2);
    const size_t hstep = (size_t)HALF * K * 2;
    const size_t tstep = 2 * hstep;
    const unsigned ldsw = (unsigned)wid * 1024u;
    const int aoff = lds_byte(wr * 64 + fr, fq * 8), boff = lds_byte(wc * 32 + fr, fq * 8);
#define PG8_SA(b, h) (((b) * 2 + (h)) * HTB)
#define PG8_SB(b, h) ((4 + (b) * 2 + (h)) * HTB)
#define PG8_STAGE(bufoff, gbase, voff) do { _Pragma("unroll") for (int _i = 0; _i < 2; ++_i) \
        __builtin_amdgcn_global_load_lds((const unsigned*)((const char*)(gbase) + (voff)[_i]), (PG8_LAS unsigned*)(lds + (bufoff) + ldsw + _i * 8192), 16, 0, 0); } while (0)
#define PG8_LDA(dst, b, h) do { _Pragma("unroll") for (int m = 0; m < 4; ++m) _Pragma("unroll") for (int k = 0; k < 2; ++k) dst[m][k] = *(const PG8_LAS bf16x8*)(lds + PG8_SA(b, h) + aoff + m * 2048 + k * 1024); } while (0)
#define PG8_LDB(dst, b, h) do { _Pragma("unroll") for (int n = 0; n < 2; ++n) _Pragma("unroll") for (int k = 0; k < 2; ++k) dst[n][k] = *(const PG8_LAS bf16x8*)(lds + PG8_SB(b, h) + boff + n * 2048 + k * 1024); } while (0)
#define PG8_MMA(ai, bj, At, Bt) do { __builtin_amdgcn_s_setprio(1); _Pragma("unroll") for (int m = 0; m < 4; ++m) _Pragma("unroll") for (int n = 0; n < 2; ++n) _Pragma("unroll") for (int k = 0; k < 2; ++k) \
        acc[ai][bj][m][n] = __builtin_amdgcn_mfma_f32_16x16x32_bf16(Bt[n][k], At[m][k], acc[ai][bj][m][n], 0, 0, 0); __builtin_amdgcn_s_setprio(0); } while (0)
#define PG8_WAIT_V(n) asm volatile("s_waitcnt vmcnt(" #n ")" ::: "memory")
#define PG8_WAIT_L(n) asm volatile("s_waitcnt lgkmcnt(" #n ")" ::: "memory")
#define PG8_BAR __builtin_amdgcn_s_barrier()
#define PG8_SCHED __builtin_amdgcn_sched_barrier(0)
    Unit cur, nxt; int ui = 0;
    if (!S.next(0, cur)) return;
    f32x4 acc[2][2][4][2];
#pragma unroll
    for (int a = 0; a < 2; ++a)
#pragma unroll
        for (int b = 0; b < 2; ++b)
#pragma unroll
            for (int m = 0; m < 4; ++m)
#pragma unroll
                for (int n = 0; n < 2; ++n) acc[a][b][m][n] = (f32x4){0.f, 0.f, 0.f, 0.f};
    bf16x8 At[4][2], B0[2][2], B1[2][2];
    const char* cA = (const char*)g.A + (size_t)cur.pm * tstep; const char* cB = (const char*)g.Bt + (size_t)cur.pn * tstep;
    S.a_ready(cur);
    if constexpr (SP2) {
        PG8_STAGE(PG8_SB(0, 0), cB, voffB); PG8_STAGE(PG8_SB(0, 1), cB + hstep, voffB); PG8_STAGE(PG8_SA(0, 0), cA, voffA); PG8_STAGE(PG8_SA(0, 1), cA + hstep, voffA);
        if (wr == 1) PG8_BAR;
        PG8_WAIT_V(2); PG8_BAR;
        PG8_STAGE(PG8_SB(1, 0), cB + kstep, voffB); PG8_STAGE(PG8_SA(1, 0), cA + kstep, voffA); PG8_STAGE(PG8_SB(1, 1), cB + hstep + kstep, voffB);
        PG8_WAIT_V(6); PG8_BAR;
    } else {
        PG8_STAGE(PG8_SB(0, 0), cB, voffB); PG8_STAGE(PG8_SA(0, 0), cA, voffA); PG8_STAGE(PG8_SB(0, 1), cB + hstep, voffB); PG8_STAGE(PG8_SA(0, 1), cA + hstep, voffA);
        if (wr == 1) PG8_BAR;
        PG8_WAIT_V(4); PG8_BAR;
        PG8_STAGE(PG8_SB(1, 0), cB + kstep, voffB); PG8_STAGE(PG8_SA(1, 0), cA + kstep, voffA); PG8_STAGE(PG8_SB(1, 1), cB + hstep + kstep, voffB);
        PG8_WAIT_V(6); PG8_BAR;
    }
    for (;;) {
        const bool has_next = S.next(ui + 1, nxt);
        const char* nA = has_next ? (const char*)g.A + (size_t)nxt.pm * tstep : cA; const char* nB = has_next ? (const char*)g.Bt + (size_t)nxt.pn * tstep : cB;
        for (int t = 0; t < nt; t += 2) {
            const bool last = (t == nt - 2);
            const char* a1 = cA + (size_t)(t + 1) * kstep;
            const char* a2 = last ? nA : cA + (size_t)(t + 2) * kstep; const char* b2 = last ? nB : cB + (size_t)(t + 2) * kstep;
            const char* a3 = a2 + kstep; const char* b3 = b2 + kstep;
            if (last && has_next) S.a_ready(nxt);
            if constexpr (SP2) {
            PG8_LDB(B0, 0, 0); PG8_LDB(B1, 0, 1); PG8_SCHED; PG8_LDA(At, 0, 0); PG8_STAGE(PG8_SA(1, 1), a1 + hstep, voffA);
            PG8_WAIT_V(8); PG8_WAIT_L(0); PG8_BAR; PG8_MMA(0, 0, At, B0); PG8_MMA(0, 1, At, B1); PG8_BAR; PG8_SCHED;
            PG8_LDA(At, 0, 1); PG8_STAGE(PG8_SB(0, 0), b2, voffB); PG8_STAGE(PG8_SB(0, 1), b2 + hstep, voffB); PG8_STAGE(PG8_SA(0, 0), a2, voffA);
            PG8_WAIT_V(8); PG8_WAIT_L(0); PG8_BAR; PG8_MMA(1, 0, At, B0); PG8_MMA(1, 1, At, B1); PG8_BAR; PG8_SCHED;
            PG8_LDB(B0, 1, 0); PG8_LDB(B1, 1, 1); PG8_SCHED; PG8_LDA(At, 1, 0); PG8_STAGE(PG8_SA(0, 1), a2 + hstep, voffA);
            PG8_WAIT_V(8); PG8_WAIT_L(0); PG8_BAR; PG8_MMA(0, 0, At, B0); PG8_MMA(0, 1, At, B1); PG8_BAR; PG8_SCHED;
            PG8_LDA(At, 1, 1); PG8_STAGE(PG8_SB(1, 0), b3, voffB); PG8_STAGE(PG8_SB(1, 1), b3 + hstep, voffB); PG8_STAGE(PG8_SA(1, 0), a3, voffA);
            PG8_WAIT_V(8); PG8_WAIT_L(0); PG8_BAR; PG8_MMA(1, 0, At, B0); PG8_MMA(1, 1, At, B1); PG8_BAR; PG8_SCHED;
            } else {
            PG8_LDB(B0, 0, 0); PG8_SCHED; PG8_LDA(At, 0, 0); PG8_STAGE(PG8_SA(1, 1), a1 + hstep, voffA);
            PG8_WAIT_L(8); PG8_BAR; PG8_WAIT_L(0); PG8_MMA(0, 0, At, B0); PG8_BAR; PG8_SCHED;
            PG8_LDB(B1, 0, 1); PG8_STAGE(PG8_SB(0, 0), b2, voffB);
            PG8_BAR; PG8_WAIT_L(0); PG8_MMA(0, 1, At, B1); PG8_BAR;
            PG8_LDA(At, 0, 1); PG8_STAGE(PG8_SA(0, 0), a2, voffA);
            PG8_BAR; PG8_WAIT_L(0); PG8_MMA(1, 0, At, B0); PG8_BAR; PG8_SCHED;
            PG8_STAGE(PG8_SB(0, 1), b2 + hstep, voffB);
            PG8_WAIT_V(6); PG8_BAR; PG8_MMA(1, 1, At, B1); PG8_BAR;
            PG8_LDB(B0, 1, 0); PG8_SCHED; PG8_LDA(At, 1, 0); PG8_STAGE(PG8_SA(0, 1), a2 + hstep, voffA);
            PG8_WAIT_L(8); PG8_BAR; PG8_WAIT_L(0); PG8_MMA(0, 0, At, B0); PG8_BAR; PG8_SCHED;
            PG8_LDB(B1, 1, 1); PG8_STAGE(PG8_SB(1, 0), b3, voffB);
            PG8_BAR; PG8_WAIT_L(0); PG8_MMA(0, 1, At, B1); PG8_BAR;
            PG8_LDA(At, 1, 1); PG8_STAGE(PG8_SA(1, 0), a3, voffA);
            PG8_BAR; PG8_WAIT_L(0); PG8_MMA(1, 0, At, B0); PG8_BAR; PG8_SCHED;
            PG8_STAGE(PG8_SB(1, 1), b3 + hstep, voffB);
            PG8_WAIT_V(6); PG8_BAR; PG8_MMA(1, 1, At, B1); PG8_BAR;
            }
        }
        if constexpr (ALIGN_EPI) { if (wr == 0) PG8_BAR; }
        if constexpr (!Epi::AFTER_DRAIN) { E(acc, cur, wr, wc, fr, fq); S.done(cur); }
        if (!has_next) break;
#pragma unroll
        for (int a = 0; a < 2; ++a)
#pragma unroll
            for (int b = 0; b < 2; ++b)
#pragma unroll
                for (int m = 0; m < 4; ++m)
#pragma unroll
                    for (int n = 0; n < 2; ++n) acc[a][b][m][n] = (f32x4){0.f, 0.f, 0.f, 0.f};
        cur = nxt; cA = nA; cB = nB; ++ui;
        if constexpr (ALIGN_EPI) { if (wr == 1) PG8_BAR; }
    }
    PG8_WAIT_V(0);
    if constexpr (!ALIGN_EPI) { if (wr == 0) PG8_BAR; }
    PG8_BAR;
    if constexpr (Epi::AFTER_DRAIN) { E.fused(acc, cur, wr, wc, fr, fq, lds, wid, lane); S.done(cur); }
#undef PG8_SA
#undef PG8_SB
#undef PG8_STAGE
#undef PG8_LDA
#undef PG8_LDB
#undef PG8_MMA
#undef PG8_WAIT_V
#undef PG8_WAIT_L
#undef PG8_BAR
#undef PG8_SCHED
}
}

constexpr int NB = 2, T = 8192, D = 1024, M = NB * T;
constexpr int NH = 8, DK = 128, DV = 128, CH = 64, NCH = T / CH;
constexpr int NQKV = 3072, IN_TOTAL = 9232;
constexpr int NE = 32, EPG = 8, NGRP = 4, DE = 512;
constexpr int NUNIT = NB * NH * NCH;
constexpr float EPS = 1e-6f;
constexpr int MOE_CAP = 40960;
constexpr int NWAVES = 8;

constexpr size_t MiB = 1u << 20;
constexpr size_t WS_CTL = 0, CTL_ZERO_BYTES = 1 * MiB;
constexpr size_t WS_BG = 1 * MiB;
constexpr size_t WS_TOKE = 2 * MiB;
constexpr size_t WS_TOKW = WS_TOKE + 128 * 1024;
constexpr size_t WS_ROWTOK = WS_TOKE + 256 * 1024;
constexpr size_t WS_ROWW = WS_TOKE + 512 * 1024;
constexpr size_t WS_DEC = 3 * MiB;
constexpr size_t WS_WGHIST = 3 * MiB + 64 * 1024;
constexpr size_t WS_WINA = 4 * MiB;
constexpr size_t WS_IN = 4 * MiB;
constexpr size_t WS_WINB = 20 * MiB;
constexpr size_t WS_WA = 27 * MiB, WS_WB = 29 * MiB, WS_WO = 31 * MiB;
constexpr size_t WS_QKV = 33 * MiB;
constexpr size_t WS_W13 = 33 * MiB;
constexpr size_t WS_W2 = 97 * MiB;
constexpr size_t WS_SB = 129 * MiB, WS_YB = 129 * MiB;
constexpr size_t WS_P = 161 * MiB, WS_OR = 161 * MiB;
constexpr size_t WS_UT = 193 * MiB, WS_W = 225 * MiB, WS_QD = 257 * MiB, WS_KDT = 289 * MiB;
constexpr size_t WS_GA = 193 * MiB, WS_GB = 225 * MiB;
constexpr size_t WS_H2 = 257 * MiB;
constexpr size_t WS_XS = 129 * MiB;
constexpr size_t WS_HID = 209 * MiB;
constexpr size_t WS_YBUF = 129 * MiB;
constexpr size_t OUT_PHI = 32 * MiB, OUT_LSEG = 40 * MiB;
constexpr size_t WS_END = 321 * MiB;
constexpr int CW_TMO = 0, CW_BAR = 4096, CW_Q = 8192;
constexpr size_t CTL_MODACC = 64 * 1024;
constexpr size_t CTL_SSQ = 128 * 1024;
constexpr int LDS_BYTES = 163840, MISC_OFF = LDS_BYTES - 2048;

#define GAS __attribute__((address_space(1)))
#define LAS __attribute__((address_space(3)))
typedef unsigned short bf16;
typedef unsigned v4u __attribute__((ext_vector_type(4)));
typedef unsigned v2u __attribute__((ext_vector_type(2)));
typedef float f32x4 __attribute__((ext_vector_type(4)));
#define LDS_WAIT() asm volatile("s_waitcnt lgkmcnt(0)" ::: "memory")
__device__ __forceinline__ unsigned f2bf(float f) { unsigned u = __builtin_bit_cast(unsigned, f); return (u + 0x7fffu + ((u >> 16) & 1u)) >> 16; }
__device__ __forceinline__ unsigned pk2(float lo, float hi) { return f2bf(lo) | (f2bf(hi) << 16); }
__device__ __forceinline__ float bf2f(unsigned short b) { return __builtin_bit_cast(float, ((unsigned)b) << 16); }
__device__ __forceinline__ float bflo(unsigned w) { return __builtin_bit_cast(float, w << 16); }
__device__ __forceinline__ float bfhi(unsigned w) { return __builtin_bit_cast(float, w & 0xffff0000u); }
__device__ __forceinline__ float sigmoidf_(float x) { return __builtin_amdgcn_rcpf(1.0f + __expf(-x)); }
__device__ __forceinline__ float siluf_(float x) { return x * __builtin_amdgcn_rcpf(1.0f + __expf(-x)); }
__device__ __forceinline__ float readlane_f(float v, int l) { return __builtin_bit_cast(float, __builtin_amdgcn_readlane(__builtin_bit_cast(int, v), l)); }
__device__ __forceinline__ float wave_sum(float v) {
#pragma unroll
    for (int o = 1; o < 64; o <<= 1) v += __shfl_xor(v, o);
    return v;
}


template <int N, int CAP> __device__ __forceinline__ void fold_step(float (&v)[CAP], int xr, bool bit) {
#pragma unroll
    for (int i = 0; i < N / 2; ++i) { const float send = bit ? v[i] : v[i + N / 2]; const float keep = bit ? v[i + N / 2] : v[i]; v[i] = keep + __shfl_xor(send, xr); }
}

#define XB_TMO      128
#define XB_XCNT(j)  (256  + 64 * (j))
#define XB_XSUB(j)  (1280 + 64 * (j))
#define XB_XGEN(j)  (2304 + 64 * (j))
#define XB_TOP      3328
#define XB_TOPGEN   3392
#define XCD_BAR_WORDS 3456
#define XB_SPIN_CAP (1u << 18)
__device__ __forceinline__ unsigned xb_ld(unsigned* p)              { return __hip_atomic_load(p, __ATOMIC_RELAXED, __HIP_MEMORY_SCOPE_AGENT); }
__device__ __forceinline__ unsigned xb_add(unsigned* p, unsigned v) { return __hip_atomic_fetch_add(p, v, __ATOMIC_RELAXED, __HIP_MEMORY_SCOPE_AGENT); }
__device__ __forceinline__ unsigned xb_xcc_id() { return (unsigned)__builtin_amdgcn_s_getreg((3 << 11) | 20) & 0xFu; }
#define XB_SPIN(cond, bar) do { unsigned _sp = 0; while (cond) { __builtin_amdgcn_s_sleep(1); \
    if ((++_sp & 255u) == 0u) { if (xb_ld(&(bar)[XB_TMO])) break; if (_sp > XB_SPIN_CAP) { atomicAdd(&(bar)[XB_TMO], 1u); break; } } } } while (0)
struct XcdBarrier { unsigned* bar; unsigned x; volatile LAS unsigned* st; };
__device__ __forceinline__ XcdBarrier xcd_barrier_post(unsigned* bar, volatile LAS unsigned* st) {
    XcdBarrier b; b.bar = bar; b.x = xb_xcc_id(); b.st = st;
    if (threadIdx.x == 0) (void)xb_add(&bar[XB_XCNT(b.x)], 1u);
    return b;
}
__device__ __forceinline__ void xcd_barrier_complete(unsigned* bar, unsigned x, unsigned& nloc, unsigned& nx) {
    const unsigned G = gridDim.x * gridDim.y * gridDim.z;
    unsigned sum, cnt, mine, sp = 0u;
    for (;;) {
        sum = 0u; cnt = 0u; mine = 0u;
#pragma unroll
        for (unsigned j = 0; j < 16; ++j) { const unsigned c = xb_ld(&bar[XB_XCNT(j)]); sum += c; cnt += (c > 0u) ? 1u : 0u; mine = (j == x) ? c : mine; }
        if (sum == G) break;
        __builtin_amdgcn_s_sleep(1);
        if ((++sp & 255u) == 0u) { if (xb_ld(&bar[XB_TMO])) break; if (sp > XB_SPIN_CAP) { atomicAdd(&bar[XB_TMO], 1u); break; } }
    }
    nloc = mine > 0u ? mine : 1u; nx = cnt > 0u ? cnt : 1u;
}
__device__ __forceinline__ void xcd_barrier(const XcdBarrier& b) {
    asm volatile("s_waitcnt vmcnt(0)" ::: "memory");
    __syncthreads();
    if (threadIdx.x == 0) {
        unsigned* bar = b.bar;
        __builtin_amdgcn_s_waitcnt(0);
        unsigned nloc = b.st[0], nx = b.st[1];
        if (nloc == 0u) { xcd_barrier_complete(bar, b.x, nloc, nx); b.st[0] = nloc; b.st[1] = nx; }
        const unsigned old = xb_add(&bar[XB_XSUB(b.x)], 1u);
        const unsigned gen = old / nloc;
        if (old + 1u == (gen + 1u) * nloc) {
            __builtin_amdgcn_fence(__ATOMIC_RELEASE, "agent");
            asm volatile("s_waitcnt vmcnt(0)" ::: "memory");
            const unsigned og = xb_add(&bar[XB_TOP], 1u);
            const unsigned tg = og / nx;
            if (og + 1u == (tg + 1u) * nx) xb_add(&bar[XB_TOPGEN], 1u);
            else XB_SPIN(xb_ld(&bar[XB_TOPGEN]) == tg, bar);
            __builtin_amdgcn_fence(__ATOMIC_ACQUIRE, "agent");
            xb_add(&bar[XB_XGEN(b.x)], 1u);
            asm volatile("s_waitcnt vmcnt(0)" ::: "memory");
        } else {
            XB_SPIN(xb_ld(&bar[XB_XGEN(b.x)]) == gen, bar);
            __builtin_amdgcn_fence(__ATOMIC_ACQUIRE, "agent");
            asm volatile("s_waitcnt vmcnt(0)" ::: "memory");
        }
    }
    __syncthreads();
}

struct Frame {
    LAS unsigned char* lds;
    volatile LAS unsigned* MISC;
    unsigned* ctl;
    int tid, lane, wave, vcu, G;
    const float *x, *c, *w_ada, *b_ada, *norm1_g, *w_in, *conv_qkv_w, *a_log, *dt_bias, *onorm_g, *w_proj_a, *conv_sc_w, *w_proj_b, *w_out,
                *norm2_g, *w_group, *b_group, *w_expert, *b_expert, *w1, *w3, *w2, *normf_g;
    float* out; unsigned char* ws;
};
__device__ __forceinline__ float mod_at(const Frame& F, int b, int idx) {
    return ((const float*)(F.ws + CTL_MODACC))[b * 6144 + idx];
}

using pg8::Unit; using pg8::cvt_pk_bf16;
__device__ __forceinline__ v4u pack8(const f32x4 a, const f32x4 b) { v4u w; w.x = cvt_pk_bf16(a[0], a[1]); w.y = cvt_pk_bf16(a[2], a[3]); w.z = cvt_pk_bf16(b[0], b[1]); w.w = cvt_pk_bf16(b[2], b[3]); return w; }
__device__ __forceinline__ void unpack8(const v4u w, f32x4& a, f32x4& b) { a = (f32x4){bflo(w.x), bfhi(w.x), bflo(w.y), bfhi(w.y)}; b = (f32x4){bflo(w.z), bfhi(w.z), bflo(w.w), bfhi(w.w)}; }

struct EpiInA {
    static constexpr bool PERM = true, AFTER_DRAIN = false;
    bf16 *QKV, *SB, *P;
    __device__ __forceinline__ void operator()(const f32x4 (&acc)[2][2][4][2], const Unit& u, int wr, int wc, int fr, int fq) const {
        const int row0 = u.pm * 256 + wr * 64 + fr;
        if (u.pn < 16) {
            bf16* base; int ldc, colt;
            if (u.pn < 12) { base = QKV; ldc = NQKV; colt = u.pn * 256; } else { base = SB; ldc = D; colt = (u.pn - 12) * 256; }
            const int col0 = colt + wc * 32 + 8 * fq;
#pragma unroll
            for (int ai = 0; ai < 2; ++ai)
#pragma unroll
                for (int m = 0; m < 4; ++m) { bf16* rowp = base + (size_t)(row0 + ai * 128 + m * 16) * ldc + col0;
#pragma unroll
                    for (int bj = 0; bj < 2; ++bj) *(v4u*)(rowp + bj * 128) = pack8(acc[ai][bj][m][0], acc[ai][bj][m][1]); }
        } else {
            const int col0 = (u.pn - 16) * 128 + wc * 32 + 8 * fq;
#pragma unroll
            for (int ai = 0; ai < 2; ++ai)
#pragma unroll
                for (int m = 0; m < 4; ++m) { bf16* rowp = P + (size_t)(row0 + ai * 128 + m * 16) * D + col0;
                    *(v4u*)rowp = pack8(acc[ai][0][m][0] * acc[ai][1][m][0], acc[ai][0][m][1] * acc[ai][1][m][1]); }
        }
    }
};
struct EpiInB {
    static constexpr bool PERM = true, AFTER_DRAIN = false;
    unsigned char* ws;
    __device__ __forceinline__ void operator()(const f32x4 (&acc)[2][2][4][2], const Unit& u, int wr, int wc, int fr, int fq) const {
        const int row0 = u.pm * 256 + wr * 64 + fr, col0 = (u.pn & 3) * 256 + wc * 32 + 8 * fq;
        const bool zt = u.pn < 4;
        bf16* base = (bf16*)(ws + (zt ? WS_OR : ((u.pn < 8) ? WS_GA : WS_GB)));
        v4u cur[2] = {{0u, 0u, 0u, 0u}, {0u, 0u, 0u, 0u}}, nxt[2] = {{0u, 0u, 0u, 0u}, {0u, 0u, 0u, 0u}};
        if (zt) { const bf16* rp = base + (size_t)row0 * D + col0; cur[0] = *(const v4u*)rp; cur[1] = *(const v4u*)(rp + 128); }
#pragma unroll
        for (int g = 0; g < 8; ++g) { const int ai = g >> 2, m = g & 3; bf16* rowp = base + (size_t)(row0 + ai * 128 + m * 16) * D + col0;
            if (zt && g < 7) { const bf16* rn = base + (size_t)(row0 + ((g + 1) >> 2) * 128 + ((g + 1) & 3) * 16) * D + col0; nxt[0] = *(const v4u*)rn; nxt[1] = *(const v4u*)(rn + 128); }
            __builtin_amdgcn_sched_barrier(0);
#pragma unroll
            for (int bj = 0; bj < 2; ++bj) { f32x4 a = acc[ai][bj][m][0], b = acc[ai][bj][m][1];
                f32x4 sa, sb;
#pragma unroll
                for (int j = 0; j < 4; ++j) { sa[j] = sigmoidf_(a[j]); sb[j] = sigmoidf_(b[j]); }
                if (zt) { f32x4 o0, o1; unpack8(cur[bj], o0, o1); sa = sa * a * o0; sb = sb * b * o1; }
                *(v4u*)(rowp + bj * 128) = pack8(sa, sb); }
            cur[0] = nxt[0]; cur[1] = nxt[1];
            __builtin_amdgcn_sched_barrier(0); }
    }
};
struct EpiPlain {
    static constexpr bool PERM = true, AFTER_DRAIN = false;
    bf16* O; int ldc;
    __device__ __forceinline__ void operator()(const f32x4 (&acc)[2][2][4][2], const Unit& u, int wr, int wc, int fr, int fq) const {
        const int row0 = u.pm * 256 + wr * 64 + fr, col0 = u.pn * 256 + wc * 32 + 8 * fq;
#pragma unroll
        for (int ai = 0; ai < 2; ++ai)
#pragma unroll
            for (int m = 0; m < 4; ++m) { bf16* rowp = O + (size_t)(row0 + ai * 128 + m * 16) * ldc + col0;
#pragma unroll
                for (int bj = 0; bj < 2; ++bj) *(v4u*)(rowp + bj * 128) = pack8(acc[ai][bj][m][0], acc[ai][bj][m][1]); }
    }
};
struct EpiMerge {
    static constexpr bool PERM = true, AFTER_DRAIN = false;
    const bf16 *GA, *GB, *YB; bf16* MG;
    __device__ __forceinline__ void operator()(const f32x4 (&acc)[2][2][4][2], const Unit& u, int wr, int wc, int fr, int fq) const {
        const int row0 = u.pm * 256 + wr * 64 + fr, col0 = u.pn * 256 + wc * 32 + 8 * fq;
        v4u cur[6], nxt[6];
#define EPM_LOAD(dst, g_) do { const size_t o_ = (size_t)(row0 + ((g_) >> 2) * 128 + ((g_) & 3) * 16) * D + col0; \
        dst[0] = *(const v4u*)(GA + o_); dst[1] = *(const v4u*)(GA + o_ + 128); dst[2] = *(const v4u*)(GB + o_); dst[3] = *(const v4u*)(GB + o_ + 128); dst[4] = *(const v4u*)(YB + o_); dst[5] = *(const v4u*)(YB + o_ + 128); } while (0)
        EPM_LOAD(cur, 0);
#pragma unroll
        for (int g = 0; g < 8; ++g) { const int ai = g >> 2, m = g & 3; const size_t off = (size_t)(row0 + ai * 128 + m * 16) * D + col0;
            if (g < 7) EPM_LOAD(nxt, g + 1);
            __builtin_amdgcn_sched_barrier(0);
#pragma unroll
            for (int bj = 0; bj < 2; ++bj) { f32x4 a0, a1, b0, b1, y0, y1; unpack8(cur[bj], a0, a1); unpack8(cur[2 + bj], b0, b1); unpack8(cur[4 + bj], y0, y1);
                *(v4u*)(MG + off + bj * 128) = pack8(a0 * acc[ai][bj][m][0] + b0 * y0, a1 * acc[ai][bj][m][1] + b1 * y1); }
#pragma unroll
            for (int q = 0; q < 6; ++q) cur[q] = nxt[q];
            __builtin_amdgcn_sched_barrier(0); }
#undef EPM_LOAD
    }
};
struct EpiX1 {
    static constexpr bool PERM = true, AFTER_DRAIN = false;
    const float* X; float* X1; const float* modacc; const float* b_ada;
    __device__ __forceinline__ void operator()(const f32x4 (&acc)[2][2][4][2], const Unit& u, int wr, int wc, int fr, int fq) const {
        const int row0 = u.pm * 256 + wr * 64 + fr, col0 = u.pn * 256 + wc * 32 + 8 * fq, b = u.pm >> 5;
        f32x4 gt[2][2];
#pragma unroll
        for (int bj = 0; bj < 2; ++bj)
#pragma unroll
            for (int n = 0; n < 2; ++n) gt[bj][n] = *(const f32x4*)(modacc + b * 6144 + 2048 + col0 + bj * 128 + 4 * n);
        f32x4 cur[4], nxt[4];
#define EPX_LOAD(dst, g_) do { const size_t o_ = (size_t)(row0 + ((g_) >> 2) * 128 + ((g_) & 3) * 16) * D + col0; \
        dst[0] = *(const f32x4*)(X + o_); dst[1] = *(const f32x4*)(X + o_ + 4); dst[2] = *(const f32x4*)(X + o_ + 128); dst[3] = *(const f32x4*)(X + o_ + 132); } while (0)
        EPX_LOAD(cur, 0);
#pragma unroll
        for (int g = 0; g < 8; ++g) { const int ai = g >> 2, m = g & 3; const size_t off = (size_t)(row0 + ai * 128 + m * 16) * D + col0;
            if (g < 7) EPX_LOAD(nxt, g + 1);
            __builtin_amdgcn_sched_barrier(0);
#pragma unroll
            for (int bj = 0; bj < 2; ++bj)
#pragma unroll
                for (int n = 0; n < 2; ++n) *(f32x4*)(X1 + off + bj * 128 + 4 * n) = cur[bj * 2 + n] + gt[bj][n] * acc[ai][bj][m][n];
#pragma unroll
            for (int q = 0; q < 4; ++q) cur[q] = nxt[q];
            __builtin_amdgcn_sched_barrier(0); }
#undef EPX_LOAD
    }
};
struct EpiHid {
    static constexpr bool PERM = true, AFTER_DRAIN = false;
    bf16* HID;
    __device__ __forceinline__ void operator()(const f32x4 (&acc)[2][2][4][2], const Unit& u, int wr, int wc, int fr, int fq) const {
        const int row0 = u.pm * 256 + wr * 64 + fr, col0 = (u.pn & 3) * 128 + wc * 32 + 8 * fq;
#pragma unroll
        for (int ai = 0; ai < 2; ++ai)
#pragma unroll
            for (int m = 0; m < 4; ++m) { f32x4 a = acc[ai][0][m][0], b = acc[ai][0][m][1];
#pragma unroll
                for (int j = 0; j < 4; ++j) { a[j] = siluf_(a[j]) * acc[ai][1][m][0][j]; b[j] = siluf_(b[j]) * acc[ai][1][m][1][j]; }
                *(v4u*)(HID + (size_t)(row0 + ai * 128 + m * 16) * DE + col0) = pack8(a, b); }
    }
};
struct EpiMoeOut {
    static constexpr bool PERM = true, AFTER_DRAIN = false;
    bf16* YBUF; const int* ROWTOK; const float* ROWW;
    __device__ __forceinline__ void operator()(const f32x4 (&acc)[2][2][4][2], const Unit& u, int wr, int wc, int fr, int fq) const {
        const int row0 = u.pm * 256 + wr * 64 + fr, col0 = (u.pn & 3) * 256 + wc * 32 + 8 * fq;
        int tk[8]; float wgt[8];
#pragma unroll
        for (int g = 0; g < 8; ++g) { const int r = row0 + (g >> 2) * 128 + (g & 3) * 16; tk[g] = ROWTOK[r]; wgt[g] = ROWW[r]; }
        __builtin_amdgcn_sched_barrier(0);
#pragma unroll
        for (int g = 0; g < 8; ++g) { const int ai = g >> 2, m = g & 3;
            if (tk[g] >= 0) { const float w = wgt[g]; bf16* rowp = YBUF + (size_t)tk[g] * D + col0;
#pragma unroll
                for (int bj = 0; bj < 2; ++bj) *(v4u*)(rowp + bj * 128) = pack8(acc[ai][bj][m][0] * w, acc[ai][bj][m][1] * w); } }
    }
};
struct MoeOrder {
    int nt, G, c; const volatile LAS int* tile_e;
    __device__ __forceinline__ bool next(int i, Unit& u) const {
        const int x = c & 7, vi = c >> 3, per = G >> 3, lo = (nt * x) >> 3, hi = (nt * (x + 1)) >> 3, q = i * per + vi;
        if (q >= 4 * (hi - lo)) return false;
        const int rb = lo + (q >> 2); u.pm = rb; u.pn = tile_e[rb] * 4 + (q & 3); return true; }
    __device__ __forceinline__ void a_ready(const Unit&) const {}
    __device__ __forceinline__ void done(const Unit&) const {}
};

__device__ __forceinline__ void transpose_item(const float* W, int ldw, int src_col0, int k0, bf16* WT, int dst_row0, int K, LAS float* scr, int lane) {
#pragma unroll 8
    for (int i = 0; i < 32; ++i) { const int kk = 2 * i + (lane >> 5); scr[kk * 33 + (lane & 31)] = W[(size_t)(k0 + kk) * ldw + src_col0 + (lane & 31)]; }
    LDS_WAIT(); asm volatile("" ::: "memory");
    const int c = lane & 7;
#pragma unroll
    for (int j = 0; j < 4; ++j) { const int n = (lane >> 3) + 8 * j; const LAS float* s = scr + (8 * c) * 33 + n;
        v4u o; o.x = pk2(s[0 * 33], s[1 * 33]); o.y = pk2(s[2 * 33], s[3 * 33]); o.z = pk2(s[4 * 33], s[5 * 33]); o.w = pk2(s[6 * 33], s[7 * 33]);
        *(v4u*)(WT + (size_t)(dst_row0 + n) * K + k0 + 8 * c) = o; }
    LDS_WAIT(); asm volatile("" ::: "memory");
}
__device__ __forceinline__ int win_src_col(int d0) {
    if (d0 < 3072) return d0;
    if (d0 < 4096) return 4112 + (d0 - 3072);
    if (d0 < 6144) { const int j = (d0 - 4096) >> 8, r = (d0 - 4096) & 255; return (r < 128 ? 5136 + r : 6160 + (r - 128)) + 128 * j; }
    if (d0 < 7168) return 3072 + (d0 - 6144);
    if (d0 < 8192) return 7184 + (d0 - 7168);
    return 8208 + (d0 - 8192);
}

__device__ __forceinline__ void p0_prologue(Frame& F) {
    LAS float* sC = (LAS float*)(F.lds + 8 * 8448);
    for (int i = F.tid; i < 2 * D; i += 512) sC[i] = siluf_(F.c[i]);
    __syncthreads();
    const int gw = F.vcu * NWAVES + F.wave, NGW = F.G * NWAVES;
    float* modv = (float*)(F.ws + CTL_MODACC);
    LAS float* sPart = sC + 2 * D;
    for (int cg = blockIdx.x; cg < 96; cg += F.G) {
        const int col = cg * 64 + F.lane, k0 = F.wave * 128;
        float a0 = 0.f, a1 = 0.f;
#pragma unroll 16
        for (int k = 0; k < 128; ++k) { const float wv = F.w_ada[(size_t)(k0 + k) * 6144 + col]; a0 += sC[k0 + k] * wv; a1 += sC[D + k0 + k] * wv; }
        sPart[F.wave * 128 + F.lane] = a0; sPart[F.wave * 128 + 64 + F.lane] = a1;
        __syncthreads();
        if (F.wave < 2) { float t = 0.f;
#pragma unroll
            for (int q = 0; q < 8; ++q) t += sPart[q * 128 + F.wave * 64 + F.lane];
            modv[F.wave * 6144 + col] = t + F.b_ada[col]; }
        __syncthreads();
    }
    LAS float* scr = (LAS float*)(F.lds + F.wave * 8448);
    constexpr int I_IN = 288 * 16, I_SQ = 32 * 16;
    for (int it = gw; it < I_IN + 3 * I_SQ; it += NGW) {
        int r = it;
        if (r < I_IN) { const int dg = r % 288, kb = r / 288, d0 = dg * 32; bf16* dst = (d0 < 6144) ? (bf16*)(F.ws + WS_WINA) : (bf16*)(F.ws + WS_WINB);
            transpose_item(F.w_in, IN_TOTAL, win_src_col(d0), kb * 64, dst, d0 < 6144 ? d0 : d0 - 6144, D, scr, F.lane); continue; }
        r -= I_IN;
        if (r < I_SQ) { transpose_item(F.w_proj_a, D, (r % 32) * 32, (r / 32) * 64, (bf16*)(F.ws + WS_WA), (r % 32) * 32, D, scr, F.lane); continue; } r -= I_SQ;
        if (r < I_SQ) { transpose_item(F.w_proj_b, D, (r % 32) * 32, (r / 32) * 64, (bf16*)(F.ws + WS_WB), (r % 32) * 32, D, scr, F.lane); continue; } r -= I_SQ;
        transpose_item(F.w_out, D, (r % 32) * 32, (r / 32) * 64, (bf16*)(F.ws + WS_WO), (r % 32) * 32, D, scr, F.lane);
    }
}
__device__ __forceinline__ void moe_weight_item(Frame& F, int it, LAS float* scr) {
    constexpr int I13 = NE * 32 * 16;
    if (it < I13) { const int e = it / 512, r = it % 512, dg = r % 32, kb = r / 32, d0 = dg * 32, j = d0 >> 8, rr = d0 & 255;
        if (rr < 128) transpose_item(F.w1 + (size_t)e * D * DE, DE, 128 * j + (rr & 127), kb * 64, (bf16*)(F.ws + WS_W13) + (size_t)e * D * D, d0, D, scr, F.lane);
        else          transpose_item(F.w3 + (size_t)e * D * DE, DE, 128 * j + (rr & 127), kb * 64, (bf16*)(F.ws + WS_W13) + (size_t)e * D * D, d0, D, scr, F.lane);
    } else { const int r2 = it - I13, e = r2 / 256, r = r2 % 256, dg = r % 32, kb = r / 32;
        transpose_item(F.w2 + (size_t)e * DE * D, D, dg * 32, kb * 64, (bf16*)(F.ws + WS_W2) + (size_t)e * D * DE, dg * 32, DE, scr, F.lane); }
}
__device__ __forceinline__ void p_moe_weights(Frame& F) {
    LAS float* scr = (LAS float*)(F.lds + F.wave * 8448);
    constexpr int NBATCH = (NE * 32 * 16 + NE * 32 * 8) / 64;
    __syncthreads();
    for (;;) {
        if (F.tid == 0) F.MISC[3] = atomicAdd(F.ctl + CW_Q, 1u);
        __syncthreads();
        const int bt = (int)F.MISC[3];
        __syncthreads();
        if (bt >= NBATCH) break;
        for (int i = 0; i < 8; ++i) moe_weight_item(F, bt * 64 + F.wave * 8 + i, scr);
    }
}

__device__ __forceinline__ void p1_norm1(Frame& F) {
    LAS float* sBA = (LAS float*)F.lds;
    for (int i = F.tid; i < 16 * D; i += 512) { const int k = i >> 4, o = i & 15; sBA[o * D + k] = F.w_in[(size_t)k * IN_TOTAL + 4096 + o]; }
    __syncthreads();
    const int gw = blockIdx.x * NWAVES + F.wave, RPW = M / (F.G * NWAVES);
    bf16* H = (bf16*)F.out; float* BG = (float*)(F.ws + WS_BG);
    f32x4 gsc[4], gsh[4];
    { const int b = (gw * RPW) / T;
#pragma unroll
      for (int j = 0; j < 4; ++j) { const int col = 256 * j + 4 * F.lane; const f32x4 g1 = *(const f32x4*)(F.norm1_g + col);
          gsc[j] = g1 * (1.0f + *(const f32x4*)((const float*)(F.ws + CTL_MODACC) + b * 6144 + D + col)); gsh[j] = *(const f32x4*)((const float*)(F.ws + CTL_MODACC) + b * 6144 + col); } }
    for (int m = gw * RPW; m < (gw + 1) * RPW; ++m) {
        const f32x4* xr = (const f32x4*)(F.x + (size_t)m * D) + F.lane;
        f32x4 v[4]; float s = 0.f;
#pragma unroll
        for (int j = 0; j < 4; ++j) { v[j] = xr[64 * j]; s += (v[j].x * v[j].x + v[j].y * v[j].y) + (v[j].z * v[j].z + v[j].w * v[j].w); }
        const float rstd = __frsqrt_rn(wave_sum(s) * (1.f / D) + EPS);
        f32x4 hv[4];
#pragma unroll
        for (int j = 0; j < 4; ++j) { const int col = 256 * j + 4 * F.lane;
            hv[j] = v[j] * rstd * gsc[j] + gsh[j];
            *(v2u*)(H + (size_t)m * D + col) = (v2u){pk2(hv[j][0], hv[j][1]), pk2(hv[j][2], hv[j][3])};
        }
        float lg[16];
#pragma unroll
        for (int o = 0; o < 16; ++o) { float p = 0.f;
#pragma unroll
            for (int j = 0; j < 4; ++j) { const f32x4 w = *(const LAS f32x4*)(sBA + o * D + 256 * j + 4 * F.lane); p += (hv[j][0] * w[0] + hv[j][1] * w[1]) + (hv[j][2] * w[2] + hv[j][3] * w[3]); }
            lg[o] = p; if ((o & 3) == 3) __builtin_amdgcn_sched_barrier(0); }
        fold_step<16, 16>(lg, 32, (F.lane & 32) != 0); fold_step<8, 16>(lg, 16, (F.lane & 16) != 0); fold_step<4, 16>(lg, 8, (F.lane & 8) != 0); fold_step<2, 16>(lg, 4, (F.lane & 4) != 0);
        float val = lg[0]; val += __shfl_xor(val, 2); val += __shfl_xor(val, 1);
        const int oidx = ((F.lane >> 5) & 1) * 8 + ((F.lane >> 4) & 1) * 4 + ((F.lane >> 3) & 1) * 2 + ((F.lane >> 2) & 1);
        if ((F.lane & 3) == 0) {
            float r;
            if (oidx < 8) r = sigmoidf_(val);
            else { const int hh = oidx - 8; const float xx = val + F.dt_bias[hh]; const float sp = xx > 20.f ? xx : log1pf(__expf(xx)); r = -__expf(F.a_log[hh]) * sp; }
            BG[(size_t)m * 16 + oidx] = r;
        }
    }
}

__device__ __forceinline__ void p3a_ybp(Frame& F) {
    const bf16* SB = (const bf16*)(F.ws + WS_SB); const bf16* P = (const bf16*)(F.ws + WS_P); bf16* YBP = (bf16*)F.out + (size_t)M * D;
    const size_t total = (size_t)M * (D / 8);
    for (size_t i = (size_t)blockIdx.x * 512 + F.tid; i < total; i += (size_t)F.G * 512) {
        const int m = (int)(i >> 7), c8 = (int)(i & 127) * 8, t = m % T;
        f32x4 a0 = {0.f, 0.f, 0.f, 0.f}, a1 = a0;
#pragma unroll
        for (int j = 0; j < 3; ++j) { const int tt = t - 2 + j;
            if (tt >= 0) { f32x4 p0, p1; unpack8(*(const v4u*)(P + (size_t)(m - 2 + j) * D + c8), p0, p1);
                a0 += *(const f32x4*)(F.conv_sc_w + j * D + c8) * p0; a1 += *(const f32x4*)(F.conv_sc_w + j * D + c8 + 4) * p1; } }
        f32x4 s0, s1; unpack8(*(const v4u*)(SB + (size_t)m * D + c8), s0, s1);
        *(v4u*)(YBP + (size_t)m * D + c8) = pack8(s0 * a0, s1 * a1);
    }
}

__device__ __forceinline__ void p3b_chunk(Frame& F, int unit) {
    const int n = unit % NCH, bh = unit / NCH, h = bh % NH, b = bh / NH, t0 = n * CH, row0 = b * T + t0;
    LAS float* sq = (LAS float*)F.lds; LAS float* sk = sq + 64 * 129; LAS float* sv = sk + 64 * 129; LAS float* sA = sv + 64 * 129; LAS float* sT = sA + 64 * 65;
    LAS float* sgc = sT + 64 * 65; LAS float* sbeta = sgc + 64;
    const bf16* QKV = (const bf16*)(F.ws + WS_QKV); const float* BG = (const float*)(F.ws + WS_BG);
    for (int idx = F.tid; idx < 3 * 64 * 128; idx += 512) {
        const int sec = idx >> 13, r = (idx >> 7) & 63, c = idx & 127, gcol = sec * 1024 + h * 128 + c;
        float a = 0.f;
#pragma unroll
        for (int j = 0; j < 4; ++j) { const int tt = t0 + r - 3 + j; if (tt >= 0) a += F.conv_qkv_w[j * NQKV + gcol] * bf2f(QKV[(size_t)(b * T + tt) * NQKV + gcol]); }
        sq[sec * (64 * 129) + r * 129 + c] = siluf_(a);
    }
    if (F.tid < 64) { sgc[F.tid] = BG[(size_t)(row0 + F.tid) * 16 + 8 + h]; sbeta[F.tid] = BG[(size_t)(row0 + F.tid) * 16 + h]; }
    __syncthreads();
    for (int r = F.wave * 8; r < F.wave * 8 + 8; ++r) {
        const float q0 = sq[r * 129 + F.lane], q1 = sq[r * 129 + 64 + F.lane], k0 = sk[r * 129 + F.lane], k1 = sk[r * 129 + 64 + F.lane];
        const float qs = __frsqrt_rn(wave_sum(q0 * q0 + q1 * q1) + EPS) * 0.08838834764831845f, ks = __frsqrt_rn(wave_sum(k0 * k0 + k1 * k1) + EPS);
        sq[r * 129 + F.lane] = q0 * qs; sq[r * 129 + 64 + F.lane] = q1 * qs; sk[r * 129 + F.lane] = k0 * ks; sk[r * 129 + 64 + F.lane] = k1 * ks;
    }
    if (F.tid == 0) { float a = 0.f; for (int i = 0; i < 64; ++i) { a += sgc[i]; sgc[i] = a; } }
    __syncthreads();
    bf16* INo = (bf16*)(F.ws + WS_IN) + (size_t)unit * 4096;
    for (int idx = F.tid; idx < 4096; idx += 512) {
        const int i = idx >> 6, j = idx & 63; float av = 0.f, iv = 0.f;
        if (j <= i) { float dkk = 0.f, dqk = 0.f;
            for (int d = 0; d < 128; ++d) { const float kj = sk[j * 129 + d]; dkk += sk[i * 129 + d] * kj; dqk += sq[i * 129 + d] * kj; }
            const float dec = __expf(sgc[i] - sgc[j]); iv = dqk * dec; av = (j < i) ? sbeta[i] * dkk * dec : 0.f; }
        sA[i * 65 + j] = av; INo[idx] = (bf16)f2bf(iv);
    }
    __syncthreads();
    if (F.tid < 64) { const int c = F.tid;
        for (int i = 0; i < 64; ++i) { float t = 0.f;
            for (int j = 0; j < i; ++j) t -= sA[i * 65 + j] * sT[j * 65 + c];
            sT[i * 65 + c] = (i == c) ? 1.0f : ((i < c) ? 0.f : t); } }
    __syncthreads();
    bf16* UTo = (bf16*)(F.ws + WS_UT) + (size_t)unit * 8192; bf16* Wo = (bf16*)(F.ws + WS_W) + (size_t)unit * 8192;
    bf16* QDo = (bf16*)(F.ws + WS_QD) + (size_t)unit * 8192; bf16* KDTo = (bf16*)(F.ws + WS_KDT) + (size_t)unit * 8192;
    const float glast = sgc[63];
    for (int idx = F.tid; idx < 8192; idx += 512) {
        { const int dv = idx >> 6, i = idx & 63; float u = 0.f;
          for (int j = 0; j <= i; ++j) u += sT[i * 65 + j] * sbeta[j] * sv[j * 129 + dv];
          UTo[idx] = (bf16)f2bf(u);
          KDTo[idx] = (bf16)f2bf(sk[i * 129 + dv] * __expf(glast - sgc[i])); }
        { const int i = idx >> 7, dk = idx & 127; float w = 0.f;
          for (int j = 0; j <= i; ++j) w += sT[i * 65 + j] * sbeta[j] * __expf(sgc[j]) * sk[j * 129 + dk];
          Wo[idx] = (bf16)f2bf(w);
          QDo[idx] = (bf16)f2bf(sq[i * 129 + dk] * __expf(sgc[i])); }
    }
    if (F.tid == 0) ((float*)(F.ws + WS_DEC))[unit] = __expf(glast);
    __syncthreads();
}

__device__ __forceinline__ void p4_scan(Frame& F, int item) {
    const int bh = item >> 2, sl = item & 3, h = bh % NH, b = bh / NH;
    LAS float* sS = (LAS float*)F.lds;
    LAS float* sV = sS + 128 * 33;
    LAS bf16* sW = (LAS bf16*)(sV + 64 * 33);
    LAS bf16* sQ = sW + 64 * 136;
    LAS bf16* sK = sQ + 64 * 136;
    LAS bf16* sI = sK + 128 * 72;
    for (int i = F.tid; i < 128 * 33; i += 512) sS[i] = 0.f;
    bf16* OR = (bf16*)(F.ws + WS_OR); float* SSQ = (float*)(F.ws + CTL_SSQ);
    const int c = F.tid >> 3, d4 = (F.tid & 7) * 4, dk2 = F.tid >> 2, d8 = (F.tid & 3) * 8;
    for (int n = 0; n < NCH; ++n) {
        const int unit = bh * NCH + n;
        const bf16* Wg = (const bf16*)(F.ws + WS_W) + (size_t)unit * 8192; const bf16* Qg = (const bf16*)(F.ws + WS_QD) + (size_t)unit * 8192;
        const bf16* Kg = (const bf16*)(F.ws + WS_KDT) + (size_t)unit * 8192; const bf16* Ig = (const bf16*)(F.ws + WS_IN) + (size_t)unit * 4096;
        const bf16* Ug = (const bf16*)(F.ws + WS_UT) + (size_t)unit * 8192;
        __syncthreads();
        for (int i = F.tid; i < 1024; i += 512) { const int r = i >> 4, c8 = (i & 15) * 8;
            *(LAS v4u*)(sW + r * 136 + c8) = *(const v4u*)(Wg + r * 128 + c8); *(LAS v4u*)(sQ + r * 136 + c8) = *(const v4u*)(Qg + r * 128 + c8); }
        for (int i = F.tid; i < 1024; i += 512) { const int r = i >> 3, c8 = (i & 7) * 8; *(LAS v4u*)(sK + r * 72 + c8) = *(const v4u*)(Kg + r * 64 + c8); }
        { const int r = F.tid >> 3, c8 = (F.tid & 7) * 8; *(LAS v4u*)(sI + r * 72 + c8) = *(const v4u*)(Ig + r * 64 + c8); }
        const float dec = ((const float*)(F.ws + WS_DEC))[unit];
        __syncthreads();
        float pS[4] = {0.f, 0.f, 0.f, 0.f}, qS[4] = {0.f, 0.f, 0.f, 0.f};
        for (int dk = 0; dk < 128; ++dk) { const float wv = bf2f(sW[c * 136 + dk]), qv = bf2f(sQ[c * 136 + dk]);
#pragma unroll
            for (int e = 0; e < 4; ++e) { const float s = sS[dk * 33 + d4 + e]; pS[e] += wv * s; qS[e] += qv * s; } }
        float vn[4];
#pragma unroll
        for (int e = 0; e < 4; ++e) { vn[e] = bf2f(Ug[(sl * 32 + d4 + e) * 64 + c]) - pS[e]; sV[c * 33 + d4 + e] = vn[e]; }
        __syncthreads();
        float o[4] = {qS[0], qS[1], qS[2], qS[3]};
        for (int j = 0; j < 64; ++j) { const float iv = bf2f(sI[c * 72 + j]);
#pragma unroll
            for (int e = 0; e < 4; ++e) o[e] += iv * sV[j * 33 + d4 + e]; }
        const int row = b * T + n * CH + c;
        *(v2u*)(OR + (size_t)row * D + h * 128 + sl * 32 + d4) = (v2u){pk2(o[0], o[1]), pk2(o[2], o[3])};
        float ss = (o[0] * o[0] + o[1] * o[1]) + (o[2] * o[2] + o[3] * o[3]);
        ss += __shfl_xor(ss, 1); ss += __shfl_xor(ss, 2); ss += __shfl_xor(ss, 4);
        if ((F.tid & 7) == 0) atomicAdd(SSQ + (size_t)row * 8 + h, ss);
        float sn[8];
#pragma unroll
        for (int e = 0; e < 8; ++e) sn[e] = dec * sS[dk2 * 33 + d8 + e];
        for (int cc = 0; cc < 64; ++cc) { const float kv = bf2f(sK[dk2 * 72 + cc]);
#pragma unroll
            for (int e = 0; e < 8; ++e) sn[e] += kv * sV[cc * 33 + d8 + e]; }
        __syncthreads();
#pragma unroll
        for (int e = 0; e < 8; ++e) sS[dk2 * 33 + d8 + e] = sn[e];
    }
    __syncthreads();
}


typedef pg8::bf16x8 bx8;
#define MFMA16(a, b, c) __builtin_amdgcn_mfma_f32_16x16x32_bf16(a, b, c, 0, 0, 0)
__device__ __forceinline__ v2u pack4(const f32x4 a) { v2u r; r.x = cvt_pk_bf16(a[0], a[1]); r.y = cvt_pk_bf16(a[2], a[3]); return r; }
__device__ __forceinline__ void p4_scan_fast(Frame& F, int bh) {
    const int h = bh % NH, b = bh / NH, w = F.wave, l15 = F.lane & 15, lq = F.lane >> 4, ct = w >> 1, dvh = w & 1;
    LAS bf16* sST = (LAS bf16*)F.lds;
    LAS bf16* sVT = sST + 128 * 136;
    LAS float* sSS = (LAS float*)(sVT + 128 * 72);
    LAS float* sDEC = sSS + 128;
    if (F.tid < NCH) sDEC[F.tid] = ((const float*)(F.ws + WS_DEC))[bh * NCH + F.tid];
    for (int i = F.tid; i < 128 * 136 / 2; i += 512) ((LAS unsigned*)sST)[i] = 0u;
    const bf16* Wg = (const bf16*)(F.ws + WS_W) + (size_t)bh * NCH * 8192 + (16 * ct + l15) * 128 + 8 * lq;
    const bf16* Qg = (const bf16*)(F.ws + WS_QD) + (size_t)bh * NCH * 8192 + (16 * ct + l15) * 128 + 8 * lq;
    const bf16* Ig = (const bf16*)(F.ws + WS_IN) + (size_t)bh * NCH * 4096 + (16 * ct + l15) * 64 + 8 * lq;
    const bf16* Kg = (const bf16*)(F.ws + WS_KDT) + (size_t)bh * NCH * 8192 + (16 * w + l15) * 64 + 8 * lq;
    const bf16* Ug = (const bf16*)(F.ws + WS_UT) + (size_t)bh * NCH * 8192 + (16 * 4 * dvh + l15) * 64 + 16 * ct + 4 * lq;
    bf16* OR = (bf16*)(F.ws + WS_OR);
    bx8 fW[4], fQ[4], fI[2], fK[2]; v2u fU[4];
#pragma unroll
    for (int ks = 0; ks < 4; ++ks) { fW[ks] = *(const bx8*)(Wg + 32 * ks); fQ[ks] = *(const bx8*)(Qg + 32 * ks); fU[ks] = *(const v2u*)(Ug + ks * 16 * 64); }
#pragma unroll
    for (int ks = 0; ks < 2; ++ks) { fI[ks] = *(const bx8*)(Ig + 32 * ks); fK[ks] = *(const bx8*)(Kg + 32 * ks); }
    f32x4 S[8], gn[4];
#pragma unroll
    for (int t = 0; t < 8; ++t) S[t] = (f32x4){0.f, 0.f, 0.f, 0.f};
#pragma unroll
    for (int t = 0; t < 4; ++t) gn[t] = *(const f32x4*)(F.onorm_g + 16 * (4 * dvh + t) + 4 * lq);
    __syncthreads();
    for (int n = 0; n < NCH; ++n) {
        const float dec = sDEC[n];
        const int nn = (n + 1 < NCH) ? 1 : 0;
        f32x4 pS[4], qS[4];
#pragma unroll
        for (int t = 0; t < 4; ++t) { bx8 fS[4];
#pragma unroll
            for (int ks = 0; ks < 4; ++ks) fS[ks] = *(const LAS bx8*)(sST + (16 * (4 * dvh + t) + l15) * 136 + 32 * ks + 8 * lq);
            f32x4 p = {0.f, 0.f, 0.f, 0.f}, q = {0.f, 0.f, 0.f, 0.f};
#pragma unroll
            for (int ks = 0; ks < 4; ++ks) { p = MFMA16(fW[ks], fS[ks], p); q = MFMA16(fS[ks], fQ[ks], q); }
            pS[t] = p; qS[t] = q; }
#pragma unroll
        for (int t = 0; t < 4; ++t) { const f32x4 u = {bflo(fU[t].x), bfhi(fU[t].x), bflo(fU[t].y), bfhi(fU[t].y)};
            *(LAS v2u*)(sVT + (16 * (4 * dvh + t) + l15) * 72 + 16 * ct + 4 * lq) = pack4(u - pS[t]); }
        Wg += nn * 8192; Qg += nn * 8192; Ug += nn * 8192;
#pragma unroll
        for (int ks = 0; ks < 4; ++ks) { fW[ks] = *(const bx8*)(Wg + 32 * ks); fQ[ks] = *(const bx8*)(Qg + 32 * ks); fU[ks] = *(const v2u*)(Ug + ks * 16 * 64); }
        __syncthreads();
        float ss = 0.f;
#pragma unroll
        for (int t = 0; t < 4; ++t) {
#pragma unroll
            for (int ks = 0; ks < 2; ++ks) { const bx8 fV = *(const LAS bx8*)(sVT + (16 * (4 * dvh + t) + l15) * 72 + 32 * ks + 8 * lq); qS[t] = MFMA16(fV, fI[ks], qS[t]); }
            ss += (qS[t][0] * qS[t][0] + qS[t][1] * qS[t][1]) + (qS[t][2] * qS[t][2] + qS[t][3] * qS[t][3]); }
        ss += __shfl_xor(ss, 16); ss += __shfl_xor(ss, 32);
        if (lq == 0) sSS[dvh * 64 + 16 * ct + l15] = ss;
        Ig += nn * 4096;
#pragma unroll
        for (int ks = 0; ks < 2; ++ks) fI[ks] = *(const bx8*)(Ig + 32 * ks);
#pragma unroll
        for (int t = 0; t < 8; ++t) { S[t] = S[t] * dec;
#pragma unroll
            for (int ks = 0; ks < 2; ++ks) { const bx8 fV = *(const LAS bx8*)(sVT + (16 * t + l15) * 72 + 32 * ks + 8 * lq); S[t] = MFMA16(fK[ks], fV, S[t]); }
            *(LAS v2u*)(sST + (16 * t + l15) * 136 + 16 * w + 4 * lq) = pack4(S[t]); }
        Kg += nn * 8192;
#pragma unroll
        for (int ks = 0; ks < 2; ++ks) fK[ks] = *(const bx8*)(Kg + 32 * ks);
        __syncthreads();
        const float rstd = __frsqrt_rn((sSS[16 * ct + l15] + sSS[64 + 16 * ct + l15]) * (1.0f / 128.0f) + EPS);
        bf16* orow = OR + (size_t)(b * T + n * CH + 16 * ct + l15) * D + h * 128 + 16 * 4 * dvh + 4 * lq;
#pragma unroll
        for (int t = 0; t < 4; ++t) *(v2u*)(orow + 16 * t) = pack4(qS[t] * rstd * gn[t]);
    }
    __syncthreads();
}


#define MFMA_F32(a, b, c) __builtin_amdgcn_mfma_f32_16x16x4f32(a, b, c, 0, 0, 0)
__device__ __forceinline__ void solve_block(LAS float* sA, LAS float* sT, int bi, int bj, int l15, int lq) {
    f32x4 y = {0.f, 0.f, 0.f, 0.f};
    for (int km = bj; km < bi; ++km)
#pragma unroll
        for (int kb = 0; kb < 4; ++kb) y = MFMA_F32(sA[(16 * bi + l15) * 68 + 16 * km + 4 * kb + lq], sT[(16 * km + 4 * kb + lq) * 68 + 16 * bj + l15], y);
    f32x4 z = {0.f, 0.f, 0.f, 0.f};
#pragma unroll
    for (int e = 0; e < 4; ++e) z = MFMA_F32(sT[(16 * bi + l15) * 68 + 16 * bi + 4 * lq + e], y[e], z);
#pragma unroll
    for (int e = 0; e < 4; ++e) sT[(16 * bi + 4 * lq + e) * 68 + 16 * bj + l15] = -z[e];
}
__device__ __forceinline__ void p3b_loop(Frame& F) {
    const int tid = F.tid, w = F.wave, lane = F.lane, l15 = lane & 15, lq = lane >> 4;
    LAS bf16* sQ = (LAS bf16*)F.lds; LAS bf16* sK = sQ + 64 * 136; LAS bf16* sKG0 = sK + 64 * 136; LAS bf16* sVB0 = sKG0 + 2 * 128 * 72;
    LAS float* sA = (LAS float*)(sVB0 + 2 * 128 * 72); LAS float* sT = sA + 64 * 68; LAS bf16* sTb = (LAS bf16*)(sT + 64 * 68); LAS float* sgc0 = (LAS float*)(sTb + 64 * 72);
    const bf16* QKV = (const bf16*)(F.ws + WS_QKV); const float* BG = (const float*)(F.ws + WS_BG);
    const int rs = tid / 48, cg = tid % 48, sec = cg >> 4, c8 = (cg & 15) * 8, r0 = 8 * rs;
    const int wswz = (cg & 7), rswz = (2 * w + (l15 >> 3)) & 7;
    v4u raw[11]; f32x4 wt[4][2]; float pg = 0.f, pb = 0.f;
#define P3B_PREFETCH(U) do { const int n_ = (U) % NCH, bh_ = (U) / NCH, h_ = bh_ % NH, b_ = bh_ / NH, t0_ = n_ * CH; \
        pg = BG[(size_t)(b_ * T + t0_ + lane) * 16 + 8 + h_]; pb = BG[(size_t)(b_ * T + t0_ + lane) * 16 + h_]; \
        if (tid < 384) { const int gcol_ = sec * 1024 + h_ * 128 + c8; \
            _Pragma("unroll") for (int i = 0; i < 11; ++i) { const int tt = t0_ + r0 - 3 + i; raw[i] = (tt >= 0) ? *(const v4u*)(QKV + (size_t)(b_ * T + tt) * NQKV + gcol_) : (v4u){0u, 0u, 0u, 0u}; } } } while (0)
#define P3B_CONV(U, BUF) do { \
        int zr = 0; asm volatile("" : "+v"(zr)); \
        const int c8z = c8 + zr, r0z = r0 + zr; \
        LAS bf16* sKG = sKG0 + (BUF) * 128 * 72; LAS bf16* sVB = sVB0 + (BUF) * 128 * 72; LAS float* sgc = sgc0 + (BUF) * 128; \
        bf16* QDo = (bf16*)(F.ws + WS_QD) + (size_t)(U) * 8192; bf16* KDTo = (bf16*)(F.ws + WS_KDT) + (size_t)(U) * 8192; \
        float gcs = pg; \
        _Pragma("unroll") for (int o = 1; o < 64; o <<= 1) { const float t = __shfl_up(gcs, o); if (lane >= o) gcs += t; } \
        const float gl = __shfl(gcs, 63), bts = pb; \
        if (w == 7) { sgc[lane] = gcs; sgc[64 + lane] = bts; if (lane == 0) ((float*)(F.ws + WS_DEC))[(U)] = __expf(gl); } \
        if (tid < 384) { \
            { const int gcol = sec * 1024 + (((U) / NCH) % NH) * 128 + c8; \
              _Pragma("unroll") for (int j = 0; j < 4; ++j) { wt[j][0] = *(const f32x4*)(F.conv_qkv_w + j * NQKV + gcol); wt[j][1] = *(const f32x4*)(F.conv_qkv_w + j * NQKV + gcol + 4); } } \
            const int wb = 8 * (rs ^ wswz) + zr; \
            _Pragma("unroll") for (int g = 0; g < 2; ++g) { \
                float gcr[4], btr[4]; \
                _Pragma("unroll") for (int r = 0; r < 4; ++r) { gcr[r] = __shfl(gcs, r0 + 4 * g + r); btr[r] = __shfl(bts, r0 + 4 * g + r); } \
                f32x4 o0[4], o1[4]; \
                _Pragma("unroll") for (int r = 0; r < 4; ++r) { f32x4 a0 = {0.f, 0.f, 0.f, 0.f}, a1 = a0; \
                    _Pragma("unroll") for (int j = 0; j < 4; ++j) { f32x4 x0, x1; unpack8(raw[4 * g + r + j], x0, x1); a0 += wt[j][0] * x0; a1 += wt[j][1] * x1; } \
                    _Pragma("unroll") for (int e = 0; e < 4; ++e) { a0[e] = siluf_(a0[e]); a1[e] = siluf_(a1[e]); } \
                    float ss = (a0[0] * a0[0] + a0[1] * a0[1]) + (a0[2] * a0[2] + a0[3] * a0[3]) + (a1[0] * a1[0] + a1[1] * a1[1]) + (a1[2] * a1[2] + a1[3] * a1[3]); \
                    ss += __shfl_xor(ss, 1); ss += __shfl_xor(ss, 2); ss += __shfl_xor(ss, 4); ss += __shfl_xor(ss, 8); \
                    const float sc = (sec == 2) ? 1.0f : __frsqrt_rn(ss + EPS) * (sec == 0 ? 0.08838834764831845f : 1.0f); \
                    o0[r] = a0 * sc; o1[r] = a1 * sc; } \
                const int rb = r0z + 4 * g; \
                if (sec == 0) { \
                    _Pragma("unroll") for (int r = 0; r < 4; ++r) { *(LAS v4u*)(sQ + (rb + r) * 136 + c8z) = pack8(o0[r], o1[r]); const float eg = __expf(gcr[r]); \
                        *(v4u*)(QDo + (rb + r) * 128 + c8z) = pack8(o0[r] * eg, o1[r] * eg); } \
                } else if (sec == 1) { \
                    float fk[4], fd[4]; \
                    _Pragma("unroll") for (int r = 0; r < 4; ++r) { *(LAS v4u*)(sK + (rb + r) * 136 + c8z) = pack8(o0[r], o1[r]); fk[r] = btr[r] * __expf(gcr[r]); fd[r] = __expf(gl - gcr[r]); } \
                    _Pragma("unroll") for (int e = 0; e < 4; ++e) { \
                        *(LAS v2u*)(sKG + (c8z + e) * 72 + wb + 4 * g) = pack4((f32x4){o0[0][e] * fk[0], o0[1][e] * fk[1], o0[2][e] * fk[2], o0[3][e] * fk[3]}); \
                        *(v2u*)(KDTo + (c8z + e) * 64 + rb) = pack4((f32x4){o0[0][e] * fd[0], o0[1][e] * fd[1], o0[2][e] * fd[2], o0[3][e] * fd[3]}); \
                        *(LAS v2u*)(sKG + (c8z + 4 + e) * 72 + wb + 4 * g) = pack4((f32x4){o1[0][e] * fk[0], o1[1][e] * fk[1], o1[2][e] * fk[2], o1[3][e] * fk[3]}); \
                        *(v2u*)(KDTo + (c8z + 4 + e) * 64 + rb) = pack4((f32x4){o1[0][e] * fd[0], o1[1][e] * fd[1], o1[2][e] * fd[2], o1[3][e] * fd[3]}); } \
                } else { \
                    _Pragma("unroll") for (int e = 0; e < 4; ++e) { \
                        *(LAS v2u*)(sVB + (c8z + e) * 72 + wb + 4 * g) = pack4((f32x4){o0[0][e] * btr[0], o0[1][e] * btr[1], o0[2][e] * btr[2], o0[3][e] * btr[3]}); \
                        *(LAS v2u*)(sVB + (c8z + 4 + e) * 72 + wb + 4 * g) = pack4((f32x4){o1[0][e] * btr[0], o1[1][e] * btr[1], o1[2][e] * btr[2], o1[3][e] * btr[3]}); } \
                } \
            } \
        } } while (0)
    int unit = blockIdx.x;
    if (unit >= NUNIT) return;
    for (int i = tid; i < 64 * 68; i += 512) sT[i] = 0.f;
    P3B_PREFETCH(unit);
    if (w != 6) P3B_CONV(unit, 0);
    __builtin_amdgcn_sched_barrier(0);
    if (unit + F.G < NUNIT) P3B_PREFETCH(unit + F.G);
    __builtin_amdgcn_sched_barrier(0);
    __syncthreads();
    int buf = 0;
    for (; unit < NUNIT; unit += F.G, buf ^= 1) {
        int zq = 0; asm volatile("" : "+v"(zq));
        const int l15z = l15 + zq;
        bf16* INo = (bf16*)(F.ws + WS_IN) + (size_t)unit * 4096; bf16* UTo = (bf16*)(F.ws + WS_UT) + (size_t)unit * 8192; bf16* Wo = (bf16*)(F.ws + WS_W) + (size_t)unit * 8192;
        LAS bf16* sKGc = sKG0 + buf * 128 * 72; LAS bf16* sVBc = sVB0 + buf * 128 * 72; LAS float* sgc = sgc0 + buf * 128;
        {
            const int jt = w & 3, itp = w >> 2;
            bx8 ak[4];
#pragma unroll
            for (int ks = 0; ks < 4; ++ks) ak[ks] = *(const LAS bx8*)(sK + (16 * jt + l15) * 136 + 32 * ks + 8 * lq);
#pragma unroll
            for (int ii = 0; ii < 2; ++ii) { const int it = 2 * itp + ii, ci = 16 * it + l15z;
                f32x4 xk = {0.f, 0.f, 0.f, 0.f}, xq = xk;
#pragma unroll
                for (int ks = 0; ks < 4; ++ks) { const bx8 bk = *(const LAS bx8*)(sK + ci * 136 + 32 * ks + 8 * lq), bq = *(const LAS bx8*)(sQ + ci * 136 + 32 * ks + 8 * lq);
                    xk = MFMA16(ak[ks], bk, xk); xq = MFMA16(ak[ks], bq, xq); }
                const float gi = sgc[ci], bi = sgc[64 + ci];
                f32x4 av, iv;
#pragma unroll
                for (int e = 0; e < 4; ++e) { const int cj = 16 * jt + 4 * lq + e; const float dec = __expf(gi - sgc[cj]);
                    av[e] = (cj < ci) ? bi * xk[e] * dec : 0.f; iv[e] = (cj <= ci) ? xq[e] * dec : 0.f; }
                *(LAS f32x4*)(sA + ci * 68 + 16 * jt + 4 * lq) = av;
                *(v2u*)(INo + ci * 64 + 16 * jt + 4 * lq) = pack4(iv); }
        }
        __syncthreads();
        if (w == 6) {
            { const int blk = lq, c = l15; float t[16];
#pragma unroll
              for (int i = 0; i < 16; ++i) { float s2 = 0.f;
#pragma unroll
                  for (int jb = 0; jb < (i + 3) / 4; ++jb) { const f32x4 a4 = *(const LAS f32x4*)(sA + (16 * blk + i) * 68 + 16 * blk + 4 * jb);
#pragma unroll
                      for (int e = 0; e < 4; ++e) if (4 * jb + e < i) s2 -= a4[e] * t[4 * jb + e]; }
                  t[i] = (i == c) ? 1.0f : s2;
                  sT[(16 * blk + i) * 68 + 16 * blk + c] = t[i];
                  if ((i & 3) == 3) __builtin_amdgcn_sched_barrier(0); } }
            solve_block(sA, sT, 1, 0, l15, lq); solve_block(sA, sT, 2, 1, l15, lq); solve_block(sA, sT, 3, 2, l15, lq);
            solve_block(sA, sT, 2, 0, l15, lq); solve_block(sA, sT, 3, 1, l15, lq);
            solve_block(sA, sT, 3, 0, l15, lq);
#pragma unroll
            for (int q = 0; q < 8; ++q) { const int i = 8 * q + (lane >> 3), j8 = (lane & 7) * 8;
                *(LAS v4u*)(sTb + i * 72 + j8) = pack8(*(const LAS f32x4*)(sT + i * 68 + j8), *(const LAS f32x4*)(sT + i * 68 + j8 + 4)); }
        } else if (unit + F.G < NUNIT) {
            P3B_CONV(unit + F.G, buf ^ 1);
            __builtin_amdgcn_sched_barrier(0);
            if (unit + 2 * F.G < NUNIT) P3B_PREFETCH(unit + 2 * F.G);
            __builtin_amdgcn_sched_barrier(0);
        }
        __syncthreads();
        {
            bx8 bv[2], ag[2];
#pragma unroll
            for (int ks = 0; ks < 2; ++ks) { const int cb = 8 * ((4 * ks + lq) ^ rswz);
                bv[ks] = *(const LAS bx8*)(sVBc + (16 * w + l15) * 72 + cb); ag[ks] = *(const LAS bx8*)(sKGc + (16 * w + l15) * 72 + cb); }
#pragma unroll
            for (int it = 0; it < 4; ++it) { f32x4 u = {0.f, 0.f, 0.f, 0.f}, ww = u;
#pragma unroll
                for (int ks = 0; ks < 2; ++ks) { const bx8 ft = *(const LAS bx8*)(sTb + (16 * it + l15) * 72 + 32 * ks + 8 * lq); u = MFMA16(ft, bv[ks], u); ww = MFMA16(ag[ks], ft, ww); }
                *(v2u*)(UTo + (16 * w + l15z) * 64 + 16 * it + 4 * lq) = pack4(u);
                *(v2u*)(Wo + (16 * it + l15z) * 128 + 16 * w + 4 * lq) = pack4(ww); }
        }
    }
    __syncthreads();
#undef P3B_PREFETCH
#undef P3B_CONV
}

__device__ __forceinline__ void p4a_seg(Frame& F, int seg) {
    const int w = F.wave, l15 = F.lane & 15, lq = F.lane >> 4, ct = w >> 1, ch = w & 1;
    const int bh = seg >> 4, g = seg & 15, unit0 = bh * NCH + 8 * g;
    LAS bf16* sST = (LAS bf16*)F.lds;
    LAS bf16* sVT = sST + 256 * 136;
    LAS float* sDEC = (LAS float*)(sVT + 256 * 72);
    if (F.tid < 8) sDEC[F.tid] = ((const float*)(F.ws + WS_DEC))[unit0 + F.tid];
    for (int i = F.tid; i < 256 * 136 / 2; i += 512) ((LAS unsigned*)sST)[i] = 0u;
    __syncthreads();
    if (F.tid < 128) sST[F.tid * 136 + F.tid] = (bf16)0x3F80;
    f32x4 ST[16];
#pragma unroll
    for (int t = 0; t < 16; ++t)
#pragma unroll
        for (int e = 0; e < 4; ++e) ST[t][e] = (t == w && l15 == 4 * lq + e) ? 1.0f : 0.0f;
    const bf16* Wg = (const bf16*)(F.ws + WS_W) + (size_t)unit0 * 8192 + (16 * ct + l15) * 128 + 8 * lq;
    const bf16* Kg = (const bf16*)(F.ws + WS_KDT) + (size_t)unit0 * 8192 + (16 * w + l15) * 64 + 8 * lq;
    const bf16* Ug = (const bf16*)(F.ws + WS_UT) + (size_t)unit0 * 8192 + l15 * 64 + 16 * ct + 4 * lq;
    bx8 fW[4], fK[2]; v2u fU[8];
#pragma unroll
    for (int ks = 0; ks < 4; ++ks) fW[ks] = *(const bx8*)(Wg + 32 * ks);
#pragma unroll
    for (int ks = 0; ks < 2; ++ks) fK[ks] = *(const bx8*)(Kg + 32 * ks);
#pragma unroll
    for (int t = 0; t < 8; ++t) fU[t] = ch ? *(const v2u*)(Ug + t * 16 * 64) : (v2u){0u, 0u};
    __syncthreads();
    for (int sI = 0; sI < 8; ++sI) {
        const float dec = sDEC[sI];
        const int nn = (sI < 7) ? 1 : 0;
#pragma unroll
        for (int t = 0; t < 8; ++t) { const int Tc = 8 * ch + t; f32x4 p = {0.f, 0.f, 0.f, 0.f};
#pragma unroll
            for (int ks = 0; ks < 4; ++ks) { const bx8 fS = *(const LAS bx8*)(sST + (16 * Tc + l15) * 136 + 32 * ks + 8 * lq); p = MFMA16(fW[ks], fS, p); }
            const f32x4 u = {bflo(fU[t].x), bfhi(fU[t].x), bflo(fU[t].y), bfhi(fU[t].y)};
            *(LAS v2u*)(sVT + (16 * Tc + l15) * 72 + 16 * ct + 4 * lq) = pack4(u - p); }
        Wg += nn * 8192; Ug += nn * 8192;
#pragma unroll
        for (int ks = 0; ks < 4; ++ks) fW[ks] = *(const bx8*)(Wg + 32 * ks);
#pragma unroll
        for (int t = 0; t < 8; ++t) fU[t] = ch ? *(const v2u*)(Ug + t * 16 * 64) : (v2u){0u, 0u};
        __syncthreads();
#pragma unroll
        for (int t = 0; t < 16; ++t) { ST[t] = ST[t] * dec;
#pragma unroll
            for (int ks = 0; ks < 2; ++ks) { const bx8 fV = *(const LAS bx8*)(sVT + (16 * t + l15) * 72 + 32 * ks + 8 * lq); ST[t] = MFMA16(fK[ks], fV, ST[t]); }
            *(LAS v2u*)(sST + (16 * t + l15) * 136 + 16 * w + 4 * lq) = pack4(ST[t]); }
        Kg += nn * 8192;
#pragma unroll
        for (int ks = 0; ks < 2; ++ks) fK[ks] = *(const bx8*)(Kg + 32 * ks);
        __syncthreads();
    }
    bf16* PHI = (bf16*)((unsigned char*)F.out + OUT_PHI) + (size_t)seg * 16384;
#pragma unroll
    for (int t = 0; t < 8; ++t)
#pragma unroll
        for (int e = 0; e < 4; ++e) PHI[(16 * w + 4 * lq + e) * 128 + 16 * t + l15] = (bf16)f2bf(ST[t][e]);
    f32x4* LS = (f32x4*)((unsigned char*)F.out + OUT_LSEG) + ((size_t)(seg * 8 + w) * 8) * 64 + F.lane;
#pragma unroll
    for (int t = 0; t < 8; ++t) LS[t * 64] = ST[8 + t];
}
__device__ __forceinline__ void p4b_fold(Frame& F, int item) {
    const int w = F.wave, l15 = F.lane & 15, lq = F.lane >> 4, bh = item >> 2, dvs = item & 3;
    LAS bf16* sS = (LAS bf16*)F.lds;
    for (int i = F.tid; i < 32 * 136 / 2; i += 512) ((LAS unsigned*)sS)[i] = 0u;
    const bf16* Pg = (const bf16*)((const unsigned char*)F.out + OUT_PHI) + (size_t)(bh * 16) * 16384 + (16 * w + l15) * 128 + 8 * lq;
    const f32x4* Lg = (const f32x4*)((const unsigned char*)F.out + OUT_LSEG) + ((size_t)(bh * 16 * 8 + w) * 8 + 2 * dvs) * 64 + F.lane;
    f32x4* So = (f32x4*)((unsigned char*)F.out + OUT_LSEG) + ((size_t)(bh * 16 * 8 + w) * 8 + 2 * dvs) * 64 + F.lane;
    bx8 fP[4]; f32x4 L[2];
#pragma unroll
    for (int ks = 0; ks < 4; ++ks) fP[ks] = *(const bx8*)(Pg + 32 * ks);
    L[0] = Lg[0]; L[1] = Lg[64];
    __syncthreads();
    for (int g = 0; g < 15; ++g) {
        f32x4 Sn[2];
#pragma unroll
        for (int t = 0; t < 2; ++t) { f32x4 acc = L[t];
#pragma unroll
            for (int ks = 0; ks < 4; ++ks) { const bx8 fS = *(const LAS bx8*)(sS + (16 * t + l15) * 136 + 32 * ks + 8 * lq); acc = MFMA16(fP[ks], fS, acc); }
            Sn[t] = acc; }
        const int nn = (g < 14) ? 1 : 0;
        Pg += nn * 16384; Lg += nn * 8 * 8 * 64;
#pragma unroll
        for (int ks = 0; ks < 4; ++ks) fP[ks] = *(const bx8*)(Pg + 32 * ks);
        L[0] = Lg[0]; L[1] = Lg[64];
        __syncthreads();
#pragma unroll
        for (int t = 0; t < 2; ++t) { *(LAS v2u*)(sS + (16 * t + l15) * 136 + 16 * w + 4 * lq) = pack4(Sn[t]); So[t * 64] = Sn[t]; }
        So += 8 * 8 * 64;
        __syncthreads();
    }
}
__device__ __forceinline__ void p4c_seg(Frame& F, int seg) {
    const int bh = seg >> 4, g = seg & 15, unit0 = bh * NCH + 8 * g;
    const int h = bh % NH, b = bh / NH, w = F.wave, l15 = F.lane & 15, lq = F.lane >> 4, ct = w >> 1, dvh = w & 1;
    LAS bf16* sST = (LAS bf16*)F.lds;
    LAS bf16* sVT = sST + 128 * 136;
    LAS float* sSS = (LAS float*)(sVT + 128 * 72);
    LAS float* sDEC = sSS + 128;
    if (F.tid < 8) sDEC[F.tid] = ((const float*)(F.ws + WS_DEC))[unit0 + F.tid];
    f32x4 S[8], gn[4];
    { const f32x4* Sg = (const f32x4*)((const unsigned char*)F.out + OUT_LSEG) + ((size_t)((seg - 1) * 8 + w) * 8) * 64 + F.lane;
#pragma unroll
      for (int t = 0; t < 8; ++t) { S[t] = (f32x4){0.f, 0.f, 0.f, 0.f}; if (g != 0) S[t] = Sg[t * 64];
          *(LAS v2u*)(sST + (16 * t + l15) * 136 + 16 * w + 4 * lq) = pack4(S[t]); } }
    const bf16* Wg = (const bf16*)(F.ws + WS_W) + (size_t)unit0 * 8192 + (16 * ct + l15) * 128 + 8 * lq;
    const bf16* Qg = (const bf16*)(F.ws + WS_QD) + (size_t)unit0 * 8192 + (16 * ct + l15) * 128 + 8 * lq;
    const bf16* Ig = (const bf16*)(F.ws + WS_IN) + (size_t)unit0 * 4096 + (16 * ct + l15) * 64 + 8 * lq;
    const bf16* Kg = (const bf16*)(F.ws + WS_KDT) + (size_t)unit0 * 8192 + (16 * w + l15) * 64 + 8 * lq;
    const bf16* Ug = (const bf16*)(F.ws + WS_UT) + (size_t)unit0 * 8192 + (16 * 4 * dvh + l15) * 64 + 16 * ct + 4 * lq;
    bf16* OR = (bf16*)(F.ws + WS_OR);
    bx8 fW[4], fQ[4], fI[2], fK[2]; v2u fU[4];
#pragma unroll
    for (int ks = 0; ks < 4; ++ks) { fW[ks] = *(const bx8*)(Wg + 32 * ks); fQ[ks] = *(const bx8*)(Qg + 32 * ks); fU[ks] = *(const v2u*)(Ug + ks * 16 * 64); }
#pragma unroll
    for (int ks = 0; ks < 2; ++ks) { fI[ks] = *(const bx8*)(Ig + 32 * ks); fK[ks] = *(const bx8*)(Kg + 32 * ks); }
#pragma unroll
    for (int t = 0; t < 4; ++t) gn[t] = *(const f32x4*)(F.onorm_g + 16 * (4 * dvh + t) + 4 * lq);
    __syncthreads();
    for (int sI = 0; sI < 8; ++sI) {
        const float dec = sDEC[sI];
        const int nn = (sI < 7) ? 1 : 0;
        f32x4 pS[4], qS[4];
#pragma unroll
        for (int t = 0; t < 4; ++t) { bx8 fS[4];
#pragma unroll
            for (int ks = 0; ks < 4; ++ks) fS[ks] = *(const LAS bx8*)(sST + (16 * (4 * dvh + t) + l15) * 136 + 32 * ks + 8 * lq);
            f32x4 p = {0.f, 0.f, 0.f, 0.f}, q = {0.f, 0.f, 0.f, 0.f};
#pragma unroll
            for (int ks = 0; ks < 4; ++ks) { p = MFMA16(fW[ks], fS[ks], p); q = MFMA16(fS[ks], fQ[ks], q); }
            pS[t] = p; qS[t] = q; }
#pragma unroll
        for (int t = 0; t < 4; ++t) { const f32x4 u = {bflo(fU[t].x), bfhi(fU[t].x), bflo(fU[t].y), bfhi(fU[t].y)};
            *(LAS v2u*)(sVT + (16 * (4 * dvh + t) + l15) * 72 + 16 * ct + 4 * lq) = pack4(u - pS[t]); }
        Wg += nn * 8192; Qg += nn * 8192; Ug += nn * 8192;
#pragma unroll
        for (int ks = 0; ks < 4; ++ks) { fW[ks] = *(const bx8*)(Wg + 32 * ks); fQ[ks] = *(const bx8*)(Qg + 32 * ks); fU[ks] = *(const v2u*)(Ug + ks * 16 * 64); }
        __syncthreads();
        float ss = 0.f;
#pragma unroll
        for (int t = 0; t < 4; ++t) {
#pragma unroll
            for (int ks = 0; ks < 2; ++ks) { const bx8 fV = *(const LAS bx8*)(sVT + (16 * (4 * dvh + t) + l15) * 72 + 32 * ks + 8 * lq); qS[t] = MFMA16(fV, fI[ks], qS[t]); }
            ss += (qS[t][0] * qS[t][0] + qS[t][1] * qS[t][1]) + (qS[t][2] * qS[t][2] + qS[t][3] * qS[t][3]); }
        ss += __shfl_xor(ss, 16); ss += __shfl_xor(ss, 32);
        if (lq == 0) sSS[dvh * 64 + 16 * ct + l15] = ss;
        Ig += nn * 4096;
#pragma unroll
        for (int ks = 0; ks < 2; ++ks) fI[ks] = *(const bx8*)(Ig + 32 * ks);
#pragma unroll
        for (int t = 0; t < 8; ++t) { S[t] = S[t] * dec;
#pragma unroll
            for (int ks = 0; ks < 2; ++ks) { const bx8 fV = *(const LAS bx8*)(sVT + (16 * t + l15) * 72 + 32 * ks + 8 * lq); S[t] = MFMA16(fK[ks], fV, S[t]); }
            *(LAS v2u*)(sST + (16 * t + l15) * 136 + 16 * w + 4 * lq) = pack4(S[t]); }
        Kg += nn * 8192;
#pragma unroll
        for (int ks = 0; ks < 2; ++ks) fK[ks] = *(const bx8*)(Kg + 32 * ks);
        __syncthreads();
        const float rstd = __frsqrt_rn((sSS[16 * ct + l15] + sSS[64 + 16 * ct + l15]) * (1.0f / 128.0f) + EPS);
        bf16* orow = OR + (size_t)(b * T + (8 * g + sI) * CH + 16 * ct + l15) * D + h * 128 + 16 * 4 * dvh + 4 * lq;
#pragma unroll
        for (int t = 0; t < 4; ++t) *(v2u*)(orow + 16 * t) = pack4(qS[t] * rstd * gn[t]);
    }
    __syncthreads();
}

__device__ __forceinline__ void p8_router(Frame& F) {
    const int gw = blockIdx.x * NWAVES + F.wave, RPW = M / (F.G * NWAVES);
    bf16* H2 = (bf16*)(F.ws + WS_H2); int* TOKE = (int*)(F.ws + WS_TOKE); float* TOKW = (float*)(F.ws + WS_TOKW);
    LAS float* wT = (LAS float*)F.lds;
    LAS unsigned* hist = (LAS unsigned*)(wT + 36 * 1028);
    for (int i = F.tid; i < D * NGRP; i += 512) wT[(i & 3) * 1028 + (i >> 2)] = F.w_group[i];
    for (int i = F.tid; i < D * NE; i += 512) wT[(4 + (i & 31)) * 1028 + (i >> 5)] = F.w_expert[i];
    if (F.tid < NE) hist[F.tid] = 0u;
    __syncthreads();
    f32x4 gsc[4], gsh[4];
    { const int b = (gw * RPW) / T;
#pragma unroll
      for (int j = 0; j < 4; ++j) { const int col = 256 * j + 4 * F.lane; const f32x4 g2 = *(const f32x4*)(F.norm2_g + col);
          gsc[j] = g2 * (1.0f + *(const f32x4*)((const float*)(F.ws + CTL_MODACC) + b * 6144 + 4 * D + col)); gsh[j] = *(const f32x4*)((const float*)(F.ws + CTL_MODACC) + b * 6144 + 3 * D + col); } }
    for (int m = gw * RPW; m < (gw + 1) * RPW; ++m) {
        const f32x4* xr = (const f32x4*)(F.out + (size_t)m * D) + F.lane;
        f32x4 v[4]; float s = 0.f;
#pragma unroll
        for (int j = 0; j < 4; ++j) { v[j] = xr[64 * j]; s += (v[j].x * v[j].x + v[j].y * v[j].y) + (v[j].z * v[j].z + v[j].w * v[j].w); }
        const float rstd = __frsqrt_rn(wave_sum(s) * (1.f / D) + EPS);
#pragma unroll
        for (int j = 0; j < 4; ++j) { v[j] = v[j] * rstd * gsc[j] + gsh[j];
            *(v2u*)(H2 + (size_t)m * D + 256 * j + 4 * F.lane) = (v2u){pk2(v[j][0], v[j][1]), pk2(v[j][2], v[j][3])}; }
        float gp[4];
#pragma unroll
        for (int q = 0; q < 4; ++q) { float p = 0.f;
#pragma unroll
            for (int j = 0; j < 4; ++j) { const f32x4 w = *(const LAS f32x4*)(wT + q * 1028 + 256 * j + 4 * F.lane); p += (v[j][0] * w[0] + v[j][1] * w[1]) + (v[j][2] * w[2] + v[j][3] * w[3]); }
            gp[q] = p; }
        fold_step<4, 4>(gp, 32, (F.lane & 32) != 0); fold_step<2, 4>(gp, 16, (F.lane & 16) != 0);
        float gv = gp[0]; gv += __shfl_xor(gv, 8); gv += __shfl_xor(gv, 4); gv += __shfl_xor(gv, 2); gv += __shfl_xor(gv, 1);
        float gl[4];
#pragma unroll
        for (int q = 0; q < 4; ++q) gl[q] = readlane_f(gv, 32 * (q >> 1) + 16 * (q & 1)) + F.b_group[q];
        int gs = 0; float gm = gl[0];
#pragma unroll
        for (int q = 1; q < 4; ++q) if (gl[q] > gm) { gm = gl[q]; gs = q; }
        float den = 0.f;
#pragma unroll
        for (int q = 0; q < 4; ++q) den += __expf(gl[q] - gm);
        const float pg = 1.0f / den;
        float ep[8];
#pragma unroll
        for (int q = 0; q < 8; ++q) { float p = 0.f;
#pragma unroll
            for (int j = 0; j < 4; ++j) { const f32x4 w = *(const LAS f32x4*)(wT + (4 + gs * 8 + q) * 1028 + 256 * j + 4 * F.lane); p += (v[j][0] * w[0] + v[j][1] * w[1]) + (v[j][2] * w[2] + v[j][3] * w[3]); }
            ep[q] = p; }
        fold_step<8, 8>(ep, 32, (F.lane & 32) != 0); fold_step<4, 8>(ep, 16, (F.lane & 16) != 0); fold_step<2, 8>(ep, 8, (F.lane & 8) != 0);
        float ev = ep[0]; ev += __shfl_xor(ev, 4); ev += __shfl_xor(ev, 2); ev += __shfl_xor(ev, 1);
        float el[8];
#pragma unroll
        for (int q = 0; q < 8; ++q) el[q] = readlane_f(ev, 32 * (q >> 2) + 16 * ((q >> 1) & 1) + 8 * (q & 1)) + F.b_expert[gs * 8 + q];
        int i0 = 0; float v0 = el[0];
#pragma unroll
        for (int q = 1; q < 8; ++q) if (el[q] > v0) { v0 = el[q]; i0 = q; }
        int i1 = -1; float v1 = -3.0e38f;
#pragma unroll
        for (int q = 0; q < 8; ++q) if (q != i0 && el[q] > v1) { v1 = el[q]; i1 = q; }
        const float e1 = __expf(v1 - v0), sw = 1.0f / (1.0f + e1);
        if (F.lane == 0) {
            const int ea = gs * 8 + i0, eb = gs * 8 + i1;
            TOKE[m * 2] = ea; TOKE[m * 2 + 1] = eb; TOKW[m * 2] = pg * sw; TOKW[m * 2 + 1] = pg * e1 * sw;
            __hip_atomic_fetch_add((unsigned*)(hist + ea), 1u, __ATOMIC_RELAXED, __HIP_MEMORY_SCOPE_WORKGROUP); __hip_atomic_fetch_add((unsigned*)(hist + eb), 1u, __ATOMIC_RELAXED, __HIP_MEMORY_SCOPE_WORKGROUP);
        }
    }
    __syncthreads();
    if (F.tid < NE) ((unsigned*)(F.ws + WS_WGHIST))[blockIdx.x * NE + F.tid] = hist[F.tid];
}
__device__ __forceinline__ int moe_tables(Frame& F) {
    volatile LAS int* ps = (volatile LAS int*)(F.lds + MISC_OFF + 64); volatile LAS int* te = (volatile LAS int*)(F.lds + MISC_OFF + 256);
    volatile LAS int* tot = (volatile LAS int*)(F.lds + MISC_OFF + 1024); volatile LAS int* base = (volatile LAS int*)(F.lds + MISC_OFF + 1152);
    LAS int* part = (LAS int*)(F.lds + MISC_OFF - 4096);
    const unsigned* WGH = (const unsigned*)(F.ws + WS_WGHIST);
    __syncthreads();
    { const int e = F.tid & 31, p = F.tid >> 5; int t = 0, bsum = 0;
      for (int j = p; j < F.G; j += 16) { const int v = (int)WGH[j * NE + e]; t += v; bsum += (j < (int)blockIdx.x) ? v : 0; }
      part[p * 32 + e] = t; part[512 + p * 32 + e] = bsum; }
    __syncthreads();
    if (F.tid < 32) { int t = 0, bsum = 0;
#pragma unroll
        for (int p = 0; p < 16; ++p) { t += part[p * 32 + F.tid]; bsum += part[512 + p * 32 + F.tid]; }
        tot[F.tid] = t; base[F.tid] = bsum; }
    __syncthreads();
    if (F.tid == 0) { int a = 0;
        for (int e = 0; e < NE; ++e) { const int cnt = tot[e]; ps[e] = a; const int nb = (cnt + 255) >> 8;
            for (int r = 0; r < nb; ++r) te[(a >> 8) + r] = e; a += nb << 8; }
        ps[32] = a; }
    __syncthreads();
    return ps[32] >> 8;
}
__device__ __forceinline__ void p9_gather(Frame& F) {
    moe_tables(F);
    volatile LAS int* ps = (volatile LAS int*)(F.lds + MISC_OFF + 64); volatile LAS int* tot = (volatile LAS int*)(F.lds + MISC_OFF + 1024); volatile LAS int* base = (volatile LAS int*)(F.lds + MISC_OFF + 1152);
    LAS unsigned* lcur = (LAS unsigned*)F.lds;
    if (F.tid < NE) lcur[F.tid] = 0u;
    __syncthreads();
    const int gw = blockIdx.x * NWAVES + F.wave, RPW = M / (F.G * NWAVES);
    int* ROWTOK = (int*)(F.ws + WS_ROWTOK); float* ROWW = (float*)(F.ws + WS_ROWW);
    const int* TOKE = (const int*)(F.ws + WS_TOKE); const float* TOKW = (const float*)(F.ws + WS_TOKW);
    const bf16* H2 = (const bf16*)(F.ws + WS_H2); bf16* XS = (bf16*)(F.ws + WS_XS);
    for (int e = blockIdx.x; e < NE; e += F.G) for (int r = ps[e] + tot[e] + F.tid; r < ps[e + 1]; r += 512) ROWTOK[r] = -1;
    for (int m = gw * RPW; m < (gw + 1) * RPW; ++m) {
        int pos = 0;
        if (F.lane < 2) { const int e = TOKE[m * 2 + F.lane]; pos = ps[e] + base[e] + (int)__hip_atomic_fetch_add((unsigned*)(lcur + e), 1u, __ATOMIC_RELAXED, __HIP_MEMORY_SCOPE_WORKGROUP); ROWTOK[pos] = m * 2 + F.lane; ROWW[pos] = TOKW[m * 2 + F.lane]; }
        const int p0 = __shfl(pos, 0), p1 = __shfl(pos, 1);
        const v4u a = *((const v4u*)(H2 + (size_t)m * D) + F.lane), bb = *((const v4u*)(H2 + (size_t)m * D) + 64 + F.lane);
        *((v4u*)(XS + (size_t)p0 * D) + F.lane) = a; *((v4u*)(XS + (size_t)p0 * D) + 64 + F.lane) = bb;
        *((v4u*)(XS + (size_t)p1 * D) + F.lane) = a; *((v4u*)(XS + (size_t)p1 * D) + 64 + F.lane) = bb;
    }
}
__device__ __forceinline__ void p12_final(Frame& F) {
    const int gw = blockIdx.x * NWAVES + F.wave, RPW = M / (F.G * NWAVES);
    const bf16* YBUF = (const bf16*)(F.ws + WS_YBUF);
    f32x4 gt[4], gf[4];
    { const int b = (gw * RPW) / T;
#pragma unroll
      for (int j = 0; j < 4; ++j) { gt[j] = *(const f32x4*)((const float*)(F.ws + CTL_MODACC) + b * 6144 + 5 * D + 256 * j + 4 * F.lane); gf[j] = *(const f32x4*)(F.normf_g + 256 * j + 4 * F.lane); } }
    for (int m = gw * RPW; m < (gw + 1) * RPW; ++m) {
        f32x4* xr = (f32x4*)(F.out + (size_t)m * D) + F.lane;
        f32x4 v[4]; float s = 0.f;
#pragma unroll
        for (int j = 0; j < 4; ++j) { const int col = 256 * j + 4 * F.lane; v[j] = xr[64 * j];
            const v2u y0 = *(const v2u*)(YBUF + (size_t)(2 * m) * D + col), y1 = *(const v2u*)(YBUF + (size_t)(2 * m + 1) * D + col);
            const f32x4 ys = {bflo(y0.x) + bflo(y1.x), bfhi(y0.x) + bfhi(y1.x), bflo(y0.y) + bflo(y1.y), bfhi(y0.y) + bfhi(y1.y)};
            v[j] += gt[j] * ys;
            s += (v[j].x * v[j].x + v[j].y * v[j].y) + (v[j].z * v[j].z + v[j].w * v[j].w); }
        const float rstd = __frsqrt_rn(wave_sum(s) * (1.f / D) + EPS);
#pragma unroll
        for (int j = 0; j < 4; ++j) xr[64 * j] = v[j] * rstd * gf[j];
    }
}

constexpr int NPH = 16;
struct Args { const float* in[23]; float* out; unsigned char* ws; int ph_lo, ph_hi; };
__global__ void __launch_bounds__(NWAVES * 64, 2) fwd(Args args) {
    extern __shared__ __attribute__((aligned(16))) unsigned char lds[];
    Frame F;
    F.lds = (LAS unsigned char*)lds; F.MISC = (volatile LAS unsigned*)(F.lds + MISC_OFF);
    F.tid = threadIdx.x; F.lane = F.tid & 63; F.wave = __builtin_amdgcn_readfirstlane(F.tid >> 6);
    F.G = gridDim.x; { const int bx = blockIdx.x; F.vcu = (F.G % 8 == 0) ? (bx % 8) * (F.G / 8) + bx / 8 : bx; }
    F.ws = args.ws; F.out = args.out; F.ctl = (unsigned*)(args.ws + WS_CTL);
    F.x = args.in[0]; F.c = args.in[1]; F.w_ada = args.in[2]; F.b_ada = args.in[3]; F.norm1_g = args.in[4]; F.w_in = args.in[5]; F.conv_qkv_w = args.in[6];
    F.a_log = args.in[7]; F.dt_bias = args.in[8]; F.onorm_g = args.in[9]; F.w_proj_a = args.in[10]; F.conv_sc_w = args.in[11]; F.w_proj_b = args.in[12]; F.w_out = args.in[13];
    F.norm2_g = args.in[14]; F.w_group = args.in[15]; F.b_group = args.in[16]; F.w_expert = args.in[17]; F.b_expert = args.in[18]; F.w1 = args.in[19]; F.w3 = args.in[20];
    F.w2 = args.in[21]; F.normf_g = args.in[22];
    if (F.tid < 4) F.MISC[F.tid] = 0u;
    __syncthreads();
    const int lo = args.ph_lo, hi = args.ph_hi;
    const bool fused = (hi - lo) > 1;
    XcdBarrier bar; bar.bar = F.ctl + CW_BAR; bar.x = 0; bar.st = F.MISC;
    if (fused) bar = xcd_barrier_post(F.ctl + CW_BAR, F.MISC);
#ifndef PH_MASK
#define PH_MASK 0xFFFFFFFFu
#endif
#define IN(k) (((PH_MASK >> (k)) & 1) && lo <= (k) && (k) < hi)
#define SEAM(k) do { if (IN(k) && IN((k) + 1)) xcd_barrier(bar); } while (0)
    bf16* H = (bf16*)F.out; bf16* YBP = (bf16*)F.out + (size_t)M * D;

    if (IN(0)) { p0_prologue(F); } SEAM(0);
    if (IN(1)) { p1_norm1(F); } SEAM(1);
    if (IN(2)) {
        pg8::Gemm g{H, (const bf16*)(F.ws + WS_WINA), M, 6144, D}; pg8::StaticOrder S; S.init(M, 6144, F.G, (int)blockIdx.x);
        EpiInA E{(bf16*)(F.ws + WS_QKV), (bf16*)(F.ws + WS_SB), (bf16*)(F.ws + WS_P)};
        pg8::gemm_phase<EpiInA, pg8::StaticOrder, true, true>(F.lds, g, S, E);
    } SEAM(2);
    if (IN(3)) { p3a_ybp(F); p3b_loop(F); } SEAM(3);
    if (IN(4)) {
        pg8::Gemm g{YBP, (const bf16*)(F.ws + WS_WB), M, D, D}; pg8::StaticOrder S; S.init(M, D, F.G, (int)blockIdx.x);
        EpiPlain E{(bf16*)(F.ws + WS_YB), D};
        pg8::gemm_phase<EpiPlain, pg8::StaticOrder, true, true>(F.lds, g, S, E);
    } SEAM(4);
    if (IN(5)) { for (int it = blockIdx.x; it < NB * NH * 16; it += F.G) p4a_seg(F, it); } SEAM(5);
    if (IN(6)) { for (int it = blockIdx.x; it < NB * NH * 4; it += F.G) p4b_fold(F, it); p_moe_weights(F); } SEAM(6);
    if (IN(7)) { for (int it = blockIdx.x; it < NB * NH * 16; it += F.G) p4c_seg(F, it); } SEAM(7);
    if (IN(8)) {
        pg8::Gemm g{H, (const bf16*)(F.ws + WS_WINB), M, 3072, D}; pg8::StaticOrder S; S.init(M, 3072, F.G, (int)blockIdx.x);
        EpiInB E{F.ws};
        pg8::gemm_phase<EpiInB, pg8::StaticOrder, true, true>(F.lds, g, S, E);
    } SEAM(8);
    if (IN(9)) {
        pg8::Gemm g{(const bf16*)(F.ws + WS_OR), (const bf16*)(F.ws + WS_WA), M, D, D}; pg8::StaticOrder S; S.init(M, D, F.G, (int)blockIdx.x);
        EpiMerge E{(const bf16*)(F.ws + WS_GA), (const bf16*)(F.ws + WS_GB), (const bf16*)(F.ws + WS_YB), (bf16*)(F.ws + WS_GA)};
        pg8::gemm_phase<EpiMerge, pg8::StaticOrder, true, true>(F.lds, g, S, E);
    } SEAM(9);
    if (IN(10)) {
        pg8::Gemm g{(const bf16*)(F.ws + WS_GA), (const bf16*)(F.ws + WS_WO), M, D, D}; pg8::StaticOrder S; S.init(M, D, F.G, (int)blockIdx.x);
        EpiX1 E{F.x, F.out, (const float*)(F.ws + CTL_MODACC), F.b_ada};
        pg8::gemm_phase<EpiX1, pg8::StaticOrder, true, true>(F.lds, g, S, E);
    } SEAM(10);
    if (IN(11)) { p8_router(F); } SEAM(11);
    if (IN(12)) { p9_gather(F); } SEAM(12);
    if (IN(13)) {
        const int nt = moe_tables(F);
        pg8::Gemm g{(const bf16*)(F.ws + WS_XS), (const bf16*)(F.ws + WS_W13), MOE_CAP, NE * D, D};
        MoeOrder S{nt, F.G, (int)blockIdx.x, (const volatile LAS int*)(F.lds + MISC_OFF + 256)};
        EpiHid E{(bf16*)(F.ws + WS_HID)};
        pg8::gemm_phase<EpiHid, MoeOrder, true, true>(F.lds, g, S, E);
    } SEAM(13);
    if (IN(14)) {
        const int nt = moe_tables(F);
        pg8::Gemm g{(const bf16*)(F.ws + WS_HID), (const bf16*)(F.ws + WS_W2), MOE_CAP, NE * D, DE};
        MoeOrder S{nt, F.G, (int)blockIdx.x, (const volatile LAS int*)(F.lds + MISC_OFF + 256)};
        EpiMoeOut E{(bf16*)(F.ws + WS_YBUF), (const int*)(F.ws + WS_ROWTOK), (const float*)(F.ws + WS_ROWW)};
        pg8::gemm_phase<EpiMoeOut, MoeOrder, true, true>(F.lds, g, S, E);
    } SEAM(14);
    if (IN(15)) { p12_final(F); }
#undef IN
#undef SEAM
}

extern "C" void kernel_launch(void* const* d_in, const int* in_sizes, int n_in, void* d_out, int out_size, void* d_ws, size_t ws_size, hipStream_t stream) {
    static int grid = 0;
    if (grid == 0) {
        if (n_in != 23 || out_size != M * D || ws_size < WS_END) { fprintf(stderr, "kernel_launch: unexpected problem (n_in %d, out %d, ws %zu)\n", n_in, out_size, ws_size); grid = -1; return; }
        int dev = 0, cus = 0, per_cu = 0;
        if (hipGetDevice(&dev) != hipSuccess || hipDeviceGetAttribute(&cus, hipDeviceAttributeMultiprocessorCount, dev) != hipSuccess) { grid = -1; return; }
        if (hipFuncSetAttribute((const void*)fwd, hipFuncAttributeMaxDynamicSharedMemorySize, LDS_BYTES) != hipSuccess) { fprintf(stderr, "kernel_launch: hipFuncSetAttribute failed\n"); grid = -1; return; }
        if (hipOccupancyMaxActiveBlocksPerMultiprocessor(&per_cu, (const void*)fwd, NWAVES * 64, LDS_BYTES) != hipSuccess || per_cu < 1) { fprintf(stderr, "kernel_launch: occupancy query says %d\n", per_cu); }
        (void)hipGetLastError();
        grid = cus;
        if (M % (grid * NWAVES) != 0 || grid < 64) { fprintf(stderr, "kernel_launch: unsupported CU count %d\n", cus); grid = -1; return; }
    }
    if (grid < 0) return;
    (void)hipMemsetAsync((char*)d_ws + WS_CTL, 0, CTL_ZERO_BYTES, stream);
    Args a{};
    for (int i = 0; i < 23; ++i) a.in[i] = (const float*)d_in[i];
    a.out = (float*)d_out; a.ws = (unsigned char*)d_ws;
#ifndef MK_FUSED
#define MK_FUSED 1
#endif
#ifdef PROBE_DUP
    { const int cuts[4] = {0, PROBE_DUP + 1, PROBE_DUP, NPH}; const int ends[3] = {PROBE_DUP + 1, PROBE_DUP + 1, NPH};
      for (int li = 0; li < 3; ++li) { a.ph_lo = (li == 0) ? 0 : (li == 1 ? PROBE_DUP : PROBE_DUP + 1); a.ph_hi = ends[li]; (void)cuts;
          hipMemsetAsync((char*)d_ws + WS_CTL + CW_BAR * 4, 0, XCD_BAR_WORDS * 4, stream);
          if (a.ph_lo < a.ph_hi) hipLaunchKernelGGL(fwd, dim3(grid), dim3(NWAVES * 64), LDS_BYTES, stream, a); } return; }
#endif
    if (MK_FUSED) { a.ph_lo = 0; a.ph_hi = NPH; hipLaunchKernelGGL(fwd, dim3(grid), dim3(NWAVES * 64), LDS_BYTES, stream, a); }
    else for (int p = 0; p < NPH; ++p) { a.ph_lo = p; a.ph_hi = p + 1; hipLaunchKernelGGL(fwd, dim3(grid), dim3(NWAVES * 64), LDS_BYTES, stream, a); }
}
```

```cpp
#include <hip/hip_runtime.h>
#include <cstdio>
#include <cstdint>
namespace pg8 {
#define PG8_LAS __attribute__((address_space(3)))
typedef unsigned short bf16_t;
typedef short bf16x8 __attribute__((ext_vector_type(8)));
typedef float f32x4 __attribute__((ext_vector_type(4)));
typedef unsigned u32x4 __attribute__((ext_vector_type(4)));
constexpr int BM = 256, BK = 64, HALF = 128, HTB = HALF * BK * 2  , STAGE_BYTES = 8 * HTB, NXCD = 8, WGM = 8;

__host__ __device__ __forceinline__ int lds_byte(int r, int c) { const int st = (r >> 4) * 2 + (c >> 5), rr = r & 15, cc = c & 31, ob = rr * 64 + cc * 2; return st * 1024 + (ob ^ (((ob >> 9) & 1) << 5)); }
__host__ __device__ __forceinline__ void stage_rc(int b, int& R, int& C) { const int st = b / 1024, sb = b % 1024, swz = sb ^ (((sb >> 9) & 1) << 5); R = (st >> 1) * 16 + swz / 64; C = (st & 1) * 32 + (swz % 64) / 2; }
__host__ __device__ __forceinline__ int perm32(int rho) { const int n = rho >> 4, i = rho & 15; return 8 * (i >> 2) + 4 * n + (i & 3); }

struct Unit { int pm, pn; };
struct Gemm { const bf16_t* A; const bf16_t* Bt; int M, N, K; };

struct StaticOrder {
    int nM, nN, nwg, G, c;
    __host__ __device__ void init(int M, int N, int G_, int c_) { nM = M / BM; nN = N / BM; nwg = nM * nN; G = G_; c = c_; }
    __host__ __device__ bool next(int i, Unit& u) const {
        const long L = (long)i * G + c; if (L >= nwg) return false;
        int wgid = (int)L; { const int q = nwg / NXCD, r = nwg % NXCD, xcd = wgid % NXCD, off = wgid / NXCD; wgid = (xcd < r ? xcd * (q + 1) : r * (q + 1) + (xcd - r) * q) + off; }
        const int nig = WGM * nN, gid = wgid / nig, fm = gid * WGM, gsz = (nM - fm) < WGM ? (nM - fm) : WGM;
        u.pm = fm + ((wgid % nig) % gsz); u.pn = (wgid % nig) / gsz; return true;
    }
    __device__ __forceinline__ void a_ready(const Unit&) const {}
    __device__ __forceinline__ void done(const Unit&) const {}
};

typedef float f32x2_cv __attribute__((ext_vector_type(2)));
typedef __bf16 bf16x2_cv __attribute__((ext_vector_type(2)));
__device__ __forceinline__ unsigned cvt_pk_bf16(float lo, float hi) { const f32x2_cv v = {lo, hi}; return __builtin_bit_cast(unsigned, __builtin_convertvector(v, bf16x2_cv)); }
template <class Epi, class Sched, bool ALIGN_EPI = false, bool SP2 = false>
__device__ __forceinline__ void gemm_phase(PG8_LAS unsigned char* lds, const Gemm g, const Sched& S, const Epi& E) {
    const int tid = threadIdx.x, wid = __builtin_amdgcn_readfirstlane(tid >> 6), lane = tid & 63, wr = wid >> 2, wc = wid & 3, fr = lane & 15, fq = lane >> 4;
    const int K = g.K, nt = K / BK;
    unsigned voffA[2], voffB[2];
#pragma unroll
    for (int i = 0; i < 2; ++i) { int R, C; stage_rc(tid * 16 + i * 8192, R, C); const int Rb = Epi::PERM ? ((R & ~31) + perm32(R & 31)) : R;
        voffA[i] = (unsigned)(R * K + C) * 2u; voffB[i] = (unsigned)(Rb * K + C) * 2u; }
    const size_t kstep = (size_t)(BK * 2);
    const size_t hstep = (size_t)HALF * K * 2;
    const size_t tstep = 2 * hstep;
    const unsigned ldsw = (unsigned)wid * 1024u;
    const int aoff = lds_byte(wr * 64 + fr, fq * 8), boff = lds_byte(wc * 32 + fr, fq * 8);
#define PG8_SA(b, h) (((b) * 2 + (h)) * HTB)
#define PG8_SB(b, h) ((4 + (b) * 2 + (h)) * HTB)
#define PG8_STAGE(bufoff, gbase, voff) do { _Pragma("unroll") for (int _i = 0; _i < 2; ++_i) \
        __builtin_amdgcn_global_load_lds((const unsigned*)((const char*)(gbase) + (voff)[_i]), (PG8_LAS unsigned*)(lds + (bufoff) + ldsw + _i * 8192), 16, 0, 0); } while (0)
#define PG8_LDA(dst, b, h) do { _Pragma("unroll") for (int m = 0; m < 4; ++m) _Pragma("unroll") for (int k = 0; k < 2; ++k) dst[m][k] = *(const PG8_LAS bf16x8*)(lds + PG8_SA(b, h) + aoff + m * 2048 + k * 1024); } while (0)
#define PG8_LDB(dst, b, h) do { _Pragma("unroll") for (int n = 0; n < 2; ++n) _Pragma("unroll") for (int k = 0; k < 2; ++k) dst[n][k] = *(const PG8_LAS bf16x8*)(lds + PG8_SB(b, h) + boff + n * 2048 + k * 1024); } while (0)
#define PG8_MMA(ai, bj, At, Bt) do { __builtin_amdgcn_s_setprio(1); _Pragma("unroll") for (int m = 0; m < 4; ++m) _Pragma("unroll") for (int n = 0; n < 2; ++n) _Pragma("unroll") for (int k = 0; k < 2; ++k) \
        acc[ai][bj][m][n] = __builtin_amdgcn_mfma_f32_16x16x32_bf16(Bt[n][k], At[m][k], acc[ai][bj][m][n], 0, 0, 0); __builtin_amdgcn_s_setprio(0); } while (0)
#define PG8_WAIT_V(n) asm volatile("s_waitcnt vmcnt(" #n ")" ::: "memory")
#define PG8_WAIT_L(n) asm volatile("s_waitcnt lgkmcnt(" #n ")" ::: "memory")
#define PG8_BAR __builtin_amdgcn_s_barrier()
#define PG8_SCHED __builtin_amdgcn_sched_barrier(0)
    Unit cur, nxt; int ui = 0;
    if (!S.next(0, cur)) return;
    f32x4 acc[2][2][4][2];
#pragma unroll
    for (int a = 0; a < 2; ++a)
#pragma unroll
        for (int b = 0; b < 2; ++b)
#pragma unroll
            for (int m = 0; m < 4; ++m)
#pragma unroll
                for (int n = 0; n < 2; ++n) acc[a][b][m][n] = (f32x4){0.f, 0.f, 0.f, 0.f};
    bf16x8 At[4][2], B0[2][2], B1[2][2];
    const char* cA = (const char*)g.A + (size_t)cur.pm * tstep; const char* cB = (const char*)g.Bt + (size_t)cur.pn * tstep;
    S.a_ready(cur);
    if constexpr (SP2) {
        PG8_STAGE(PG8_SB(0, 0), cB, voffB); PG8_STAGE(PG8_SB(0, 1), cB + hstep, voffB); PG8_STAGE(PG8_SA(0, 0), cA, voffA); PG8_STAGE(PG8_SA(0, 1), cA + hstep, voffA);
        if (wr == 1) PG8_BAR;
        PG8_WAIT_V(2); PG8_BAR;
        PG8_STAGE(PG8_SB(1, 0), cB + kstep, voffB); PG8_STAGE(PG8_SA(1, 0), cA + kstep, voffA); PG8_STAGE(PG8_SB(1, 1), cB + hstep + kstep, voffB);
        PG8_WAIT_V(6); PG8_BAR;
    } else {
        PG8_STAGE(PG8_SB(0, 0), cB, voffB); PG8_STAGE(PG8_SA(0, 0), cA, voffA); PG8_STAGE(PG8_SB(0, 1), cB + hstep, voffB); PG8_STAGE(PG8_SA(0, 1), cA + hstep, voffA);
        if (wr == 1) PG8_BAR;
        PG8_WAIT_V(4); PG8_BAR;
        PG8_STAGE(PG8_SB(1, 0), cB + kstep, voffB); PG8_STAGE(PG8_SA(1, 0), cA + kstep, voffA); PG8_STAGE(PG8_SB(1, 1), cB + hstep + kstep, voffB);
        PG8_WAIT_V(6); PG8_BAR;
    }
    for (;;) {
        const bool has_next = S.next(ui + 1, nxt);
        const char* nA = has_next ? (const char*)g.A + (size_t)nxt.pm * tstep : cA; const char* nB = has_next ? (const char*)g.Bt + (size_t)nxt.pn * tstep : cB;
        for (int t = 0; t < nt; t += 2) {
            const bool last = (t == nt - 2);
            const char* a1 = cA + (size_t)(t + 1) * kstep;
            const char* a2 = last ? nA : cA + (size_t)(t + 2) * kstep; const char* b2 = last ? nB : cB + (size_t)(t + 2) * kstep;
            const char* a3 = a2 + kstep; const char* b3 = b2 + kstep;
            if (last && has_next) S.a_ready(nxt);
            if constexpr (SP2) {
            PG8_LDB(B0, 0, 0); PG8_LDB(B1, 0, 1); PG8_SCHED; PG8_LDA(At, 0, 0); PG8_STAGE(PG8_SA(1, 1), a1 + hstep, voffA);
            PG8_WAIT_V(8); PG8_WAIT_L(0); PG8_BAR; PG8_MMA(0, 0, At, B0); PG8_MMA(0, 1, At, B1); PG8_BAR; PG8_SCHED;
            PG8_LDA(At, 0, 1); PG8_STAGE(PG8_SB(0, 0), b2, voffB); PG8_STAGE(PG8_SB(0, 1), b2 + hstep, voffB); PG8_STAGE(PG8_SA(0, 0), a2, voffA);
            PG8_WAIT_V(8); PG8_WAIT_L(0); PG8_BAR; PG8_MMA(1, 0, At, B0); PG8_MMA(1, 1, At, B1); PG8_BAR; PG8_SCHED;
            PG8_LDB(B0, 1, 0); PG8_LDB(B1, 1, 1); PG8_SCHED; PG8_LDA(At, 1, 0); PG8_STAGE(PG8_SA(0, 1), a2 + hstep, voffA);
            PG8_WAIT_V(8); PG8_WAIT_L(0); PG8_BAR; PG8_MMA(0, 0, At, B0); PG8_MMA(0, 1, At, B1); PG8_BAR; PG8_SCHED;
            PG8_LDA(At, 1, 1); PG8_STAGE(PG8_SB(1, 0), b3, voffB); PG8_STAGE(PG8_SB(1, 1), b3 + hstep, voffB); PG8_STAGE(PG8_SA(1, 0), a3, voffA);
            PG8_WAIT_V(8); PG8_WAIT_L(0); PG8_BAR; PG8_MMA(1, 0, At, B0); PG8_MMA(1, 1, At, B1); PG8_BAR; PG8_SCHED;
            } else {
            PG8_LDB(B0, 0, 0); PG8_SCHED; PG8_LDA(At, 0, 0); PG8_STAGE(PG8_SA(1, 1), a1 + hstep, voffA);
            PG8_WAIT_L(8); PG8_BAR; PG8_WAIT_L(0); PG8_MMA(0, 0, At, B0); PG8_BAR; PG8_SCHED;
            PG8_LDB(B1, 0, 1); PG8_STAGE(PG8_SB(0, 0), b2, voffB);
            PG8_BAR; PG8_WAIT_L(0); PG8_MMA(0, 1, At, B1); PG8_BAR;
            PG8_LDA(At, 0, 1); PG8_STAGE(PG8_SA(0, 0), a2, voffA);
            PG8_BAR; PG8_WAIT_L(0); PG8_MMA(1, 0, At, B0); PG8_BAR; PG8_SCHED;
            PG8_STAGE(PG8_SB(0, 1), b2 + hstep, voffB);
            PG8_WAIT_V(6); PG8_BAR; PG8_MMA(1, 1, At, B1); PG8_BAR;
            PG8_LDB(B0, 1, 0); PG8_SCHED; PG8_LDA(At, 1, 0); PG8_STAGE(PG8_SA(0, 1), a2 + hstep, voffA);
            PG8_WAIT_L(8); PG8_BAR; PG8_WAIT_L(0); PG8_MMA(0, 0, At, B0); PG8_BAR; PG8_SCHED;
            PG8_LDB(B1, 1, 1); PG8_STAGE(PG8_SB(1, 0), b3, voffB);
            PG8_BAR; PG8_WAIT_L(0); PG8_MMA(0, 1, At, B1); PG8_BAR;
            PG8_LDA(At, 1, 1); PG8_STAGE(PG8_SA(1, 0), a3, voffA);
            PG8_BAR; PG8_WAIT_L(0); PG8_MMA(1, 0, At, B0); PG8_BAR; PG8_SCHED;
            PG8_STAGE(PG8_SB(1, 1), b3 + hstep, voffB);
            PG8_WAIT_V(6); PG8_BAR; PG8_MMA(1, 1, At, B1); PG8_BAR;
            }
        }
        if constexpr (ALIGN_EPI) { if (wr == 0) PG8_BAR; }
        if constexpr (!Epi::AFTER_DRAIN) { E(acc, cur, wr, wc, fr, fq); S.done(cur); }
        if (!has_next) break;
#pragma unroll
        for (int a = 0; a < 2; ++a)
#pragma unroll
            for (int b = 0; b < 2; ++b)
#pragma unroll
                for (int m = 0; m < 4; ++m)
#pragma unroll
                    for (int n = 0; n < 2; ++n) acc[a][b][m][n] = (f32x4){0.f, 0.f, 0.f, 0.f};
        cur = nxt; cA = nA; cB = nB; ++ui;
        if constexpr (ALIGN_EPI) { if (wr == 1) PG8_BAR; }
    }
    PG8_WAIT_V(0);
    if constexpr (!ALIGN_EPI) { if (wr == 0) PG8_BAR; }
    PG8_BAR;
    if constexpr (Epi::AFTER_DRAIN) { E.fused(acc, cur, wr, wc, fr, fq, lds, wid, lane); S.done(cur); }
#undef PG8_SA
#undef PG8_SB
#undef PG8_STAGE
#undef PG8_LDA
#undef PG8_LDB
#undef PG8_MMA
#undef PG8_WAIT_V
#undef PG8_WAIT_L
#undef PG8_BAR
#undef PG8_SCHED
}
}

constexpr int NB = 2, T = 8192, D = 1024, M = NB * T;
constexpr int NH = 8, DK = 128, DV = 128, CH = 64, NCH = T / CH;
constexpr int NQKV = 3072, IN_TOTAL = 9232;
constexpr int NE = 32, EPG = 8, NGRP = 4, DE = 512;
constexpr int NUNIT = NB * NH * NCH;
constexpr float EPS = 1e-6f;
constexpr int MOE_CAP = 40960;
constexpr int NWAVES = 8;

constexpr size_t MiB = 1u << 20;
constexpr size_t WS_CTL = 0, CTL_ZERO_BYTES = 1 * MiB;
constexpr size_t WS_BG = 1 * MiB;
constexpr size_t WS_TOKE = 2 * MiB;
constexpr size_t WS_TOKW = WS_TOKE + 128 * 1024;
constexpr size_t WS_ROWTOK = WS_TOKE + 256 * 1024;
constexpr size_t WS_ROWW = WS_TOKE + 512 * 1024;
constexpr size_t WS_DEC = 3 * MiB;
constexpr size_t WS_WGHIST = 3 * MiB + 64 * 1024;
constexpr size_t WS_WINA = 4 * MiB;
constexpr size_t WS_IN = 4 * MiB;
constexpr size_t WS_WINB = 20 * MiB;
constexpr size_t WS_WA = 27 * MiB, WS_WB = 29 * MiB, WS_WO = 31 * MiB;
constexpr size_t WS_QKV = 33 * MiB;
constexpr size_t WS_W13 = 33 * MiB;
constexpr size_t WS_W2 = 97 * MiB;
constexpr size_t WS_SB = 129 * MiB, WS_YB = 129 * MiB;
constexpr size_t WS_P = 161 * MiB;
constexpr size_t OUT_OR = 32 * MiB;
constexpr size_t WS_UT = 193 * MiB, WS_W = 225 * MiB, WS_QD = 257 * MiB, WS_KDT = 289 * MiB;
constexpr size_t WS_GA = 193 * MiB, WS_GB = 225 * MiB;
constexpr size_t WS_H2 = 257 * MiB;
constexpr size_t WS_XS = 129 * MiB;
constexpr size_t WS_HID = 209 * MiB;
constexpr size_t WS_YBUF = 129 * MiB;
constexpr size_t WS_PHI = 161 * MiB, WS_LSEG = 169 * MiB;
constexpr size_t WS_END = 321 * MiB;
constexpr int CW_TMO = 0, CW_BAR = 4096, CW_Q = 8192;
constexpr size_t CTL_MODACC = 64 * 1024;
constexpr size_t CTL_SSQ = 128 * 1024;
constexpr int LDS_BYTES = 163840, MISC_OFF = LDS_BYTES - 2048;

#define GAS __attribute__((address_space(1)))
#define LAS __attribute__((address_space(3)))
typedef unsigned short bf16;
typedef unsigned v4u __attribute__((ext_vector_type(4)));
typedef unsigned v2u __attribute__((ext_vector_type(2)));
typedef float f32x4 __attribute__((ext_vector_type(4)));
#define LDS_WAIT() asm volatile("s_waitcnt lgkmcnt(0)" ::: "memory")
__device__ __forceinline__ unsigned f2bf(float f) { unsigned u = __builtin_bit_cast(unsigned, f); return (u + 0x7fffu + ((u >> 16) & 1u)) >> 16; }
__device__ __forceinline__ unsigned pk2(float lo, float hi) { return f2bf(lo) | (f2bf(hi) << 16); }
__device__ __forceinline__ float bf2f(unsigned short b) { return __builtin_bit_cast(float, ((unsigned)b) << 16); }
__device__ __forceinline__ float bflo(unsigned w) { return __builtin_bit_cast(float, w << 16); }
__device__ __forceinline__ float bfhi(unsigned w) { return __builtin_bit_cast(float, w & 0xffff0000u); }
__device__ __forceinline__ float sigmoidf_(float x) { return __builtin_amdgcn_rcpf(1.0f + __expf(-x)); }
__device__ __forceinline__ float siluf_(float x) { return x * __builtin_amdgcn_rcpf(1.0f + __expf(-x)); }
__device__ __forceinline__ float readlane_f(float v, int l) { return __builtin_bit_cast(float, __builtin_amdgcn_readlane(__builtin_bit_cast(int, v), l)); }
__device__ __forceinline__ float wave_sum(float v) {
#pragma unroll
    for (int o = 1; o < 64; o <<= 1) v += __shfl_xor(v, o);
    return v;
}


template <int N, int CAP> __device__ __forceinline__ void fold_step(float (&v)[CAP], int xr, bool bit) {
#pragma unroll
    for (int i = 0; i < N / 2; ++i) { const float send = bit ? v[i] : v[i + N / 2]; const float keep = bit ? v[i + N / 2] : v[i]; v[i] = keep + __shfl_xor(send, xr); }
}

#define XB_TMO      128
#define XB_XCNT(j)  (256  + 64 * (j))
#define XB_XSUB(j)  (1280 + 64 * (j))
#define XB_XGEN(j)  (2304 + 64 * (j))
#define XB_TOP      3328
#define XB_TOPGEN   3392
#define XCD_BAR_WORDS 3456
#define XB_SPIN_CAP (1u << 18)
__device__ __forceinline__ unsigned xb_ld(unsigned* p)              { return __hip_atomic_load(p, __ATOMIC_RELAXED, __HIP_MEMORY_SCOPE_AGENT); }
__device__ __forceinline__ unsigned xb_add(unsigned* p, unsigned v) { return __hip_atomic_fetch_add(p, v, __ATOMIC_RELAXED, __HIP_MEMORY_SCOPE_AGENT); }
__device__ __forceinline__ unsigned xb_xcc_id() { return (unsigned)__builtin_amdgcn_s_getreg((3 << 11) | 20) & 0xFu; }
#define XB_SPIN(cond, bar) do { unsigned _sp = 0; while (cond) { __builtin_amdgcn_s_sleep(1); \
    if ((++_sp & 255u) == 0u) { if (xb_ld(&(bar)[XB_TMO])) break; if (_sp > XB_SPIN_CAP) { atomicAdd(&(bar)[XB_TMO], 1u); break; } } } } while (0)
struct XcdBarrier { unsigned* bar; unsigned x; volatile LAS unsigned* st; };
__device__ __forceinline__ XcdBarrier xcd_barrier_post(unsigned* bar, volatile LAS unsigned* st) {
    XcdBarrier b; b.bar = bar; b.x = xb_xcc_id(); b.st = st;
    if (threadIdx.x == 0) (void)xb_add(&bar[XB_XCNT(b.x)], 1u);
    return b;
}
__device__ __forceinline__ void xcd_barrier_complete(unsigned* bar, unsigned x, unsigned& nloc, unsigned& nx) {
    const unsigned G = gridDim.x * gridDim.y * gridDim.z;
    unsigned sum, cnt, mine, sp = 0u;
    for (;;) {
        sum = 0u; cnt = 0u; mine = 0u;
#pragma unroll
        for (unsigned j = 0; j < 16; ++j) { const unsigned c = xb_ld(&bar[XB_XCNT(j)]); sum += c; cnt += (c > 0u) ? 1u : 0u; mine = (j == x) ? c : mine; }
        if (sum == G) break;
        __builtin_amdgcn_s_sleep(1);
        if ((++sp & 255u) == 0u) { if (xb_ld(&bar[XB_TMO])) break; if (sp > XB_SPIN_CAP) { atomicAdd(&bar[XB_TMO], 1u); break; } }
    }
    nloc = mine > 0u ? mine : 1u; nx = cnt > 0u ? cnt : 1u;
}
__device__ __forceinline__ void xcd_barrier(const XcdBarrier& b) {
    asm volatile("s_waitcnt vmcnt(0)" ::: "memory");
    __syncthreads();
    if (threadIdx.x == 0) {
        unsigned* bar = b.bar;
        __builtin_amdgcn_s_waitcnt(0);
        unsigned nloc = b.st[0], nx = b.st[1];
        if (nloc == 0u) { xcd_barrier_complete(bar, b.x, nloc, nx); b.st[0] = nloc; b.st[1] = nx; }
        const unsigned old = xb_add(&bar[XB_XSUB(b.x)], 1u);
        const unsigned gen = old / nloc;
        if (old + 1u == (gen + 1u) * nloc) {
            __builtin_amdgcn_fence(__ATOMIC_RELEASE, "agent");
            asm volatile("s_waitcnt vmcnt(0)" ::: "memory");
            const unsigned og = xb_add(&bar[XB_TOP], 1u);
            const unsigned tg = og / nx;
            if (og + 1u == (tg + 1u) * nx) xb_add(&bar[XB_TOPGEN], 1u);
            else XB_SPIN(xb_ld(&bar[XB_TOPGEN]) == tg, bar);
            __builtin_amdgcn_fence(__ATOMIC_ACQUIRE, "agent");
            xb_add(&bar[XB_XGEN(b.x)], 1u);
            asm volatile("s_waitcnt vmcnt(0)" ::: "memory");
        } else {
            XB_SPIN(xb_ld(&bar[XB_XGEN(b.x)]) == gen, bar);
            __builtin_amdgcn_fence(__ATOMIC_ACQUIRE, "agent");
            asm volatile("s_waitcnt vmcnt(0)" ::: "memory");
        }
    }
    __syncthreads();
}

struct Frame {
    LAS unsigned char* lds;
    volatile LAS unsigned* MISC;
    unsigned* ctl;
    int tid, lane, wave, vcu, G;
    const float *x, *c, *w_ada, *b_ada, *norm1_g, *w_in, *conv_qkv_w, *a_log, *dt_bias, *onorm_g, *w_proj_a, *conv_sc_w, *w_proj_b, *w_out,
                *norm2_g, *w_group, *b_group, *w_expert, *b_expert, *w1, *w3, *w2, *normf_g;
    float* out; unsigned char* ws;
};
__device__ __forceinline__ float mod_at(const Frame& F, int b, int idx) {
    return ((const float*)(F.ws + CTL_MODACC))[b * 6144 + idx];
}

using pg8::Unit; using pg8::cvt_pk_bf16;
__device__ __forceinline__ v4u pack8(const f32x4 a, const f32x4 b) { v4u w; w.x = cvt_pk_bf16(a[0], a[1]); w.y = cvt_pk_bf16(a[2], a[3]); w.z = cvt_pk_bf16(b[0], b[1]); w.w = cvt_pk_bf16(b[2], b[3]); return w; }
__device__ __forceinline__ void unpack8(const v4u w, f32x4& a, f32x4& b) { a = (f32x4){bflo(w.x), bfhi(w.x), bflo(w.y), bfhi(w.y)}; b = (f32x4){bflo(w.z), bfhi(w.z), bflo(w.w), bfhi(w.w)}; }

struct EpiInA {
    static constexpr bool PERM = true, AFTER_DRAIN = false;
    bf16 *QKV, *SB, *P;
    __device__ __forceinline__ void operator()(const f32x4 (&acc)[2][2][4][2], const Unit& u, int wr, int wc, int fr, int fq) const {
        const int row0 = u.pm * 256 + wr * 64 + fr;
        if (u.pn < 16) {
            bf16* base; int ldc, colt;
            if (u.pn < 12) { base = QKV; ldc = NQKV; colt = u.pn * 256; } else { base = SB; ldc = D; colt = (u.pn - 12) * 256; }
            const int col0 = colt + wc * 32 + 8 * fq;
#pragma unroll
            for (int ai = 0; ai < 2; ++ai)
#pragma unroll
                for (int m = 0; m < 4; ++m) { bf16* rowp = base + (size_t)(row0 + ai * 128 + m * 16) * ldc + col0;
#pragma unroll
                    for (int bj = 0; bj < 2; ++bj) *(v4u*)(rowp + bj * 128) = pack8(acc[ai][bj][m][0], acc[ai][bj][m][1]); }
        } else {
            const int col0 = (u.pn - 16) * 128 + wc * 32 + 8 * fq;
#pragma unroll
            for (int ai = 0; ai < 2; ++ai)
#pragma unroll
                for (int m = 0; m < 4; ++m) { bf16* rowp = P + (size_t)(row0 + ai * 128 + m * 16) * D + col0;
                    *(v4u*)rowp = pack8(acc[ai][0][m][0] * acc[ai][1][m][0], acc[ai][0][m][1] * acc[ai][1][m][1]); }
        }
    }
};
struct EpiInB {
    static constexpr bool PERM = true, AFTER_DRAIN = false;
    unsigned char* ws; long og_minus_ws;
    __device__ __forceinline__ void operator()(const f32x4 (&acc)[2][2][4][2], const Unit& u, int wr, int wc, int fr, int fq) const {
        const int row0 = u.pm * 256 + wr * 64 + fr, col0 = (u.pn & 3) * 256 + wc * 32 + 8 * fq;
        const bool zt = u.pn < 4;
        bf16* base = (bf16*)(ws + (zt ? og_minus_ws : (long)((u.pn < 8) ? WS_GA : WS_GB)));
        v4u cur[2] = {{0u, 0u, 0u, 0u}, {0u, 0u, 0u, 0u}}, nxt[2] = {{0u, 0u, 0u, 0u}, {0u, 0u, 0u, 0u}};
        if (zt) { const bf16* rp = base + (size_t)row0 * D + col0; cur[0] = *(const v4u*)rp; cur[1] = *(const v4u*)(rp + 128); }
#pragma unroll
        for (int g = 0; g < 8; ++g) { const int ai = g >> 2, m = g & 3; bf16* rowp = base + (size_t)(row0 + ai * 128 + m * 16) * D + col0;
            if (zt && g < 7) { const bf16* rn = base + (size_t)(row0 + ((g + 1) >> 2) * 128 + ((g + 1) & 3) * 16) * D + col0; nxt[0] = *(const v4u*)rn; nxt[1] = *(const v4u*)(rn + 128); }
            __builtin_amdgcn_sched_barrier(0);
#pragma unroll
            for (int bj = 0; bj < 2; ++bj) { f32x4 a = acc[ai][bj][m][0], b = acc[ai][bj][m][1];
                f32x4 sa, sb;
#pragma unroll
                for (int j = 0; j < 4; ++j) { sa[j] = sigmoidf_(a[j]); sb[j] = sigmoidf_(b[j]); }
                if (zt) { f32x4 o0, o1; unpack8(cur[bj], o0, o1); sa = sa * a * o0; sb = sb * b * o1; }
                *(v4u*)(rowp + bj * 128) = pack8(sa, sb); }
            cur[0] = nxt[0]; cur[1] = nxt[1];
            __builtin_amdgcn_sched_barrier(0); }
    }
};
struct EpiPlain {
    static constexpr bool PERM = true, AFTER_DRAIN = false;
    bf16* O; int ldc;
    __device__ __forceinline__ void operator()(const f32x4 (&acc)[2][2][4][2], const Unit& u, int wr, int wc, int fr, int fq) const {
        const int row0 = u.pm * 256 + wr * 64 + fr, col0 = u.pn * 256 + wc * 32 + 8 * fq;
#pragma unroll
        for (int ai = 0; ai < 2; ++ai)
#pragma unroll
            for (int m = 0; m < 4; ++m) { bf16* rowp = O + (size_t)(row0 + ai * 128 + m * 16) * ldc + col0;
#pragma unroll
                for (int bj = 0; bj < 2; ++bj) *(v4u*)(rowp + bj * 128) = pack8(acc[ai][bj][m][0], acc[ai][bj][m][1]); }
    }
};
struct EpiMerge {
    static constexpr bool PERM = true, AFTER_DRAIN = false;
    const bf16 *GA, *GB, *YB; bf16* MG;
    __device__ __forceinline__ void operator()(const f32x4 (&acc)[2][2][4][2], const Unit& u, int wr, int wc, int fr, int fq) const {
        const int row0 = u.pm * 256 + wr * 64 + fr, col0 = u.pn * 256 + wc * 32 + 8 * fq;
        v4u cur[6], nxt[6];
#define EPM_LOAD(dst, g_) do { const size_t o_ = (size_t)(row0 + ((g_) >> 2) * 128 + ((g_) & 3) * 16) * D + col0; \
        dst[0] = *(const v4u*)(GA + o_); dst[1] = *(const v4u*)(GA + o_ + 128); dst[2] = *(const v4u*)(GB + o_); dst[3] = *(const v4u*)(GB + o_ + 128); dst[4] = *(const v4u*)(YB + o_); dst[5] = *(const v4u*)(YB + o_ + 128); } while (0)
        EPM_LOAD(cur, 0);
#pragma unroll
        for (int g = 0; g < 8; ++g) { const int ai = g >> 2, m = g & 3; const size_t off = (size_t)(row0 + ai * 128 + m * 16) * D + col0;
            if (g < 7) EPM_LOAD(nxt, g + 1);
            __builtin_amdgcn_sched_barrier(0);
#pragma unroll
            for (int bj = 0; bj < 2; ++bj) { f32x4 a0, a1, b0, b1, y0, y1; unpack8(cur[bj], a0, a1); unpack8(cur[2 + bj], b0, b1); unpack8(cur[4 + bj], y0, y1);
                *(v4u*)(MG + off + bj * 128) = pack8(a0 * acc[ai][bj][m][0] + b0 * y0, a1 * acc[ai][bj][m][1] + b1 * y1); }
#pragma unroll
            for (int q = 0; q < 6; ++q) cur[q] = nxt[q];
            __builtin_amdgcn_sched_barrier(0); }
#undef EPM_LOAD
    }
};
struct EpiX1 {
    static constexpr bool PERM = true, AFTER_DRAIN = false;
    const float* X; float* X1; const float* modacc; const float* b_ada;
    __device__ __forceinline__ void operator()(const f32x4 (&acc)[2][2][4][2], const Unit& u, int wr, int wc, int fr, int fq) const {
        const int row0 = u.pm * 256 + wr * 64 + fr, col0 = u.pn * 256 + wc * 32 + 8 * fq, b = u.pm >> 5;
        f32x4 gt[2][2];
#pragma unroll
        for (int bj = 0; bj < 2; ++bj)
#pragma unroll
            for (int n = 0; n < 2; ++n) gt[bj][n] = *(const f32x4*)(modacc + b * 6144 + 2048 + col0 + bj * 128 + 4 * n);
        f32x4 cur[4], nxt[4];
#define EPX_LOAD(dst, g_) do { const size_t o_ = (size_t)(row0 + ((g_) >> 2) * 128 + ((g_) & 3) * 16) * D + col0; \
        dst[0] = *(const f32x4*)(X + o_); dst[1] = *(const f32x4*)(X + o_ + 4); dst[2] = *(const f32x4*)(X + o_ + 128); dst[3] = *(const f32x4*)(X + o_ + 132); } while (0)
        EPX_LOAD(cur, 0);
#pragma unroll
        for (int g = 0; g < 8; ++g) { const int ai = g >> 2, m = g & 3; const size_t off = (size_t)(row0 + ai * 128 + m * 16) * D + col0;
            if (g < 7) EPX_LOAD(nxt, g + 1);
            __builtin_amdgcn_sched_barrier(0);
#pragma unroll
            for (int bj = 0; bj < 2; ++bj)
#pragma unroll
                for (int n = 0; n < 2; ++n) *(f32x4*)(X1 + off + bj * 128 + 4 * n) = cur[bj * 2 + n] + gt[bj][n] * acc[ai][bj][m][n];
#pragma unroll
            for (int q = 0; q < 4; ++q) cur[q] = nxt[q];
            __builtin_amdgcn_sched_barrier(0); }
#undef EPX_LOAD
    }
};
struct EpiHid {
    static constexpr bool PERM = true, AFTER_DRAIN = false;
    bf16* HID;
    __device__ __forceinline__ void operator()(const f32x4 (&acc)[2][2][4][2], const Unit& u, int wr, int wc, int fr, int fq) const {
        const int row0 = u.pm * 256 + wr * 64 + fr, col0 = (u.pn & 3) * 128 + wc * 32 + 8 * fq;
#pragma unroll
        for (int ai = 0; ai < 2; ++ai)
#pragma unroll
            for (int m = 0; m < 4; ++m) { f32x4 a = acc[ai][0][m][0], b = acc[ai][0][m][1];
#pragma unroll
                for (int j = 0; j < 4; ++j) { a[j] = siluf_(a[j]) * acc[ai][1][m][0][j]; b[j] = siluf_(b[j]) * acc[ai][1][m][1][j]; }
                *(v4u*)(HID + (size_t)(row0 + ai * 128 + m * 16) * DE + col0) = pack8(a, b); }
    }
};
struct EpiMoeOut {
    static constexpr bool PERM = true, AFTER_DRAIN = false;
    bf16* YBUF; const int* ROWTOK; const float* ROWW;
    __device__ __forceinline__ void operator()(const f32x4 (&acc)[2][2][4][2], const Unit& u, int wr, int wc, int fr, int fq) const {
        const int row0 = u.pm * 256 + wr * 64 + fr, col0 = (u.pn & 3) * 256 + wc * 32 + 8 * fq;
        int tk[8]; float wgt[8];
#pragma unroll
        for (int g = 0; g < 8; ++g) { const int r = row0 + (g >> 2) * 128 + (g & 3) * 16; tk[g] = ROWTOK[r]; wgt[g] = ROWW[r]; }
        __builtin_amdgcn_sched_barrier(0);
#pragma unroll
        for (int g = 0; g < 8; ++g) { const int ai = g >> 2, m = g & 3;
            if (tk[g] >= 0) { const float w = wgt[g]; bf16* rowp = YBUF + (size_t)tk[g] * D + col0;
#pragma unroll
                for (int bj = 0; bj < 2; ++bj) *(v4u*)(rowp + bj * 128) = pack8(acc[ai][bj][m][0] * w, acc[ai][bj][m][1] * w); } }
    }
};
struct MoeOrder {
    int nt, G, c; const volatile LAS int* tile_e;
    __device__ __forceinline__ bool next(int i, Unit& u) const {
        const int x = c & 7, vi = c >> 3, per = G >> 3, lo = (nt * x) >> 3, hi = (nt * (x + 1)) >> 3, q = i * per + vi;
        if (q >= 4 * (hi - lo)) return false;
        const int rb = lo + (q >> 2); u.pm = rb; u.pn = tile_e[rb] * 4 + (q & 3); return true; }
    __device__ __forceinline__ void a_ready(const Unit&) const {}
    __device__ __forceinline__ void done(const Unit&) const {}
};

__device__ __forceinline__ void transpose_item(const float* W, int ldw, int src_col0, int k0, bf16* WT, int dst_row0, int K, LAS float* scr, int lane) {
#pragma unroll 8
    for (int i = 0; i < 32; ++i) { const int kk = 2 * i + (lane >> 5); scr[kk * 33 + (lane & 31)] = W[(size_t)(k0 + kk) * ldw + src_col0 + (lane & 31)]; }
    LDS_WAIT(); asm volatile("" ::: "memory");
    const int c = lane & 7;
#pragma unroll
    for (int j = 0; j < 4; ++j) { const int n = (lane >> 3) + 8 * j; const LAS float* s = scr + (8 * c) * 33 + n;
        v4u o; o.x = pk2(s[0 * 33], s[1 * 33]); o.y = pk2(s[2 * 33], s[3 * 33]); o.z = pk2(s[4 * 33], s[5 * 33]); o.w = pk2(s[6 * 33], s[7 * 33]);
        *(v4u*)(WT + (size_t)(dst_row0 + n) * K + k0 + 8 * c) = o; }
    LDS_WAIT(); asm volatile("" ::: "memory");
}
__device__ __forceinline__ int win_src_col(int d0) {
    if (d0 < 3072) return d0;
    if (d0 < 4096) return 4112 + (d0 - 3072);
    if (d0 < 6144) { const int j = (d0 - 4096) >> 8, r = (d0 - 4096) & 255; return (r < 128 ? 5136 + r : 6160 + (r - 128)) + 128 * j; }
    if (d0 < 7168) return 3072 + (d0 - 6144);
    if (d0 < 8192) return 7184 + (d0 - 7168);
    return 8208 + (d0 - 8192);
}

__device__ __forceinline__ void p0_prologue(Frame& F) {
    LAS float* sC = (LAS float*)(F.lds + 8 * 8448);
    for (int i = F.tid; i < 2 * D; i += 512) sC[i] = siluf_(F.c[i]);
    __syncthreads();
    const int gw = F.vcu * NWAVES + F.wave, NGW = F.G * NWAVES;
    float* modv = (float*)(F.ws + CTL_MODACC);
    LAS float* sPart = sC + 2 * D;
    for (int cg = blockIdx.x; cg < 96; cg += F.G) {
        const int col = cg * 64 + F.lane, k0 = F.wave * 128;
        float a0 = 0.f, a1 = 0.f;
#pragma unroll 16
        for (int k = 0; k < 128; ++k) { const float wv = F.w_ada[(size_t)(k0 + k) * 6144 + col]; a0 += sC[k0 + k] * wv; a1 += sC[D + k0 + k] * wv; }
        sPart[F.wave * 128 + F.lane] = a0; sPart[F.wave * 128 + 64 + F.lane] = a1;
        __syncthreads();
        if (F.wave < 2) { float t = 0.f;
#pragma unroll
            for (int q = 0; q < 8; ++q) t += sPart[q * 128 + F.wave * 64 + F.lane];
            modv[F.wave * 6144 + col] = t + F.b_ada[col]; }
        __syncthreads();
    }
}
__device__ __forceinline__ void p0_weights(Frame& F) {
    const int gw = F.vcu * NWAVES + F.wave, NGW = F.G * NWAVES;
    LAS float* scr = (LAS float*)(F.lds + F.wave * 8448);
    constexpr int I_IN = 288 * 16, I_SQ = 32 * 16;
    for (int it = gw; it < I_IN + 3 * I_SQ; it += NGW) {
        int r = it;
        if (r < I_IN) { const int dg = r % 288, kb = r / 288, d0 = dg * 32; bf16* dst = (d0 < 6144) ? (bf16*)(F.ws + WS_WINA) : (bf16*)(F.ws + WS_WINB);
            transpose_item(F.w_in, IN_TOTAL, win_src_col(d0), kb * 64, dst, d0 < 6144 ? d0 : d0 - 6144, D, scr, F.lane); continue; }
        r -= I_IN;
        if (r < I_SQ) { transpose_item(F.w_proj_a, D, (r % 32) * 32, (r / 32) * 64, (bf16*)(F.ws + WS_WA), (r % 32) * 32, D, scr, F.lane); continue; } r -= I_SQ;
        if (r < I_SQ) { transpose_item(F.w_proj_b, D, (r % 32) * 32, (r / 32) * 64, (bf16*)(F.ws + WS_WB), (r % 32) * 32, D, scr, F.lane); continue; } r -= I_SQ;
        transpose_item(F.w_out, D, (r % 32) * 32, (r / 32) * 64, (bf16*)(F.ws + WS_WO), (r % 32) * 32, D, scr, F.lane);
    }
}
__device__ __forceinline__ void moe_weight_item(Frame& F, int it, LAS float* scr) {
    constexpr int I13 = NE * 32 * 16;
    if (it < I13) { const int e = it / 512, r = it % 512, dg = r % 32, kb = r / 32, d0 = dg * 32, j = d0 >> 8, rr = d0 & 255;
        if (rr < 128) transpose_item(F.w1 + (size_t)e * D * DE, DE, 128 * j + (rr & 127), kb * 64, (bf16*)(F.ws + WS_W13) + (size_t)e * D * D, d0, D, scr, F.lane);
        else          transpose_item(F.w3 + (size_t)e * D * DE, DE, 128 * j + (rr & 127), kb * 64, (bf16*)(F.ws + WS_W13) + (size_t)e * D * D, d0, D, scr, F.lane);
    } else { const int r2 = it - I13, e = r2 / 256, r = r2 % 256, dg = r % 32, kb = r / 32;
        transpose_item(F.w2 + (size_t)e * DE * D, D, dg * 32, kb * 64, (bf16*)(F.ws + WS_W2) + (size_t)e * D * DE, dg * 32, DE, scr, F.lane); }
}
__device__ __forceinline__ void p_moe_weights(Frame& F) {
    LAS float* scr = (LAS float*)(F.lds + F.wave * 8448);
    constexpr int NBATCH = (NE * 32 * 16 + NE * 32 * 8) / 64;
    __syncthreads();
    for (;;) {
        if (F.tid == 0) F.MISC[3] = atomicAdd(F.ctl + CW_Q, 1u);
        __syncthreads();
        const int bt = (int)F.MISC[3];
        __syncthreads();
        if (bt >= NBATCH) break;
        for (int i = 0; i < 8; ++i) moe_weight_item(F, bt * 64 + F.wave * 8 + i, scr);
    }
}

__device__ __forceinline__ void p1_norm1(Frame& F) {
    LAS float* sBA = (LAS float*)F.lds;
    for (int i = F.tid; i < 16 * D; i += 512) { const int k = i >> 4, o = i & 15; sBA[o * D + k] = F.w_in[(size_t)k * IN_TOTAL + 4096 + o]; }
    __syncthreads();
    const int gw = blockIdx.x * NWAVES + F.wave, RPW = M / (F.G * NWAVES);
    bf16* H = (bf16*)F.out; float* BG = (float*)(F.ws + WS_BG);
    f32x4 gsc[4], gsh[4];
    { const int b = (gw * RPW) / T;
#pragma unroll
      for (int j = 0; j < 4; ++j) { const int col = 256 * j + 4 * F.lane; const f32x4 g1 = *(const f32x4*)(F.norm1_g + col);
          gsc[j] = g1 * (1.0f + *(const f32x4*)((const float*)(F.ws + CTL_MODACC) + b * 6144 + D + col)); gsh[j] = *(const f32x4*)((const float*)(F.ws + CTL_MODACC) + b * 6144 + col); } }
    for (int m = gw * RPW; m < (gw + 1) * RPW; ++m) {
        const f32x4* xr = (const f32x4*)(F.x + (size_t)m * D) + F.lane;
        f32x4 v[4]; float s = 0.f;
#pragma unroll
        for (int j = 0; j < 4; ++j) { v[j] = xr[64 * j]; s += (v[j].x * v[j].x + v[j].y * v[j].y) + (v[j].z * v[j].z + v[j].w * v[j].w); }
        const float rstd = __frsqrt_rn(wave_sum(s) * (1.f / D) + EPS);
        f32x4 hv[4];
#pragma unroll
        for (int j = 0; j < 4; ++j) { const int col = 256 * j + 4 * F.lane;
            hv[j] = v[j] * rstd * gsc[j] + gsh[j];
            *(v2u*)(H + (size_t)m * D + col) = (v2u){pk2(hv[j][0], hv[j][1]), pk2(hv[j][2], hv[j][3])};
        }
        float lg[16];
#pragma unroll
        for (int o = 0; o < 16; ++o) { float p = 0.f;
#pragma unroll
            for (int j = 0; j < 4; ++j) { const f32x4 w = *(const LAS f32x4*)(sBA + o * D + 256 * j + 4 * F.lane); p += (hv[j][0] * w[0] + hv[j][1] * w[1]) + (hv[j][2] * w[2] + hv[j][3] * w[3]); }
            lg[o] = p; if ((o & 3) == 3) __builtin_amdgcn_sched_barrier(0); }
        fold_step<16, 16>(lg, 32, (F.lane & 32) != 0); fold_step<8, 16>(lg, 16, (F.lane & 16) != 0); fold_step<4, 16>(lg, 8, (F.lane & 8) != 0); fold_step<2, 16>(lg, 4, (F.lane & 4) != 0);
        float val = lg[0]; val += __shfl_xor(val, 2); val += __shfl_xor(val, 1);
        const int oidx = ((F.lane >> 5) & 1) * 8 + ((F.lane >> 4) & 1) * 4 + ((F.lane >> 3) & 1) * 2 + ((F.lane >> 2) & 1);
        if ((F.lane & 3) == 0) {
            float r;
            if (oidx < 8) r = sigmoidf_(val);
            else { const int hh = oidx - 8; const float xx = val + F.dt_bias[hh]; const float sp = xx > 20.f ? xx : log1pf(__expf(xx)); r = -__expf(F.a_log[hh]) * sp; }
            BG[(size_t)m * 16 + oidx] = r;
        }
    }
}

__device__ __forceinline__ void p3a_ybp(Frame& F) {
    const bf16* SB = (const bf16*)(F.ws + WS_SB); const bf16* P = (const bf16*)(F.ws + WS_P); bf16* YBP = (bf16*)F.out + (size_t)M * D;
    const size_t total = (size_t)M * (D / 8);
    for (size_t i = (size_t)blockIdx.x * 512 + F.tid; i < total; i += (size_t)F.G * 512) {
        const int m = (int)(i >> 7), c8 = (int)(i & 127) * 8, t = m % T;
        f32x4 a0 = {0.f, 0.f, 0.f, 0.f}, a1 = a0;
#pragma unroll
        for (int j = 0; j < 3; ++j) { const int tt = t - 2 + j;
            if (tt >= 0) { f32x4 p0, p1; unpack8(*(const v4u*)(P + (size_t)(m - 2 + j) * D + c8), p0, p1);
                a0 += *(const f32x4*)(F.conv_sc_w + j * D + c8) * p0; a1 += *(const f32x4*)(F.conv_sc_w + j * D + c8 + 4) * p1; } }
        f32x4 s0, s1; unpack8(*(const v4u*)(SB + (size_t)m * D + c8), s0, s1);
        *(v4u*)(YBP + (size_t)m * D + c8) = pack8(s0 * a0, s1 * a1);
    }
}

__device__ __forceinline__ void p3b_chunk(Frame& F, int unit) {
    const int n = unit % NCH, bh = unit / NCH, h = bh % NH, b = bh / NH, t0 = n * CH, row0 = b * T + t0;
    LAS float* sq = (LAS float*)F.lds; LAS float* sk = sq + 64 * 129; LAS float* sv = sk + 64 * 129; LAS float* sA = sv + 64 * 129; LAS float* sT = sA + 64 * 65;
    LAS float* sgc = sT + 64 * 65; LAS float* sbeta = sgc + 64;
    const bf16* QKV = (const bf16*)(F.ws + WS_QKV); const float* BG = (const float*)(F.ws + WS_BG);
    for (int idx = F.tid; idx < 3 * 64 * 128; idx += 512) {
        const int sec = idx >> 13, r = (idx >> 7) & 63, c = idx & 127, gcol = sec * 1024 + h * 128 + c;
        float a = 0.f;
#pragma unroll
        for (int j = 0; j < 4; ++j) { const int tt = t0 + r - 3 + j; if (tt >= 0) a += F.conv_qkv_w[j * NQKV + gcol] * bf2f(QKV[(size_t)(b * T + tt) * NQKV + gcol]); }
        sq[sec * (64 * 129) + r * 129 + c] = siluf_(a);
    }
    if (F.tid < 64) { sgc[F.tid] = BG[(size_t)(row0 + F.tid) * 16 + 8 + h]; sbeta[F.tid] = BG[(size_t)(row0 + F.tid) * 16 + h]; }
    __syncthreads();
    for (int r = F.wave * 8; r < F.wave * 8 + 8; ++r) {
        const float q0 = sq[r * 129 + F.lane], q1 = sq[r * 129 + 64 + F.lane], k0 = sk[r * 129 + F.lane], k1 = sk[r * 129 + 64 + F.lane];
        const float qs = __frsqrt_rn(wave_sum(q0 * q0 + q1 * q1) + EPS) * 0.08838834764831845f, ks = __frsqrt_rn(wave_sum(k0 * k0 + k1 * k1) + EPS);
        sq[r * 129 + F.lane] = q0 * qs; sq[r * 129 + 64 + F.lane] = q1 * qs; sk[r * 129 + F.lane] = k0 * ks; sk[r * 129 + 64 + F.lane] = k1 * ks;
    }
    if (F.tid == 0) { float a = 0.f; for (int i = 0; i < 64; ++i) { a += sgc[i]; sgc[i] = a; } }
    __syncthreads();
    bf16* INo = (bf16*)(F.ws + WS_IN) + (size_t)unit * 4096;
    for (int idx = F.tid; idx < 4096; idx += 512) {
        const int i = idx >> 6, j = idx & 63; float av = 0.f, iv = 0.f;
        if (j <= i) { float dkk = 0.f, dqk = 0.f;
            for (int d = 0; d < 128; ++d) { const float kj = sk[j * 129 + d]; dkk += sk[i * 129 + d] * kj; dqk += sq[i * 129 + d] * kj; }
            const float dec = __expf(sgc[i] - sgc[j]); iv = dqk * dec; av = (j < i) ? sbeta[i] * dkk * dec : 0.f; }
        sA[i * 65 + j] = av; INo[idx] = (bf16)f2bf(iv);
    }
    __syncthreads();
    if (F.tid < 64) { const int c = F.tid;
        for (int i = 0; i < 64; ++i) { float t = 0.f;
            for (int j = 0; j < i; ++j) t -= sA[i * 65 + j] * sT[j * 65 + c];
            sT[i * 65 + c] = (i == c) ? 1.0f : ((i < c) ? 0.f : t); } }
    __syncthreads();
    bf16* UTo = (bf16*)(F.ws + WS_UT) + (size_t)unit * 8192; bf16* Wo = (bf16*)(F.ws + WS_W) + (size_t)unit * 8192;
    bf16* QDo = (bf16*)(F.ws + WS_QD) + (size_t)unit * 8192; bf16* KDTo = (bf16*)(F.ws + WS_KDT) + (size_t)unit * 8192;
    const float glast = sgc[63];
    for (int idx = F.tid; idx < 8192; idx += 512) {
        { const int dv = idx >> 6, i = idx & 63; float u = 0.f;
          for (int j = 0; j <= i; ++j) u += sT[i * 65 + j] * sbeta[j] * sv[j * 129 + dv];
          UTo[idx] = (bf16)f2bf(u);
          KDTo[idx] = (bf16)f2bf(sk[i * 129 + dv] * __expf(glast - sgc[i])); }
        { const int i = idx >> 7, dk = idx & 127; float w = 0.f;
          for (int j = 0; j <= i; ++j) w += sT[i * 65 + j] * sbeta[j] * __expf(sgc[j]) * sk[j * 129 + dk];
          Wo[idx] = (bf16)f2bf(w);
          QDo[idx] = (bf16)f2bf(sq[i * 129 + dk] * __expf(sgc[i])); }
    }
    if (F.tid == 0) ((float*)(F.ws + WS_DEC))[unit] = __expf(glast);
    __syncthreads();
}

__device__ __forceinline__ void p4_scan(Frame& F, int item) {
    const int bh = item >> 2, sl = item & 3, h = bh % NH, b = bh / NH;
    LAS float* sS = (LAS float*)F.lds;
    LAS float* sV = sS + 128 * 33;
    LAS bf16* sW = (LAS bf16*)(sV + 64 * 33);
    LAS bf16* sQ = sW + 64 * 136;
    LAS bf16* sK = sQ + 64 * 136;
    LAS bf16* sI = sK + 128 * 72;
    for (int i = F.tid; i < 128 * 33; i += 512) sS[i] = 0.f;
    bf16* OR = (bf16*)((unsigned char*)F.out + OUT_OR); float* SSQ = (float*)(F.ws + CTL_SSQ);
    const int c = F.tid >> 3, d4 = (F.tid & 7) * 4, dk2 = F.tid >> 2, d8 = (F.tid & 3) * 8;
    for (int n = 0; n < NCH; ++n) {
        const int unit = bh * NCH + n;
        const bf16* Wg = (const bf16*)(F.ws + WS_W) + (size_t)unit * 8192; const bf16* Qg = (const bf16*)(F.ws + WS_QD) + (size_t)unit * 8192;
        const bf16* Kg = (const bf16*)(F.ws + WS_KDT) + (size_t)unit * 8192; const bf16* Ig = (const bf16*)(F.ws + WS_IN) + (size_t)unit * 4096;
        const bf16* Ug = (const bf16*)(F.ws + WS_UT) + (size_t)unit * 8192;
        __syncthreads();
        for (int i = F.tid; i < 1024; i += 512) { const int r = i >> 4, c8 = (i & 15) * 8;
            *(LAS v4u*)(sW + r * 136 + c8) = *(const v4u*)(Wg + r * 128 + c8); *(LAS v4u*)(sQ + r * 136 + c8) = *(const v4u*)(Qg + r * 128 + c8); }
        for (int i = F.tid; i < 1024; i += 512) { const int r = i >> 3, c8 = (i & 7) * 8; *(LAS v4u*)(sK + r * 72 + c8) = *(const v4u*)(Kg + r * 64 + c8); }
        { const int r = F.tid >> 3, c8 = (F.tid & 7) * 8; *(LAS v4u*)(sI + r * 72 + c8) = *(const v4u*)(Ig + r * 64 + c8); }
        const float dec = ((const float*)(F.ws + WS_DEC))[unit];
        __syncthreads();
        float pS[4] = {0.f, 0.f, 0.f, 0.f}, qS[4] = {0.f, 0.f, 0.f, 0.f};
        for (int dk = 0; dk < 128; ++dk) { const float wv = bf2f(sW[c * 136 + dk]), qv = bf2f(sQ[c * 136 + dk]);
#pragma unroll
            for (int e = 0; e < 4; ++e) { const float s = sS[dk * 33 + d4 + e]; pS[e] += wv * s; qS[e] += qv * s; } }
        float vn[4];
#pragma unroll
        for (int e = 0; e < 4; ++e) { vn[e] = bf2f(Ug[(sl * 32 + d4 + e) * 64 + c]) - pS[e]; sV[c * 33 + d4 + e] = vn[e]; }
        __syncthreads();
        float o[4] = {qS[0], qS[1], qS[2], qS[3]};
        for (int j = 0; j < 64; ++j) { const float iv = bf2f(sI[c * 72 + j]);
#pragma unroll
            for (int e = 0; e < 4; ++e) o[e] += iv * sV[j * 33 + d4 + e]; }
        const int row = b * T + n * CH + c;
        *(v2u*)(OR + (size_t)row * D + h * 128 + sl * 32 + d4) = (v2u){pk2(o[0], o[1]), pk2(o[2], o[3])};
        float ss = (o[0] * o[0] + o[1] * o[1]) + (o[2] * o[2] + o[3] * o[3]);
        ss += __shfl_xor(ss, 1); ss += __shfl_xor(ss, 2); ss += __shfl_xor(ss, 4);
        if ((F.tid & 7) == 0) atomicAdd(SSQ + (size_t)row * 8 + h, ss);
        float sn[8];
#pragma unroll
        for (int e = 0; e < 8; ++e) sn[e] = dec * sS[dk2 * 33 + d8 + e];
        for (int cc = 0; cc < 64; ++cc) { const float kv = bf2f(sK[dk2 * 72 + cc]);
#pragma unroll
            for (int e = 0; e < 8; ++e) sn[e] += kv * sV[cc * 33 + d8 + e]; }
        __syncthreads();
#pragma unroll
        for (int e = 0; e < 8; ++e) sS[dk2 * 33 + d8 + e] = sn[e];
    }
    __syncthreads();
}


typedef pg8::bf16x8 bx8;
#define MFMA16(a, b, c) __builtin_amdgcn_mfma_f32_16x16x32_bf16(a, b, c, 0, 0, 0)
__device__ __forceinline__ v2u pack4(const f32x4 a) { v2u r; r.x = cvt_pk_bf16(a[0], a[1]); r.y = cvt_pk_bf16(a[2], a[3]); return r; }
__device__ __forceinline__ void p4_scan_fast(Frame& F, int bh) {
    const int h = bh % NH, b = bh / NH, w = F.wave, l15 = F.lane & 15, lq = F.lane >> 4, ct = w >> 1, dvh = w & 1;
    LAS bf16* sST = (LAS bf16*)F.lds;
    LAS bf16* sVT = sST + 128 * 136;
    LAS float* sSS = (LAS float*)(sVT + 128 * 72);
    LAS float* sDEC = sSS + 128;
    if (F.tid < NCH) sDEC[F.tid] = ((const float*)(F.ws + WS_DEC))[bh * NCH + F.tid];
    for (int i = F.tid; i < 128 * 136 / 2; i += 512) ((LAS unsigned*)sST)[i] = 0u;
    const bf16* Wg = (const bf16*)(F.ws + WS_W) + (size_t)bh * NCH * 8192 + (16 * ct + l15) * 128 + 8 * lq;
    const bf16* Qg = (const bf16*)(F.ws + WS_QD) + (size_t)bh * NCH * 8192 + (16 * ct + l15) * 128 + 8 * lq;
    const bf16* Ig = (const bf16*)(F.ws + WS_IN) + (size_t)bh * NCH * 4096 + (16 * ct + l15) * 64 + 8 * lq;
    const bf16* Kg = (const bf16*)(F.ws + WS_KDT) + (size_t)bh * NCH * 8192 + (16 * w + l15) * 64 + 8 * lq;
    const bf16* Ug = (const bf16*)(F.ws + WS_UT) + (size_t)bh * NCH * 8192 + (16 * 4 * dvh + l15) * 64 + 16 * ct + 4 * lq;
    bf16* OR = (bf16*)((unsigned char*)F.out + OUT_OR);
    bx8 fW[4], fQ[4], fI[2], fK[2]; v2u fU[4];
#pragma unroll
    for (int ks = 0; ks < 4; ++ks) { fW[ks] = *(const bx8*)(Wg + 32 * ks); fQ[ks] = *(const bx8*)(Qg + 32 * ks); fU[ks] = *(const v2u*)(Ug + ks * 16 * 64); }
#pragma unroll
    for (int ks = 0; ks < 2; ++ks) { fI[ks] = *(const bx8*)(Ig + 32 * ks); fK[ks] = *(const bx8*)(Kg + 32 * ks); }
    f32x4 S[8], gn[4];
#pragma unroll
    for (int t = 0; t < 8; ++t) S[t] = (f32x4){0.f, 0.f, 0.f, 0.f};
#pragma unroll
    for (int t = 0; t < 4; ++t) gn[t] = *(const f32x4*)(F.onorm_g + 16 * (4 * dvh + t) + 4 * lq);
    __syncthreads();
    for (int n = 0; n < NCH; ++n) {
        const float dec = sDEC[n];
        const int nn = (n + 1 < NCH) ? 1 : 0;
        f32x4 pS[4], qS[4];
#pragma unroll
        for (int t = 0; t < 4; ++t) { bx8 fS[4];
#pragma unroll
            for (int ks = 0; ks < 4; ++ks) fS[ks] = *(const LAS bx8*)(sST + (16 * (4 * dvh + t) + l15) * 136 + 32 * ks + 8 * lq);
            f32x4 p = {0.f, 0.f, 0.f, 0.f}, q = {0.f, 0.f, 0.f, 0.f};
#pragma unroll
            for (int ks = 0; ks < 4; ++ks) { p = MFMA16(fW[ks], fS[ks], p); q = MFMA16(fS[ks], fQ[ks], q); }
            pS[t] = p; qS[t] = q; }
#pragma unroll
        for (int t = 0; t < 4; ++t) { const f32x4 u = {bflo(fU[t].x), bfhi(fU[t].x), bflo(fU[t].y), bfhi(fU[t].y)};
            *(LAS v2u*)(sVT + (16 * (4 * dvh + t) + l15) * 72 + 16 * ct + 4 * lq) = pack4(u - pS[t]); }
        Wg += nn * 8192; Qg += nn * 8192; Ug += nn * 8192;
#pragma unroll
        for (int ks = 0; ks < 4; ++ks) { fW[ks] = *(const bx8*)(Wg + 32 * ks); fQ[ks] = *(const bx8*)(Qg + 32 * ks); fU[ks] = *(const v2u*)(Ug + ks * 16 * 64); }
        __syncthreads();
        float ss = 0.f;
#pragma unroll
        for (int t = 0; t < 4; ++t) {
#pragma unroll
            for (int ks = 0; ks < 2; ++ks) { const bx8 fV = *(const LAS bx8*)(sVT + (16 * (4 * dvh + t) + l15) * 72 + 32 * ks + 8 * lq); qS[t] = MFMA16(fV, fI[ks], qS[t]); }
            ss += (qS[t][0] * qS[t][0] + qS[t][1] * qS[t][1]) + (qS[t][2] * qS[t][2] + qS[t][3] * qS[t][3]); }
        ss += __shfl_xor(ss, 16); ss += __shfl_xor(ss, 32);
        if (lq == 0) sSS[dvh * 64 + 16 * ct + l15] = ss;
        Ig += nn * 4096;
#pragma unroll
        for (int ks = 0; ks < 2; ++ks) fI[ks] = *(const bx8*)(Ig + 32 * ks);
#pragma unroll
        for (int t = 0; t < 8; ++t) { S[t] = S[t] * dec;
#pragma unroll
            for (int ks = 0; ks < 2; ++ks) { const bx8 fV = *(const LAS bx8*)(sVT + (16 * t + l15) * 72 + 32 * ks + 8 * lq); S[t] = MFMA16(fK[ks], fV, S[t]); }
            *(LAS v2u*)(sST + (16 * t + l15) * 136 + 16 * w + 4 * lq) = pack4(S[t]); }
        Kg += nn * 8192;
#pragma unroll
        for (int ks = 0; ks < 2; ++ks) fK[ks] = *(const bx8*)(Kg + 32 * ks);
        __syncthreads();
        const float rstd = __frsqrt_rn((sSS[16 * ct + l15] + sSS[64 + 16 * ct + l15]) * (1.0f / 128.0f) + EPS);
        bf16* orow = OR + (size_t)(b * T + n * CH + 16 * ct + l15) * D + h * 128 + 16 * 4 * dvh + 4 * lq;
#pragma unroll
        for (int t = 0; t < 4; ++t) *(v2u*)(orow + 16 * t) = pack4(qS[t] * rstd * gn[t]);
    }
    __syncthreads();
}


#define MFMA_F32(a, b, c) __builtin_amdgcn_mfma_f32_16x16x4f32(a, b, c, 0, 0, 0)
__device__ __forceinline__ void solve_block(LAS float* sA, LAS float* sT, int bi, int bj, int l15, int lq) {
    f32x4 y = {0.f, 0.f, 0.f, 0.f};
    for (int km = bj; km < bi; ++km)
#pragma unroll
        for (int kb = 0; kb < 4; ++kb) y = MFMA_F32(sA[(16 * bi + l15) * 68 + 16 * km + 4 * kb + lq], sT[(16 * km + 4 * kb + lq) * 68 + 16 * bj + l15], y);
    f32x4 z = {0.f, 0.f, 0.f, 0.f};
#pragma unroll
    for (int e = 0; e < 4; ++e) z = MFMA_F32(sT[(16 * bi + l15) * 68 + 16 * bi + 4 * lq + e], y[e], z);
#pragma unroll
    for (int e = 0; e < 4; ++e) sT[(16 * bi + 4 * lq + e) * 68 + 16 * bj + l15] = -z[e];
}
__device__ __forceinline__ void p3b_loop(Frame& F) {
    const int tid = F.tid, w = F.wave, lane = F.lane, l15 = lane & 15, lq = lane >> 4;
    LAS bf16* sQ = (LAS bf16*)F.lds; LAS bf16* sK = sQ + 64 * 136; LAS bf16* sKG0 = sK + 64 * 136; LAS bf16* sVB0 = sKG0 + 2 * 128 * 72;
    LAS float* sA = (LAS float*)(sVB0 + 2 * 128 * 72); LAS float* sT = sA + 64 * 68; LAS bf16* sTb = (LAS bf16*)(sT + 64 * 68); LAS float* sgc0 = (LAS float*)(sTb + 64 * 72);
    const bf16* QKV = (const bf16*)(F.ws + WS_QKV); const float* BG = (const float*)(F.ws + WS_BG);
    const int sec = w >> 1, rs = (w & 1) * 4 + (lane >> 4), cg = lane & 15, c8 = cg * 8, r0 = 8 * rs;
    const int wswz = (cg & 7), rswz = (2 * w + (l15 >> 3)) & 7;
    v4u raw[11]; f32x4 wt[4][2]; float pg = 0.f, pb = 0.f;
#define P3B_PREFETCH(U) do { const int n_ = (U) % NCH, bh_ = (U) / NCH, h_ = bh_ % NH, b_ = bh_ / NH, t0_ = n_ * CH; \
        pg = BG[(size_t)(b_ * T + t0_ + lane) * 16 + 8 + h_]; pb = BG[(size_t)(b_ * T + t0_ + lane) * 16 + h_]; \
        if (tid < 384) { const int gcol_ = sec * 1024 + h_ * 128 + c8; \
            _Pragma("unroll") for (int i = 0; i < 11; ++i) { const int tt = t0_ + r0 - 3 + i; raw[i] = (tt >= 0) ? *(const v4u*)(QKV + (size_t)(b_ * T + tt) * NQKV + gcol_) : (v4u){0u, 0u, 0u, 0u}; } } } while (0)
#define P3B_CONV(U, BUF) do { \
        int zr = 0; asm volatile("" : "+v"(zr)); \
        const int c8z = c8 + zr, r0z = r0 + zr; \
        LAS bf16* sKG = sKG0 + (BUF) * 128 * 72; LAS bf16* sVB = sVB0 + (BUF) * 128 * 72; LAS float* sgc = sgc0 + (BUF) * 128; \
        bf16* QDo = (bf16*)(F.ws + WS_QD) + (size_t)(U) * 8192; bf16* KDTo = (bf16*)(F.ws + WS_KDT) + (size_t)(U) * 8192; \
        float gcs = pg; \
        _Pragma("unroll") for (int o = 1; o < 64; o <<= 1) { const float t = __shfl_up(gcs, o); if (lane >= o) gcs += t; } \
        const float gl = __shfl(gcs, 63), bts = pb; \
        if (w == 7) { sgc[lane] = gcs; sgc[64 + lane] = bts; if (lane == 0) ((float*)(F.ws + WS_DEC))[(U)] = __expf(gl); } \
        if (tid < 384) { \
            { const int gcol = sec * 1024 + (((U) / NCH) % NH) * 128 + c8; \
              _Pragma("unroll") for (int j = 0; j < 4; ++j) { wt[j][0] = *(const f32x4*)(F.conv_qkv_w + j * NQKV + gcol); wt[j][1] = *(const f32x4*)(F.conv_qkv_w + j * NQKV + gcol + 4); } } \
            const int wb = 8 * (rs ^ wswz) + zr; \
            _Pragma("unroll") for (int g = 0; g < 2; ++g) { \
                float gcr[4], btr[4]; \
                _Pragma("unroll") for (int r = 0; r < 4; ++r) { gcr[r] = __shfl(gcs, r0 + 4 * g + r); btr[r] = __shfl(bts, r0 + 4 * g + r); } \
                f32x4 o0[4], o1[4]; \
                _Pragma("unroll") for (int r = 0; r < 4; ++r) { f32x4 a0 = {0.f, 0.f, 0.f, 0.f}, a1 = a0; \
                    _Pragma("unroll") for (int j = 0; j < 4; ++j) { f32x4 x0, x1; unpack8(raw[4 * g + r + j], x0, x1); a0 += wt[j][0] * x0; a1 += wt[j][1] * x1; } \
                    _Pragma("unroll") for (int e = 0; e < 4; ++e) { a0[e] = siluf_(a0[e]); a1[e] = siluf_(a1[e]); } \
                    float ss = (a0[0] * a0[0] + a0[1] * a0[1]) + (a0[2] * a0[2] + a0[3] * a0[3]) + (a1[0] * a1[0] + a1[1] * a1[1]) + (a1[2] * a1[2] + a1[3] * a1[3]); \
                    ss += __shfl_xor(ss, 1); ss += __shfl_xor(ss, 2); ss += __shfl_xor(ss, 4); ss += __shfl_xor(ss, 8); \
                    const float sc = (sec == 2) ? 1.0f : __frsqrt_rn(ss + EPS) * (sec == 0 ? 0.08838834764831845f : 1.0f); \
                    o0[r] = a0 * sc; o1[r] = a1 * sc; } \
                const int rb = r0z + 4 * g; \
                if (sec == 0) { \
                    _Pragma("unroll") for (int r = 0; r < 4; ++r) { *(LAS v4u*)(sQ + (rb + r) * 136 + c8z) = pack8(o0[r], o1[r]); const float eg = __expf(gcr[r]); \
                        *(v4u*)(QDo + (rb + r) * 128 + c8z) = pack8(o0[r] * eg, o1[r] * eg); } \
                } else if (sec == 1) { \
                    float fk[4], fd[4]; \
                    _Pragma("unroll") for (int r = 0; r < 4; ++r) { *(LAS v4u*)(sK + (rb + r) * 136 + c8z) = pack8(o0[r], o1[r]); fk[r] = btr[r] * __expf(gcr[r]); fd[r] = __expf(gl - gcr[r]); } \
                    _Pragma("unroll") for (int e = 0; e < 4; ++e) { \
                        *(LAS v2u*)(sKG + (c8z + e) * 72 + wb + 4 * g) = pack4((f32x4){o0[0][e] * fk[0], o0[1][e] * fk[1], o0[2][e] * fk[2], o0[3][e] * fk[3]}); \
                        *(v2u*)(KDTo + (c8z + e) * 64 + rb) = pack4((f32x4){o0[0][e] * fd[0], o0[1][e] * fd[1], o0[2][e] * fd[2], o0[3][e] * fd[3]}); \
                        *(LAS v2u*)(sKG + (c8z + 4 + e) * 72 + wb + 4 * g) = pack4((f32x4){o1[0][e] * fk[0], o1[1][e] * fk[1], o1[2][e] * fk[2], o1[3][e] * fk[3]}); \
                        *(v2u*)(KDTo + (c8z + 4 + e) * 64 + rb) = pack4((f32x4){o1[0][e] * fd[0], o1[1][e] * fd[1], o1[2][e] * fd[2], o1[3][e] * fd[3]}); } \
                } else { \
                    _Pragma("unroll") for (int e = 0; e < 4; ++e) { \
                        *(LAS v2u*)(sVB + (c8z + e) * 72 + wb + 4 * g) = pack4((f32x4){o0[0][e] * btr[0], o0[1][e] * btr[1], o0[2][e] * btr[2], o0[3][e] * btr[3]}); \
                        *(LAS v2u*)(sVB + (c8z + 4 + e) * 72 + wb + 4 * g) = pack4((f32x4){o1[0][e] * btr[0], o1[1][e] * btr[1], o1[2][e] * btr[2], o1[3][e] * btr[3]}); } \
                } \
            } \
        } } while (0)
    int unit = blockIdx.x;
    if (unit >= NUNIT) return;
    for (int i = tid; i < 64 * 68; i += 512) sT[i] = 0.f;
    P3B_PREFETCH(unit);
    if (w != 6) P3B_CONV(unit, 0);
    __builtin_amdgcn_sched_barrier(0);
    if (unit + F.G < NUNIT) P3B_PREFETCH(unit + F.G);
    __builtin_amdgcn_sched_barrier(0);
    __syncthreads();
    int buf = 0;
    for (; unit < NUNIT; unit += F.G, buf ^= 1) {
        int zq = 0; asm volatile("" : "+v"(zq));
        const int l15z = l15 + zq;
        bf16* INo = (bf16*)(F.ws + WS_IN) + (size_t)unit * 4096; bf16* UTo = (bf16*)(F.ws + WS_UT) + (size_t)unit * 8192; bf16* Wo = (bf16*)(F.ws + WS_W) + (size_t)unit * 8192;
        LAS bf16* sKGc = sKG0 + buf * 128 * 72; LAS bf16* sVBc = sVB0 + buf * 128 * 72; LAS float* sgc = sgc0 + buf * 128;
        {
            const int jt = w & 3, itp = w >> 2;
            bx8 ak[4];
#pragma unroll
            for (int ks = 0; ks < 4; ++ks) ak[ks] = *(const LAS bx8*)(sK + (16 * jt + l15) * 136 + 32 * ks + 8 * lq);
#pragma unroll
            for (int ii = 0; ii < 2; ++ii) { const int it = 2 * itp + ii, ci = 16 * it + l15z;
                f32x4 xk = {0.f, 0.f, 0.f, 0.f}, xq = xk;
#pragma unroll
                for (int ks = 0; ks < 4; ++ks) { const bx8 bk = *(const LAS bx8*)(sK + ci * 136 + 32 * ks + 8 * lq), bq = *(const LAS bx8*)(sQ + ci * 136 + 32 * ks + 8 * lq);
                    xk = MFMA16(ak[ks], bk, xk); xq = MFMA16(ak[ks], bq, xq); }
                const float gi = sgc[ci], bi = sgc[64 + ci];
                f32x4 av, iv;
#pragma unroll
                for (int e = 0; e < 4; ++e) { const int cj = 16 * jt + 4 * lq + e; const float dec = __expf(gi - sgc[cj]);
                    av[e] = (cj < ci) ? bi * xk[e] * dec : 0.f; iv[e] = (cj <= ci) ? xq[e] * dec : 0.f; }
                *(LAS f32x4*)(sA + ci * 68 + 16 * jt + 4 * lq) = av;
                *(v2u*)(INo + ci * 64 + 16 * jt + 4 * lq) = pack4(iv); }
        }
        __syncthreads();
        if (w == 6) {
            { const int blk = lq, c = l15; float t[16];
#pragma unroll
              for (int i = 0; i < 16; ++i) { float s2 = 0.f;
#pragma unroll
                  for (int jb = 0; jb < (i + 3) / 4; ++jb) { const f32x4 a4 = *(const LAS f32x4*)(sA + (16 * blk + i) * 68 + 16 * blk + 4 * jb);
#pragma unroll
                      for (int e = 0; e < 4; ++e) if (4 * jb + e < i) s2 -= a4[e] * t[4 * jb + e]; }
                  t[i] = (i == c) ? 1.0f : s2;
                  sT[(16 * blk + i) * 68 + 16 * blk + c] = t[i];
                  if ((i & 3) == 3) __builtin_amdgcn_sched_barrier(0); } }
            solve_block(sA, sT, 1, 0, l15, lq); solve_block(sA, sT, 2, 1, l15, lq); solve_block(sA, sT, 3, 2, l15, lq);
            solve_block(sA, sT, 2, 0, l15, lq); solve_block(sA, sT, 3, 1, l15, lq);
            solve_block(sA, sT, 3, 0, l15, lq);
#pragma unroll
            for (int q = 0; q < 8; ++q) { const int i = 8 * q + (lane >> 3), j8 = (lane & 7) * 8;
                *(LAS v4u*)(sTb + i * 72 + j8) = pack8(*(const LAS f32x4*)(sT + i * 68 + j8), *(const LAS f32x4*)(sT + i * 68 + j8 + 4)); }
        } else if (unit + F.G < NUNIT) {
            P3B_CONV(unit + F.G, buf ^ 1);
            __builtin_amdgcn_sched_barrier(0);
            if (unit + 2 * F.G < NUNIT) P3B_PREFETCH(unit + 2 * F.G);
            __builtin_amdgcn_sched_barrier(0);
        }
        __syncthreads();
        {
            bx8 bv[2], ag[2];
#pragma unroll
            for (int ks = 0; ks < 2; ++ks) { const int cb = 8 * ((4 * ks + lq) ^ rswz);
                bv[ks] = *(const LAS bx8*)(sVBc + (16 * w + l15) * 72 + cb); ag[ks] = *(const LAS bx8*)(sKGc + (16 * w + l15) * 72 + cb); }
#pragma unroll
            for (int it = 0; it < 4; ++it) { f32x4 u = {0.f, 0.f, 0.f, 0.f}, ww = u;
#pragma unroll
                for (int ks = 0; ks < 2; ++ks) { const bx8 ft = *(const LAS bx8*)(sTb + (16 * it + l15) * 72 + 32 * ks + 8 * lq); u = MFMA16(ft, bv[ks], u); ww = MFMA16(ag[ks], ft, ww); }
                *(v2u*)(UTo + (16 * w + l15z) * 64 + 16 * it + 4 * lq) = pack4(u);
                *(v2u*)(Wo + (16 * it + l15z) * 128 + 16 * w + 4 * lq) = pack4(ww); }
        }
    }
    __syncthreads();
#undef P3B_PREFETCH
#undef P3B_CONV
}

__device__ __forceinline__ void p4a_seg(Frame& F, int seg) {
    const int w = F.wave, l15 = F.lane & 15, lq = F.lane >> 4, ct = w >> 1, ch = w & 1;
    const int bh = seg >> 4, g = seg & 15, unit0 = bh * NCH + 8 * g;
    LAS bf16* sST = (LAS bf16*)F.lds;
    LAS bf16* sVT = sST + 256 * 136;
    LAS float* sDEC = (LAS float*)(sVT + 256 * 72);
    if (F.tid < 8) sDEC[F.tid] = ((const float*)(F.ws + WS_DEC))[unit0 + F.tid];
    for (int i = F.tid; i < 256 * 136 / 2; i += 512) ((LAS unsigned*)sST)[i] = 0u;
    __syncthreads();
    if (F.tid < 128) sST[F.tid * 136 + F.tid] = (bf16)0x3F80;
    f32x4 ST[16];
#pragma unroll
    for (int t = 0; t < 16; ++t)
#pragma unroll
        for (int e = 0; e < 4; ++e) ST[t][e] = (t == w && l15 == 4 * lq + e) ? 1.0f : 0.0f;
    const bf16* Wg = (const bf16*)(F.ws + WS_W) + (size_t)unit0 * 8192 + (16 * ct + l15) * 128 + 8 * lq;
    const bf16* Kg = (const bf16*)(F.ws + WS_KDT) + (size_t)unit0 * 8192 + (16 * w + l15) * 64 + 8 * lq;
    const bf16* Ug = (const bf16*)(F.ws + WS_UT) + (size_t)unit0 * 8192 + l15 * 64 + 16 * ct + 4 * lq;
    bx8 fW[4], fK[2]; v2u fU[8];
#pragma unroll
    for (int ks = 0; ks < 4; ++ks) fW[ks] = *(const bx8*)(Wg + 32 * ks);
#pragma unroll
    for (int ks = 0; ks < 2; ++ks) fK[ks] = *(const bx8*)(Kg + 32 * ks);
#pragma unroll
    for (int t = 0; t < 8; ++t) fU[t] = ch ? *(const v2u*)(Ug + t * 16 * 64) : (v2u){0u, 0u};
    __syncthreads();
    for (int sI = 0; sI < 8; ++sI) {
        const float dec = sDEC[sI];
        const int nn = (sI < 7) ? 1 : 0;
#pragma unroll
        for (int t = 0; t < 8; ++t) { const int Tc = 8 * ch + t; f32x4 p = {0.f, 0.f, 0.f, 0.f};
#pragma unroll
            for (int ks = 0; ks < 4; ++ks) { const bx8 fS = *(const LAS bx8*)(sST + (16 * Tc + l15) * 136 + 32 * ks + 8 * lq); p = MFMA16(fW[ks], fS, p); }
            const f32x4 u = {bflo(fU[t].x), bfhi(fU[t].x), bflo(fU[t].y), bfhi(fU[t].y)};
            *(LAS v2u*)(sVT + (16 * Tc + l15) * 72 + 16 * ct + 4 * lq) = pack4(u - p); }
        Wg += nn * 8192; Ug += nn * 8192;
#pragma unroll
        for (int ks = 0; ks < 4; ++ks) fW[ks] = *(const bx8*)(Wg + 32 * ks);
#pragma unroll
        for (int t = 0; t < 8; ++t) fU[t] = ch ? *(const v2u*)(Ug + t * 16 * 64) : (v2u){0u, 0u};
        __syncthreads();
#pragma unroll
        for (int t = 0; t < 16; ++t) { ST[t] = ST[t] * dec;
#pragma unroll
            for (int ks = 0; ks < 2; ++ks) { const bx8 fV = *(const LAS bx8*)(sVT + (16 * t + l15) * 72 + 32 * ks + 8 * lq); ST[t] = MFMA16(fK[ks], fV, ST[t]); }
            *(LAS v2u*)(sST + (16 * t + l15) * 136 + 16 * w + 4 * lq) = pack4(ST[t]); }
        Kg += nn * 8192;
#pragma unroll
        for (int ks = 0; ks < 2; ++ks) fK[ks] = *(const bx8*)(Kg + 32 * ks);
        __syncthreads();
    }
    bf16* PHI = (bf16*)(F.ws + WS_PHI) + (size_t)seg * 16384;
#pragma unroll
    for (int t = 0; t < 8; ++t)
#pragma unroll
        for (int e = 0; e < 4; ++e) PHI[(16 * w + 4 * lq + e) * 128 + 16 * t + l15] = (bf16)f2bf(ST[t][e]);
    f32x4* LS = (f32x4*)(F.ws + WS_LSEG) + ((size_t)(seg * 8 + w) * 8) * 64 + F.lane;
#pragma unroll
    for (int t = 0; t < 8; ++t) LS[t * 64] = ST[8 + t];
}
__device__ __forceinline__ void p4b_fold(Frame& F, int item) {
    const int w = F.wave, l15 = F.lane & 15, lq = F.lane >> 4, bh = item >> 2, dvs = item & 3;
    LAS bf16* sS = (LAS bf16*)F.lds;
    for (int i = F.tid; i < 32 * 136 / 2; i += 512) ((LAS unsigned*)sS)[i] = 0u;
    const bf16* Pg = (const bf16*)(F.ws + WS_PHI) + (size_t)(bh * 16) * 16384 + (16 * w + l15) * 128 + 8 * lq;
    const f32x4* Lg = (const f32x4*)(F.ws + WS_LSEG) + ((size_t)(bh * 16 * 8 + w) * 8 + 2 * dvs) * 64 + F.lane;
    f32x4* So = (f32x4*)(F.ws + WS_LSEG) + ((size_t)(bh * 16 * 8 + w) * 8 + 2 * dvs) * 64 + F.lane;
    bx8 fP[4]; f32x4 L[2];
#pragma unroll
    for (int ks = 0; ks < 4; ++ks) fP[ks] = *(const bx8*)(Pg + 32 * ks);
    L[0] = Lg[0]; L[1] = Lg[64];
    __syncthreads();
    for (int g = 0; g < 15; ++g) {
        f32x4 Sn[2];
#pragma unroll
        for (int t = 0; t < 2; ++t) { f32x4 acc = L[t];
#pragma unroll
            for (int ks = 0; ks < 4; ++ks) { const bx8 fS = *(const LAS bx8*)(sS + (16 * t + l15) * 136 + 32 * ks + 8 * lq); acc = MFMA16(fP[ks], fS, acc); }
            Sn[t] = acc; }
        const int nn = (g < 14) ? 1 : 0;
        Pg += nn * 16384; Lg += nn * 8 * 8 * 64;
#pragma unroll
        for (int ks = 0; ks < 4; ++ks) fP[ks] = *(const bx8*)(Pg + 32 * ks);
        L[0] = Lg[0]; L[1] = Lg[64];
        __syncthreads();
#pragma unroll
        for (int t = 0; t < 2; ++t) { *(LAS v2u*)(sS + (16 * t + l15) * 136 + 16 * w + 4 * lq) = pack4(Sn[t]); So[t * 64] = Sn[t]; }
        So += 8 * 8 * 64;
        __syncthreads();
    }
}
__device__ __forceinline__ void p4c_seg(Frame& F, int seg) {
    const int bh = seg >> 4, g = seg & 15, unit0 = bh * NCH + 8 * g;
    const int h = bh % NH, b = bh / NH, w = F.wave, l15 = F.lane & 15, lq = F.lane >> 4, ct = w >> 1, dvh = w & 1;
    LAS bf16* sST = (LAS bf16*)F.lds;
    LAS bf16* sVT = sST + 128 * 136;
    LAS float* sSS = (LAS float*)(sVT + 128 * 72);
    LAS float* sDEC = sSS + 128;
    if (F.tid < 8) sDEC[F.tid] = ((const float*)(F.ws + WS_DEC))[unit0 + F.tid];
    f32x4 S[8], gn[4];
    { const f32x4* Sg = (const f32x4*)(F.ws + WS_LSEG) + ((size_t)((seg - 1) * 8 + w) * 8) * 64 + F.lane;
#pragma unroll
      for (int t = 0; t < 8; ++t) { S[t] = (f32x4){0.f, 0.f, 0.f, 0.f}; if (g != 0) S[t] = Sg[t * 64];
          *(LAS v2u*)(sST + (16 * t + l15) * 136 + 16 * w + 4 * lq) = pack4(S[t]); } }
    const bf16* Wg = (const bf16*)(F.ws + WS_W) + (size_t)unit0 * 8192 + (16 * ct + l15) * 128 + 8 * lq;
    const bf16* Qg = (const bf16*)(F.ws + WS_QD) + (size_t)unit0 * 8192 + (16 * ct + l15) * 128 + 8 * lq;
    const bf16* Ig = (const bf16*)(F.ws + WS_IN) + (size_t)unit0 * 4096 + (16 * ct + l15) * 64 + 8 * lq;
    const bf16* Kg = (const bf16*)(F.ws + WS_KDT) + (size_t)unit0 * 8192 + (16 * w + l15) * 64 + 8 * lq;
    const bf16* Ug = (const bf16*)(F.ws + WS_UT) + (size_t)unit0 * 8192 + (16 * 4 * dvh + l15) * 64 + 16 * ct + 4 * lq;
    bf16* OR = (bf16*)((unsigned char*)F.out + OUT_OR);
    bx8 fW[4], fQ[4], fI[2], fK[2]; v2u fU[4];
#pragma unroll
    for (int ks = 0; ks < 4; ++ks) { fW[ks] = *(const bx8*)(Wg + 32 * ks); fQ[ks] = *(const bx8*)(Qg + 32 * ks); fU[ks] = *(const v2u*)(Ug + ks * 16 * 64); }
#pragma unroll
    for (int ks = 0; ks < 2; ++ks) { fI[ks] = *(const bx8*)(Ig + 32 * ks); fK[ks] = *(const bx8*)(Kg + 32 * ks); }
#pragma unroll
    for (int t = 0; t < 4; ++t) gn[t] = *(const f32x4*)(F.onorm_g + 16 * (4 * dvh + t) + 4 * lq);
    __syncthreads();
    for (int sI = 0; sI < 8; ++sI) {
        const float dec = sDEC[sI];
        const int nn = (sI < 7) ? 1 : 0;
        f32x4 pS[4], qS[4];
#pragma unroll
        for (int t = 0; t < 4; ++t) { bx8 fS[4];
#pragma unroll
            for (int ks = 0; ks < 4; ++ks) fS[ks] = *(const LAS bx8*)(sST + (16 * (4 * dvh + t) + l15) * 136 + 32 * ks + 8 * lq);
            f32x4 p = {0.f, 0.f, 0.f, 0.f}, q = {0.f, 0.f, 0.f, 0.f};
#pragma unroll
            for (int ks = 0; ks < 4; ++ks) { p = MFMA16(fW[ks], fS[ks], p); q = MFMA16(fS[ks], fQ[ks], q); }
            pS[t] = p; qS[t] = q; }
#pragma unroll
        for (int t = 0; t < 4; ++t) { const f32x4 u = {bflo(fU[t].x), bfhi(fU[t].x), bflo(fU[t].y), bfhi(fU[t].y)};
            *(LAS v2u*)(sVT + (16 * (4 * dvh + t) + l15) * 72 + 16 * ct + 4 * lq) = pack4(u - pS[t]); }
        Wg += nn * 8192; Qg += nn * 8192; Ug += nn * 8192;
#pragma unroll
        for (int ks = 0; ks < 4; ++ks) { fW[ks] = *(const bx8*)(Wg + 32 * ks); fQ[ks] = *(const bx8*)(Qg + 32 * ks); fU[ks] = *(const v2u*)(Ug + ks * 16 * 64); }
        __syncthreads();
        float ss = 0.f;
#pragma unroll
        for (int t = 0; t < 4; ++t) {
#pragma unroll
            for (int ks = 0; ks < 2; ++ks) { const bx8 fV = *(const LAS bx8*)(sVT + (16 * (4 * dvh + t) + l15) * 72 + 32 * ks + 8 * lq); qS[t] = MFMA16(fV, fI[ks], qS[t]); }
            ss += (qS[t][0] * qS[t][0] + qS[t][1] * qS[t][1]) + (qS[t][2] * qS[t][2] + qS[t][3] * qS[t][3]); }
        ss += __shfl_xor(ss, 16); ss += __shfl_xor(ss, 32);
        if (lq == 0) sSS[dvh * 64 + 16 * ct + l15] = ss;
        Ig += nn * 4096;
#pragma unroll
        for (int ks = 0; ks < 2; ++ks) fI[ks] = *(const bx8*)(Ig + 32 * ks);
#pragma unroll
        for (int t = 0; t < 8; ++t) { S[t] = S[t] * dec;
#pragma unroll
            for (int ks = 0; ks < 2; ++ks) { const bx8 fV = *(const LAS bx8*)(sVT + (16 * t + l15) * 72 + 32 * ks + 8 * lq); S[t] = MFMA16(fK[ks], fV, S[t]); }
            *(LAS v2u*)(sST + (16 * t + l15) * 136 + 16 * w + 4 * lq) = pack4(S[t]); }
        Kg += nn * 8192;
#pragma unroll
        for (int ks = 0; ks < 2; ++ks) fK[ks] = *(const bx8*)(Kg + 32 * ks);
        __syncthreads();
        const float rstd = __frsqrt_rn((sSS[16 * ct + l15] + sSS[64 + 16 * ct + l15]) * (1.0f / 128.0f) + EPS);
        bf16* orow = OR + (size_t)(b * T + (8 * g + sI) * CH + 16 * ct + l15) * D + h * 128 + 16 * 4 * dvh + 4 * lq;
#pragma unroll
        for (int t = 0; t < 4; ++t) *(v2u*)(orow + 16 * t) = pack4(qS[t] * rstd * gn[t]);
    }
    __syncthreads();
}

__device__ __forceinline__ void p8_router(Frame& F) {
    const int gw = blockIdx.x * NWAVES + F.wave, RPW = M / (F.G * NWAVES);
    bf16* H2 = (bf16*)(F.ws + WS_H2); int* TOKE = (int*)(F.ws + WS_TOKE); float* TOKW = (float*)(F.ws + WS_TOKW);
    LAS float* wT = (LAS float*)F.lds;
    LAS unsigned* hist = (LAS unsigned*)(wT + 36 * 1028);
    for (int i = F.tid; i < D * NGRP; i += 512) wT[(i & 3) * 1028 + (i >> 2)] = F.w_group[i];
    for (int i = F.tid; i < D * NE; i += 512) wT[(4 + (i & 31)) * 1028 + (i >> 5)] = F.w_expert[i];
    if (F.tid < NE) hist[F.tid] = 0u;
    __syncthreads();
    f32x4 gsc[4], gsh[4];
    { const int b = (gw * RPW) / T;
#pragma unroll
      for (int j = 0; j < 4; ++j) { const int col = 256 * j + 4 * F.lane; const f32x4 g2 = *(const f32x4*)(F.norm2_g + col);
          gsc[j] = g2 * (1.0f + *(const f32x4*)((const float*)(F.ws + CTL_MODACC) + b * 6144 + 4 * D + col)); gsh[j] = *(const f32x4*)((const float*)(F.ws + CTL_MODACC) + b * 6144 + 3 * D + col); } }
    for (int m = gw * RPW; m < (gw + 1) * RPW; ++m) {
        const f32x4* xr = (const f32x4*)(F.out + (size_t)m * D) + F.lane;
        f32x4 v[4]; float s = 0.f;
#pragma unroll
        for (int j = 0; j < 4; ++j) { v[j] = xr[64 * j]; s += (v[j].x * v[j].x + v[j].y * v[j].y) + (v[j].z * v[j].z + v[j].w * v[j].w); }
        const float rstd = __frsqrt_rn(wave_sum(s) * (1.f / D) + EPS);
#pragma unroll
        for (int j = 0; j < 4; ++j) { v[j] = v[j] * rstd * gsc[j] + gsh[j];
            *(v2u*)(H2 + (size_t)m * D + 256 * j + 4 * F.lane) = (v2u){pk2(v[j][0], v[j][1]), pk2(v[j][2], v[j][3])}; }
        float gp[4];
#pragma unroll
        for (int q = 0; q < 4; ++q) { float p = 0.f;
#pragma unroll
            for (int j = 0; j < 4; ++j) { const f32x4 w = *(const LAS f32x4*)(wT + q * 1028 + 256 * j + 4 * F.lane); p += (v[j][0] * w[0] + v[j][1] * w[1]) + (v[j][2] * w[2] + v[j][3] * w[3]); }
            gp[q] = p; }
        fold_step<4, 4>(gp, 32, (F.lane & 32) != 0); fold_step<2, 4>(gp, 16, (F.lane & 16) != 0);
        float gv = gp[0]; gv += __shfl_xor(gv, 8); gv += __shfl_xor(gv, 4); gv += __shfl_xor(gv, 2); gv += __shfl_xor(gv, 1);
        float gl[4];
#pragma unroll
        for (int q = 0; q < 4; ++q) gl[q] = readlane_f(gv, 32 * (q >> 1) + 16 * (q & 1)) + F.b_group[q];
        int gs = 0; float gm = gl[0];
#pragma unroll
        for (int q = 1; q < 4; ++q) if (gl[q] > gm) { gm = gl[q]; gs = q; }
        float den = 0.f;
#pragma unroll
        for (int q = 0; q < 4; ++q) den += __expf(gl[q] - gm);
        const float pg = 1.0f / den;
        float ep[8];
#pragma unroll
        for (int q = 0; q < 8; ++q) { float p = 0.f;
#pragma unroll
            for (int j = 0; j < 4; ++j) { const f32x4 w = *(const LAS f32x4*)(wT + (4 + gs * 8 + q) * 1028 + 256 * j + 4 * F.lane); p += (v[j][0] * w[0] + v[j][1] * w[1]) + (v[j][2] * w[2] + v[j][3] * w[3]); }
            ep[q] = p; }
        fold_step<8, 8>(ep, 32, (F.lane & 32) != 0); fold_step<4, 8>(ep, 16, (F.lane & 16) != 0); fold_step<2, 8>(ep, 8, (F.lane & 8) != 0);
        float ev = ep[0]; ev += __shfl_xor(ev, 4); ev += __shfl_xor(ev, 2); ev += __shfl_xor(ev, 1);
        float el[8];
#pragma unroll
        for (int q = 0; q < 8; ++q) el[q] = readlane_f(ev, 32 * (q >> 2) + 16 * ((q >> 1) & 1) + 8 * (q & 1)) + F.b_expert[gs * 8 + q];
        int i0 = 0; float v0 = el[0];
#pragma unroll
        for (int q = 1; q < 8; ++q) if (el[q] > v0) { v0 = el[q]; i0 = q; }
        int i1 = -1; float v1 = -3.0e38f;
#pragma unroll
        for (int q = 0; q < 8; ++q) if (q != i0 && el[q] > v1) { v1 = el[q]; i1 = q; }
        const float e1 = __expf(v1 - v0), sw = 1.0f / (1.0f + e1);
        if (F.lane == 0) {
            const int ea = gs * 8 + i0, eb = gs * 8 + i1;
            TOKE[m * 2] = ea; TOKE[m * 2 + 1] = eb; TOKW[m * 2] = pg * sw; TOKW[m * 2 + 1] = pg * e1 * sw;
            __hip_atomic_fetch_add((unsigned*)(hist + ea), 1u, __ATOMIC_RELAXED, __HIP_MEMORY_SCOPE_WORKGROUP); __hip_atomic_fetch_add((unsigned*)(hist + eb), 1u, __ATOMIC_RELAXED, __HIP_MEMORY_SCOPE_WORKGROUP);
        }
    }
    __syncthreads();
    if (F.tid < NE) ((unsigned*)(F.ws + WS_WGHIST))[blockIdx.x * NE + F.tid] = hist[F.tid];
}
__device__ __forceinline__ int moe_tables(Frame& F) {
    volatile LAS int* ps = (volatile LAS int*)(F.lds + MISC_OFF + 64); volatile LAS int* te = (volatile LAS int*)(F.lds + MISC_OFF + 256);
    volatile LAS int* tot = (volatile LAS int*)(F.lds + MISC_OFF + 1024); volatile LAS int* base = (volatile LAS int*)(F.lds + MISC_OFF + 1152);
    LAS int* part = (LAS int*)(F.lds + MISC_OFF - 4096);
    const unsigned* WGH = (const unsigned*)(F.ws + WS_WGHIST);
    __syncthreads();
    { const int e = F.tid & 31, p = F.tid >> 5; int t = 0, bsum = 0;
      for (int j = p; j < F.G; j += 16) { const int v = (int)WGH[j * NE + e]; t += v; bsum += (j < (int)blockIdx.x) ? v : 0; }
      part[p * 32 + e] = t; part[512 + p * 32 + e] = bsum; }
    __syncthreads();
    if (F.tid < 32) { int t = 0, bsum = 0;
#pragma unroll
        for (int p = 0; p < 16; ++p) { t += part[p * 32 + F.tid]; bsum += part[512 + p * 32 + F.tid]; }
        tot[F.tid] = t; base[F.tid] = bsum; }
    __syncthreads();
    if (F.tid == 0) { int a = 0;
        for (int e = 0; e < NE; ++e) { const int cnt = tot[e]; ps[e] = a; const int nb = (cnt + 255) >> 8;
            for (int r = 0; r < nb; ++r) te[(a >> 8) + r] = e; a += nb << 8; }
        ps[32] = a; }
    __syncthreads();
    return ps[32] >> 8;
}
__device__ __forceinline__ void p9_gather(Frame& F) {
    moe_tables(F);
    volatile LAS int* ps = (volatile LAS int*)(F.lds + MISC_OFF + 64); volatile LAS int* tot = (volatile LAS int*)(F.lds + MISC_OFF + 1024); volatile LAS int* base = (volatile LAS int*)(F.lds + MISC_OFF + 1152);
    LAS unsigned* lcur = (LAS unsigned*)F.lds;
    if (F.tid < NE) lcur[F.tid] = 0u;
    __syncthreads();
    const int gw = blockIdx.x * NWAVES + F.wave, RPW = M / (F.G * NWAVES);
    int* ROWTOK = (int*)(F.ws + WS_ROWTOK); float* ROWW = (float*)(F.ws + WS_ROWW);
    const int* TOKE = (const int*)(F.ws + WS_TOKE); const float* TOKW = (const float*)(F.ws + WS_TOKW);
    const bf16* H2 = (const bf16*)(F.ws + WS_H2); bf16* XS = (bf16*)(F.ws + WS_XS);
    for (int e = blockIdx.x; e < NE; e += F.G) for (int r = ps[e] + tot[e] + F.tid; r < ps[e + 1]; r += 512) ROWTOK[r] = -1;
    for (int m = gw * RPW; m < (gw + 1) * RPW; ++m) {
        int pos = 0;
        if (F.lane < 2) { const int e = TOKE[m * 2 + F.lane]; pos = ps[e] + base[e] + (int)__hip_atomic_fetch_add((unsigned*)(lcur + e), 1u, __ATOMIC_RELAXED, __HIP_MEMORY_SCOPE_WORKGROUP); ROWTOK[pos] = m * 2 + F.lane; ROWW[pos] = TOKW[m * 2 + F.lane]; }
        const int p0 = __shfl(pos, 0), p1 = __shfl(pos, 1);
        const v4u a = *((const v4u*)(H2 + (size_t)m * D) + F.lane), bb = *((const v4u*)(H2 + (size_t)m * D) + 64 + F.lane);
        *((v4u*)(XS + (size_t)p0 * D) + F.lane) = a; *((v4u*)(XS + (size_t)p0 * D) + 64 + F.lane) = bb;
        *((v4u*)(XS + (size_t)p1 * D) + F.lane) = a; *((v4u*)(XS + (size_t)p1 * D) + 64 + F.lane) = bb;
    }
}
__device__ __forceinline__ void p12_final(Frame& F) {
    const int gw = blockIdx.x * NWAVES + F.wave, RPW = M / (F.G * NWAVES);
    const bf16* YBUF = (const bf16*)(F.ws + WS_YBUF);
    f32x4 gt[4], gf[4];
    { const int b = (gw * RPW) / T;
#pragma unroll
      for (int j = 0; j < 4; ++j) { gt[j] = *(const f32x4*)((const float*)(F.ws + CTL_MODACC) + b * 6144 + 5 * D + 256 * j + 4 * F.lane); gf[j] = *(const f32x4*)(F.normf_g + 256 * j + 4 * F.lane); } }
    for (int m = gw * RPW; m < (gw + 1) * RPW; ++m) {
        f32x4* xr = (f32x4*)(F.out + (size_t)m * D) + F.lane;
        f32x4 v[4]; float s = 0.f;
#pragma unroll
        for (int j = 0; j < 4; ++j) { const int col = 256 * j + 4 * F.lane; v[j] = xr[64 * j];
            const v2u y0 = *(const v2u*)(YBUF + (size_t)(2 * m) * D + col), y1 = *(const v2u*)(YBUF + (size_t)(2 * m + 1) * D + col);
            const f32x4 ys = {bflo(y0.x) + bflo(y1.x), bfhi(y0.x) + bfhi(y1.x), bflo(y0.y) + bflo(y1.y), bfhi(y0.y) + bfhi(y1.y)};
            v[j] += gt[j] * ys;
            s += (v[j].x * v[j].x + v[j].y * v[j].y) + (v[j].z * v[j].z + v[j].w * v[j].w); }
        const float rstd = __frsqrt_rn(wave_sum(s) * (1.f / D) + EPS);
#pragma unroll
        for (int j = 0; j < 4; ++j) xr[64 * j] = v[j] * rstd * gf[j];
    }
}

constexpr int NPH = 15;
struct Args { const float* in[23]; float* out; unsigned char* ws; int ph_lo, ph_hi; };
__global__ void __launch_bounds__(NWAVES * 64, 2) fwd(Args args) {
    extern __shared__ __attribute__((aligned(16))) unsigned char lds[];
    Frame F;
    F.lds = (LAS unsigned char*)lds; F.MISC = (volatile LAS unsigned*)(F.lds + MISC_OFF);
    F.tid = threadIdx.x; F.lane = F.tid & 63; F.wave = __builtin_amdgcn_readfirstlane(F.tid >> 6);
    F.G = gridDim.x; { const int bx = blockIdx.x; F.vcu = (F.G % 8 == 0) ? (bx % 8) * (F.G / 8) + bx / 8 : bx; }
    F.ws = args.ws; F.out = args.out; F.ctl = (unsigned*)(args.ws + WS_CTL);
    F.x = args.in[0]; F.c = args.in[1]; F.w_ada = args.in[2]; F.b_ada = args.in[3]; F.norm1_g = args.in[4]; F.w_in = args.in[5]; F.conv_qkv_w = args.in[6];
    F.a_log = args.in[7]; F.dt_bias = args.in[8]; F.onorm_g = args.in[9]; F.w_proj_a = args.in[10]; F.conv_sc_w = args.in[11]; F.w_proj_b = args.in[12]; F.w_out = args.in[13];
    F.norm2_g = args.in[14]; F.w_group = args.in[15]; F.b_group = args.in[16]; F.w_expert = args.in[17]; F.b_expert = args.in[18]; F.w1 = args.in[19]; F.w3 = args.in[20];
    F.w2 = args.in[21]; F.normf_g = args.in[22];
    if (F.tid < 4) F.MISC[F.tid] = 0u;
    __syncthreads();
    const int lo = args.ph_lo, hi = args.ph_hi;
    const bool fused = (hi - lo) > 1;
    XcdBarrier bar; bar.bar = F.ctl + CW_BAR; bar.x = 0; bar.st = F.MISC;
    if (fused) bar = xcd_barrier_post(F.ctl + CW_BAR, F.MISC);
#ifndef PH_MASK
#define PH_MASK 0xFFFFFFFFu
#endif
#define IN(k) (((PH_MASK >> (k)) & 1) && lo <= (k) && (k) < hi)
#define SEAM(k) do { if (IN(k) && IN((k) + 1)) xcd_barrier(bar); } while (0)
    bf16* H = (bf16*)F.out; bf16* YBP = (bf16*)F.out + (size_t)M * D;

    if (IN(0)) { p0_prologue(F); } SEAM(0);
    if (IN(1)) { p1_norm1(F); __syncthreads(); p0_weights(F); } SEAM(1);
    if (IN(2)) {
        pg8::Gemm g{H, (const bf16*)(F.ws + WS_WINA), M, 6144, D}; pg8::StaticOrder S; S.init(M, 6144, F.G, (int)blockIdx.x);
        EpiInA E{(bf16*)(F.ws + WS_QKV), (bf16*)(F.ws + WS_SB), (bf16*)(F.ws + WS_P)};
        pg8::gemm_phase<EpiInA, pg8::StaticOrder, true, true>(F.lds, g, S, E);
    } SEAM(2);
    if (IN(3)) { p3a_ybp(F); p3b_loop(F); } SEAM(3);
    if (IN(4)) {
        pg8::Gemm g{YBP, (const bf16*)(F.ws + WS_WB), M, D, D}; pg8::StaticOrder S; S.init(M, D, F.G, (int)blockIdx.x);
        EpiPlain E{(bf16*)(F.ws + WS_YB), D};
        pg8::gemm_phase<EpiPlain, pg8::StaticOrder, true, true>(F.lds, g, S, E);
        __syncthreads();
        for (int it = blockIdx.x; it < NB * NH * 16; it += F.G) p4a_seg(F, it);
    } SEAM(4);
    if (IN(5)) { for (int it = blockIdx.x; it < NB * NH * 4; it += F.G) p4b_fold(F, it); p_moe_weights(F); } SEAM(5);
    if (IN(6)) { for (int it = blockIdx.x; it < NB * NH * 16; it += F.G) p4c_seg(F, it); } SEAM(6);
    if (IN(7)) {
        pg8::Gemm g{H, (const bf16*)(F.ws + WS_WINB), M, 3072, D}; pg8::StaticOrder S; S.init(M, 3072, F.G, (int)blockIdx.x);
        EpiInB E{F.ws, (long)(((unsigned char*)F.out + OUT_OR) - F.ws)};
        pg8::gemm_phase<EpiInB, pg8::StaticOrder, true, true>(F.lds, g, S, E);
    } SEAM(7);
    if (IN(8)) {
        pg8::Gemm g{(const bf16*)((unsigned char*)F.out + OUT_OR), (const bf16*)(F.ws + WS_WA), M, D, D}; pg8::StaticOrder S; S.init(M, D, F.G, (int)blockIdx.x);
        EpiMerge E{(const bf16*)(F.ws + WS_GA), (const bf16*)(F.ws + WS_GB), (const bf16*)(F.ws + WS_YB), (bf16*)(F.ws + WS_GA)};
        pg8::gemm_phase<EpiMerge, pg8::StaticOrder, true, true>(F.lds, g, S, E);
    } SEAM(8);
    if (IN(9)) {
        pg8::Gemm g{(const bf16*)(F.ws + WS_GA), (const bf16*)(F.ws + WS_WO), M, D, D}; pg8::StaticOrder S; S.init(M, D, F.G, (int)blockIdx.x);
        EpiX1 E{F.x, F.out, (const float*)(F.ws + CTL_MODACC), F.b_ada};
        pg8::gemm_phase<EpiX1, pg8::StaticOrder, true, true>(F.lds, g, S, E);
    } SEAM(9);
    if (IN(10)) { p8_router(F); } SEAM(10);
    if (IN(11)) { p9_gather(F); } SEAM(11);
    if (IN(12)) {
        const int nt = moe_tables(F);
        pg8::Gemm g{(const bf16*)(F.ws + WS_XS), (const bf16*)(F.ws + WS_W13), MOE_CAP, NE * D, D};
        MoeOrder S{nt, F.G, (int)blockIdx.x, (const volatile LAS int*)(F.lds + MISC_OFF + 256)};
        EpiHid E{(bf16*)(F.ws + WS_HID)};
        pg8::gemm_phase<EpiHid, MoeOrder, true, true>(F.lds, g, S, E);
    } SEAM(12);
    if (IN(13)) {
        const int nt = moe_tables(F);
        pg8::Gemm g{(const bf16*)(F.ws + WS_HID), (const bf16*)(F.ws + WS_W2), MOE_CAP, NE * D, DE};
        MoeOrder S{nt, F.G, (int)blockIdx.x, (const volatile LAS int*)(F.lds + MISC_OFF + 256)};
        EpiMoeOut E{(bf16*)(F.ws + WS_YBUF), (const int*)(F.ws + WS_ROWTOK), (const float*)(F.ws + WS_ROWW)};
        pg8::gemm_phase<EpiMoeOut, MoeOrder, true, true>(F.lds, g, S, E);
    } SEAM(13);
    if (IN(14)) { p12_final(F); }
#undef IN
#undef SEAM
}

extern "C" void kernel_launch(void* const* d_in, const int* in_sizes, int n_in, void* d_out, int out_size, void* d_ws, size_t ws_size, hipStream_t stream) {
    static int grid = 0;
    if (grid == 0) {
        if (n_in != 23 || out_size != M * D || ws_size < WS_END) { fprintf(stderr, "kernel_launch: unexpected problem (n_in %d, out %d, ws %zu)\n", n_in, out_size, ws_size); grid = -1; return; }
        int dev = 0, cus = 0, per_cu = 0;
        if (hipGetDevice(&dev) != hipSuccess || hipDeviceGetAttribute(&cus, hipDeviceAttributeMultiprocessorCount, dev) != hipSuccess) { grid = -1; return; }
        if (hipFuncSetAttribute((const void*)fwd, hipFuncAttributeMaxDynamicSharedMemorySize, LDS_BYTES) != hipSuccess) { fprintf(stderr, "kernel_launch: hipFuncSetAttribute failed\n"); grid = -1; return; }
        if (hipOccupancyMaxActiveBlocksPerMultiprocessor(&per_cu, (const void*)fwd, NWAVES * 64, LDS_BYTES) != hipSuccess || per_cu < 1) { fprintf(stderr, "kernel_launch: occupancy query says %d\n", per_cu); }
        (void)hipGetLastError();
        grid = cus;
        if (M % (grid * NWAVES) != 0 || grid < 64) { fprintf(stderr, "kernel_launch: unsupported CU count %d\n", cus); grid = -1; return; }
    }
    if (grid < 0) return;
    (void)hipMemsetAsync((char*)d_ws + WS_CTL, 0, CTL_ZERO_BYTES, stream);
    Args a{};
    for (int i = 0; i < 23; ++i) a.in[i] = (const float*)d_in[i];
    a.out = (float*)d_out; a.ws = (unsigned char*)d_ws;
#ifndef MK_FUSED
#define MK_FUSED 1
#endif
#ifdef PROBE_DUP
    { const int cuts[4] = {0, PROBE_DUP + 1, PROBE_DUP, NPH}; const int ends[3] = {PROBE_DUP + 1, PROBE_DUP + 1, NPH};
      for (int li = 0; li < 3; ++li) { a.ph_lo = (li == 0) ? 0 : (li == 1 ? PROBE_DUP : PROBE_DUP + 1); a.ph_hi = ends[li]; (void)cuts;
          hipMemsetAsync((char*)d_ws + WS_CTL + CW_BAR * 4, 0, XCD_BAR_WORDS * 4, stream);
          if (a.ph_lo < a.ph_hi) hipLaunchKernelGGL(fwd, dim3(grid), dim3(NWAVES * 64), LDS_BYTES, stream, a); } return; }
#endif
    if (MK_FUSED) { a.ph_lo = 0; a.ph_hi = NPH; hipLaunchKernelGGL(fwd, dim3(grid), dim3(NWAVES * 64), LDS_BYTES, stream, a); }
    else for (int p = 0; p < NPH; ++p) { a.ph_lo = p; a.ph_hi = p + 1; hipLaunchKernelGGL(fwd, dim3(grid), dim3(NWAVES * 64), LDS_BYTES, stream, a); }
}
```
